# Optimizing an MI355X kernel written in HIP

```python
import jax
import jax.numpy as jnp
from jax import lax
import numpy as np

D_MODEL = 4096
BATCH = 2
SEQ = 8192
DEPTH = 2

GRID_W = 64
CTX_LEN = 256
N_EVEN = (DEPTH + 1) // 2
N_ODD = DEPTH // 2
N_MOD = 6
W_A = D_MODEL // 2
W_B = D_MODEL // 2
A_CONV = 31
B_CONV = 3
AB_IN = 2 * W_A + 3 * W_B
M_HEADS = 8
M_DQK = D_MODEL // (2 * M_HEADS)
M_DV = D_MODEL // M_HEADS
M_CHUNK = 128
N_DIR = 2
Q_COLS = M_HEADS * M_DQK
V_COLS = M_HEADS * M_DV
G_COLS = N_DIR * 2 * M_HEADS
C_IN = 2 * Q_COLS + 2 * V_COLS + G_COLS
D_FF = 11008
FFN_CONV = 3
EPS = 1e-6

kernel_name = 'hybrid_conformer_shortconv_mlstm_dit'


def rms_norm(x, g):
    xf = x.astype(jnp.float32)
    y = xf * lax.rsqrt(jnp.mean(xf * xf, axis=-1, keepdims=True) + EPS)
    return (y * g).astype(x.dtype)


def layer_norm(x, g, b):
    xf = x.astype(jnp.float32)
    mu = jnp.mean(xf, axis=-1, keepdims=True)
    xc = xf - mu
    y = xc * lax.rsqrt(jnp.mean(xc * xc, axis=-1, keepdims=True) + EPS)
    return (y * g + b).astype(x.dtype)


def modulate(h, shift, scale):
    return h * (1 + scale[:, None, :]) + shift[:, None, :]


def dwconv2d(x4, w):
    return lax.conv_general_dilated(x4, w[:, :, None, :], (1, 1), 'SAME',
                                    dimension_numbers=('NHWC', 'HWIO', 'NHWC'),
                                    feature_group_count=x4.shape[-1])


def conv_grid(x, w, rows, vertical):
    b, s, ch = x.shape
    k = w[:, None, :] if vertical else w[None, :, :]
    return dwconv2d(x.reshape(b, rows, GRID_W, ch), k).reshape(b, s, ch)


def conv_seq(x, w):
    return dwconv2d(x[:, None], w[None])[:, 0]


def mixer_ab(h, w_in, a_conv_w, a_conv_b, a_ln_g, a_ln_b, b_conv_w, w_out, rows):
    a_val, a_gate, b_b, b_c, b_x = jnp.split(
        h @ w_in, [W_A, 2 * W_A, 2 * W_A + W_B, 2 * W_A + 2 * W_B], axis=-1)
    u = a_val * jax.nn.sigmoid(a_gate)
    z = b_c * b_x
    if rows is None:
        u = conv_seq(u, a_conv_w)
        z = conv_seq(z, b_conv_w)
    else:
        u = conv_grid(u, a_conv_w, rows, False)
        z = conv_grid(z, b_conv_w, rows, True)
    u = jax.nn.silu(layer_norm(u + a_conv_b, a_ln_g, a_ln_b))
    return jnp.concatenate([u, b_b * z], axis=-1) @ w_out


def conv_ffn(h, w_up, conv_w, w_down, rows):
    u = h @ w_up
    u = conv_seq(u, conv_w) if rows is None else conv_grid(u, conv_w, rows, False)
    gate, val = jnp.split(u, 2, axis=-1)
    return (jax.nn.silu(gate) * val) @ w_down


def mlstm_project(h, w_in, b_gates):
    b, L, _ = h.shape
    q, k, v, o, g = jnp.split(
        h @ w_in, [Q_COLS, 2 * Q_COLS, 2 * Q_COLS + V_COLS, 2 * Q_COLS + 2 * V_COLS], axis=-1)
    heads = lambda t, d: jnp.transpose(t.reshape(b, L, M_HEADS, d), (0, 2, 1, 3)).astype(jnp.float32)
    q = heads(q, M_DQK)
    k = heads(k, M_DQK) * (M_DQK ** -0.5)
    v = heads(v, M_DV)
    g = (g + b_gates).astype(jnp.float32).reshape(b, L, N_DIR, 2, M_HEADS)
    ig = jnp.transpose(g[:, :, :, 0], (2, 0, 3, 1))
    lf = jax.nn.log_sigmoid(jnp.transpose(g[:, :, :, 1], (2, 0, 3, 1)))
    return q, k, v, o, ig, lf


def mlstm_scan(q, k, v, ig, lf, state):
    b, hh, L, _ = q.shape
    nc = L // M_CHUNK
    tril = jnp.tril(jnp.ones((M_CHUNK, M_CHUNK), bool))

    def to_chunks(t):
        return jnp.moveaxis(t.reshape(b, hh, nc, M_CHUNK, *t.shape[3:]), 2, 0)

    def step(carry, inp):
        C, n, m = carry
        qc, kc, vc, ic, fc = inp
        bcum = jnp.cumsum(fc, axis=-1)
        dmat = jnp.where(tril, bcum[..., :, None] - bcum[..., None, :] + ic[..., None, :], -jnp.inf)
        inter = bcum + m[..., None]
        m_t = jnp.maximum(inter, jnp.max(dmat, axis=-1))
        w_inter = jnp.exp(inter - m_t)
        s = jnp.einsum('bhtd,bhsd->bhts', qc, kc) * jnp.exp(dmat - m_t[..., None])
        num = jnp.einsum('bhts,bhsv->bhtv', s, vc) + w_inter[..., None] * jnp.einsum('bhvd,bhtd->bhtv', C, qc)
        den = jnp.sum(s, axis=-1) + w_inter * jnp.einsum('bhd,bhtd->bht', n, qc)
        h = num / jnp.maximum(jnp.abs(den), jnp.exp(-m_t))[..., None]
        g = bcum[..., -1]
        dend = g[..., None] - bcum + ic
        m_new = jnp.maximum(g + m, jnp.max(dend, axis=-1))
        w_old = jnp.exp(g + m - m_new)
        w_s = jnp.exp(dend - m_new[..., None])
        C_new = w_old[..., None, None] * C + jnp.einsum('bhsv,bhsd->bhvd', vc * w_s[..., None], kc)
        n_new = w_old[..., None] * n + jnp.einsum('bhs,bhsd->bhd', w_s, kc)
        return (C_new, n_new, m_new), h

    state, hs = lax.scan(step, state, tuple(map(to_chunks, (q, k, v, ig, lf))))
    return jnp.moveaxis(hs, 0, 2).reshape(b, hh, L, M_DV), state


def mlstm_out(hs, o, hn_g, w_out):
    b, hh, L, dv = hs.shape
    ht = jnp.transpose(hs, (0, 2, 1, 3))
    ht = ht * lax.rsqrt(jnp.mean(ht * ht, axis=-1, keepdims=True) + EPS)
    ht = (ht.reshape(b, L, hh * dv) * hn_g).astype(o.dtype) * jax.nn.sigmoid(o)
    return ht @ w_out


def mixer_c(h_lat, h_ctx, w_in, b_gates, hn_g, w_out, need_ctx):
    ql, kl, vl, ol, igl, lfl = mlstm_project(h_lat, w_in, b_gates)
    qc, kc, vc, oc, igc, lfc = mlstm_project(h_ctx, w_in, b_gates)
    b = h_lat.shape[0]
    zero = (jnp.zeros((b, M_HEADS, M_DV, M_DQK), jnp.float32),
            jnp.zeros((b, M_HEADS, M_DQK), jnp.float32),
            jnp.zeros((b, M_HEADS), jnp.float32))
    fl = lambda t: jnp.flip(t, axis=2)
    hc_f, st_f = mlstm_scan(qc, kc, vc, igc[0], lfc[0], zero)
    hl_f, _ = mlstm_scan(ql, kl, vl, igl[0], lfl[0], st_f)
    hc_b, st_b = mlstm_scan(fl(qc), fl(kc), fl(vc), fl(igc[1]), fl(lfc[1]), zero)
    hl_b, _ = mlstm_scan(fl(ql), fl(kl), fl(vl), fl(igl[1]), fl(lfl[1]), st_b)
    y_lat = mlstm_out(hl_f + fl(hl_b), ol, hn_g, w_out)
    y_ctx = mlstm_out(hc_f + fl(hc_b), oc, hn_g, w_out) if need_ctx else None
    return y_lat, y_ctx


def setup_inputs(seed: int = 0) -> dict:
    key = jax.random.key(seed)
    ks = iter(jax.random.split(key, 32))
    D = D_MODEL

    def nrm(shape, scale):
        return scale * jax.random.normal(next(ks), shape, jnp.float32)

    gates_i = nrm((N_ODD, N_DIR, M_HEADS), 0.1)
    gates_f = 3.0 + nrm((N_ODD, N_DIR, M_HEADS), 0.5)
    m_b_gates = jnp.stack([gates_i, gates_f], axis=2).reshape(N_ODD, G_COLS)
    return {
        'x': nrm((BATCH, SEQ, D), 1.0),
        'c': nrm((BATCH, D), 1.0),
        'ctx': nrm((BATCH, CTX_LEN, D), 1.0),
        'c_ctx': nrm((D,), 1.0),
        'ada_w': nrm((DEPTH, D, N_MOD * D), 0.5 * D ** -0.5),
        'ada_b': nrm((DEPTH, N_MOD * D), 0.02),
        'norm_g': 1.0 + nrm((DEPTH, 4, D), 0.1),
        'ab_w_in': nrm((N_EVEN, D, AB_IN), D ** -0.5),
        'a_conv_w': nrm((N_EVEN, A_CONV, W_A), A_CONV ** -0.5),
        'a_conv_b': nrm((N_EVEN, W_A), 0.02),
        'a_ln_g': 1.0 + nrm((N_EVEN, W_A), 0.1),
        'a_ln_b': nrm((N_EVEN, W_A), 0.02),
        'b_conv_w': nrm((N_EVEN, B_CONV, W_B), B_CONV ** -0.5),
        'ab_w_out': nrm((N_EVEN, W_A + W_B, D), (W_A + W_B) ** -0.5),
        'm_w_in': nrm((N_ODD, D, C_IN), D ** -0.5),
        'm_b_gates': m_b_gates,
        'm_hn_g': 1.0 + nrm((N_ODD, V_COLS), 0.1),
        'm_w_out': nrm((N_ODD, V_COLS, D), V_COLS ** -0.5),
        'ffn_w_up': nrm((DEPTH, D, 2 * D_FF), D ** -0.5),
        'ffn_conv_w': nrm((DEPTH, FFN_CONV, 2 * D_FF), FFN_CONV ** -0.5),
        'ffn_w_down': nrm((DEPTH, D_FF, D), D_FF ** -0.5),
    }


def reference(x, c, ctx, c_ctx, ada_w, ada_b, norm_g, ab_w_in, a_conv_w, a_conv_b, a_ln_g, a_ln_b,
              b_conv_w, ab_w_out, m_w_in, m_b_gates, m_hn_g, m_w_out, ffn_w_up, ffn_conv_w, ffn_w_down):
    rows = x.shape[1] // GRID_W
    for layer in range(DEPTH):
        last = layer == DEPTH - 1
        j = layer // 2
        mx = jnp.split(jax.nn.silu(c) @ ada_w[layer] + ada_b[layer], N_MOD, axis=-1)
        mc = jnp.split(jax.nn.silu(c_ctx)[None] @ ada_w[layer] + ada_b[layer], N_MOD, axis=-1)
        g_pre, g_post, f_pre, f_post = norm_g[layer][0], norm_g[layer][1], norm_g[layer][2], norm_g[layer][3]
        hx = modulate(rms_norm(x, g_pre), mx[0], mx[1])
        hc = modulate(rms_norm(ctx, g_pre), mc[0], mc[1])
        if layer % 2 == 0:
            yx = mixer_ab(hx, ab_w_in[j], a_conv_w[j], a_conv_b[j], a_ln_g[j], a_ln_b[j],
                          b_conv_w[j], ab_w_out[j], rows)
            yc = None if last else mixer_ab(hc, ab_w_in[j], a_conv_w[j], a_conv_b[j], a_ln_g[j],
                                            a_ln_b[j], b_conv_w[j], ab_w_out[j], None)
        else:
            yx, yc = mixer_c(hx, hc, m_w_in[j], m_b_gates[j], m_hn_g[j], m_w_out[j], not last)
        x = x + mx[2][:, None, :] * rms_norm(yx, g_post)
        fx = conv_ffn(modulate(rms_norm(x, f_pre), mx[3], mx[4]),
                      ffn_w_up[layer], ffn_conv_w[layer], ffn_w_down[layer], rows)
        x = x + mx[5][:, None, :] * rms_norm(fx, f_post)
        if not last:
            ctx = ctx + mc[2][:, None, :] * rms_norm(yc, g_post)
            fc = conv_ffn(modulate(rms_norm(ctx, f_pre), mc[3], mc[4]),
                          ffn_w_up[layer], ffn_conv_w[layer], ffn_w_down[layer], None)
            ctx = ctx + mc[5][:, None, :] * rms_norm(fc, f_post)
    return x
```

```cpp
#include <hip/hip_runtime.h>
#include <cstdio>
#include <cstdint>

#ifndef PROBE_E1
#define PROBE_E1 0
#endif
#ifndef MK_PER_PHASE
#define MK_PER_PHASE 0
#endif

namespace pg8 {
#define PG8_LAS __attribute__((address_space(3)))
typedef unsigned short bf16_t;
typedef short bf16x8 __attribute__((ext_vector_type(8)));
typedef float f32x4 __attribute__((ext_vector_type(4)));
typedef unsigned u32x4 __attribute__((ext_vector_type(4)));
constexpr int BM = 256, BK = 64, HALF = 128, HTB = HALF * BK * 2, STAGE_BYTES = 8 * HTB, NXCD = 8, WGM = 8;

__host__ __device__ __forceinline__ int lds_byte(int r, int c) { const int st = (r >> 4) * 2 + (c >> 5), rr = r & 15, cc = c & 31, ob = rr * 64 + cc * 2; return st * 1024 + (ob ^ (((ob >> 9) & 1) << 5)); }
__host__ __device__ __forceinline__ void stage_rc(int b, int& R, int& C) { const int st = b / 1024, sb = b % 1024, swz = sb ^ (((sb >> 9) & 1) << 5); R = (st >> 1) * 16 + swz / 64; C = (st & 1) * 32 + (swz % 64) / 2; }
__host__ __device__ __forceinline__ int perm32(int rho) { const int n = rho >> 4, i = rho & 15; return 8 * (i >> 2) + 4 * n + (i & 3); }

struct Unit { int pm, pn; };
struct Gemm { const bf16_t* A; const bf16_t* Bt; int M, N, K; };

struct StaticOrder {
    int nM, nN, nwg, G, c;
    __host__ __device__ void init(int M, int N, int G_, int c_) { nM = M / BM; nN = N / BM; nwg = nM * nN; G = G_; c = c_; }
    __host__ __device__ bool next(int i, Unit& u) const {
        const long L = (long)i * G + c; if (L >= nwg) return false;
        int wgid = (int)L; { const int q = nwg / NXCD, r = nwg % NXCD, xcd = wgid % NXCD, off = wgid / NXCD; wgid = (xcd < r ? xcd * (q + 1) : r * (q + 1) + (xcd - r) * q) + off; }
        const int nig = WGM * nN, gid = wgid / nig, fm = gid * WGM, gsz = (nM - fm) < WGM ? (nM - fm) : WGM;
        u.pm = fm + ((wgid % nig) % gsz); u.pn = (wgid % nig) / gsz; return true;
    }
    __device__ __forceinline__ void a_ready(const Unit&) const {}
    __device__ __forceinline__ void done(const Unit&) const {}
};

__device__ __forceinline__ unsigned cvt_pk_bf16(float lo, float hi) { unsigned r; asm volatile("v_cvt_pk_bf16_f32 %0, %1, %2" : "=v"(r) : "v"(lo), "v"(hi)); return r; }

struct EpiBf16 {
    static constexpr bool PERM = true, AFTER_DRAIN = false, PERM_A = false; static constexpr int VM_OPS = 16;
    bf16_t* O; int ldc;
    __device__ __forceinline__ void operator()(const f32x4 (&acc)[2][2][4][2], const Unit& u, int wr, int wc, int fr, int fq) const {
        const int row0 = u.pm * BM + wr * 64 + fr, col0 = u.pn * BM + wc * 32 + 8 * fq;
#pragma unroll
        for (int ai = 0; ai < 2; ++ai)
#pragma unroll
            for (int m = 0; m < 4; ++m) { bf16_t* rowp = O + (size_t)(row0 + ai * HALF + m * 16) * ldc + col0;
#pragma unroll
                for (int bj = 0; bj < 2; ++bj) { const f32x4 v0 = acc[ai][bj][m][0], v1 = acc[ai][bj][m][1];
                    u32x4 w; w.x = cvt_pk_bf16(v0[0], v0[1]); w.y = cvt_pk_bf16(v0[2], v0[3]); w.z = cvt_pk_bf16(v1[0], v1[1]); w.w = cvt_pk_bf16(v1[2], v1[3]);
                    *(u32x4*)(rowp + bj * HALF) = w; } }
    }
};
struct EpiAB {
    static constexpr bool PERM = true, AFTER_DRAIN = false, PERM_A = false; static constexpr int VM_OPS = 8;
    bf16_t* O;
    __device__ __forceinline__ void operator()(const f32x4 (&acc)[2][2][4][2], const Unit& u, int wr, int wc, int fr, int fq) const {
        const int row0 = u.pm * BM + wr * 64 + fr;
        if (u.pn >= 16 && u.pn < 24) {
            const int col0 = 2048 + (u.pn - 16) * BM + wc * 32 + 8 * fq;
#pragma unroll
            for (int ai = 0; ai < 2; ++ai)
#pragma unroll
                for (int m = 0; m < 4; ++m) { bf16_t* rowp = O + (size_t)(row0 + ai * HALF + m * 16) * 6144 + col0;
#pragma unroll
                    for (int bj = 0; bj < 2; ++bj) { const f32x4 v0 = acc[ai][bj][m][0], v1 = acc[ai][bj][m][1];
                        u32x4 w; w.x = cvt_pk_bf16(v0[0], v0[1]); w.y = cvt_pk_bf16(v0[2], v0[3]); w.z = cvt_pk_bf16(v1[0], v1[1]); w.w = cvt_pk_bf16(v1[2], v1[3]);
                        *(u32x4*)(rowp + bj * HALF) = w; } }
            return;
        }
        const bool glu = u.pn < 16;
        const int col0 = (glu ? u.pn * 128 : 4096 + (u.pn - 24) * 128) + wc * 32 + 8 * fq;
#pragma unroll
        for (int ai = 0; ai < 2; ++ai)
#pragma unroll
            for (int m = 0; m < 4; ++m) { float o[8];
#pragma unroll
                for (int n = 0; n < 2; ++n)
#pragma unroll
                    for (int j = 0; j < 4; ++j) { const float x = acc[ai][0][m][n][j], y = acc[ai][1][m][n][j];
                        o[4 * n + j] = glu ? x * __builtin_amdgcn_rcpf(1.0f + __expf(-y)) : x * y; }
                u32x4 w; w.x = cvt_pk_bf16(o[0], o[1]); w.y = cvt_pk_bf16(o[2], o[3]); w.z = cvt_pk_bf16(o[4], o[5]); w.w = cvt_pk_bf16(o[6], o[7]);
                *(u32x4*)(O + (size_t)(row0 + ai * HALF + m * 16) * 6144 + col0) = w; }
    }
};
struct EpiMIn {
    static constexpr bool PERM = true, AFTER_DRAIN = false, PERM_A = false; static constexpr int VM_OPS = 0;
    bf16_t* O; int ldc; float* gates;
    __device__ __forceinline__ void operator()(const f32x4 (&acc)[2][2][4][2], const Unit& u, int wr, int wc, int fr, int fq) const {
        const int row0 = u.pm * BM + wr * 64 + fr;
        if (u.pn < 48) {
            const int col0 = u.pn * BM + wc * 32 + 8 * fq;
#pragma unroll
            for (int ai = 0; ai < 2; ++ai)
#pragma unroll
                for (int m = 0; m < 4; ++m) { bf16_t* rowp = O + (size_t)(row0 + ai * HALF + m * 16) * ldc + col0;
#pragma unroll
                    for (int bj = 0; bj < 2; ++bj) { const f32x4 v0 = acc[ai][bj][m][0], v1 = acc[ai][bj][m][1];
                        u32x4 w; w.x = cvt_pk_bf16(v0[0], v0[1]); w.y = cvt_pk_bf16(v0[2], v0[3]); w.z = cvt_pk_bf16(v1[0], v1[1]); w.w = cvt_pk_bf16(v1[2], v1[3]);
                        *(u32x4*)(rowp + bj * HALF) = w; } }
        } else if (wc == 0) {
#pragma unroll
            for (int ai = 0; ai < 2; ++ai)
#pragma unroll
                for (int m = 0; m < 4; ++m) { float* rowp = gates + (size_t)(row0 + ai * HALF + m * 16) * 32 + 8 * fq;
#pragma unroll
                    for (int n = 0; n < 2; ++n) *(f32x4*)(rowp + 4 * n) = acc[ai][0][m][n]; }
        }
    }
};

__device__ __forceinline__ float dpp_ror1(float v) { return __builtin_bit_cast(float, __builtin_amdgcn_update_dpp(0, __builtin_bit_cast(int, v), 0x121, 0xf, 0xf, false)); }
__device__ __forceinline__ float dpp_rol1(float v) { return __builtin_bit_cast(float, __builtin_amdgcn_update_dpp(0, __builtin_bit_cast(int, v), 0x12F, 0xf, 0xf, false)); }
template <bool NOLOAD = false, bool NOSTORE = false> struct EpiGateT {
    static constexpr bool PERM = true, AFTER_DRAIN = false, PERM_A = true; static constexpr int VM_OPS = NOSTORE ? 0 : 8;
    bf16_t* G; bf16_t* UC; const float* cw;
    __device__ __forceinline__ static float shr1(float v) { return __builtin_bit_cast(float, __builtin_amdgcn_update_dpp(0, __builtin_bit_cast(int, v), 0x111, 0xf, 0xf, true)); }
    __device__ __forceinline__ static float shl1(float v) { return __builtin_bit_cast(float, __builtin_amdgcn_update_dpp(0, __builtin_bit_cast(int, v), 0x101, 0xf, 0xf, true)); }
    __device__ __forceinline__ void operator()(const f32x4 (&acc)[2][2][4][2], const Unit& u, int wr, int wc, int fr, int fq) const {
        const int row0 = u.pm * BM + wr * 64 + 4 * fr;
        if (u.pm >= 64) {
            const int col0 = u.pn * BM + wc * 32 + 8 * fq;
#pragma unroll
            for (int ai = 0; ai < 2; ++ai)
#pragma unroll
                for (int m = 0; m < 4; ++m) { bf16_t* rowp = UC + (size_t)(row0 - 64 * BM + ai * HALF + m) * 22016 + col0;
#pragma unroll
                    for (int bj = 0; bj < 2; ++bj) { const f32x4 v0 = acc[ai][bj][m][0], v1 = acc[ai][bj][m][1];
                        u32x4 w; w.x = cvt_pk_bf16(v0[0], v0[1]); w.y = cvt_pk_bf16(v0[2], v0[3]); w.z = cvt_pk_bf16(v1[0], v1[1]); w.w = cvt_pk_bf16(v1[2], v1[3]);
                        *(u32x4*)(rowp + bj * HALF) = w; } }
            return;
        }
        const int ch = u.pn * 128 + wc * 32 + 8 * fq;
        typedef unsigned u32x2 __attribute__((ext_vector_type(2)));
#pragma unroll
        for (int n = 0; n < 2; ++n) {
            f32x4 wg[3], wv[3];
#pragma unroll
            for (int k = 0; k < 3; ++k) { if (NOLOAD) { wg[k] = (f32x4){0.3f, 0.4f, 0.5f, 0.6f}; wv[k] = (f32x4){0.6f, 0.5f, 0.4f, 0.3f}; } else { wg[k] = *(const f32x4*)(cw + k * 22016 + ch + 4 * n); wv[k] = *(const f32x4*)(cw + k * 22016 + 11008 + ch + 4 * n); } }
#pragma unroll
            for (int ai = 0; ai < 2; ++ai) {
                float o[4][4];
#pragma unroll
                for (int j = 0; j < 4; ++j) {
                    const float gp = shr1(acc[ai][0][3][n][j]), gn = shl1(acc[ai][0][0][n][j]), vp = shr1(acc[ai][1][3][n][j]), vn = shl1(acc[ai][1][0][n][j]);
#pragma unroll
                    for (int m = 0; m < 4; ++m) {
                        const float gL = m > 0 ? acc[ai][0][m - 1][n][j] : gp, gR = m < 3 ? acc[ai][0][m + 1][n][j] : gn;
                        const float vL = m > 0 ? acc[ai][1][m - 1][n][j] : vp, vR = m < 3 ? acc[ai][1][m + 1][n][j] : vn;
                        const float g = wg[0][j] * gL + wg[1][j] * acc[ai][0][m][n][j] + wg[2][j] * gR;
                        const float v = wv[0][j] * vL + wv[1][j] * acc[ai][1][m][n][j] + wv[2][j] * vR;
                        o[m][j] = g * __builtin_amdgcn_rcpf(1.0f + __expf(-g)) * v; }
                }
#pragma unroll
                for (int m = 0; m < 4; ++m) { u32x2 w; w.x = cvt_pk_bf16(o[m][0], o[m][1]); w.y = cvt_pk_bf16(o[m][2], o[m][3]);
                    if (NOSTORE) asm volatile("" :: "v"(w)); else *(u32x2*)(G + (size_t)(row0 + ai * HALF + m) * 11008 + ch + 4 * n) = w; }
                __builtin_amdgcn_sched_barrier(0);
            }
        }
    }
};
typedef EpiGateT<false, false> EpiGate;

template <class Epi, class Sched, bool ALIGN_EPI = false, bool SP2 = false>
__device__ __forceinline__ void gemm_phase(PG8_LAS unsigned char* lds, const Gemm g, const Sched& S, const Epi& E, const int tid) {
    const int wid = __builtin_amdgcn_readfirstlane(tid >> 6), lane = tid & 63, wr = wid >> 2, wc = wid & 3, fr = lane & 15, fq = lane >> 4;
    const int K = g.K, nt = K / BK;
    unsigned voffA[2], voffB[2];
#pragma unroll
    for (int i = 0; i < 2; ++i) { int R, C; stage_rc(tid * 16 + i * 8192, R, C); const int Rb = Epi::PERM ? ((R & ~31) + perm32(R & 31)) : R;
        const int Ra = Epi::PERM_A ? ((R & ~63) + 4 * (R & 15) + ((R >> 4) & 3)) : R;
        voffA[i] = (unsigned)(Ra * K + C) * 2u; voffB[i] = (unsigned)(Rb * K + C) * 2u; }
    const size_t kstep = (size_t)(BK * 2);
    const size_t hstep = (size_t)HALF * K * 2;
    const size_t tstep = 2 * hstep;
    const unsigned ldsw = (unsigned)wid * 1024u;
    const int aoff = lds_byte(wr * 64 + fr, fq * 8), boff = lds_byte(wc * 32 + fr, fq * 8);
#define PG8_SA(b, h) (((b) * 2 + (h)) * HTB)
#define PG8_SB(b, h) ((4 + (b) * 2 + (h)) * HTB)
#define PG8_STAGE(bufoff, gbase, voff) do { _Pragma("unroll") for (int _i = 0; _i < 2; ++_i) \
        __builtin_amdgcn_global_load_lds((const unsigned*)((const char*)(gbase) + (voff)[_i]), (PG8_LAS unsigned*)(lds + (bufoff) + ldsw + _i * 8192), 16, 0, 0); } while (0)
#define PG8_LDA(dst, b, h) do { _Pragma("unroll") for (int m = 0; m < 4; ++m) _Pragma("unroll") for (int k = 0; k < 2; ++k) dst[m][k] = *(const PG8_LAS bf16x8*)(lds + PG8_SA(b, h) + aoff + m * 2048 + k * 1024); } while (0)
#define PG8_LDB(dst, b, h) do { _Pragma("unroll") for (int n = 0; n < 2; ++n) _Pragma("unroll") for (int k = 0; k < 2; ++k) dst[n][k] = *(const PG8_LAS bf16x8*)(lds + PG8_SB(b, h) + boff + n * 2048 + k * 1024); } while (0)
#define PG8_MMA(ai, bj, At, Bt) do { __builtin_amdgcn_s_setprio(1); _Pragma("unroll") for (int m = 0; m < 4; ++m) _Pragma("unroll") for (int n = 0; n < 2; ++n) _Pragma("unroll") for (int k = 0; k < 2; ++k) \
        acc[ai][bj][m][n] = __builtin_amdgcn_mfma_f32_16x16x32_bf16(Bt[n][k], At[m][k], acc[ai][bj][m][n], 0, 0, 0); __builtin_amdgcn_s_setprio(0); } while (0)
#define PG8_WAIT_V(n) asm volatile("s_waitcnt vmcnt(" #n ")" ::: "memory")
#define PG8_WAIT_L(n) asm volatile("s_waitcnt lgkmcnt(" #n ")" ::: "memory")
#define PG8_BAR __builtin_amdgcn_s_barrier()
#define PG8_SCHED __builtin_amdgcn_sched_barrier(0)
    Unit cur, nxt; int ui = 0;
    if (!S.next(0, cur)) return;
    f32x4 acc[2][2][4][2];
#pragma unroll
    for (int a = 0; a < 2; ++a)
#pragma unroll
        for (int b = 0; b < 2; ++b)
#pragma unroll
            for (int m = 0; m < 4; ++m)
#pragma unroll
                for (int n = 0; n < 2; ++n) acc[a][b][m][n] = (f32x4){0.f, 0.f, 0.f, 0.f};
    bf16x8 At[4][2], B0[2][2], B1[2][2];
    const char* cA = (const char*)g.A + (size_t)cur.pm * tstep; const char* cB = (const char*)g.Bt + (size_t)cur.pn * tstep;
    S.a_ready(cur);
    if constexpr (SP2) {
        PG8_STAGE(PG8_SB(0, 0), cB, voffB); PG8_STAGE(PG8_SB(0, 1), cB + hstep, voffB); PG8_STAGE(PG8_SA(0, 0), cA, voffA); PG8_STAGE(PG8_SA(0, 1), cA + hstep, voffA);
        if (wr == 1) PG8_BAR;
        PG8_WAIT_V(2); PG8_BAR;
        PG8_STAGE(PG8_SB(1, 0), cB + kstep, voffB); PG8_STAGE(PG8_SA(1, 0), cA + kstep, voffA); PG8_STAGE(PG8_SB(1, 1), cB + hstep + kstep, voffB);
        PG8_WAIT_V(6); PG8_BAR;
    } else {
        PG8_STAGE(PG8_SB(0, 0), cB, voffB); PG8_STAGE(PG8_SA(0, 0), cA, voffA); PG8_STAGE(PG8_SB(0, 1), cB + hstep, voffB); PG8_STAGE(PG8_SA(0, 1), cA + hstep, voffA);
        if (wr == 1) PG8_BAR;
        PG8_WAIT_V(4); PG8_BAR;
        PG8_STAGE(PG8_SB(1, 0), cB + kstep, voffB); PG8_STAGE(PG8_SA(1, 0), cA + kstep, voffA); PG8_STAGE(PG8_SB(1, 1), cB + hstep + kstep, voffB);
        PG8_WAIT_V(6); PG8_BAR;
    }
    for (;;) {
        const bool has_next = S.next(ui + 1, nxt);
        const char* nA = has_next ? (const char*)g.A + (size_t)nxt.pm * tstep : cA; const char* nB = has_next ? (const char*)g.Bt + (size_t)nxt.pn * tstep : cB;
        for (int t = 0; t < nt; t += 2) {
            const bool last = (t == nt - 2);
            const char* a1 = cA + (size_t)(t + 1) * kstep;
            const char* a2 = last ? nA : cA + (size_t)(t + 2) * kstep; const char* b2 = last ? nB : cB + (size_t)(t + 2) * kstep;
            const char* a3 = a2 + kstep; const char* b3 = b2 + kstep;
            if (last && has_next) S.a_ready(nxt);
            if constexpr (SP2) {
            const int after_epi = __builtin_amdgcn_readfirstlane((t == 0 && ui > 0) ? 1 : 0);
#define PG8_WAIT_V8_OR(n) asm volatile("s_cmp_lg_u32 %0, 0\n\ts_cbranch_scc0 .Lpg8w8_%=\n\ts_waitcnt vmcnt(" #n ")\n\ts_branch .Lpg8we_%=\n.Lpg8w8_%=:\n\ts_waitcnt vmcnt(8)\n.Lpg8we_%=:" :: "s"(after_epi) : "memory", "scc")
            PG8_LDB(B0, 0, 0); PG8_LDB(B1, 0, 1); PG8_SCHED; PG8_LDA(At, 0, 0); PG8_STAGE(PG8_SA(1, 1), a1 + hstep, voffA);
            if constexpr (Epi::VM_OPS == 16) PG8_WAIT_V8_OR(24); else if constexpr (Epi::VM_OPS == 8) PG8_WAIT_V8_OR(16); else PG8_WAIT_V(8);
            PG8_WAIT_L(0); PG8_BAR; PG8_MMA(0, 0, At, B0); PG8_MMA(0, 1, At, B1); PG8_BAR; PG8_SCHED;
            PG8_LDA(At, 0, 1); PG8_STAGE(PG8_SB(0, 0), b2, voffB); PG8_STAGE(PG8_SB(0, 1), b2 + hstep, voffB); PG8_STAGE(PG8_SA(0, 0), a2, voffA);
            if constexpr (Epi::VM_OPS == 16) PG8_WAIT_V8_OR(24); else if constexpr (Epi::VM_OPS == 8) PG8_WAIT_V8_OR(16); else PG8_WAIT_V(8);
            PG8_WAIT_L(0); PG8_BAR; PG8_MMA(1, 0, At, B0); PG8_MMA(1, 1, At, B1); PG8_BAR; PG8_SCHED;
#undef PG8_WAIT_V8_OR
            PG8_LDB(B0, 1, 0); PG8_LDB(B1, 1, 1); PG8_SCHED; PG8_LDA(At, 1, 0); PG8_STAGE(PG8_SA(0, 1), a2 + hstep, voffA);
            PG8_WAIT_V(8); PG8_WAIT_L(0); PG8_BAR; PG8_MMA(0, 0, At, B0); PG8_MMA(0, 1, At, B1); PG8_BAR; PG8_SCHED;
            PG8_LDA(At, 1, 1); PG8_STAGE(PG8_SB(1, 0), b3, voffB); PG8_STAGE(PG8_SB(1, 1), b3 + hstep, voffB); PG8_STAGE(PG8_SA(1, 0), a3, voffA);
            PG8_WAIT_V(8); PG8_WAIT_L(0); PG8_BAR; PG8_MMA(1, 0, At, B0); PG8_MMA(1, 1, At, B1); PG8_BAR; PG8_SCHED;
            } else {
            PG8_LDB(B0, 0, 0); PG8_SCHED; PG8_LDA(At, 0, 0); PG8_STAGE(PG8_SA(1, 1), a1 + hstep, voffA);
            PG8_WAIT_L(8); PG8_BAR; PG8_WAIT_L(0); PG8_MMA(0, 0, At, B0); PG8_BAR; PG8_SCHED;
            PG8_LDB(B1, 0, 1); PG8_STAGE(PG8_SB(0, 0), b2, voffB);
            PG8_BAR; PG8_WAIT_L(0); PG8_MMA(0, 1, At, B1); PG8_BAR;
            PG8_LDA(At, 0, 1); PG8_STAGE(PG8_SA(0, 0), a2, voffA);
            PG8_BAR; PG8_WAIT_L(0); PG8_MMA(1, 0, At, B0); PG8_BAR; PG8_SCHED;
            PG8_STAGE(PG8_SB(0, 1), b2 + hstep, voffB);
            PG8_WAIT_V(6); PG8_BAR; PG8_MMA(1, 1, At, B1); PG8_BAR;
            PG8_LDB(B0, 1, 0); PG8_SCHED; PG8_LDA(At, 1, 0); PG8_STAGE(PG8_SA(0, 1), a2 + hstep, voffA);
            PG8_WAIT_L(8); PG8_BAR; PG8_WAIT_L(0); PG8_MMA(0, 0, At, B0); PG8_BAR; PG8_SCHED;
            PG8_LDB(B1, 1, 1); PG8_STAGE(PG8_SB(1, 0), b3, voffB);
            PG8_BAR; PG8_WAIT_L(0); PG8_MMA(0, 1, At, B1); PG8_BAR;
            PG8_LDA(At, 1, 1); PG8_STAGE(PG8_SA(1, 0), a3, voffA);
            PG8_BAR; PG8_WAIT_L(0); PG8_MMA(1, 0, At, B0); PG8_BAR; PG8_SCHED;
            PG8_STAGE(PG8_SB(1, 1), b3 + hstep, voffB);
            PG8_WAIT_V(6); PG8_BAR; PG8_MMA(1, 1, At, B1); PG8_BAR;
            }
        }
        if constexpr (ALIGN_EPI) { if (wr == 0) PG8_BAR; }
        if constexpr (!Epi::AFTER_DRAIN) { E(acc, cur, wr, wc, fr, fq); S.done(cur); }
        if (!has_next) break;
#pragma unroll
        for (int a = 0; a < 2; ++a)
#pragma unroll
            for (int b = 0; b < 2; ++b)
#pragma unroll
                for (int m = 0; m < 4; ++m)
#pragma unroll
                    for (int n = 0; n < 2; ++n) acc[a][b][m][n] = (f32x4){0.f, 0.f, 0.f, 0.f};
        cur = nxt; cA = nA; cB = nB; ++ui;
        if constexpr (ALIGN_EPI) { if (wr == 1) PG8_BAR; }
    }
    PG8_WAIT_V(0);
    if constexpr (!ALIGN_EPI) { if (wr == 0) PG8_BAR; }
    PG8_BAR;
#undef PG8_SA
#undef PG8_SB
#undef PG8_STAGE
#undef PG8_LDA
#undef PG8_LDB
#undef PG8_MMA
#undef PG8_WAIT_V
#undef PG8_WAIT_L
#undef PG8_BAR
#undef PG8_SCHED
}
}

constexpr int NWAVES = 8, NTHREADS = 512;
constexpr int D = 4096, BATCH = 2, SEQ = 8192, CTXL = 256;
constexpr int ML = BATCH * SEQ;
constexpr int MC = BATCH * CTXL;
constexpr int MT = ML + MC;
constexpr int NMODC = 6 * D;
constexpr int WA = 2048, ABIN = 10240, ABU = 6144, ACONV = 31;
constexpr int HEADS = 8, DQK = 256, DV = 512;
constexpr int QKVO = 12288, CIN = 12320, CINP = 12544;
constexpr int DFF = 11008, DFF2 = 22016;
constexpr int NCH = 66;
constexpr float EPS = 1e-6f;

constexpr size_t MiB = 1u << 20;
constexpr size_t WS_CTL = 0, CTL_ZERO_BYTES = 1 * MiB;
constexpr size_t WS_MOD = 1 * MiB;
constexpr size_t WS_SCP = 2 * MiB;
constexpr size_t WS_SCC = 7 * MiB;
constexpr size_t WS_GATES = 8 * MiB;
constexpr size_t WS_CTXS = 12 * MiB;
constexpr size_t WS_WABIN = 20 * MiB;
constexpr size_t WS_WABOUT = 100 * MiB;
constexpr size_t WS_WMIN = 132 * MiB;
constexpr size_t WS_WMOUT = 230 * MiB;
constexpr size_t WS_WUP0 = 262 * MiB;
constexpr size_t WS_WDN0 = 606 * MiB;
constexpr size_t WS_H = 778 * MiB;
constexpr size_t WS_U = 910 * MiB;
constexpr size_t WS_UC = 1590 * MiB;
constexpr size_t WS_G = 1620 * MiB;
constexpr size_t WS_Y = 1975 * MiB;
constexpr size_t WS_HS = 2239 * MiB;
constexpr size_t WS_END = 2751 * MiB;
static_assert(WS_WUP0 + 2 * 172 * MiB == WS_WDN0 && WS_WDN0 + 2 * 86 * MiB <= WS_H, "ws map");
static_assert((size_t)DFF2 * D * 2 <= 172 * MiB && (size_t)D * DFF * 2 <= 86 * MiB && (size_t)CINP * D * 2 <= 98 * MiB, "ws map");
static_assert(WS_H + (size_t)MT * D * 2 <= WS_U && WS_U + (size_t)MT * DFF2 * 2 <= WS_G && WS_G + (size_t)MT * DFF * 2 <= WS_Y && WS_Y + (size_t)MT * D * 4 <= WS_HS && WS_HS + (size_t)2 * ML * D * 4 <= WS_END, "ws map");
static_assert(WS_SCP + (size_t)32 * NCH * 3 * 128 * 4 <= WS_SCC && WS_GATES + (size_t)MT * 32 * 4 <= WS_CTXS && WS_CTXS + (size_t)MC * D * 4 <= WS_WABIN, "ws map");

constexpr int CW_BAR = 4096;
constexpr int LDS_BYTES = 163840;
constexpr int MISC_OFF = LDS_BYTES - 64;

#define LAS __attribute__((address_space(3)))
typedef unsigned short bf16;
typedef unsigned v4u __attribute__((ext_vector_type(4)));
typedef unsigned v2u __attribute__((ext_vector_type(2)));
typedef float f32x4 __attribute__((ext_vector_type(4)));
typedef float f32x2 __attribute__((ext_vector_type(2)));
typedef short bf16x8 __attribute__((ext_vector_type(8)));
typedef short s16x4 __attribute__((ext_vector_type(4)));
#define LDS_WAIT() asm volatile("s_waitcnt lgkmcnt(0)" ::: "memory")

__device__ __forceinline__ unsigned f2bf(float f) { unsigned u = __builtin_bit_cast(unsigned, f); return (u + 0x7fffu + ((u >> 16) & 1u)) >> 16; }
__device__ __forceinline__ unsigned pk2(float lo, float hi) { unsigned r; asm("v_cvt_pk_bf16_f32 %0, %1, %2" : "=v"(r) : "v"(lo), "v"(hi)); return r; }
__device__ __forceinline__ float bflo(unsigned w) { return __builtin_bit_cast(float, w << 16); }
__device__ __forceinline__ float bfhi(unsigned w) { return __builtin_bit_cast(float, w & 0xffff0000u); }
__device__ __forceinline__ float bf1(unsigned short h) { return __builtin_bit_cast(float, ((unsigned)h) << 16); }
__device__ __forceinline__ void cvt8(const v4u r, float (&f)[8]) {
    f[0] = bflo(r.x); f[1] = bfhi(r.x); f[2] = bflo(r.y); f[3] = bfhi(r.y); f[4] = bflo(r.z); f[5] = bfhi(r.z); f[6] = bflo(r.w); f[7] = bfhi(r.w);
}
__device__ __forceinline__ float sigmoidf_(float x) { return __builtin_amdgcn_rcpf(1.0f + __expf(-x)); }
__device__ __forceinline__ float siluf_(float x) { return x * sigmoidf_(x); }
__device__ __forceinline__ float wave_sum(float v) {
#pragma unroll
    for (int o = 1; o < 64; o <<= 1) v += __shfl_xor(v, o);
    return v;
}

#define XB_TMO      128
#define XB_XCNT(j)  (256  + 64 * (j))
#define XB_XSUB(j)  (1280 + 64 * (j))
#define XB_XGEN(j)  (2304 + 64 * (j))
#define XB_TOP      3328
#define XB_TOPGEN   3392
#define XCD_BAR_WORDS 3456
#define XB_SPIN_CAP (1u << 22)

__device__ __forceinline__ unsigned xb_ld(unsigned* p)              { return __hip_atomic_load(p, __ATOMIC_RELAXED, __HIP_MEMORY_SCOPE_AGENT); }
__device__ __forceinline__ unsigned xb_add(unsigned* p, unsigned v) { return __hip_atomic_fetch_add(p, v, __ATOMIC_RELAXED, __HIP_MEMORY_SCOPE_AGENT); }
__device__ __forceinline__ unsigned xb_xcc_id() { return (unsigned)__builtin_amdgcn_s_getreg((3 << 11) | 20) & 0xFu; }
#define XB_SPIN(cond, bar) do { unsigned _sp = 0; while (cond) { __builtin_amdgcn_s_sleep(1); \
    if ((++_sp & 255u) == 0u) { if (xb_ld(&(bar)[XB_TMO])) break; if (_sp > XB_SPIN_CAP) { atomicAdd(&(bar)[XB_TMO], 1u); break; } } } } while (0)

struct XcdBarrier { unsigned* bar; unsigned x; volatile LAS unsigned* st; };

__device__ __forceinline__ XcdBarrier xcd_barrier_post(unsigned* bar, volatile LAS unsigned* st) {
    XcdBarrier b; b.bar = bar; b.x = xb_xcc_id(); b.st = st;
    if (threadIdx.x == 0) (void)xb_add(&bar[XB_XCNT(b.x)], 1u);
    return b;
}
__device__ __forceinline__ void xcd_barrier_complete(unsigned* bar, unsigned x, unsigned& nloc, unsigned& nx) {
    const unsigned G = gridDim.x * gridDim.y * gridDim.z;
    unsigned sum, cnt, mine, sp = 0u;
    for (;;) {
        sum = 0u; cnt = 0u; mine = 0u;
#pragma unroll
        for (unsigned j = 0; j < 16; ++j) { const unsigned c = xb_ld(&bar[XB_XCNT(j)]); sum += c; cnt += (c > 0u) ? 1u : 0u; mine = (j == x) ? c : mine; }
        if (sum == G) break;
        __builtin_amdgcn_s_sleep(1);
        if ((++sp & 255u) == 0u) { if (xb_ld(&bar[XB_TMO])) break; if (sp > XB_SPIN_CAP) { atomicAdd(&bar[XB_TMO], 1u); break; } }
    }
    nloc = mine > 0u ? mine : 1u; nx = cnt > 0u ? cnt : 1u;
}
__device__ __forceinline__ void xcd_barrier(const XcdBarrier& b) {
    asm volatile("s_waitcnt vmcnt(0)" ::: "memory");
    __syncthreads();
    if (threadIdx.x == 0) {
        unsigned* bar = b.bar;
        __builtin_amdgcn_s_waitcnt(0);
        unsigned nloc = b.st[0], nx = b.st[1];
        if (nloc == 0u) { xcd_barrier_complete(bar, b.x, nloc, nx); b.st[0] = nloc; b.st[1] = nx; }
        const unsigned old = xb_add(&bar[XB_XSUB(b.x)], 1u);
        const unsigned gen = old / nloc;
        if (old + 1u == (gen + 1u) * nloc) {
            __builtin_amdgcn_fence(__ATOMIC_RELEASE, "agent");
            asm volatile("s_waitcnt vmcnt(0)" ::: "memory");
            const unsigned og = xb_add(&bar[XB_TOP], 1u);
            const unsigned tg = og / nx;
            if (og + 1u == (tg + 1u) * nx) xb_add(&bar[XB_TOPGEN], 1u);
            else XB_SPIN(xb_ld(&bar[XB_TOPGEN]) == tg, bar);
            __builtin_amdgcn_fence(__ATOMIC_ACQUIRE, "agent");
            xb_add(&bar[XB_XGEN(b.x)], 1u);
            asm volatile("s_waitcnt vmcnt(0)" ::: "memory");
        } else {
            XB_SPIN(xb_ld(&bar[XB_XGEN(b.x)]) == gen, bar);
            __builtin_amdgcn_fence(__ATOMIC_ACQUIRE, "agent");
            asm volatile("s_waitcnt vmcnt(0)" ::: "memory");
        }
    }
    __syncthreads();
}

struct Args { const float* in[21]; float* out; unsigned char* ws; int ph_lo, ph_hi; };
typedef const __attribute__((address_space(4))) Args* CArgs;
__device__ __forceinline__ int opaque_tid(int wave_s) { int t = wave_s * 64 + (int)__builtin_amdgcn_mbcnt_hi(~0u, __builtin_amdgcn_mbcnt_lo(~0u, 0u)); asm volatile("" : "+v"(t)); return t; }
__device__ __forceinline__ CArgs get_args() { CArgs p = (CArgs)__builtin_amdgcn_kernarg_segment_ptr(); asm volatile("" : "+s"(p)); return p; }
enum { I_X = 0, I_C, I_CTX, I_CCTX, I_ADAW, I_ADAB, I_NORMG, I_ABWIN, I_ACONVW, I_ACONVB, I_ALNG, I_ALNB, I_BCONVW, I_ABWOUT, I_MWIN, I_MBG, I_MHNG, I_MWOUT, I_FUP, I_FCONV, I_FDN };

template <int MODE> __device__ __forceinline__ int perm_row(int n0) {
    if (MODE == 1) return n0 < DFF ? 256 * (n0 / 128) + (n0 % 128) : 256 * ((n0 - DFF) / 128) + 128 + ((n0 - DFF) % 128);
    if (MODE == 2) { if (n0 < 4096) { const int ch = n0 & 2047, hi = n0 >> 11; return 256 * (ch / 128) + 128 * hi + (ch % 128); }
                     if (n0 < 6144) return n0;
                     const int j = n0 - 6144, ch = j & 2047, hi = j >> 11; return 6144 + 256 * (ch / 128) + 128 * hi + (ch % 128); }
    return n0;
}
template <int GATE_PERM = 0>
__device__ __forceinline__ void p0_transpose_item(const float* W, int K, int N, bf16* WT, LAS float* scr, int item, int lane) {
    const int nblk = N / 32, kb = item / nblk, nb = item % nblk, k0 = 64 * kb, n0 = 32 * nb;
    const int r0 = perm_row<GATE_PERM>(n0);
#pragma unroll 8
    for (int i = 0; i < 32; ++i) { const int kk = 2 * i + (lane >> 5); scr[kk * 33 + (lane & 31)] = W[(size_t)(k0 + kk) * N + n0 + (lane & 31)]; }
    LDS_WAIT(); asm volatile("" ::: "memory");
    const int c = lane & 7;
#pragma unroll
    for (int j = 0; j < 4; ++j) { const int n = (lane >> 3) + 8 * j; const LAS float* s = scr + (8 * c) * 33 + n;
        v4u o; o.x = pk2(s[0 * 33], s[1 * 33]); o.y = pk2(s[2 * 33], s[3 * 33]); o.z = pk2(s[4 * 33], s[5 * 33]); o.w = pk2(s[6 * 33], s[7 * 33]);
        __builtin_nontemporal_store(o, (v4u*)(WT + (size_t)(r0 + n) * K + k0 + 8 * c)); }
    LDS_WAIT(); asm volatile("" ::: "memory");
}

__device__ __forceinline__ void gemv_units(CArgs a, LAS unsigned char* lds, int layer, int first, int stride, int tid, int lane, int wave) {
    float* MOD = (float*)(a->ws + WS_MOD);
    LAS float* sv = (LAS float*)lds;
    LAS float* red = (LAS float*)(lds + 49152);
    for (int i = tid; i < 3 * D; i += NTHREADS) { const int r = i / D, k = i % D; const float v = (r < 2) ? a->in[I_C][r * D + k] : a->in[I_CCTX][k]; sv[i] = siluf_(v); }
    __syncthreads();
    for (int unit = first; unit < 768; unit += stride) {
        const int n0 = unit * 32;
        const int kg = wave * 8 + (lane >> 3), c4 = (lane & 7) * 4;
        const float* W = a->in[I_ADAW] + (size_t)layer * D * NMODC + (size_t)(kg * 64) * NMODC + n0 + c4;
        f32x4 a0 = {0.f, 0.f, 0.f, 0.f}, a1 = a0, a2 = a0;
        for (int k = 0; k < 64; k += 16) {
            f32x4 w[16];
#pragma unroll
            for (int j = 0; j < 16; ++j) w[j] = __builtin_nontemporal_load((const f32x4*)(W + (size_t)(k + j) * NMODC));
#pragma unroll
            for (int j = 0; j < 16; ++j) { const int kk = kg * 64 + k + j; a0 += w[j] * sv[kk]; a1 += w[j] * sv[D + kk]; a2 += w[j] * sv[2 * D + kk]; }
        }
        *(LAS f32x4*)(red + (kg * 3 + 0) * 32 + c4) = a0; *(LAS f32x4*)(red + (kg * 3 + 1) * 32 + c4) = a1; *(LAS f32x4*)(red + (kg * 3 + 2) * 32 + c4) = a2;
        __syncthreads();
        if (tid < 96) { const int r = tid >> 5, cc = tid & 31; float s = 0.f;
#pragma unroll 8
            for (int g = 0; g < 64; ++g) s += red[(g * 3 + r) * 32 + cc];
            MOD[((size_t)layer * 3 + r) * NMODC + n0 + cc] = s + a->in[I_ADAB][(size_t)layer * NMODC + n0 + cc]; }
        __syncthreads();
    }
}
template <int GATE_PERM>
__device__ __forceinline__ void transpose_item64(const float* W, int K, int N, bf16* WT, LAS float* scr, int item, int lane, int nblk) {
    const int kb = item / nblk, nb = item % nblk, k0 = 64 * kb, n0 = 64 * nb;
    const int r0 = perm_row<GATE_PERM>(n0);
    const int kq = lane >> 4, j4 = (lane & 15) * 4;
    f32x4 v[16];
#pragma unroll
    for (int i = 0; i < 16; ++i) v[i] = __builtin_nontemporal_load((const f32x4*)(W + (size_t)(k0 + 4 * i + kq) * N + n0 + j4));
#pragma unroll
    for (int i = 0; i < 16; ++i) { LAS float* p = scr + (4 * i + kq) * 65 + j4; p[0] = v[i].x; p[1] = v[i].y; p[2] = v[i].z; p[3] = v[i].w; }
    LDS_WAIT(); asm volatile("" ::: "memory");
    const int c = lane & 7;
#pragma unroll
    for (int j = 0; j < 8; ++j) { const int n = (lane >> 3) + 8 * j; const LAS float* p = scr + (8 * c) * 65 + n;
        v4u o; o.x = pk2(p[0 * 65], p[1 * 65]); o.y = pk2(p[2 * 65], p[3 * 65]); o.z = pk2(p[4 * 65], p[5 * 65]); o.w = pk2(p[6 * 65], p[7 * 65]);
        __builtin_nontemporal_store(o, (v4u*)(WT + (size_t)(r0 + n) * K + k0 + 8 * c)); }
    LDS_WAIT(); asm volatile("" ::: "memory");
}
template <int GATE_PERM>
__device__ __forceinline__ void conv_items(const float* W, int K, int N, bf16* WT, LAS unsigned char* lds, int first, int stride, int lane, int wave) {
    LAS float* scr = (LAS float*)(lds + wave * 16640);
    const int nb64 = N / 64, nitems = (K / 64) * nb64;
    for (int it = first; it < nitems; it += stride) transpose_item64<GATE_PERM>(W, K, N, WT, scr, it, lane, nb64);
    if (N % 64) for (int kb = first; kb < K / 64; kb += stride) p0_transpose_item<GATE_PERM>(W, K, N, WT, scr, kb * (N / 32) + (N / 32 - 1), lane);
}
enum { CV_ABIN = 0, CV_ABOUT, CV_MIN, CV_MOUT, CV_UP0, CV_UP1, CV_DN0, CV_DN1 };
template <int WHICH>
__device__ __forceinline__ void conv_matrix(CArgs a, LAS unsigned char* lds, int first, int stride, int lane, int wave) {
    unsigned char* ws = a->ws;
    if (WHICH == CV_ABIN) conv_items<2>(a->in[I_ABWIN], D, ABIN, (bf16*)(ws + WS_WABIN), lds, first, stride, lane, wave);
    if (WHICH == CV_ABOUT) conv_items<0>(a->in[I_ABWOUT], D, D, (bf16*)(ws + WS_WABOUT), lds, first, stride, lane, wave);
    if (WHICH == CV_MIN) { conv_items<0>(a->in[I_MWIN], D, CIN, (bf16*)(ws + WS_WMIN), lds, first, stride, lane, wave);
        v4u* p = (v4u*)((bf16*)(ws + WS_WMIN) + (size_t)CIN * D); const int n16 = (CINP - CIN) * D * 2 / 16;
        for (int i = first * 64 + lane; i < n16; i += stride * 64) p[i] = (v4u){0u, 0u, 0u, 0u}; }
    if (WHICH == CV_MOUT) conv_items<0>(a->in[I_MWOUT], D, D, (bf16*)(ws + WS_WMOUT), lds, first, stride, lane, wave);
    if (WHICH == CV_UP0) conv_items<1>(a->in[I_FUP], D, DFF2, (bf16*)(ws + WS_WUP0), lds, first, stride, lane, wave);
    if (WHICH == CV_UP1) conv_items<1>(a->in[I_FUP] + (size_t)D * DFF2, D, DFF2, (bf16*)(ws + WS_WUP0 + 172 * MiB), lds, first, stride, lane, wave);
    if (WHICH == CV_DN0) conv_items<0>(a->in[I_FDN], DFF, D, (bf16*)(ws + WS_WDN0), lds, first, stride, lane, wave);
    if (WHICH == CV_DN1) conv_items<0>(a->in[I_FDN] + (size_t)DFF * D, DFF, D, (bf16*)(ws + WS_WDN0 + 86 * MiB), lds, first, stride, lane, wave);
}
__device__ __forceinline__ void p0_prologue(CArgs a, LAS unsigned char* lds, int tid, int lane, int wave) {
    gemv_units(a, lds, 0, blockIdx.x, gridDim.x, tid, lane, wave);
    const int gw = blockIdx.x * NWAVES + wave, NGW = gridDim.x * NWAVES;
    conv_matrix<CV_ABIN>(a, lds, gw, NGW, lane, wave);
#if PROBE_E1
    conv_matrix<CV_ABOUT>(a, lds, gw, NGW, lane, wave);
    conv_matrix<CV_UP0>(a, lds, gw, NGW, lane, wave); conv_matrix<CV_DN0>(a, lds, gw, NGW, lane, wave); conv_matrix<CV_MIN>(a, lds, gw, NGW, lane, wave); conv_matrix<CV_MOUT>(a, lds, gw, NGW, lane, wave);
    conv_matrix<CV_UP1>(a, lds, gw, NGW, lane, wave); conv_matrix<CV_DN1>(a, lds, gw, NGW, lane, wave); __syncthreads(); gemv_units(a, lds, 1, blockIdx.x, gridDim.x, tid, lane, wave);
#endif
}
__device__ __forceinline__ int gemm_wgs(int nwg) { const int G = gridDim.x, rounds = (nwg + G - 1) / G; const int g = ((nwg + rounds - 1) / rounds + 7) & ~7; return g < G ? g : G; }

template <bool RES, bool DOH>
__device__ __forceinline__ void row_phase(LAS unsigned char* lds, int nrows, const float* xin_lat, const float* xin_ctx, float* xout_lat, float* xout_ctx,
                                          const bf16* Y, const float* gpost, const float* modres, int gate_idx,
                                          const float* gpre, const float* modh, int shift_idx, int scale_idx, bf16* H, int tid, int lane, int wave) {
    LAS f32x4* pG = (LAS f32x4*)lds; LAS f32x4* pA = pG + 1024; LAS f32x4* pB = pA + 1024;
    const int G = gridDim.x, rpw = (nrows + G - 1) / G, r0 = (int)blockIdx.x * rpw, r1 = (r0 + rpw < nrows) ? r0 + rpw : nrows;
    for (int vb = r0; vb < r1;) {
        const int mr = vb < ML ? (vb >> 13) : 2;
        const int lim = mr == 0 ? SEQ : (mr == 1 ? ML : nrows), vend = r1 < lim ? r1 : lim;
        __syncthreads();
        for (int i = tid; i < 1024; i += NTHREADS) {
            if (RES) pG[i] = ((const f32x4*)(modres + (size_t)mr * NMODC + gate_idx * D))[i] * ((const f32x4*)gpost)[i];
            if (DOH) { pA[i] = ((const f32x4*)gpre)[i] * (((const f32x4*)(modh + (size_t)mr * NMODC + scale_idx * D))[i] + 1.0f); pB[i] = ((const f32x4*)(modh + (size_t)mr * NMODC + shift_idx * D))[i]; }
        }
        __syncthreads();
        for (int row = vb + wave; row < vend; row += NWAVES) {
            const float* xr = row < ML ? xin_lat + (size_t)row * D : xin_ctx + (size_t)(row - ML) * D;
            f32x4 v[16];
            if (RES) {
                const bf16* yr = Y + (size_t)row * D; float s = 0.f;
#pragma unroll
                for (int j = 0; j < 16; ++j) { const v2u yw = *(const v2u*)(yr + j * 256 + lane * 4); v[j] = (f32x4){bflo(yw.x), bfhi(yw.x), bflo(yw.y), bfhi(yw.y)}; s += (v[j].x * v[j].x + v[j].y * v[j].y) + (v[j].z * v[j].z + v[j].w * v[j].w); }
                const float rstd = 1.0f / sqrtf(wave_sum(s) * (1.0f / D) + EPS);
                float* xo = row < ML ? xout_lat + (size_t)row * D : xout_ctx + (size_t)(row - ML) * D;
#pragma unroll
                for (int j = 0; j < 16; ++j) { const int o = j * 256 + lane * 4;
                    const f32x4 x = *(const f32x4*)(xr + o);
                    v[j] = x + (v[j] * rstd) * pG[j * 64 + lane];
                    *(f32x4*)(xo + o) = v[j];
                    if ((j & 3) == 3) asm volatile("" ::: "memory"); }
            } else {
#pragma unroll
                for (int j = 0; j < 16; ++j) v[j] = *(const f32x4*)(xr + j * 256 + lane * 4);
            }
            if (DOH) {
                float s = 0.f;
#pragma unroll
                for (int j = 0; j < 16; ++j) s += (v[j].x * v[j].x + v[j].y * v[j].y) + (v[j].z * v[j].z + v[j].w * v[j].w);
                const float rstd = 1.0f / sqrtf(wave_sum(s) * (1.0f / D) + EPS);
                bf16* hr = H + (size_t)row * D;
#pragma unroll
                for (int j = 0; j < 16; ++j) { const int o = j * 256 + lane * 4;
                    const f32x4 h = (v[j] * rstd) * pA[j * 64 + lane] + pB[j * 64 + lane];
                    v2u w; w.x = pk2(h.x, h.y); w.y = pk2(h.z, h.w);
                    *(v2u*)(hr + o) = w; }
            }
        }
        vb = vend;
    }
}

__device__ __forceinline__ void mixer_conv_phase(CArgs a, LAS unsigned char* lds, int tid, int lane) {
    const bf16* U = (const bf16*)(a->ws + WS_U);
    bf16* T1 = (bf16*)(a->ws + WS_Y);
    bf16* V = (bf16*)(a->ws + WS_G);
    LAS float* tile = (LAS float*)lds;
    const float* cw = a->in[I_ACONVW]; const float* cb = a->in[I_ACONVB];
    v4u rva[6]; f32x2 w[ACONV]; f32x2 bias = {0.f, 0.f}; int cc_w = -1;
#define MX_ROW(tb_, j_) ((tb_) < 256 ? (((j_) >= 15 && (j_) < 79) ? (tb_) * 64 + ((j_) - 15) : -1) \
        : ((((tb_) - 256) & 3) * 64 + ((j_) - 15) >= 0 && (((tb_) - 256) & 3) * 64 + ((j_) - 15) < CTXL ? ML + (((tb_) - 256) >> 2) * CTXL + (((tb_) - 256) & 3) * 64 + ((j_) - 15) : -1))
#define MX_LOAD(unit_) do { const int tb_ = (unit_) >> 3, cc_ = (unit_) & 7; \
        _Pragma("unroll") for (int q = 0; q < 6; ++q) { const int it = tid + NTHREADS * q; const int j = it >> 5, ch8 = it & 31; const int row = it < 94 * 32 ? MX_ROW(tb_, j) : -1; \
            const size_t o_ = (size_t)(row >= 0 ? row : 0) * ABU + cc_ * 256 + ch8 * 8; rva[q] = *(const v4u*)(U + o_); } } while (0)
    if ((int)blockIdx.x < 264 * 8) MX_LOAD(blockIdx.x);
    for (int unit = blockIdx.x; unit < 264 * 8; unit += gridDim.x) {
        const int tb = unit >> 3, cc = unit & 7;
#pragma unroll
        for (int q = 0; q < 6; ++q) { const int it = tid + NTHREADS * q; const int j = it >> 5, ch8 = it & 31;
            if (it < 94 * 32) { const int row = MX_ROW(tb, j); const float f = row >= 0 ? 1.f : 0.f; const v4u va = rva[q]; f32x4 g0, g1;
                g0.x = f * bflo(va.x); g0.y = f * bfhi(va.x); g0.z = f * bflo(va.y); g0.w = f * bfhi(va.y);
                g1.x = f * bflo(va.z); g1.y = f * bfhi(va.z); g1.z = f * bflo(va.w); g1.w = f * bfhi(va.w);
                *(LAS f32x4*)(tile + j * 256 + ch8 * 8) = g0; *(LAS f32x4*)(tile + j * 256 + ch8 * 8 + 4) = g1; } }
        __syncthreads();
        if (unit + (int)gridDim.x < 264 * 8) MX_LOAD(unit + (int)gridDim.x);
        {
            const int cp = tid & 127, tg = tid >> 7, c = cc * 256 + 2 * cp;
            if (cc != cc_w) { cc_w = cc;
#pragma unroll
                for (int k = 0; k < ACONV; ++k) w[k] = *(const f32x2*)(cw + k * WA + c);
                bias = *(const f32x2*)(cb + c); }
            f32x2 acc[16];
#pragma unroll
            for (int i = 0; i < 16; ++i) acc[i] = (f32x2){0.f, 0.f};
#pragma unroll
            for (int jj = 0; jj < 46; ++jj) {
                const f32x2 g = *(const LAS f32x2*)(tile + (16 * tg + jj) * 256 + 2 * cp);
#pragma unroll
                for (int i = 0; i < 16; ++i) { const int k = jj - i; if (k >= 0 && k < ACONV) acc[i] += w[k] * g; }
            }
            int row0;
            if (tb < 256) row0 = tb * 64 + 16 * tg; else { const int cbk = tb - 256; row0 = ML + (cbk >> 2) * CTXL + (cbk & 3) * 64 + 16 * tg; }
#pragma unroll
            for (int i = 0; i < 16; ++i) { const f32x2 o = acc[i] + bias; *(unsigned*)(T1 + (size_t)(row0 + i) * WA + c) = pk2(o.x, o.y); }
        }
        __syncthreads();
    }
#undef MX_ROW
#undef MX_LOAD
    const float* bw = a->in[I_BCONVW];
    constexpr int NSEG_L = 2 * 64 * 16, NIT_L = NSEG_L * 256, NIT_C = 2 * 32 * 256;
    for (int it = blockIdx.x * NTHREADS + tid; it < NIT_L + NIT_C; it += gridDim.x * NTHREADS) {
        int row0, stride, prow, nrow, c;
        if (it < NIT_L) { const int c8 = it & 255, r = it >> 8, x = r & 63, seg = (r >> 6) & 15, b = r >> 10;
            c = c8 * 8; stride = 64; row0 = b * SEQ + (seg * 8) * 64 + x; prow = seg > 0 ? row0 - 64 : -1; nrow = seg < 15 ? row0 + 8 * 64 : -1; }
        else { const int j = it - NIT_L, c8 = j & 255, r = j >> 8, seg = r & 31, b = r >> 5;
            c = c8 * 8; stride = 1; row0 = ML + b * CTXL + seg * 8; prow = seg > 0 ? row0 - 1 : -1; nrow = seg < 31 ? row0 + 8 : -1; }
        float w[3][8];
#pragma unroll
        for (int k = 0; k < 3; ++k) { const f32x4 w0 = *(const f32x4*)(bw + k * 2048 + c), w1 = *(const f32x4*)(bw + k * 2048 + c + 4);
            w[k][0] = w0.x; w[k][1] = w0.y; w[k][2] = w0.z; w[k][3] = w0.w; w[k][4] = w1.x; w[k][5] = w1.y; w[k][6] = w1.z; w[k][7] = w1.w; }
        const bf16* uz = U + 4096 + c; const bf16* ub = U + 2048 + c;
        v4u rc[10], rb[8];
#pragma unroll
        for (int i = 0; i < 10; ++i) { const int rr = i == 0 ? (prow >= 0 ? prow : row0) : (i == 9 ? (nrow >= 0 ? nrow : row0) : row0 + (i - 1) * stride);
            rc[i] = *(const v4u*)(uz + (size_t)rr * ABU); }
#pragma unroll
        for (int i = 0; i < 8; ++i) rb[i] = *(const v4u*)(ub + (size_t)(row0 + i * stride) * ABU);
        float pp[8], pc[8];
        { float a8[8]; cvt8(rc[0], a8); const float f = prow >= 0 ? 1.f : 0.f;
#pragma unroll
          for (int e = 0; e < 8; ++e) pp[e] = a8[e] * f;
          cvt8(rc[1], pc); }
#pragma unroll
        for (int i = 0; i < 8; ++i) {
            float pn[8], bb[8]; cvt8(rc[i + 2], pn); cvt8(rb[i], bb);
            const float f = (i == 7 && nrow < 0) ? 0.f : 1.f;
#pragma unroll
            for (int e = 0; e < 8; ++e) pn[e] *= f;
            float o[8];
#pragma unroll
            for (int e = 0; e < 8; ++e) o[e] = bb[e] * (w[0][e] * pp[e] + w[1][e] * pc[e] + w[2][e] * pn[e]);
            v4u ov; ov.x = pk2(o[0], o[1]); ov.y = pk2(o[2], o[3]); ov.z = pk2(o[4], o[5]); ov.w = pk2(o[6], o[7]);
            *(v4u*)(V + (size_t)(row0 + i * stride) * D + WA + c) = ov;
#pragma unroll
            for (int e = 0; e < 8; ++e) { pp[e] = pc[e]; pc[e] = pn[e]; }
        }
    }
}
__device__ __forceinline__ void mixer_ln_phase(CArgs a, LAS unsigned char* lds, int tid, int lane, int wave) {
    const bf16* T1 = (const bf16*)(a->ws + WS_Y);
    bf16* V = (bf16*)(a->ws + WS_G);
    LAS f32x4* pg = (LAS f32x4*)lds; LAS f32x4* pb = pg + 512;
    for (int i = tid; i < 512; i += NTHREADS) { pg[i] = ((const f32x4*)a->in[I_ALNG])[i]; pb[i] = ((const f32x4*)a->in[I_ALNB])[i]; }
    __syncthreads();
    const int G = gridDim.x, rpw = (MT + G - 1) / G, r0 = (int)blockIdx.x * rpw, r1 = (r0 + rpw < MT) ? r0 + rpw : MT;
    for (int row = r0 + wave; row < r1; row += NWAVES) {
        f32x4 v[8]; float s = 0.f;
#pragma unroll
        for (int j = 0; j < 8; ++j) { const v2u tw = *(const v2u*)(T1 + (size_t)row * WA + j * 256 + lane * 4); v[j] = (f32x4){bflo(tw.x), bfhi(tw.x), bflo(tw.y), bfhi(tw.y)}; s += (v[j].x + v[j].y) + (v[j].z + v[j].w); }
        const float mu = wave_sum(s) * (1.0f / WA); float q = 0.f;
#pragma unroll
        for (int j = 0; j < 8; ++j) { v[j] = v[j] - mu; q += (v[j].x * v[j].x + v[j].y * v[j].y) + (v[j].z * v[j].z + v[j].w * v[j].w); }
        const float rstd = 1.0f / sqrtf(wave_sum(q) * (1.0f / WA) + EPS);
#pragma unroll
        for (int j = 0; j < 8; ++j) { const int o = j * 256 + lane * 4;
            const f32x4 y = (v[j] * rstd) * pg[j * 64 + lane] + pb[j * 64 + lane];
            v2u w; w.x = pk2(siluf_(y.x), siluf_(y.y)); w.y = pk2(siluf_(y.z), siluf_(y.w));
            *(v2u*)(V + (size_t)row * D + o) = w; }
    }
}

template <int NR>
__device__ __forceinline__ void ffn_gate_slide(const bf16* ug, const bf16* uv, int ldu, bf16* Go, const float* cwg, const float* cwv, int row0, int prow, int nrow) {
    float wg[3][8], wv[3][8];
#pragma unroll
    for (int k = 0; k < 3; ++k) {
        const f32x4 a0 = *(const f32x4*)(cwg + k * DFF2), a1 = *(const f32x4*)(cwg + k * DFF2 + 4), b0 = *(const f32x4*)(cwv + k * DFF2), b1 = *(const f32x4*)(cwv + k * DFF2 + 4);
        wg[k][0] = a0.x; wg[k][1] = a0.y; wg[k][2] = a0.z; wg[k][3] = a0.w; wg[k][4] = a1.x; wg[k][5] = a1.y; wg[k][6] = a1.z; wg[k][7] = a1.w;
        wv[k][0] = b0.x; wv[k][1] = b0.y; wv[k][2] = b0.z; wv[k][3] = b0.w; wv[k][4] = b1.x; wv[k][5] = b1.y; wv[k][6] = b1.z; wv[k][7] = b1.w;
    }
    float pg[8], pv[8], cg[8], cv[8];
    { const float fp = prow >= 0 ? 1.f : 0.f; const int pr = prow >= 0 ? prow : row0;
      const v4u a = *(const v4u*)(ug + (size_t)pr * ldu), b = *(const v4u*)(uv + (size_t)pr * ldu); cvt8(a, pg); cvt8(b, pv);
#pragma unroll
      for (int e = 0; e < 8; ++e) { pg[e] *= fp; pv[e] *= fp; }
      const v4u a2 = *(const v4u*)(ug + (size_t)row0 * ldu), b2 = *(const v4u*)(uv + (size_t)row0 * ldu); cvt8(a2, cg); cvt8(b2, cv); }
    const float fn = nrow >= 0 ? 1.f : 0.f; const int nr = nrow >= 0 ? nrow : row0;
    for (int blk = 0; blk < NR / 4; ++blk) {
        v4u rg[4], rv[4];
#pragma unroll
        for (int i = 0; i < 4; ++i) { const int r = 4 * blk + 1 + i; const int rr = r < NR ? row0 + r : nr;
            rg[i] = *(const v4u*)(ug + (size_t)rr * ldu); rv[i] = *(const v4u*)(uv + (size_t)rr * ldu); }
#pragma unroll
        for (int i = 0; i < 4; ++i) {
            float ng[8], nv[8]; cvt8(rg[i], ng); cvt8(rv[i], nv);
            if (i == 3) { const float f = (4 * blk + 4 < NR) ? 1.f : fn;
#pragma unroll
                for (int e = 0; e < 8; ++e) { ng[e] *= f; nv[e] *= f; } }
            float o[8];
#pragma unroll
            for (int e = 0; e < 8; ++e) { const float g = wg[0][e] * pg[e] + wg[1][e] * cg[e] + wg[2][e] * ng[e], v = wv[0][e] * pv[e] + wv[1][e] * cv[e] + wv[2][e] * nv[e]; o[e] = siluf_(g) * v; }
            v4u w; w.x = pk2(o[0], o[1]); w.y = pk2(o[2], o[3]); w.z = pk2(o[4], o[5]); w.w = pk2(o[6], o[7]);
            *(v4u*)(Go + (size_t)(4 * blk + i) * DFF) = w;
#pragma unroll
            for (int e = 0; e < 8; ++e) { pg[e] = cg[e]; pv[e] = cv[e]; cg[e] = ng[e]; cv[e] = nv[e]; }
        }
    }
}
__device__ __forceinline__ void ffn_gate_ctx_phase(CArgs a, int tid) {
    const bf16* UC = (const bf16*)(a->ws + WS_UC);
    bf16* G = (bf16*)(a->ws + WS_G);
    const float* cw = a->in[I_FCONV];
    constexpr int NC8 = DFF / 8;
    constexpr int NIT = 8 * NC8 * 4, PER = (NIT + 255) / 256;
    for (int it = blockIdx.x * PER + tid; tid < PER && it < NIT; it += gridDim.x * PER) {
        const int q4 = it & 3, rest = it >> 2, c8 = rest % NC8, blk = rest / NC8, ch = c8 * 8;
        const int p0 = (blk & 3) * 64 + q4 * 16, lrow0 = (blk >> 2) * CTXL + p0;
        const bf16* ug = UC + 256 * (ch >> 7) + (ch & 127);
        ffn_gate_slide<16>(ug, ug + 128, DFF2, G + (size_t)(ML + lrow0) * DFF + ch, cw + ch, cw + DFF + ch, lrow0, p0 > 0 ? lrow0 - 1 : -1, p0 + 16 < CTXL ? lrow0 + 16 : -1);
    }
}

__device__ __forceinline__ int chunk_row0(int dir, int b, int c) {
    if (dir == 0) return c < 2 ? ML + b * CTXL + 128 * c : b * SEQ + 128 * (c - 2);
    return c < 2 ? ML + b * CTXL + 128 * (1 - c) : b * SEQ + 128 * (63 - (c - 2));
}
__device__ __forceinline__ float wave_incl_sum(float v, int lane) {
#pragma unroll
    for (int o = 1; o < 64; o <<= 1) { const float t = __shfl_up(v, o); if (lane >= o) v += t; }
    return v;
}
__device__ __forceinline__ float wave_incl_max(float v, int lane) {
#pragma unroll
    for (int o = 1; o < 64; o <<= 1) { const float t = __shfl_up(v, o); if (lane >= o) v = fmaxf(v, t); }
    return v;
}
__device__ __forceinline__ bf16x8 tr_frag(LAS unsigned char* T, int pitch, int k0, int col0, int lane) {
    const int g = lane >> 4, q = (lane & 15) >> 2, p = lane & 3;
    LAS unsigned char* p0 = T + (k0 + 8 * g + q) * pitch + (col0 + 4 * p) * 2;
    const s16x4 lo = __builtin_amdgcn_ds_read_tr16_b64_v4i16((LAS s16x4*)p0);
    const s16x4 hi = __builtin_amdgcn_ds_read_tr16_b64_v4i16((LAS s16x4*)(p0 + 4 * pitch));
    bf16x8 r; r[0] = lo[0]; r[1] = lo[1]; r[2] = lo[2]; r[3] = lo[3]; r[4] = hi[0]; r[5] = hi[1]; r[6] = hi[2]; r[7] = hi[3];
    return r;
}
#ifndef SCAN_REP
#define SCAN_REP 1
#endif
#define MFMA16(y, x, acc) __builtin_amdgcn_mfma_f32_16x16x32_bf16((y), (x), (acc), 0, 0, 0)

constexpr int SK_PITCH = 528;

constexpr size_t WS_SPP = WS_Y;
constexpr size_t WS_DEN = WS_Y + 64 * MiB;
static_assert((size_t)32 * 64 * 128 * 128 * 2 <= 64 * MiB && WS_DEN + (size_t)32 * 64 * 128 * 4 <= WS_HS, "scan scratch");
__device__ __forceinline__ void chunk_scalars(CArgs a, int dir, int b, int h, int c, LAS float* sAl, LAS float* sPl, int lane) {
    const float* GT = (const float*)(a->ws + WS_GATES);
    float* SCP = (float*)(a->ws + WS_SCP); float* SCG = (float*)(a->ws + WS_SCC);
    const int chain = dir * 16 + b * 8 + h, R0 = chunk_row0(dir, b, c);
    const float bi = a->in[I_MBG][dir * 16 + h], bf = a->in[I_MBG][dir * 16 + 8 + h];
    const int r0 = dir ? 127 - lane : lane, r1 = dir ? 63 - lane : 64 + lane;
    const float i0 = GT[(size_t)(R0 + r0) * 32 + dir * 16 + h] + bi, i1 = GT[(size_t)(R0 + r1) * 32 + dir * 16 + h] + bi;
    const float x0 = GT[(size_t)(R0 + r0) * 32 + dir * 16 + 8 + h] + bf, x1 = GT[(size_t)(R0 + r1) * 32 + dir * 16 + 8 + h] + bf;
    const float f0 = fminf(x0, 0.f) - log1pf(__expf(-fabsf(x0))), f1 = fminf(x1, 0.f) - log1pf(__expf(-fabsf(x1)));
    const float s0 = wave_incl_sum(f0, lane); const float tot0 = __shfl(s0, 63);
    const float s1 = wave_incl_sum(f1, lane) + tot0;
    const float a0 = i0 - s0, a1 = i1 - s1;
    const float p0 = wave_incl_max(a0, lane); const float pm0 = __shfl(p0, 63);
    const float p1 = fmaxf(wave_incl_max(a1, lane), pm0);
    float* o = SCP + ((size_t)chain * NCH + c) * 384;
    o[r0] = a0; o[128 + r0] = p0; o[256 + r0] = s0;
    o[r1] = a1; o[128 + r1] = p1; o[256 + r1] = s1;
    if (sAl) { sAl[r0] = a0; sAl[r1] = a1; }
    if (lane == 63) { SCG[((size_t)chain * NCH + c) * 2] = s1; SCG[((size_t)chain * NCH + c) * 2 + 1] = p1; if (sPl) sPl[0] = p1; }
}
__device__ __forceinline__ void scan_pre_phase(CArgs a, LAS unsigned char* lds, int tid, int lane, int wave) {
    const bf16* QK = (const bf16*)(a->ws + WS_U);
    bf16* SPP = (bf16*)(a->ws + WS_SPP); float* DEN = (float*)(a->ws + WS_DEN);
    LAS unsigned char* Kl = lds; LAS float* sA0 = (LAS float*)(lds + 67584); LAS float* sA1 = sA0 + 128; LAS float* sPt = sA0 + 256;
    const int g = lane >> 4, l15 = lane & 15;
    for (int unit = blockIdx.x; unit < 1024 + 64; unit += gridDim.x) {
        if (unit >= 1024) { if (wave == 0) { const int u = unit - 1024, chain = u >> 1, c = u & 1; chunk_scalars(a, chain >> 4, (chain >> 3) & 1, chain & 7, c, nullptr, nullptr, lane); } continue; }
        const int bh = unit >> 6, j = unit & 63, b = bh >> 3, h = bh & 7;
        const int R0 = b * SEQ + 128 * j, c0 = 2 + j, c1 = 2 + (63 - j);
        const int tl = 16 * wave + l15;
#pragma unroll
        for (int i = 0; i < 8; ++i) { const int idx = tid + NTHREADS * i, r = idx >> 5, ch = idx & 31;
            const v4u v = *(const v4u*)(QK + (size_t)(R0 + r) * QKVO + 2048 + h * DQK + ch * 8);
            *(LAS v4u*)(Kl + r * SK_PITCH + ch * 16) = v; }
        bf16x8 qf[8];
#pragma unroll
        for (int kk = 0; kk < 8; ++kk) qf[kk] = *(const bf16x8*)(QK + (size_t)(R0 + tl) * QKVO + h * DQK + 32 * kk + 8 * g);
        if (wave == 0) chunk_scalars(a, 0, b, h, c0, sA0, sPt, lane);
        if (wave == 1) chunk_scalars(a, 1, b, h, c1, sA1, sPt + 1, lane);
        __syncthreads();
        {
            const float pt0 = sPt[0], pt1 = sPt[1];
            float dp0 = 0.f, dp1 = 0.f;
            int tlv = tl, gv = 4 * g; asm volatile("" : "+v"(tlv), "+v"(gv));
            bf16* sp0 = SPP + ((size_t)((0 * 16 + bh) * 64 + (c0 - 2)) * 128 + tl) * 128;
            bf16* sp1 = SPP + ((size_t)((1 * 16 + bh) * 64 + (c1 - 2)) * 128 + tl) * 128;
#pragma unroll
            for (int nh = 0; nh < 2; ++nh) {
                f32x4 sacc[4];
#pragma unroll
                for (int n = 0; n < 4; ++n) sacc[n] = (f32x4){0.f, 0.f, 0.f, 0.f};
#pragma unroll
                for (int kk = 0; kk < 8; ++kk)
#pragma unroll
                    for (int n = 0; n < 4; ++n) { const bf16x8 yf = *(const LAS bf16x8*)(Kl + (16 * (4 * nh + n) + l15) * SK_PITCH + (32 * kk + 8 * g) * 2); sacc[n] = MFMA16(yf, qf[kk], sacc[n]); }
#pragma unroll
                for (int n = 0; n < 4; ++n) { float sv0[4], sv1[4]; const int n8 = 4 * nh + n;
#pragma unroll
                    for (int r = 0; r < 4; ++r) { const int sl = 16 * n8 + 4 * g + r; const int sidx = gv + (16 * n8 + r);
                        const float qk = sacc[n][r] * 0.0625f;
                        sv0[r] = (sidx <= tlv) ? qk * __expf(sA0[sl] - pt0) : 0.f; dp0 += sv0[r];
                        sv1[r] = (sidx >= tlv) ? qk * __expf(sA1[sl] - pt1) : 0.f; dp1 += sv1[r]; }
                    v2u w0; w0.x = pk2(sv0[0], sv0[1]); w0.y = pk2(sv0[2], sv0[3]); *(v2u*)(sp0 + 16 * n8 + 4 * g) = w0;
                    v2u w1; w1.x = pk2(sv1[0], sv1[1]); w1.y = pk2(sv1[2], sv1[3]); *(v2u*)(sp1 + 16 * n8 + 4 * g) = w1; }
                asm volatile("" ::: "memory");
            }
            dp0 += __shfl_xor(dp0, 16); dp0 += __shfl_xor(dp0, 32); dp1 += __shfl_xor(dp1, 16); dp1 += __shfl_xor(dp1, 32);
            if (g == 0) { DEN[(size_t)((0 * 16 + bh) * 64 + (c0 - 2)) * 128 + tl] = dp0; DEN[(size_t)((1 * 16 + bh) * 64 + (c1 - 2)) * 128 + tl] = dp1; }
        }
        __syncthreads();
    }
}

constexpr int S2V_PITCH = 160;
constexpr int S2K_PITCH = 544;
__device__ __forceinline__ int s2_sigma(int r) { return (r & ~12) | ((r & 4) << 1) | ((r & 8) >> 1); }
__device__ __forceinline__ bf16x8 tr_frag_sw(LAS unsigned char* T, int pitch, int k0, int col0, int lane) {
    const int g = lane >> 4, q = (lane & 15) >> 2, p = lane & 3;
    LAS unsigned char* p0 = T + (k0 + 16 * (g >> 1) + 4 * (g & 1) + q) * pitch + (col0 + 4 * p) * 2;
    const s16x4 lo = __builtin_amdgcn_ds_read_tr16_b64_v4i16((LAS s16x4*)p0);
    const s16x4 hi = __builtin_amdgcn_ds_read_tr16_b64_v4i16((LAS s16x4*)(p0 + 8 * pitch));
    bf16x8 r; r[0] = lo[0]; r[1] = lo[1]; r[2] = lo[2]; r[3] = lo[3]; r[4] = hi[0]; r[5] = hi[1]; r[6] = hi[2]; r[7] = hi[3];
    return r;
}
constexpr int S2K_OFF = 0, S2V_OFF = 128 * S2K_PITCH, S2S_OFF = S2V_OFF + 128 * S2V_PITCH, S2C_OFF = S2S_OFF + 128 * S2V_PITCH, S2M_OFF = S2C_OFF + 80 * SK_PITCH;
static_assert(S2M_OFF + 4 * 272 <= MISC_OFF, "scan v2 LDS map");
#define SCHED_FENCE() do { } while (0)
#define LDS_BARRIER() do { asm volatile("s_waitcnt lgkmcnt(0)" ::: "memory"); __builtin_amdgcn_s_barrier(); asm volatile("" ::: "memory"); } while (0)
__device__ __forceinline__ void scan_seq_phase(CArgs a, LAS unsigned char* lds, int tid, int lane, int wave) {
    const bf16* QK = (const bf16*)(a->ws + WS_U);
    const float* SCP = (const float*)(a->ws + WS_SCP); const float* SCG = (const float*)(a->ws + WS_SCC);
    const bf16* SPP = (const bf16*)(a->ws + WS_SPP); const float* DEN = (const float*)(a->ws + WS_DEN);
    bf16* HS = (bf16*)(a->ws + WS_HS);
    LAS unsigned char* Kl = lds + S2K_OFF; LAS unsigned char* Vl = lds + S2V_OFF; LAS unsigned char* Vs = lds + S2S_OFF; LAS unsigned char* Cl = lds + S2C_OFF;
    LAS float* mp = (LAS float*)(lds + S2M_OFF); LAS float* ml = mp + 68; LAS float* pt = mp + 136; LAS float* gl = mp + 204;
    for (int unit_ = blockIdx.x; unit_ < 256 * SCAN_REP; unit_ += gridDim.x) { const int u0 = unit_ & 255, unit = ((u0 & 7) << 5) | (u0 >> 3);
        const int chain = unit >> 3, slice = unit & 7, dir = chain >> 4, b = (chain >> 3) & 1, h = chain & 7;
        int tid_u = tid; asm volatile("" : "+v"(tid_u));
        if (tid < NCH) { gl[tid] = SCG[((size_t)chain * NCH + tid) * 2]; pt[tid] = SCG[((size_t)chain * NCH + tid) * 2 + 1]; }
        for (int i = tid_u; i < 80 * SK_PITCH / 4; i += NTHREADS) ((LAS unsigned*)Cl)[i] = 0u;
        for (int i = tid_u; i < 128 * 8; i += NTHREADS) { const int r = i >> 3, w = i & 7; ((LAS unsigned*)(Vs + r * S2V_PITCH + 128))[w] = 0u; }
        __syncthreads();
        if (tid == 0) { float m = 0.f; for (int c = 0; c < NCH; ++c) { const float mx = fmaxf(m, pt[c]); mp[c] = m; ml[c] = mx; m = gl[c] + mx; } }
        __syncthreads();
        f32x4 cacc[5][2];
#pragma unroll
        for (int mt = 0; mt < 5; ++mt)
#pragma unroll
            for (int nt = 0; nt < 2; ++nt) cacc[mt][nt] = (f32x4){0.f, 0.f, 0.f, 0.f};
        v4u kreg[8], vreg[2]; float areg[2];
#define S2_LOAD(cc, T) do { const unsigned koff = (unsigned)((((T) >> 5) * QKVO + ((T) & 31) * 8) * 2), voff = (unsigned)((((T) >> 3) * QKVO + ((T) & 7) * 8) * 2); const int R1_ = chunk_row0(dir, b, (cc)); const char* kb_ = (const char*)(QK + (size_t)R1_ * QKVO + 2048 + h * DQK); const char* vb_ = (const char*)(QK + (size_t)R1_ * QKVO + 4096 + h * DV + slice * 64); \
            const float* ab_ = SCP + ((size_t)chain * NCH + (cc)) * 384; \
            _Pragma("unroll") for (int i = 0; i < 8; ++i) kreg[i] = *(const v4u*)(kb_ + (koff + (unsigned)(i * 16 * QKVO * 2))); \
            _Pragma("unroll") for (int i = 0; i < 2; ++i) { vreg[i] = *(const v4u*)(vb_ + (voff + (unsigned)(i * 64 * QKVO * 2))); areg[i] = ab_[((T) >> 3) + 64 * i]; } } while (0)
#define S2_STORE(cc, T) do { const float mlc_ = ml[(cc)]; \
            _Pragma("unroll") for (int i = 0; i < 8; ++i) { const int idx = (T) + NTHREADS * i, r = idx >> 5, ch = idx & 31; *(LAS v4u*)(Kl + s2_sigma(r) * S2K_PITCH + ch * 16) = kreg[i]; } \
            _Pragma("unroll") for (int i = 0; i < 2; ++i) { const int idx = (T) + NTHREADS * i, r = idx >> 3, ch = idx & 7; const float ws_ = __expf(areg[i] - mlc_) * 0.0625f;     \
                *(LAS v4u*)(Vl + s2_sigma(r) * S2V_PITCH + ch * 16) = vreg[i]; \
                v4u sc_; sc_.x = pk2(bflo(vreg[i].x) * ws_, bfhi(vreg[i].x) * ws_); sc_.y = pk2(bflo(vreg[i].y) * ws_, bfhi(vreg[i].y) * ws_); sc_.z = pk2(bflo(vreg[i].z) * ws_, bfhi(vreg[i].z) * ws_); sc_.w = pk2(bflo(vreg[i].w) * ws_, bfhi(vreg[i].w) * ws_); \
                *(LAS v4u*)(Vs + s2_sigma(r) * S2V_PITCH + ch * 16) = sc_; \
                if (ch == 0) *(LAS unsigned*)(Vs + s2_sigma(r) * S2V_PITCH + 128) = f2bf(ws_); } } while (0)
        S2_LOAD(0, tid_u); S2_STORE(0, tid_u);
        __syncthreads();
#define S2_OUTP false
        for (int c = 0; c < 2; ++c) {
            const int R0 = chunk_row0(dir, b, c);
            const float m_prev = mp[c], m_last = ml[c], ptot = pt[c];
            constexpr bool outp = S2_OUTP; const bool more = (c + 1 < NCH);
            int tid_o = tid; asm volatile("" : "+v"(tid_o));
            const int lane_o = tid_o & 63, g = lane_o >> 4, l15 = lane_o & 15, tl = 16 * wave + l15;
            bf16x8 qf[8], sf[4]; float pv = 0.f, bv = 0.f, dn = 0.f;
            v2u hw[4] = {{0u, 0u}, {0u, 0u}, {0u, 0u}, {0u, 0u}}; v4u hv[2] = {{0u, 0u, 0u, 0u}, {0u, 0u, 0u, 0u}};
            if (outp) {
                const char* qb = (const char*)(QK + (size_t)R0 * QKVO + h * DQK); const unsigned qoff = (unsigned)((tl * QKVO + 8 * g) * 2);
#pragma unroll
                for (int kk = 0; kk < 8; ++kk) qf[kk] = *(const bf16x8*)(qb + (qoff + (unsigned)(kk * 64)));
                const float* scp = SCP + ((size_t)chain * NCH + c) * 384;
                pv = scp[128 + tl]; bv = scp[256 + tl]; dn = DEN[(size_t)(chain * 64 + (c - 2)) * 128 + tl];
            }
            SCHED_FENCE();
            const float w_old = __expf(m_prev - m_last);
#pragma unroll
            for (int mt = 0; mt < 5; ++mt)
#pragma unroll
                for (int nt = 0; nt < 2; ++nt) cacc[mt][nt] = cacc[mt][nt] * w_old;
#pragma unroll
            for (int kk = 0; kk < 4; ++kk) {
                bf16x8 yf[2], xf[5];
#pragma unroll
                for (int nt = 0; nt < 2; ++nt) yf[nt] = tr_frag_sw(Kl, S2K_PITCH, 32 * kk, 32 * wave + 16 * nt, lane_o);
#pragma unroll
                for (int mt = 0; mt < 5; ++mt) xf[mt] = tr_frag_sw(Vs, S2V_PITCH, 32 * kk, 16 * mt, lane_o);
                SCHED_FENCE();
#pragma unroll
                for (int mt = 0; mt < 5; ++mt)
#pragma unroll
                    for (int nt = 0; nt < 2; ++nt) cacc[mt][nt] = MFMA16(yf[nt], xf[mt], cacc[mt][nt]);
                SCHED_FENCE();
            }
            if (outp) { const char* sb = (const char*)(SPP + (size_t)(chain * 64 + (c - 2)) * 128 * 128); const unsigned soff = (unsigned)((tl * 128 + 8 * g) * 2);
#pragma unroll
                for (int kk = 0; kk < 4; ++kk) sf[kk] = *(const bf16x8*)(sb + (soff + (unsigned)(kk * 64))); }
            if (more) S2_LOAD(c + 1, tid_o);
            SCHED_FENCE();
            if (outp) {
                f32x4 qacc[5];
#pragma unroll
                for (int n = 0; n < 5; ++n) qacc[n] = (f32x4){0.f, 0.f, 0.f, 0.f};
#pragma unroll
                for (int kk = 0; kk < 8; ++kk) {
                    bf16x8 cf[5];
#pragma unroll
                    for (int n = 0; n < 5; ++n) cf[n] = *(const LAS bf16x8*)(Cl + (16 * n + l15) * SK_PITCH + (32 * kk + 8 * g) * 2);
                    SCHED_FENCE();
#pragma unroll
                    for (int n = 0; n < 5; ++n) qacc[n] = MFMA16(cf[n], qf[kk], qacc[n]);
                    SCHED_FENCE();
                }
                f32x4 nacc[4];
#pragma unroll
                for (int n = 0; n < 4; ++n) nacc[n] = (f32x4){0.f, 0.f, 0.f, 0.f};
#pragma unroll
                for (int k2 = 0; k2 < 4; k2 += 2) {
                    bf16x8 vf[2][4];
#pragma unroll
                    for (int u = 0; u < 2; ++u)
#pragma unroll
                        for (int n = 0; n < 4; ++n) vf[u][n] = tr_frag_sw(Vl, S2V_PITCH, 32 * (k2 + u), 16 * n, lane_o);
                    SCHED_FENCE();
#pragma unroll
                    for (int u = 0; u < 2; ++u)
#pragma unroll
                        for (int n = 0; n < 4; ++n) nacc[n] = MFMA16(vf[u][n], sf[k2 + u], nacc[n]);
                    SCHED_FENCE();
                }
                const float mxt = fmaxf(m_prev, pv), rowfac = __expf(ptot - mxt), winter = __expf(m_prev - mxt);
                const float nq = __shfl(qacc[4][0], l15);
                const float den = rowfac * dn + winter * nq;
                const float inv = 1.0f / fmaxf(fabsf(den), __expf(-bv - mxt));
#pragma unroll
                for (int n = 0; n < 4; ++n) { const f32x4 o = (nacc[n] * rowfac + qacc[n] * winter) * inv; hw[n].x = pk2(o.x, o.y); hw[n].y = pk2(o.z, o.w); }
                bf16* hp = HS + ((size_t)dir * ML + R0 + tl) * D + h * DV + slice * 64 + 8 * g;
                const int src0 = l15 + 16 * (2 * (g & 1)), src1 = src0 + 16; const bool hi_n = (g >> 1) != 0;
#pragma unroll
                for (int k = 0; k < 2; ++k) {
                    const unsigned a0x = __shfl(hw[2 * k].x, src0), a0y = __shfl(hw[2 * k].y, src0), a1x = __shfl(hw[2 * k].x, src1), a1y = __shfl(hw[2 * k].y, src1);
                    const unsigned b0x = __shfl(hw[2 * k + 1].x, src0), b0y = __shfl(hw[2 * k + 1].y, src0), b1x = __shfl(hw[2 * k + 1].x, src1), b1y = __shfl(hw[2 * k + 1].y, src1);
                    hv[k].x = hi_n ? b0x : a0x; hv[k].y = hi_n ? b0y : a0y; hv[k].z = hi_n ? b1x : a1x; hv[k].w = hi_n ? b1y : a1y;
                    *(v4u*)(hp + 32 * k) = hv[k]; }
            }
            LDS_BARRIER();
#pragma unroll
            for (int mt = 0; mt < 5; ++mt)
#pragma unroll
                for (int nt = 0; nt < 2; ++nt) { v2u w; w.x = pk2(cacc[mt][nt][0], cacc[mt][nt][1]); w.y = pk2(cacc[mt][nt][2], cacc[mt][nt][3]);
                    *(LAS v2u*)(Cl + (16 * mt + l15) * SK_PITCH + (32 * wave + 16 * nt + 4 * g) * 2) = w; }
            if (more) S2_STORE(c + 1, tid_o);
            asm volatile("" :: "v"(hv[0]), "v"(hv[1]));
            LDS_BARRIER();
                }
#undef S2_OUTP
#define S2_OUTP true
        for (int c = 2; c < NCH; ++c) {
            const int R0 = chunk_row0(dir, b, c);
            const float m_prev = mp[c], m_last = ml[c], ptot = pt[c];
            constexpr bool outp = S2_OUTP; const bool more = (c + 1 < NCH);
            int tid_o = tid; asm volatile("" : "+v"(tid_o));
            const int lane_o = tid_o & 63, g = lane_o >> 4, l15 = lane_o & 15, tl = 16 * wave + l15;
            bf16x8 qf[8], sf[4]; float pv = 0.f, bv = 0.f, dn = 0.f;
            v2u hw[4] = {{0u, 0u}, {0u, 0u}, {0u, 0u}, {0u, 0u}}; v4u hv[2] = {{0u, 0u, 0u, 0u}, {0u, 0u, 0u, 0u}};
            if (outp) {
                const char* qb = (const char*)(QK + (size_t)R0 * QKVO + h * DQK); const unsigned qoff = (unsigned)((tl * QKVO + 8 * g) * 2);
#pragma unroll
                for (int kk = 0; kk < 8; ++kk) qf[kk] = *(const bf16x8*)(qb + (qoff + (unsigned)(kk * 64)));
                const float* scp = SCP + ((size_t)chain * NCH + c) * 384;
                pv = scp[128 + tl]; bv = scp[256 + tl]; dn = DEN[(size_t)(chain * 64 + (c - 2)) * 128 + tl];
            }
            SCHED_FENCE();
            const float w_old = __expf(m_prev - m_last);
#pragma unroll
            for (int mt = 0; mt < 5; ++mt)
#pragma unroll
                for (int nt = 0; nt < 2; ++nt) cacc[mt][nt] = cacc[mt][nt] * w_old;
#pragma unroll
            for (int kk = 0; kk < 4; ++kk) {
                bf16x8 yf[2], xf[5];
#pragma unroll
                for (int nt = 0; nt < 2; ++nt) yf[nt] = tr_frag_sw(Kl, S2K_PITCH, 32 * kk, 32 * wave + 16 * nt, lane_o);
#pragma unroll
                for (int mt = 0; mt < 5; ++mt) xf[mt] = tr_frag_sw(Vs, S2V_PITCH, 32 * kk, 16 * mt, lane_o);
                SCHED_FENCE();
#pragma unroll
                for (int mt = 0; mt < 5; ++mt)
#pragma unroll
                    for (int nt = 0; nt < 2; ++nt) cacc[mt][nt] = MFMA16(yf[nt], xf[mt], cacc[mt][nt]);
                SCHED_FENCE();
            }
            if (outp) { const char* sb = (const char*)(SPP + (size_t)(chain * 64 + (c - 2)) * 128 * 128); const unsigned soff = (unsigned)((tl * 128 + 8 * g) * 2);
#pragma unroll
                for (int kk = 0; kk < 4; ++kk) sf[kk] = *(const bf16x8*)(sb + (soff + (unsigned)(kk * 64))); }
            if (more) S2_LOAD(c + 1, tid_o);
            SCHED_FENCE();
            if (outp) {
                f32x4 qacc[5];
#pragma unroll
                for (int n = 0; n < 5; ++n) qacc[n] = (f32x4){0.f, 0.f, 0.f, 0.f};
#pragma unroll
                for (int kk = 0; kk < 8; ++kk) {
                    bf16x8 cf[5];
#pragma unroll
                    for (int n = 0; n < 5; ++n) cf[n] = *(const LAS bf16x8*)(Cl + (16 * n + l15) * SK_PITCH + (32 * kk + 8 * g) * 2);
                    SCHED_FENCE();
#pragma unroll
                    for (int n = 0; n < 5; ++n) qacc[n] = MFMA16(cf[n], qf[kk], qacc[n]);
                    SCHED_FENCE();
                }
                f32x4 nacc[4];
#pragma unroll
                for (int n = 0; n < 4; ++n) nacc[n] = (f32x4){0.f, 0.f, 0.f, 0.f};
#pragma unroll
                for (int k2 = 0; k2 < 4; k2 += 2) {
                    bf16x8 vf[2][4];
#pragma unroll
                    for (int u = 0; u < 2; ++u)
#pragma unroll
                        for (int n = 0; n < 4; ++n) vf[u][n] = tr_frag_sw(Vl, S2V_PITCH, 32 * (k2 + u), 16 * n, lane_o);
                    SCHED_FENCE();
#pragma unroll
                    for (int u = 0; u < 2; ++u)
#pragma unroll
                        for (int n = 0; n < 4; ++n) nacc[n] = MFMA16(vf[u][n], sf[k2 + u], nacc[n]);
                    SCHED_FENCE();
                }
                const float mxt = fmaxf(m_prev, pv), rowfac = __expf(ptot - mxt), winter = __expf(m_prev - mxt);
                const float nq = __shfl(qacc[4][0], l15);
                const float den = rowfac * dn + winter * nq;
                const float inv = 1.0f / fmaxf(fabsf(den), __expf(-bv - mxt));
#pragma unroll
                for (int n = 0; n < 4; ++n) { const f32x4 o = (nacc[n] * rowfac + qacc[n] * winter) * inv; hw[n].x = pk2(o.x, o.y); hw[n].y = pk2(o.z, o.w); }
                bf16* hp = HS + ((size_t)dir * ML + R0 + tl) * D + h * DV + slice * 64 + 8 * g;
                const int src0 = l15 + 16 * (2 * (g & 1)), src1 = src0 + 16; const bool hi_n = (g >> 1) != 0;
#pragma unroll
                for (int k = 0; k < 2; ++k) {
                    const unsigned a0x = __shfl(hw[2 * k].x, src0), a0y = __shfl(hw[2 * k].y, src0), a1x = __shfl(hw[2 * k].x, src1), a1y = __shfl(hw[2 * k].y, src1);
                    const unsigned b0x = __shfl(hw[2 * k + 1].x, src0), b0y = __shfl(hw[2 * k + 1].y, src0), b1x = __shfl(hw[2 * k + 1].x, src1), b1y = __shfl(hw[2 * k + 1].y, src1);
                    hv[k].x = hi_n ? b0x : a0x; hv[k].y = hi_n ? b0y : a0y; hv[k].z = hi_n ? b1x : a1x; hv[k].w = hi_n ? b1y : a1y;
                    *(v4u*)(hp + 32 * k) = hv[k]; }
            }
            LDS_BARRIER();
#pragma unroll
            for (int mt = 0; mt < 5; ++mt)
#pragma unroll
                for (int nt = 0; nt < 2; ++nt) { v2u w; w.x = pk2(cacc[mt][nt][0], cacc[mt][nt][1]); w.y = pk2(cacc[mt][nt][2], cacc[mt][nt][3]);
                    *(LAS v2u*)(Cl + (16 * mt + l15) * SK_PITCH + (32 * wave + 16 * nt + 4 * g) * 2) = w; }
            if (more) S2_STORE(c + 1, tid_o);
            asm volatile("" :: "v"(hv[0]), "v"(hv[1]));
            LDS_BARRIER();
                }
#undef S2_OUTP
#undef S2_LOAD
#undef S2_STORE
    }
}

__device__ __forceinline__ void scan_out_phase(CArgs a, LAS unsigned char* lds, int tid, int lane, int wave) {
    const bf16* HS = (const bf16*)(a->ws + WS_HS);
    const bf16* QK = (const bf16*)(a->ws + WS_U);
    bf16* A2 = (bf16*)(a->ws + WS_G);
    LAS f32x4* pg = (LAS f32x4*)lds;
    for (int i = tid; i < 1024; i += NTHREADS) pg[i] = ((const f32x4*)a->in[I_MHNG])[i];
    __syncthreads();
    const int G = gridDim.x, rpw = (ML + G - 1) / G, r0 = (int)blockIdx.x * rpw, r1 = (r0 + rpw < ML) ? r0 + rpw : ML;
    for (int row = r0 + wave; row < r1; row += NWAVES) {
#pragma unroll 2
        for (int h = 0; h < HEADS; ++h) {
            f32x4 v[2]; float s = 0.f;
#pragma unroll
            for (int j = 0; j < 2; ++j) { const int o = h * DV + j * 256 + lane * 4;
                const v2u hf = *(const v2u*)(HS + (size_t)row * D + o), hb = *(const v2u*)(HS + ((size_t)ML + row) * D + o);
                v[j] = (f32x4){bflo(hf.x) + bflo(hb.x), bfhi(hf.x) + bfhi(hb.x), bflo(hf.y) + bflo(hb.y), bfhi(hf.y) + bfhi(hb.y)};
                s += (v[j].x * v[j].x + v[j].y * v[j].y) + (v[j].z * v[j].z + v[j].w * v[j].w); }
            const float rstd = 1.0f / sqrtf(wave_sum(s) * (1.0f / DV) + EPS);
#pragma unroll
            for (int j = 0; j < 2; ++j) { const int o = h * DV + j * 256 + lane * 4;
                const f32x4 gg = pg[(h * DV + j * 256) / 4 + lane];
                const v2u ov = *(const v2u*)(QK + (size_t)row * QKVO + 8192 + o);
                const f32x4 y = (v[j] * rstd) * gg;
                v2u w; w.x = pk2(y.x * sigmoidf_(bflo(ov.x)), y.y * sigmoidf_(bfhi(ov.x))); w.y = pk2(y.z * sigmoidf_(bflo(ov.y)), y.w * sigmoidf_(bfhi(ov.y)));
                *(v2u*)(A2 + (size_t)row * D + o) = w; }
        }
    }
}

constexpr int NPHASES = 21;
__global__ void __launch_bounds__(NTHREADS, 2) fwd_kernel(Args args_unused) {
    extern __shared__ __attribute__((aligned(16))) unsigned char lds_raw[];
    LAS unsigned char* lds = (LAS unsigned char*)lds_raw;
    const int wave_s = __builtin_amdgcn_readfirstlane((int)threadIdx.x >> 6);
    { const int tid = threadIdx.x; volatile LAS unsigned* MISC = (volatile LAS unsigned*)(lds + MISC_OFF);
      if (tid < 16) MISC[tid] = 0u;
      __syncthreads();
      if (!MK_PER_PHASE) (void)xcd_barrier_post((unsigned*)(get_args()->ws + WS_CTL) + CW_BAR, MISC); }
#define PH_IDS for (int tid = opaque_tid(wave_s), lane = tid & 63, wave = __builtin_amdgcn_readfirstlane(tid >> 6), once_ = 1; once_; once_ = 0)
#if MK_PER_PHASE
#define IN(k) (get_args()->ph_lo == (k)) PH_IDS if (true
#define SEAM(k) do { } while (0)
#else
#ifndef PROBE_PHASE
#define PROBE_PHASE -1
#endif
#define IN(k) true) for (int rep_ = 0; rep_ < ((k) == PROBE_PHASE ? 2 : 1); ++rep_) PH_IDS if (true
#define SEAM(k) do { XcdBarrier b_; b_.bar = (unsigned*)(get_args()->ws + WS_CTL) + CW_BAR; b_.x = xb_xcc_id(); b_.st = (volatile LAS unsigned*)(lds + MISC_OFF); xcd_barrier(b_); } while (0)
#endif
#define WSP(off) (get_args()->ws + (off))
#define MODP(layer) ((const float*)WSP(WS_MOD) + (layer) * 3 * NMODC)
#define NGP(i) (get_args()->in[I_NORMG] + (i) * D)

#define GEMM_PHASE(EPI, A_, B_, M_, N_, K_, EINIT, HAS_SIDE, SIDE) { const int nwg_ = ((M_) / 256) * ((N_) / 256), gg_ = (HAS_SIDE) ? gemm_wgs(nwg_) : (int)gridDim.x; \
        if ((int)blockIdx.x < gg_) { pg8::Gemm g{A_, B_, M_, N_, K_}; pg8::StaticOrder S; S.init(M_, N_, gg_, blockIdx.x); EPI E EINIT; pg8::gemm_phase<EPI, pg8::StaticOrder, true, true>(lds, g, S, E, tid); } \
          \
        const int t0_ = (HAS_SIDE) ? gg_ : ((nwg_ % (int)gridDim.x) ? nwg_ % (int)gridDim.x : (int)gridDim.x); \
        if (!PROBE_E1 && (int)blockIdx.x >= t0_) { const int si_ = (int)blockIdx.x - t0_, ns_ = (int)gridDim.x - t0_, sf_ = si_ * NWAVES + wave, sn_ = ns_ * NWAVES; (void)si_; (void)ns_; (void)sf_; (void)sn_; SIDE } }

    if (IN(0)) { p0_prologue(get_args(), lds, tid, lane, wave); __syncthreads(); } SEAM(0);
    if (IN(1)) { CArgs a = get_args(); row_phase<false, true>(lds, MT, a->in[I_X], a->in[I_CTX], nullptr, nullptr, nullptr, nullptr, nullptr, 0, NGP(0), MODP(0), 0, 1, (bf16*)WSP(WS_H), tid, lane, wave); }
    SEAM(1);
    if (IN(2)) GEMM_PHASE(pg8::EpiAB, (const bf16*)WSP(WS_H), (const bf16*)WSP(WS_WABIN), MT, ABIN, D, ({(bf16*)WSP(WS_U)}), false,
                          conv_matrix<CV_ABOUT>(get_args(), lds, sf_, sn_, lane, wave);)
    SEAM(2);
    if (IN(3)) mixer_conv_phase(get_args(), lds, tid, lane);
    SEAM(3);
    if (IN(4)) mixer_ln_phase(get_args(), lds, tid, lane, wave);
    SEAM(4);
    if (IN(5)) GEMM_PHASE(pg8::EpiBf16, (const bf16*)WSP(WS_G), (const bf16*)WSP(WS_WABOUT), MT, D, D, ({(bf16*)WSP(WS_Y), D}), true,
                          conv_matrix<CV_UP0>(get_args(), lds, sf_, sn_, lane, wave);)
    SEAM(5);
    if (IN(6)) { CArgs a = get_args(); row_phase<true, true>(lds, MT, a->in[I_X], a->in[I_CTX], a->out, (float*)WSP(WS_CTXS), (const bf16*)WSP(WS_Y), NGP(1), MODP(0), 2, NGP(2), MODP(0), 3, 4, (bf16*)WSP(WS_H), tid, lane, wave); }
    SEAM(6);
    if (IN(7)) GEMM_PHASE(pg8::EpiGate, (const bf16*)WSP(WS_H), (const bf16*)WSP(WS_WUP0), MT, DFF2, D, ({(bf16*)WSP(WS_G), (bf16*)WSP(WS_UC), get_args()->in[I_FCONV]}), false,
                          conv_matrix<CV_DN0>(get_args(), lds, sf_, sn_, lane, wave);)
    SEAM(7);
    if (IN(8)) ffn_gate_ctx_phase(get_args(), tid);
    SEAM(8);
    if (IN(9)) GEMM_PHASE(pg8::EpiBf16, (const bf16*)WSP(WS_G), (const bf16*)WSP(WS_WDN0), MT, D, DFF, ({(bf16*)WSP(WS_Y), D}), true,
                          gemv_units(get_args(), lds, 1, si_, ns_, tid, lane, wave);
                          conv_matrix<CV_MIN>(get_args(), lds, sf_, sn_, lane, wave); conv_matrix<CV_MOUT>(get_args(), lds, sf_, sn_, lane, wave);
                          conv_matrix<CV_UP1>(get_args(), lds, sf_, sn_, lane, wave);)
    SEAM(9);
    if (IN(10)) { CArgs a = get_args(); float* ct = (float*)WSP(WS_CTXS); row_phase<true, true>(lds, MT, a->out, ct, a->out, ct, (const bf16*)WSP(WS_Y), NGP(3), MODP(0), 5, NGP(4), MODP(1), 0, 1, (bf16*)WSP(WS_H), tid, lane, wave); }
    SEAM(10);
    if (IN(11)) GEMM_PHASE(pg8::EpiMIn, (const bf16*)WSP(WS_H), (const bf16*)WSP(WS_WMIN), MT, CINP, D, ({(bf16*)WSP(WS_U), QKVO, (float*)WSP(WS_GATES)}), false,
                           conv_matrix<CV_DN1>(get_args(), lds, sf_, sn_, lane, wave);)
    SEAM(11);
    if (IN(12)) scan_pre_phase(get_args(), lds, tid, lane, wave);
    SEAM(12);
    if (IN(13)) scan_seq_phase(get_args(), lds, tid, lane, wave);
    SEAM(13);
    if (IN(14)) scan_out_phase(get_args(), lds, tid, lane, wave);
    SEAM(14);
    if (IN(15)) GEMM_PHASE(pg8::EpiBf16, (const bf16*)WSP(WS_G), (const bf16*)WSP(WS_WMOUT), ML, D, D, ({(bf16*)WSP(WS_Y), D}), false, ;)
    SEAM(15);
    if (IN(16)) { CArgs a = get_args(); float* ct = (float*)WSP(WS_CTXS); row_phase<true, true>(lds, ML, a->out, ct, a->out, ct, (const bf16*)WSP(WS_Y), NGP(5), MODP(1), 2, NGP(6), MODP(1), 3, 4, (bf16*)WSP(WS_H), tid, lane, wave); }
    SEAM(16);
    if (IN(17)) GEMM_PHASE(pg8::EpiGate, (const bf16*)WSP(WS_H), (const bf16*)WSP(WS_WUP0 + 172 * MiB), ML, DFF2, D, ({(bf16*)WSP(WS_G), (bf16*)WSP(WS_UC), get_args()->in[I_FCONV] + 3 * DFF2}), false, ;)
    SEAM(17);
    if (IN(19)) GEMM_PHASE(pg8::EpiBf16, (const bf16*)WSP(WS_G), (const bf16*)WSP(WS_WDN0 + 86 * MiB), ML, D, DFF, ({(bf16*)WSP(WS_Y), D}), false, ;)
    SEAM(19);
    if (IN(20)) { CArgs a = get_args(); float* ct = (float*)WSP(WS_CTXS); row_phase<true, false>(lds, ML, a->out, ct, a->out, ct, (const bf16*)WSP(WS_Y), NGP(7), MODP(1), 5, nullptr, nullptr, 0, 0, nullptr, tid, lane, wave); }
#undef IN
#undef SEAM
}

extern "C" void kernel_launch(void* const* d_in, const int* in_sizes, int n_in, void* d_out, int out_size, void* d_ws, size_t ws_size, hipStream_t stream) {
    static int grid = 0;
    if (grid == 0) {
        if (n_in != 21 || out_size != ML * D || ws_size < WS_END) { fprintf(stderr, "kernel_launch: unexpected problem (n_in %d, out %d, ws %zu < %zu); nothing launched\n", n_in, out_size, ws_size, (size_t)WS_END); grid = -1; return; }
        int dev = 0, cus = 0, per_cu = 0;
        if (hipGetDevice(&dev) != hipSuccess || hipDeviceGetAttribute(&cus, hipDeviceAttributeMultiprocessorCount, dev) != hipSuccess) { grid = -1; return; }
        if (hipFuncSetAttribute((const void*)fwd_kernel, hipFuncAttributeMaxDynamicSharedMemorySize, LDS_BYTES) != hipSuccess) { fprintf(stderr, "kernel_launch: hipFuncSetAttribute failed\n"); grid = -1; return; }
        if (hipOccupancyMaxActiveBlocksPerMultiprocessor(&per_cu, (const void*)fwd_kernel, NTHREADS, LDS_BYTES) != hipSuccess || per_cu < 1)
            fprintf(stderr, "kernel_launch: occupancy query reports %d workgroups per CU\n", per_cu);
        (void)hipGetLastError();
        grid = cus;
    }
    if (grid < 0) return;
    if (hipMemsetAsync((char*)d_ws + WS_CTL, 0, CTL_ZERO_BYTES, stream) != hipSuccess) return;
    Args a{};
    for (int i = 0; i < 21; ++i) a.in[i] = (const float*)d_in[i];
    a.out = (float*)d_out; a.ws = (unsigned char*)d_ws;
#if MK_PER_PHASE
    for (int p = 0; p < NPHASES; ++p) { a.ph_lo = p; a.ph_hi = p + 1; hipLaunchKernelGGL(fwd_kernel, dim3(grid), dim3(NTHREADS), LDS_BYTES, stream, a); }
#else
    a.ph_lo = 0; a.ph_hi = NPHASES;
    hipLaunchKernelGGL(fwd_kernel, dim3(grid), dim3(NTHREADS), LDS_BYTES, stream, a);
#endif
}
```

```cpp
#include <hip/hip_runtime.h>
#include <cstdio>
#include <cstdint>

#ifndef PROBE_E1
#define PROBE_E1 0
#endif
#ifndef MK_PER_PHASE
#define MK_PER_PHASE 0
#endif

namespace pg8 {
#define PG8_LAS __attribute__((address_space(3)))
typedef unsigned short bf16_t;
typedef short bf16x8 __attribute__((ext_vector_type(8)));
typedef float f32x4 __attribute__((ext_vector_type(4)));
typedef unsigned u32x4 __attribute__((ext_vector_type(4)));
constexpr int BM = 256, BK = 64, HALF = 128, HTB = HALF * BK * 2, STAGE_BYTES = 8 * HTB, NXCD = 8, WGM = 4;

__host__ __device__ __forceinline__ int lds_byte(int r, int c) { const int st = (r >> 4) * 2 + (c >> 5), rr = r & 15, cc = c & 31, ob = rr * 64 + cc * 2; return st * 1024 + (ob ^ (((ob >> 9) & 1) << 5)); }
__host__ __device__ __forceinline__ void stage_rc(int b, int& R, int& C) { const int st = b / 1024, sb = b % 1024, swz = sb ^ (((sb >> 9) & 1) << 5); R = (st >> 1) * 16 + swz / 64; C = (st & 1) * 32 + (swz % 64) / 2; }
__host__ __device__ __forceinline__ int perm32(int rho) { const int n = rho >> 4, i = rho & 15; return 8 * (i >> 2) + 4 * n + (i & 3); }

struct Unit { int pm, pn; };
struct Gemm { const bf16_t* A; const bf16_t* Bt; int M, N, K; };

struct StaticOrder {
    int nM, nN, nwg, G, c;
    __host__ __device__ void init(int M, int N, int G_, int c_) { nM = M / BM; nN = N / BM; nwg = nM * nN; G = G_; c = c_; }
    __host__ __device__ bool next(int i, Unit& u) const {
        const long L = (long)i * G + c; if (L >= nwg) return false;
        int wgid = (int)L; { const int q = nwg / NXCD, r = nwg % NXCD, xcd = wgid % NXCD, off = wgid / NXCD; wgid = (xcd < r ? xcd * (q + 1) : r * (q + 1) + (xcd - r) * q) + off; }
        const int nig = WGM * nN, gid = wgid / nig, fm = gid * WGM, gsz = (nM - fm) < WGM ? (nM - fm) : WGM;
        u.pm = fm + ((wgid % nig) % gsz); u.pn = (wgid % nig) / gsz; return true;
    }
    __device__ __forceinline__ void a_ready(const Unit&) const {}
    __device__ __forceinline__ void done(const Unit&) const {}
};

__device__ __forceinline__ unsigned cvt_pk_bf16(float lo, float hi) { unsigned r; asm volatile("v_cvt_pk_bf16_f32 %0, %1, %2" : "=v"(r) : "v"(lo), "v"(hi)); return r; }

struct EpiBf16 {
    static constexpr bool PERM = true, AFTER_DRAIN = false, PERM_A = false;
    bf16_t* O; int ldc;
    __device__ __forceinline__ void operator()(const f32x4 (&acc)[2][2][4][2], const Unit& u, int wr, int wc, int fr, int fq) const {
        const int row0 = u.pm * BM + wr * 64 + fr, col0 = u.pn * BM + wc * 32 + 8 * fq;
#pragma unroll
        for (int ai = 0; ai < 2; ++ai)
#pragma unroll
            for (int m = 0; m < 4; ++m) { bf16_t* rowp = O + (size_t)(row0 + ai * HALF + m * 16) * ldc + col0;
#pragma unroll
                for (int bj = 0; bj < 2; ++bj) { const f32x4 v0 = acc[ai][bj][m][0], v1 = acc[ai][bj][m][1];
                    u32x4 w; w.x = cvt_pk_bf16(v0[0], v0[1]); w.y = cvt_pk_bf16(v0[2], v0[3]); w.z = cvt_pk_bf16(v1[0], v1[1]); w.w = cvt_pk_bf16(v1[2], v1[3]);
                    *(u32x4*)(rowp + bj * HALF) = w; } }
    }
};
struct EpiAB {
    static constexpr bool PERM = true, AFTER_DRAIN = false, PERM_A = false;
    bf16_t* O;
    __device__ __forceinline__ void operator()(const f32x4 (&acc)[2][2][4][2], const Unit& u, int wr, int wc, int fr, int fq) const {
        const int row0 = u.pm * BM + wr * 64 + fr;
        if (u.pn >= 16 && u.pn < 24) {
            const int col0 = 2048 + (u.pn - 16) * BM + wc * 32 + 8 * fq;
#pragma unroll
            for (int ai = 0; ai < 2; ++ai)
#pragma unroll
                for (int m = 0; m < 4; ++m) { bf16_t* rowp = O + (size_t)(row0 + ai * HALF + m * 16) * 6144 + col0;
#pragma unroll
                    for (int bj = 0; bj < 2; ++bj) { const f32x4 v0 = acc[ai][bj][m][0], v1 = acc[ai][bj][m][1];
                        u32x4 w; w.x = cvt_pk_bf16(v0[0], v0[1]); w.y = cvt_pk_bf16(v0[2], v0[3]); w.z = cvt_pk_bf16(v1[0], v1[1]); w.w = cvt_pk_bf16(v1[2], v1[3]);
                        *(u32x4*)(rowp + bj * HALF) = w; } }
            return;
        }
        const bool glu = u.pn < 16;
        const int col0 = (glu ? u.pn * 128 : 4096 + (u.pn - 24) * 128) + wc * 32 + 8 * fq;
#pragma unroll
        for (int ai = 0; ai < 2; ++ai)
#pragma unroll
            for (int m = 0; m < 4; ++m) { float o[8];
#pragma unroll
                for (int n = 0; n < 2; ++n)
#pragma unroll
                    for (int j = 0; j < 4; ++j) { const float x = acc[ai][0][m][n][j], y = acc[ai][1][m][n][j];
                        o[4 * n + j] = glu ? x * __builtin_amdgcn_rcpf(1.0f + __expf(-y)) : x * y; }
                u32x4 w; w.x = cvt_pk_bf16(o[0], o[1]); w.y = cvt_pk_bf16(o[2], o[3]); w.z = cvt_pk_bf16(o[4], o[5]); w.w = cvt_pk_bf16(o[6], o[7]);
                *(u32x4*)(O + (size_t)(row0 + ai * HALF + m * 16) * 6144 + col0) = w; }
    }
};
struct EpiMIn {
    static constexpr bool PERM = true, AFTER_DRAIN = false, PERM_A = false;
    bf16_t* O; int ldc; float* gates;
    __device__ __forceinline__ void operator()(const f32x4 (&acc)[2][2][4][2], const Unit& u, int wr, int wc, int fr, int fq) const {
        const int row0 = u.pm * BM + wr * 64 + fr;
        if (u.pn < 48) {
            const int col0 = u.pn * BM + wc * 32 + 8 * fq;
#pragma unroll
            for (int ai = 0; ai < 2; ++ai)
#pragma unroll
                for (int m = 0; m < 4; ++m) { bf16_t* rowp = O + (size_t)(row0 + ai * HALF + m * 16) * ldc + col0;
#pragma unroll
                    for (int bj = 0; bj < 2; ++bj) { const f32x4 v0 = acc[ai][bj][m][0], v1 = acc[ai][bj][m][1];
                        u32x4 w; w.x = cvt_pk_bf16(v0[0], v0[1]); w.y = cvt_pk_bf16(v0[2], v0[3]); w.z = cvt_pk_bf16(v1[0], v1[1]); w.w = cvt_pk_bf16(v1[2], v1[3]);
                        *(u32x4*)(rowp + bj * HALF) = w; } }
        } else if (wc == 0) {
#pragma unroll
            for (int ai = 0; ai < 2; ++ai)
#pragma unroll
                for (int m = 0; m < 4; ++m) { float* rowp = gates + (size_t)(row0 + ai * HALF + m * 16) * 32 + 8 * fq;
#pragma unroll
                    for (int n = 0; n < 2; ++n) *(f32x4*)(rowp + 4 * n) = acc[ai][0][m][n]; }
        }
    }
};

__device__ __forceinline__ float dpp_ror1(float v) { return __builtin_bit_cast(float, __builtin_amdgcn_update_dpp(0, __builtin_bit_cast(int, v), 0x121, 0xf, 0xf, false)); }
__device__ __forceinline__ float dpp_rol1(float v) { return __builtin_bit_cast(float, __builtin_amdgcn_update_dpp(0, __builtin_bit_cast(int, v), 0x12F, 0xf, 0xf, false)); }
template <bool NOLOAD = false, bool NOSTORE = false> struct EpiGateT {
    static constexpr bool PERM = true, AFTER_DRAIN = false, PERM_A = true;
    bf16_t* G; bf16_t* UC; const float* cw;
    __device__ __forceinline__ static float shr1(float v) { return __builtin_bit_cast(float, __builtin_amdgcn_update_dpp(0, __builtin_bit_cast(int, v), 0x111, 0xf, 0xf, true)); }
    __device__ __forceinline__ static float shl1(float v) { return __builtin_bit_cast(float, __builtin_amdgcn_update_dpp(0, __builtin_bit_cast(int, v), 0x101, 0xf, 0xf, true)); }
    __device__ __forceinline__ void operator()(const f32x4 (&acc)[2][2][4][2], const Unit& u, int wr, int wc, int fr, int fq) const {
        const int row0 = u.pm * BM + wr * 64 + 4 * fr;
        if (u.pm >= 64) {
            const int col0 = u.pn * BM + wc * 32 + 8 * fq;
#pragma unroll
            for (int ai = 0; ai < 2; ++ai)
#pragma unroll
                for (int m = 0; m < 4; ++m) { bf16_t* rowp = UC + (size_t)(row0 - 64 * BM + ai * HALF + m) * 22016 + col0;
#pragma unroll
                    for (int bj = 0; bj < 2; ++bj) { const f32x4 v0 = acc[ai][bj][m][0], v1 = acc[ai][bj][m][1];
                        u32x4 w; w.x = cvt_pk_bf16(v0[0], v0[1]); w.y = cvt_pk_bf16(v0[2], v0[3]); w.z = cvt_pk_bf16(v1[0], v1[1]); w.w = cvt_pk_bf16(v1[2], v1[3]);
                        *(u32x4*)(rowp + bj * HALF) = w; } }
            return;
        }
        const int ch = u.pn * 128 + wc * 32 + 8 * fq;
        typedef unsigned u32x2 __attribute__((ext_vector_type(2)));
#pragma unroll
        for (int n = 0; n < 2; ++n) {
            f32x4 wg[3], wv[3];
#pragma unroll
            for (int k = 0; k < 3; ++k) { if (NOLOAD) { wg[k] = (f32x4){0.3f, 0.4f, 0.5f, 0.6f}; wv[k] = (f32x4){0.6f, 0.5f, 0.4f, 0.3f}; } else { wg[k] = *(const f32x4*)(cw + k * 22016 + ch + 4 * n); wv[k] = *(const f32x4*)(cw + k * 22016 + 11008 + ch + 4 * n); } }
#pragma unroll
            for (int ai = 0; ai < 2; ++ai) {
                float o[4][4];
#pragma unroll
                for (int j = 0; j < 4; ++j) {
                    const float gp = shr1(acc[ai][0][3][n][j]), gn = shl1(acc[ai][0][0][n][j]), vp = shr1(acc[ai][1][3][n][j]), vn = shl1(acc[ai][1][0][n][j]);
#pragma unroll
                    for (int m = 0; m < 4; ++m) {
                        const float gL = m > 0 ? acc[ai][0][m - 1][n][j] : gp, gR = m < 3 ? acc[ai][0][m + 1][n][j] : gn;
                        const float vL = m > 0 ? acc[ai][1][m - 1][n][j] : vp, vR = m < 3 ? acc[ai][1][m + 1][n][j] : vn;
                        const float g = wg[0][j] * gL + wg[1][j] * acc[ai][0][m][n][j] + wg[2][j] * gR;
                        const float v = wv[0][j] * vL + wv[1][j] * acc[ai][1][m][n][j] + wv[2][j] * vR;
                        o[m][j] = g * __builtin_amdgcn_rcpf(1.0f + __expf(-g)) * v; }
                }
#pragma unroll
                for (int m = 0; m < 4; ++m) { u32x2 w; w.x = cvt_pk_bf16(o[m][0], o[m][1]); w.y = cvt_pk_bf16(o[m][2], o[m][3]);
                    if (NOSTORE) asm volatile("" :: "v"(w)); else *(u32x2*)(G + (size_t)(row0 + ai * HALF + m) * 11008 + ch + 4 * n) = w; }
                __builtin_amdgcn_sched_barrier(0);
            }
        }
    }
};
typedef EpiGateT<false, false> EpiGate;

template <class Epi, class Sched, bool ALIGN_EPI = false, bool SP2 = false>
__device__ __forceinline__ void gemm_phase(PG8_LAS unsigned char* lds, const Gemm g, const Sched& S, const Epi& E, const int tid) {
    const int wid = __builtin_amdgcn_readfirstlane(tid >> 6), lane = tid & 63, wr = wid >> 2, wc = wid & 3, fr = lane & 15, fq = lane >> 4;
    const int K = g.K, nt = K / BK;
    unsigned voffA[2], voffB[2];
#pragma unroll
    for (int i = 0; i < 2; ++i) { int R, C; stage_rc(tid * 16 + i * 8192, R, C); const int Rb = Epi::PERM ? ((R & ~31) + perm32(R & 31)) : R;
        const int Ra = Epi::PERM_A ? ((R & ~63) + 4 * (R & 15) + ((R >> 4) & 3)) : R;
        voffA[i] = (unsigned)(Ra * K + C) * 2u; voffB[i] = (unsigned)(Rb * K + C) * 2u; }
    const size_t kstep = (size_t)(BK * 2);
    const size_t hstep = (size_t)HALF * K * 2;
    const size_t tstep = 2 * hstep;
    const unsigned ldsw = (unsigned)wid * 1024u;
    const int aoff = lds_byte(wr * 64 + fr, fq * 8), boff = lds_byte(wc * 32 + fr, fq * 8);
#define PG8_SA(b, h) (((b) * 2 + (h)) * HTB)
#define PG8_SB(b, h) ((4 + (b) * 2 + (h)) * HTB)
#define PG8_STAGE(bufoff, gbase, voff) do { _Pragma("unroll") for (int _i = 0; _i < 2; ++_i) \
        __builtin_amdgcn_global_load_lds((const unsigned*)((const char*)(gbase) + (voff)[_i]), (PG8_LAS unsigned*)(lds + (bufoff) + ldsw + _i * 8192), 16, 0, 0); } while (0)
#define PG8_LDA(dst, b, h) do { _Pragma("unroll") for (int m = 0; m < 4; ++m) _Pragma("unroll") for (int k = 0; k < 2; ++k) dst[m][k] = *(const PG8_LAS bf16x8*)(lds + PG8_SA(b, h) + aoff + m * 2048 + k * 1024); } while (0)
#define PG8_LDB(dst, b, h) do { _Pragma("unroll") for (int n = 0; n < 2; ++n) _Pragma("unroll") for (int k = 0; k < 2; ++k) dst[n][k] = *(const PG8_LAS bf16x8*)(lds + PG8_SB(b, h) + boff + n * 2048 + k * 1024); } while (0)
#define PG8_MMA(ai, bj, At, Bt) do { __builtin_amdgcn_s_setprio(1); _Pragma("unroll") for (int m = 0; m < 4; ++m) _Pragma("unroll") for (int n = 0; n < 2; ++n) _Pragma("unroll") for (int k = 0; k < 2; ++k) \
        acc[ai][bj][m][n] = __builtin_amdgcn_mfma_f32_16x16x32_bf16(Bt[n][k], At[m][k], acc[ai][bj][m][n], 0, 0, 0); __builtin_amdgcn_s_setprio(0); } while (0)
#define PG8_WAIT_V(n) asm volatile("s_waitcnt vmcnt(" #n ")" ::: "memory")
#define PG8_WAIT_L(n) asm volatile("s_waitcnt lgkmcnt(" #n ")" ::: "memory")
#define PG8_BAR __builtin_amdgcn_s_barrier()
#define PG8_SCHED __builtin_amdgcn_sched_barrier(0)
    Unit cur, nxt; int ui = 0;
    if (!S.next(0, cur)) return;
    f32x4 acc[2][2][4][2];
#pragma unroll
    for (int a = 0; a < 2; ++a)
#pragma unroll
        for (int b = 0; b < 2; ++b)
#pragma unroll
            for (int m = 0; m < 4; ++m)
#pragma unroll
                for (int n = 0; n < 2; ++n) acc[a][b][m][n] = (f32x4){0.f, 0.f, 0.f, 0.f};
    bf16x8 At[4][2], B0[2][2], B1[2][2];
    const char* cA = (const char*)g.A + (size_t)cur.pm * tstep; const char* cB = (const char*)g.Bt + (size_t)cur.pn * tstep;
    S.a_ready(cur);
    if constexpr (SP2) {
        PG8_STAGE(PG8_SB(0, 0), cB, voffB); PG8_STAGE(PG8_SB(0, 1), cB + hstep, voffB); PG8_STAGE(PG8_SA(0, 0), cA, voffA); PG8_STAGE(PG8_SA(0, 1), cA + hstep, voffA);
        if (wr == 1) PG8_BAR;
        PG8_WAIT_V(2); PG8_BAR;
        PG8_STAGE(PG8_SB(1, 0), cB + kstep, voffB); PG8_STAGE(PG8_SA(1, 0), cA + kstep, voffA); PG8_STAGE(PG8_SB(1, 1), cB + hstep + kstep, voffB);
        PG8_WAIT_V(6); PG8_BAR;
    } else {
        PG8_STAGE(PG8_SB(0, 0), cB, voffB); PG8_STAGE(PG8_SA(0, 0), cA, voffA); PG8_STAGE(PG8_SB(0, 1), cB + hstep, voffB); PG8_STAGE(PG8_SA(0, 1), cA + hstep, voffA);
        if (wr == 1) PG8_BAR;
        PG8_WAIT_V(4); PG8_BAR;
        PG8_STAGE(PG8_SB(1, 0), cB + kstep, voffB); PG8_STAGE(PG8_SA(1, 0), cA + kstep, voffA); PG8_STAGE(PG8_SB(1, 1), cB + hstep + kstep, voffB);
        PG8_WAIT_V(6); PG8_BAR;
    }
    for (;;) {
        const bool has_next = S.next(ui + 1, nxt);
        const char* nA = has_next ? (const char*)g.A + (size_t)nxt.pm * tstep : cA; const char* nB = has_next ? (const char*)g.Bt + (size_t)nxt.pn * tstep : cB;
        for (int t = 0; t < nt; t += 2) {
            const bool last = (t == nt - 2);
            const char* a1 = cA + (size_t)(t + 1) * kstep;
            const char* a2 = last ? nA : cA + (size_t)(t + 2) * kstep; const char* b2 = last ? nB : cB + (size_t)(t + 2) * kstep;
            const char* a3 = a2 + kstep; const char* b3 = b2 + kstep;
            if (last && has_next) S.a_ready(nxt);
            if constexpr (SP2) {
            PG8_LDB(B0, 0, 0); PG8_LDB(B1, 0, 1); PG8_SCHED; PG8_LDA(At, 0, 0); PG8_STAGE(PG8_SA(1, 1), a1 + hstep, voffA);
            PG8_WAIT_V(8); PG8_WAIT_L(0); PG8_BAR; PG8_MMA(0, 0, At, B0); PG8_MMA(0, 1, At, B1); PG8_BAR; PG8_SCHED;
            PG8_LDA(At, 0, 1); PG8_STAGE(PG8_SB(0, 0), b2, voffB); PG8_STAGE(PG8_SB(0, 1), b2 + hstep, voffB); PG8_STAGE(PG8_SA(0, 0), a2, voffA);
            PG8_WAIT_V(8); PG8_WAIT_L(0); PG8_BAR; PG8_MMA(1, 0, At, B0); PG8_MMA(1, 1, At, B1); PG8_BAR; PG8_SCHED;
            PG8_LDB(B0, 1, 0); PG8_LDB(B1, 1, 1); PG8_SCHED; PG8_LDA(At, 1, 0); PG8_STAGE(PG8_SA(0, 1), a2 + hstep, voffA);
            PG8_WAIT_V(8); PG8_WAIT_L(0); PG8_BAR; PG8_MMA(0, 0, At, B0); PG8_MMA(0, 1, At, B1); PG8_BAR; PG8_SCHED;
            PG8_LDA(At, 1, 1); PG8_STAGE(PG8_SB(1, 0), b3, voffB); PG8_STAGE(PG8_SB(1, 1), b3 + hstep, voffB); PG8_STAGE(PG8_SA(1, 0), a3, voffA);
            PG8_WAIT_V(8); PG8_WAIT_L(0); PG8_BAR; PG8_MMA(1, 0, At, B0); PG8_MMA(1, 1, At, B1); PG8_BAR; PG8_SCHED;
            } else {
            PG8_LDB(B0, 0, 0); PG8_SCHED; PG8_LDA(At, 0, 0); PG8_STAGE(PG8_SA(1, 1), a1 + hstep, voffA);
            PG8_WAIT_L(8); PG8_BAR; PG8_WAIT_L(0); PG8_MMA(0, 0, At, B0); PG8_BAR; PG8_SCHED;
            PG8_LDB(B1, 0, 1); PG8_STAGE(PG8_SB(0, 0), b2, voffB);
            PG8_BAR; PG8_WAIT_L(0); PG8_MMA(0, 1, At, B1); PG8_BAR;
            PG8_LDA(At, 0, 1); PG8_STAGE(PG8_SA(0, 0), a2, voffA);
            PG8_BAR; PG8_WAIT_L(0); PG8_MMA(1, 0, At, B0); PG8_BAR; PG8_SCHED;
            PG8_STAGE(PG8_SB(0, 1), b2 + hstep, voffB);
            PG8_WAIT_V(6); PG8_BAR; PG8_MMA(1, 1, At, B1); PG8_BAR;
            PG8_LDB(B0, 1, 0); PG8_SCHED; PG8_LDA(At, 1, 0); PG8_STAGE(PG8_SA(0, 1), a2 + hstep, voffA);
            PG8_WAIT_L(8); PG8_BAR; PG8_WAIT_L(0); PG8_MMA(0, 0, At, B0); PG8_BAR; PG8_SCHED;
            PG8_LDB(B1, 1, 1); PG8_STAGE(PG8_SB(1, 0), b3, voffB);
            PG8_BAR; PG8_WAIT_L(0); PG8_MMA(0, 1, At, B1); PG8_BAR;
            PG8_LDA(At, 1, 1); PG8_STAGE(PG8_SA(1, 0), a3, voffA);
            PG8_BAR; PG8_WAIT_L(0); PG8_MMA(1, 0, At, B0); PG8_BAR; PG8_SCHED;
            PG8_STAGE(PG8_SB(1, 1), b3 + hstep, voffB);
            PG8_WAIT_V(6); PG8_BAR; PG8_MMA(1, 1, At, B1); PG8_BAR;
            }
        }
        if constexpr (ALIGN_EPI) { if (wr == 0) PG8_BAR; }
        if constexpr (!Epi::AFTER_DRAIN) { E(acc, cur, wr, wc, fr, fq); S.done(cur); }
        if (!has_next) break;
#pragma unroll
        for (int a = 0; a < 2; ++a)
#pragma unroll
            for (int b = 0; b < 2; ++b)
#pragma unroll
                for (int m = 0; m < 4; ++m)
#pragma unroll
                    for (int n = 0; n < 2; ++n) acc[a][b][m][n] = (f32x4){0.f, 0.f, 0.f, 0.f};
        cur = nxt; cA = nA; cB = nB; ++ui;
        if constexpr (ALIGN_EPI) { if (wr == 1) PG8_BAR; }
    }
    PG8_WAIT_V(0);
    if constexpr (!ALIGN_EPI) { if (wr == 0) PG8_BAR; }
    PG8_BAR;
#undef PG8_SA
#undef PG8_SB
#undef PG8_STAGE
#undef PG8_LDA
#undef PG8_LDB
#undef PG8_MMA
#undef PG8_WAIT_V
#undef PG8_WAIT_L
#undef PG8_BAR
#undef PG8_SCHED
}
}

constexpr int NWAVES = 8, NTHREADS = 512;
constexpr int D = 4096, BATCH = 2, SEQ = 8192, CTXL = 256;
constexpr int ML = BATCH * SEQ;
constexpr int MC = BATCH * CTXL;
constexpr int MT = ML + MC;
constexpr int NMODC = 6 * D;
constexpr int WA = 2048, ABIN = 10240, ABU = 6144, ACONV = 31;
constexpr int HEADS = 8, DQK = 256, DV = 512;
constexpr int QKVO = 12288, CIN = 12320, CINP = 12544;
constexpr int DFF = 11008, DFF2 = 22016;
constexpr int NCH = 66;
constexpr float EPS = 1e-6f;

constexpr size_t MiB = 1u << 20;
constexpr size_t WS_CTL = 0, CTL_ZERO_BYTES = 1 * MiB;
constexpr size_t WS_MOD = 1 * MiB;
constexpr size_t WS_SCP = 2 * MiB;
constexpr size_t WS_SCC = 7 * MiB;
constexpr size_t WS_GATES = 8 * MiB;
constexpr size_t WS_CTXS = 12 * MiB;
constexpr size_t WS_WABIN = 20 * MiB;
constexpr size_t WS_WABOUT = 100 * MiB;
constexpr size_t WS_WMIN = 132 * MiB;
constexpr size_t WS_WMOUT = 230 * MiB;
constexpr size_t WS_WUP0 = 262 * MiB;
constexpr size_t WS_WDN0 = 606 * MiB;
constexpr size_t WS_H = 778 * MiB;
constexpr size_t WS_U = 910 * MiB;
constexpr size_t WS_UC = 1590 * MiB;
constexpr size_t WS_G = 1620 * MiB;
constexpr size_t WS_Y = 1975 * MiB;
constexpr size_t WS_HS = 2239 * MiB;
constexpr size_t WS_END = 2751 * MiB;
static_assert(WS_WUP0 + 2 * 172 * MiB == WS_WDN0 && WS_WDN0 + 2 * 86 * MiB <= WS_H, "ws map");
static_assert((size_t)DFF2 * D * 2 <= 172 * MiB && (size_t)D * DFF * 2 <= 86 * MiB && (size_t)CINP * D * 2 <= 98 * MiB, "ws map");
static_assert(WS_H + (size_t)MT * D * 2 <= WS_U && WS_U + (size_t)MT * DFF2 * 2 <= WS_G && WS_G + (size_t)MT * DFF * 2 <= WS_Y && WS_Y + (size_t)MT * D * 4 <= WS_HS && WS_HS + (size_t)2 * ML * D * 4 <= WS_END, "ws map");
static_assert(WS_SCP + (size_t)32 * NCH * 3 * 128 * 4 <= WS_SCC && WS_GATES + (size_t)MT * 32 * 4 <= WS_CTXS && WS_CTXS + (size_t)MC * D * 4 <= WS_WABIN, "ws map");

constexpr int CW_BAR = 4096;
constexpr int LDS_BYTES = 163840;
constexpr int MISC_OFF = LDS_BYTES - 64;

#define LAS __attribute__((address_space(3)))
typedef unsigned short bf16;
typedef unsigned v4u __attribute__((ext_vector_type(4)));
typedef unsigned v2u __attribute__((ext_vector_type(2)));
typedef float f32x4 __attribute__((ext_vector_type(4)));
typedef float f32x2 __attribute__((ext_vector_type(2)));
typedef short bf16x8 __attribute__((ext_vector_type(8)));
typedef short s16x4 __attribute__((ext_vector_type(4)));
#define LDS_WAIT() asm volatile("s_waitcnt lgkmcnt(0)" ::: "memory")

__device__ __forceinline__ unsigned f2bf(float f) { unsigned u = __builtin_bit_cast(unsigned, f); return (u + 0x7fffu + ((u >> 16) & 1u)) >> 16; }
__device__ __forceinline__ unsigned pk2(float lo, float hi) { unsigned r; asm("v_cvt_pk_bf16_f32 %0, %1, %2" : "=v"(r) : "v"(lo), "v"(hi)); return r; }
__device__ __forceinline__ float bflo(unsigned w) { return __builtin_bit_cast(float, w << 16); }
__device__ __forceinline__ float bfhi(unsigned w) { return __builtin_bit_cast(float, w & 0xffff0000u); }
__device__ __forceinline__ float bf1(unsigned short h) { return __builtin_bit_cast(float, ((unsigned)h) << 16); }
__device__ __forceinline__ void cvt8(const v4u r, float (&f)[8]) {
    f[0] = bflo(r.x); f[1] = bfhi(r.x); f[2] = bflo(r.y); f[3] = bfhi(r.y); f[4] = bflo(r.z); f[5] = bfhi(r.z); f[6] = bflo(r.w); f[7] = bfhi(r.w);
}
__device__ __forceinline__ float sigmoidf_(float x) { return __builtin_amdgcn_rcpf(1.0f + __expf(-x)); }
__device__ __forceinline__ float siluf_(float x) { return x * sigmoidf_(x); }
__device__ __forceinline__ float wave_sum(float v) {
#pragma unroll
    for (int o = 1; o < 64; o <<= 1) v += __shfl_xor(v, o);
    return v;
}

#define XB_TMO      128
#define XB_XCNT(j)  (256  + 64 * (j))
#define XB_XSUB(j)  (1280 + 64 * (j))
#define XB_XGEN(j)  (2304 + 64 * (j))
#define XB_TOP      3328
#define XB_TOPGEN   3392
#define XCD_BAR_WORDS 3456
#define XB_SPIN_CAP (1u << 22)

__device__ __forceinline__ unsigned xb_ld(unsigned* p)              { return __hip_atomic_load(p, __ATOMIC_RELAXED, __HIP_MEMORY_SCOPE_AGENT); }
__device__ __forceinline__ unsigned xb_add(unsigned* p, unsigned v) { return __hip_atomic_fetch_add(p, v, __ATOMIC_RELAXED, __HIP_MEMORY_SCOPE_AGENT); }
__device__ __forceinline__ unsigned xb_xcc_id() { return (unsigned)__builtin_amdgcn_s_getreg((3 << 11) | 20) & 0xFu; }
#define XB_SPIN(cond, bar) do { unsigned _sp = 0; while (cond) { __builtin_amdgcn_s_sleep(1); \
    if ((++_sp & 255u) == 0u) { if (xb_ld(&(bar)[XB_TMO])) break; if (_sp > XB_SPIN_CAP) { atomicAdd(&(bar)[XB_TMO], 1u); break; } } } } while (0)

struct XcdBarrier { unsigned* bar; unsigned x; volatile LAS unsigned* st; };

__device__ __forceinline__ XcdBarrier xcd_barrier_post(unsigned* bar, volatile LAS unsigned* st) {
    XcdBarrier b; b.bar = bar; b.x = xb_xcc_id(); b.st = st;
    if (threadIdx.x == 0) (void)xb_add(&bar[XB_XCNT(b.x)], 1u);
    return b;
}
__device__ __forceinline__ void xcd_barrier_complete(unsigned* bar, unsigned x, unsigned& nloc, unsigned& nx) {
    const unsigned G = gridDim.x * gridDim.y * gridDim.z;
    unsigned sum, cnt, mine, sp = 0u;
    for (;;) {
        sum = 0u; cnt = 0u; mine = 0u;
#pragma unroll
        for (unsigned j = 0; j < 16; ++j) { const unsigned c = xb_ld(&bar[XB_XCNT(j)]); sum += c; cnt += (c > 0u) ? 1u : 0u; mine = (j == x) ? c : mine; }
        if (sum == G) break;
        __builtin_amdgcn_s_sleep(1);
        if ((++sp & 255u) == 0u) { if (xb_ld(&bar[XB_TMO])) break; if (sp > XB_SPIN_CAP) { atomicAdd(&bar[XB_TMO], 1u); break; } }
    }
    nloc = mine > 0u ? mine : 1u; nx = cnt > 0u ? cnt : 1u;
}
__device__ __forceinline__ void xcd_barrier(const XcdBarrier& b) {
    asm volatile("s_waitcnt vmcnt(0)" ::: "memory");
    __syncthreads();
    if (threadIdx.x == 0) {
        unsigned* bar = b.bar;
        __builtin_amdgcn_s_waitcnt(0);
        unsigned nloc = b.st[0], nx = b.st[1];
        if (nloc == 0u) { xcd_barrier_complete(bar, b.x, nloc, nx); b.st[0] = nloc; b.st[1] = nx; }
        const unsigned old = xb_add(&bar[XB_XSUB(b.x)], 1u);
        const unsigned gen = old / nloc;
        if (old + 1u == (gen + 1u) * nloc) {
            __builtin_amdgcn_fence(__ATOMIC_RELEASE, "agent");
            asm volatile("s_waitcnt vmcnt(0)" ::: "memory");
            const unsigned og = xb_add(&bar[XB_TOP], 1u);
            const unsigned tg = og / nx;
            if (og + 1u == (tg + 1u) * nx) xb_add(&bar[XB_TOPGEN], 1u);
            else XB_SPIN(xb_ld(&bar[XB_TOPGEN]) == tg, bar);
            __builtin_amdgcn_fence(__ATOMIC_ACQUIRE, "agent");
            xb_add(&bar[XB_XGEN(b.x)], 1u);
            asm volatile("s_waitcnt vmcnt(0)" ::: "memory");
        } else {
            XB_SPIN(xb_ld(&bar[XB_XGEN(b.x)]) == gen, bar);
            __builtin_amdgcn_fence(__ATOMIC_ACQUIRE, "agent");
            asm volatile("s_waitcnt vmcnt(0)" ::: "memory");
        }
    }
    __syncthreads();
}

struct Args { const float* in[21]; float* out; unsigned char* ws; int ph_lo, ph_hi; };
typedef const __attribute__((address_space(4))) Args* CArgs;
__device__ __forceinline__ int opaque_tid(int wave_s) { int t = wave_s * 64 + (int)__builtin_amdgcn_mbcnt_hi(~0u, __builtin_amdgcn_mbcnt_lo(~0u, 0u)); asm volatile("" : "+v"(t)); return t; }
__device__ __forceinline__ CArgs get_args() { CArgs p = (CArgs)__builtin_amdgcn_kernarg_segment_ptr(); asm volatile("" : "+s"(p)); return p; }
enum { I_X = 0, I_C, I_CTX, I_CCTX, I_ADAW, I_ADAB, I_NORMG, I_ABWIN, I_ACONVW, I_ACONVB, I_ALNG, I_ALNB, I_BCONVW, I_ABWOUT, I_MWIN, I_MBG, I_MHNG, I_MWOUT, I_FUP, I_FCONV, I_FDN };

template <int MODE> __device__ __forceinline__ int perm_row(int n0) {
    if (MODE == 1) return n0 < DFF ? 256 * (n0 / 128) + (n0 % 128) : 256 * ((n0 - DFF) / 128) + 128 + ((n0 - DFF) % 128);
    if (MODE == 2) { if (n0 < 4096) { const int ch = n0 & 2047, hi = n0 >> 11; return 256 * (ch / 128) + 128 * hi + (ch % 128); }
                     if (n0 < 6144) return n0;
                     const int j = n0 - 6144, ch = j & 2047, hi = j >> 11; return 6144 + 256 * (ch / 128) + 128 * hi + (ch % 128); }
    return n0;
}
template <int GATE_PERM = 0>
__device__ __forceinline__ void p0_transpose_item(const float* W, int K, int N, bf16* WT, LAS float* scr, int item, int lane) {
    const int nblk = N / 32, kb = item / nblk, nb = item % nblk, k0 = 64 * kb, n0 = 32 * nb;
    const int r0 = perm_row<GATE_PERM>(n0);
#pragma unroll 8
    for (int i = 0; i < 32; ++i) { const int kk = 2 * i + (lane >> 5); scr[kk * 33 + (lane & 31)] = W[(size_t)(k0 + kk) * N + n0 + (lane & 31)]; }
    LDS_WAIT(); asm volatile("" ::: "memory");
    const int c = lane & 7;
#pragma unroll
    for (int j = 0; j < 4; ++j) { const int n = (lane >> 3) + 8 * j; const LAS float* s = scr + (8 * c) * 33 + n;
        v4u o; o.x = pk2(s[0 * 33], s[1 * 33]); o.y = pk2(s[2 * 33], s[3 * 33]); o.z = pk2(s[4 * 33], s[5 * 33]); o.w = pk2(s[6 * 33], s[7 * 33]);
        __builtin_nontemporal_store(o, (v4u*)(WT + (size_t)(r0 + n) * K + k0 + 8 * c)); }
    LDS_WAIT(); asm volatile("" ::: "memory");
}

__device__ __forceinline__ void gemv_units(CArgs a, LAS unsigned char* lds, int layer, int first, int stride, int tid, int lane, int wave) {
    float* MOD = (float*)(a->ws + WS_MOD);
    LAS float* sv = (LAS float*)lds;
    LAS float* red = (LAS float*)(lds + 49152);
    for (int i = tid; i < 3 * D; i += NTHREADS) { const int r = i / D, k = i % D; const float v = (r < 2) ? a->in[I_C][r * D + k] : a->in[I_CCTX][k]; sv[i] = siluf_(v); }
    __syncthreads();
    for (int unit = first; unit < 768; unit += stride) {
        const int n0 = unit * 32;
        const int kg = wave * 8 + (lane >> 3), c4 = (lane & 7) * 4;
        const float* W = a->in[I_ADAW] + (size_t)layer * D * NMODC + (size_t)(kg * 64) * NMODC + n0 + c4;
        f32x4 a0 = {0.f, 0.f, 0.f, 0.f}, a1 = a0, a2 = a0;
        for (int k = 0; k < 64; k += 16) {
            f32x4 w[16];
#pragma unroll
            for (int j = 0; j < 16; ++j) w[j] = __builtin_nontemporal_load((const f32x4*)(W + (size_t)(k + j) * NMODC));
#pragma unroll
            for (int j = 0; j < 16; ++j) { const int kk = kg * 64 + k + j; a0 += w[j] * sv[kk]; a1 += w[j] * sv[D + kk]; a2 += w[j] * sv[2 * D + kk]; }
        }
        *(LAS f32x4*)(red + (kg * 3 + 0) * 32 + c4) = a0; *(LAS f32x4*)(red + (kg * 3 + 1) * 32 + c4) = a1; *(LAS f32x4*)(red + (kg * 3 + 2) * 32 + c4) = a2;
        __syncthreads();
        if (tid < 96) { const int r = tid >> 5, cc = tid & 31; float s = 0.f;
#pragma unroll 8
            for (int g = 0; g < 64; ++g) s += red[(g * 3 + r) * 32 + cc];
            MOD[((size_t)layer * 3 + r) * NMODC + n0 + cc] = s + a->in[I_ADAB][(size_t)layer * NMODC + n0 + cc]; }
        __syncthreads();
    }
}
template <int GATE_PERM>
__device__ __forceinline__ void transpose_item64(const float* W, int K, int N, bf16* WT, LAS float* scr, int item, int lane, int nblk) {
    const int kb = item / nblk, nb = item % nblk, k0 = 64 * kb, n0 = 64 * nb;
    const int r0 = perm_row<GATE_PERM>(n0);
    const int kq = lane >> 4, j4 = (lane & 15) * 4;
    f32x4 v[16];
#pragma unroll
    for (int i = 0; i < 16; ++i) v[i] = __builtin_nontemporal_load((const f32x4*)(W + (size_t)(k0 + 4 * i + kq) * N + n0 + j4));
#pragma unroll
    for (int i = 0; i < 16; ++i) { LAS float* p = scr + (4 * i + kq) * 65 + j4; p[0] = v[i].x; p[1] = v[i].y; p[2] = v[i].z; p[3] = v[i].w; }
    LDS_WAIT(); asm volatile("" ::: "memory");
    const int c = lane & 7;
#pragma unroll
    for (int j = 0; j < 8; ++j) { const int n = (lane >> 3) + 8 * j; const LAS float* p = scr + (8 * c) * 65 + n;
        v4u o; o.x = pk2(p[0 * 65], p[1 * 65]); o.y = pk2(p[2 * 65], p[3 * 65]); o.z = pk2(p[4 * 65], p[5 * 65]); o.w = pk2(p[6 * 65], p[7 * 65]);
        __builtin_nontemporal_store(o, (v4u*)(WT + (size_t)(r0 + n) * K + k0 + 8 * c)); }
    LDS_WAIT(); asm volatile("" ::: "memory");
}
template <int GATE_PERM>
__device__ __forceinline__ void conv_items(const float* W, int K, int N, bf16* WT, LAS unsigned char* lds, int first, int stride, int lane, int wave) {
    LAS float* scr = (LAS float*)(lds + wave * 16640);
    const int nb64 = N / 64, nitems = (K / 64) * nb64;
    for (int it = first; it < nitems; it += stride) transpose_item64<GATE_PERM>(W, K, N, WT, scr, it, lane, nb64);
    if (N % 64) for (int kb = first; kb < K / 64; kb += stride) p0_transpose_item<GATE_PERM>(W, K, N, WT, scr, kb * (N / 32) + (N / 32 - 1), lane);
}
enum { CV_ABIN = 0, CV_ABOUT, CV_MIN, CV_MOUT, CV_UP0, CV_UP1, CV_DN0, CV_DN1 };
template <int WHICH>
__device__ __forceinline__ void conv_matrix(CArgs a, LAS unsigned char* lds, int first, int stride, int lane, int wave) {
    unsigned char* ws = a->ws;
    if (WHICH == CV_ABIN) conv_items<2>(a->in[I_ABWIN], D, ABIN, (bf16*)(ws + WS_WABIN), lds, first, stride, lane, wave);
    if (WHICH == CV_ABOUT) conv_items<0>(a->in[I_ABWOUT], D, D, (bf16*)(ws + WS_WABOUT), lds, first, stride, lane, wave);
    if (WHICH == CV_MIN) { conv_items<0>(a->in[I_MWIN], D, CIN, (bf16*)(ws + WS_WMIN), lds, first, stride, lane, wave);
        v4u* p = (v4u*)((bf16*)(ws + WS_WMIN) + (size_t)CIN * D); const int n16 = (CINP - CIN) * D * 2 / 16;
        for (int i = first * 64 + lane; i < n16; i += stride * 64) p[i] = (v4u){0u, 0u, 0u, 0u}; }
    if (WHICH == CV_MOUT) conv_items<0>(a->in[I_MWOUT], D, D, (bf16*)(ws + WS_WMOUT), lds, first, stride, lane, wave);
    if (WHICH == CV_UP0) conv_items<1>(a->in[I_FUP], D, DFF2, (bf16*)(ws + WS_WUP0), lds, first, stride, lane, wave);
    if (WHICH == CV_UP1) conv_items<1>(a->in[I_FUP] + (size_t)D * DFF2, D, DFF2, (bf16*)(ws + WS_WUP0 + 172 * MiB), lds, first, stride, lane, wave);
    if (WHICH == CV_DN0) conv_items<0>(a->in[I_FDN], DFF, D, (bf16*)(ws + WS_WDN0), lds, first, stride, lane, wave);
    if (WHICH == CV_DN1) conv_items<0>(a->in[I_FDN] + (size_t)DFF * D, DFF, D, (bf16*)(ws + WS_WDN0 + 86 * MiB), lds, first, stride, lane, wave);
}
__device__ __forceinline__ void p0_prologue(CArgs a, LAS unsigned char* lds, int tid, int lane, int wave) {
    gemv_units(a, lds, 0, blockIdx.x, gridDim.x, tid, lane, wave);
    const int gw = blockIdx.x * NWAVES + wave, NGW = gridDim.x * NWAVES;
    conv_matrix<CV_ABIN>(a, lds, gw, NGW, lane, wave);
#if PROBE_E1
    conv_matrix<CV_ABOUT>(a, lds, gw, NGW, lane, wave);
    conv_matrix<CV_UP0>(a, lds, gw, NGW, lane, wave); conv_matrix<CV_DN0>(a, lds, gw, NGW, lane, wave); conv_matrix<CV_MIN>(a, lds, gw, NGW, lane, wave); conv_matrix<CV_MOUT>(a, lds, gw, NGW, lane, wave);
    conv_matrix<CV_UP1>(a, lds, gw, NGW, lane, wave); conv_matrix<CV_DN1>(a, lds, gw, NGW, lane, wave); __syncthreads(); gemv_units(a, lds, 1, blockIdx.x, gridDim.x, tid, lane, wave);
#endif
}
__device__ __forceinline__ int gemm_wgs(int nwg) { const int G = gridDim.x, rounds = (nwg + G - 1) / G; const int g = ((nwg + rounds - 1) / rounds + 7) & ~7; return g < G ? g : G; }

template <bool RES, bool DOH>
__device__ __forceinline__ void row_phase(LAS unsigned char* lds, int nrows, const float* xin_lat, const float* xin_ctx, float* xout_lat, float* xout_ctx,
                                          const bf16* Y, const float* gpost, const float* modres, int gate_idx,
                                          const float* gpre, const float* modh, int shift_idx, int scale_idx, bf16* H, int tid, int lane, int wave) {
    LAS f32x4* pG = (LAS f32x4*)lds; LAS f32x4* pA = pG + 1024; LAS f32x4* pB = pA + 1024;
    const int G = gridDim.x, rpw = (nrows + G - 1) / G, r0 = (int)blockIdx.x * rpw, r1 = (r0 + rpw < nrows) ? r0 + rpw : nrows;
    for (int vb = r0; vb < r1;) {
        const int mr = vb < ML ? (vb >> 13) : 2;
        const int lim = mr == 0 ? SEQ : (mr == 1 ? ML : nrows), vend = r1 < lim ? r1 : lim;
        __syncthreads();
        for (int i = tid; i < 1024; i += NTHREADS) {
            if (RES) pG[i] = ((const f32x4*)(modres + (size_t)mr * NMODC + gate_idx * D))[i] * ((const f32x4*)gpost)[i];
            if (DOH) { pA[i] = ((const f32x4*)gpre)[i] * (((const f32x4*)(modh + (size_t)mr * NMODC + scale_idx * D))[i] + 1.0f); pB[i] = ((const f32x4*)(modh + (size_t)mr * NMODC + shift_idx * D))[i]; }
        }
        __syncthreads();
        for (int row = vb + wave; row < vend; row += NWAVES) {
            const float* xr = row < ML ? xin_lat + (size_t)row * D : xin_ctx + (size_t)(row - ML) * D;
            f32x4 v[16];
            if (RES) {
                const bf16* yr = Y + (size_t)row * D; float s = 0.f;
#pragma unroll
                for (int j = 0; j < 16; ++j) { const v2u yw = *(const v2u*)(yr + j * 256 + lane * 4); v[j] = (f32x4){bflo(yw.x), bfhi(yw.x), bflo(yw.y), bfhi(yw.y)}; s += (v[j].x * v[j].x + v[j].y * v[j].y) + (v[j].z * v[j].z + v[j].w * v[j].w); }
                const float rstd = 1.0f / sqrtf(wave_sum(s) * (1.0f / D) + EPS);
                float* xo = row < ML ? xout_lat + (size_t)row * D : xout_ctx + (size_t)(row - ML) * D;
#pragma unroll
                for (int j = 0; j < 16; ++j) { const int o = j * 256 + lane * 4;
                    const f32x4 x = *(const f32x4*)(xr + o);
                    v[j] = x + (v[j] * rstd) * pG[j * 64 + lane];
                    *(f32x4*)(xo + o) = v[j];
                    if ((j & 3) == 3) asm volatile("" ::: "memory"); }
            } else {
#pragma unroll
                for (int j = 0; j < 16; ++j) v[j] = *(const f32x4*)(xr + j * 256 + lane * 4);
            }
            if (DOH) {
                float s = 0.f;
#pragma unroll
                for (int j = 0; j < 16; ++j) s += (v[j].x * v[j].x + v[j].y * v[j].y) + (v[j].z * v[j].z + v[j].w * v[j].w);
                const float rstd = 1.0f / sqrtf(wave_sum(s) * (1.0f / D) + EPS);
                bf16* hr = H + (size_t)row * D;
#pragma unroll
                for (int j = 0; j < 16; ++j) { const int o = j * 256 + lane * 4;
                    const f32x4 h = (v[j] * rstd) * pA[j * 64 + lane] + pB[j * 64 + lane];
                    v2u w; w.x = pk2(h.x, h.y); w.y = pk2(h.z, h.w);
                    *(v2u*)(hr + o) = w; }
            }
        }
        vb = vend;
    }
}

__device__ __forceinline__ void mixer_conv_phase(CArgs a, LAS unsigned char* lds, int tid, int lane) {
    const bf16* U = (const bf16*)(a->ws + WS_U);
    bf16* T1 = (bf16*)(a->ws + WS_Y);
    bf16* V = (bf16*)(a->ws + WS_G);
    LAS float* tile = (LAS float*)lds;
    const float* cw = a->in[I_ACONVW]; const float* cb = a->in[I_ACONVB];
    v4u rva[6]; f32x2 w[ACONV]; f32x2 bias = {0.f, 0.f}; int cc_w = -1;
#define MX_ROW(tb_, j_) ((tb_) < 256 ? (((j_) >= 15 && (j_) < 79) ? (tb_) * 64 + ((j_) - 15) : -1) \
        : ((((tb_) - 256) & 3) * 64 + ((j_) - 15) >= 0 && (((tb_) - 256) & 3) * 64 + ((j_) - 15) < CTXL ? ML + (((tb_) - 256) >> 2) * CTXL + (((tb_) - 256) & 3) * 64 + ((j_) - 15) : -1))
#define MX_LOAD(unit_) do { const int tb_ = (unit_) >> 3, cc_ = (unit_) & 7; \
        _Pragma("unroll") for (int q = 0; q < 6; ++q) { const int it = tid + NTHREADS * q; const int j = it >> 5, ch8 = it & 31; const int row = it < 94 * 32 ? MX_ROW(tb_, j) : -1; \
            const size_t o_ = (size_t)(row >= 0 ? row : 0) * ABU + cc_ * 256 + ch8 * 8; rva[q] = *(const v4u*)(U + o_); } } while (0)
    if ((int)blockIdx.x < 264 * 8) MX_LOAD(blockIdx.x);
    for (int unit = blockIdx.x; unit < 264 * 8; unit += gridDim.x) {
        const int tb = unit >> 3, cc = unit & 7;
#pragma unroll
        for (int q = 0; q < 6; ++q) { const int it = tid + NTHREADS * q; const int j = it >> 5, ch8 = it & 31;
            if (it < 94 * 32) { const int row = MX_ROW(tb, j); const float f = row >= 0 ? 1.f : 0.f; const v4u va = rva[q]; f32x4 g0, g1;
                g0.x = f * bflo(va.x); g0.y = f * bfhi(va.x); g0.z = f * bflo(va.y); g0.w = f * bfhi(va.y);
                g1.x = f * bflo(va.z); g1.y = f * bfhi(va.z); g1.z = f * bflo(va.w); g1.w = f * bfhi(va.w);
                *(LAS f32x4*)(tile + j * 256 + ch8 * 8) = g0; *(LAS f32x4*)(tile + j * 256 + ch8 * 8 + 4) = g1; } }
        __syncthreads();
        if (unit + (int)gridDim.x < 264 * 8) MX_LOAD(unit + (int)gridDim.x);
        {
            const int cp = tid & 127, tg = tid >> 7, c = cc * 256 + 2 * cp;
            if (cc != cc_w) { cc_w = cc;
#pragma unroll
                for (int k = 0; k < ACONV; ++k) w[k] = *(const f32x2*)(cw + k * WA + c);
                bias = *(const f32x2*)(cb + c); }
            f32x2 acc[16];
#pragma unroll
            for (int i = 0; i < 16; ++i) acc[i] = (f32x2){0.f, 0.f};
#pragma unroll
            for (int jj = 0; jj < 46; ++jj) {
                const f32x2 g = *(const LAS f32x2*)(tile + (16 * tg + jj) * 256 + 2 * cp);
#pragma unroll
                for (int i = 0; i < 16; ++i) { const int k = jj - i; if (k >= 0 && k < ACONV) acc[i] += w[k] * g; }
            }
            int row0;
            if (tb < 256) row0 = tb * 64 + 16 * tg; else { const int cbk = tb - 256; row0 = ML + (cbk >> 2) * CTXL + (cbk & 3) * 64 + 16 * tg; }
#pragma unroll
            for (int i = 0; i < 16; ++i) { const f32x2 o = acc[i] + bias; *(unsigned*)(T1 + (size_t)(row0 + i) * WA + c) = pk2(o.x, o.y); }
        }
        __syncthreads();
    }
#undef MX_ROW
#undef MX_LOAD
    const float* bw = a->in[I_BCONVW];
    constexpr int NSEG_L = 2 * 64 * 16, NIT_L = NSEG_L * 256, NIT_C = 2 * 32 * 256;
    for (int it = blockIdx.x * NTHREADS + tid; it < NIT_L + NIT_C; it += gridDim.x * NTHREADS) {
        int row0, stride, prow, nrow, c;
        if (it < NIT_L) { const int c8 = it & 255, r = it >> 8, x = r & 63, seg = (r >> 6) & 15, b = r >> 10;
            c = c8 * 8; stride = 64; row0 = b * SEQ + (seg * 8) * 64 + x; prow = seg > 0 ? row0 - 64 : -1; nrow = seg < 15 ? row0 + 8 * 64 : -1; }
        else { const int j = it - NIT_L, c8 = j & 255, r = j >> 8, seg = r & 31, b = r >> 5;
            c = c8 * 8; stride = 1; row0 = ML + b * CTXL + seg * 8; prow = seg > 0 ? row0 - 1 : -1; nrow = seg < 31 ? row0 + 8 : -1; }
        float w[3][8];
#pragma unroll
        for (int k = 0; k < 3; ++k) { const f32x4 w0 = *(const f32x4*)(bw + k * 2048 + c), w1 = *(const f32x4*)(bw + k * 2048 + c + 4);
            w[k][0] = w0.x; w[k][1] = w0.y; w[k][2] = w0.z; w[k][3] = w0.w; w[k][4] = w1.x; w[k][5] = w1.y; w[k][6] = w1.z; w[k][7] = w1.w; }
        const bf16* uz = U + 4096 + c; const bf16* ub = U + 2048 + c;
        v4u rc[10], rb[8];
#pragma unroll
        for (int i = 0; i < 10; ++i) { const int rr = i == 0 ? (prow >= 0 ? prow : row0) : (i == 9 ? (nrow >= 0 ? nrow : row0) : row0 + (i - 1) * stride);
            rc[i] = *(const v4u*)(uz + (size_t)rr * ABU); }
#pragma unroll
        for (int i = 0; i < 8; ++i) rb[i] = *(const v4u*)(ub + (size_t)(row0 + i * stride) * ABU);
        float pp[8], pc[8];
        { float a8[8]; cvt8(rc[0], a8); const float f = prow >= 0 ? 1.f : 0.f;
#pragma unroll
          for (int e = 0; e < 8; ++e) pp[e] = a8[e] * f;
          cvt8(rc[1], pc); }
#pragma unroll
        for (int i = 0; i < 8; ++i) {
            float pn[8], bb[8]; cvt8(rc[i + 2], pn); cvt8(rb[i], bb);
            const float f = (i == 7 && nrow < 0) ? 0.f : 1.f;
#pragma unroll
            for (int e = 0; e < 8; ++e) pn[e] *= f;
            float o[8];
#pragma unroll
            for (int e = 0; e < 8; ++e) o[e] = bb[e] * (w[0][e] * pp[e] + w[1][e] * pc[e] + w[2][e] * pn[e]);
            v4u ov; ov.x = pk2(o[0], o[1]); ov.y = pk2(o[2], o[3]); ov.z = pk2(o[4], o[5]); ov.w = pk2(o[6], o[7]);
            *(v4u*)(V + (size_t)(row0 + i * stride) * D + WA + c) = ov;
#pragma unroll
            for (int e = 0; e < 8; ++e) { pp[e] = pc[e]; pc[e] = pn[e]; }
        }
    }
}
__device__ __forceinline__ void mixer_ln_phase(CArgs a, LAS unsigned char* lds, int tid, int lane, int wave) {
    const bf16* T1 = (const bf16*)(a->ws + WS_Y);
    bf16* V = (bf16*)(a->ws + WS_G);
    LAS f32x4* pg = (LAS f32x4*)lds; LAS f32x4* pb = pg + 512;
    for (int i = tid; i < 512; i += NTHREADS) { pg[i] = ((const f32x4*)a->in[I_ALNG])[i]; pb[i] = ((const f32x4*)a->in[I_ALNB])[i]; }
    __syncthreads();
    const int G = gridDim.x, rpw = (MT + G - 1) / G, r0 = (int)blockIdx.x * rpw, r1 = (r0 + rpw < MT) ? r0 + rpw : MT;
    for (int row = r0 + wave; row < r1; row += NWAVES) {
        f32x4 v[8]; float s = 0.f;
#pragma unroll
        for (int j = 0; j < 8; ++j) { const v2u tw = *(const v2u*)(T1 + (size_t)row * WA + j * 256 + lane * 4); v[j] = (f32x4){bflo(tw.x), bfhi(tw.x), bflo(tw.y), bfhi(tw.y)}; s += (v[j].x + v[j].y) + (v[j].z + v[j].w); }
        const float mu = wave_sum(s) * (1.0f / WA); float q = 0.f;
#pragma unroll
        for (int j = 0; j < 8; ++j) { v[j] = v[j] - mu; q += (v[j].x * v[j].x + v[j].y * v[j].y) + (v[j].z * v[j].z + v[j].w * v[j].w); }
        const float rstd = 1.0f / sqrtf(wave_sum(q) * (1.0f / WA) + EPS);
#pragma unroll
        for (int j = 0; j < 8; ++j) { const int o = j * 256 + lane * 4;
            const f32x4 y = (v[j] * rstd) * pg[j * 64 + lane] + pb[j * 64 + lane];
            v2u w; w.x = pk2(siluf_(y.x), siluf_(y.y)); w.y = pk2(siluf_(y.z), siluf_(y.w));
            *(v2u*)(V + (size_t)row * D + o) = w; }
    }
}

template <int NR>
__device__ __forceinline__ void ffn_gate_slide(const bf16* ug, const bf16* uv, int ldu, bf16* Go, const float* cwg, const float* cwv, int row0, int prow, int nrow) {
    float wg[3][8], wv[3][8];
#pragma unroll
    for (int k = 0; k < 3; ++k) {
        const f32x4 a0 = *(const f32x4*)(cwg + k * DFF2), a1 = *(const f32x4*)(cwg + k * DFF2 + 4), b0 = *(const f32x4*)(cwv + k * DFF2), b1 = *(const f32x4*)(cwv + k * DFF2 + 4);
        wg[k][0] = a0.x; wg[k][1] = a0.y; wg[k][2] = a0.z; wg[k][3] = a0.w; wg[k][4] = a1.x; wg[k][5] = a1.y; wg[k][6] = a1.z; wg[k][7] = a1.w;
        wv[k][0] = b0.x; wv[k][1] = b0.y; wv[k][2] = b0.z; wv[k][3] = b0.w; wv[k][4] = b1.x; wv[k][5] = b1.y; wv[k][6] = b1.z; wv[k][7] = b1.w;
    }
    float pg[8], pv[8], cg[8], cv[8];
    { const float fp = prow >= 0 ? 1.f : 0.f; const int pr = prow >= 0 ? prow : row0;
      const v4u a = *(const v4u*)(ug + (size_t)pr * ldu), b = *(const v4u*)(uv + (size_t)pr * ldu); cvt8(a, pg); cvt8(b, pv);
#pragma unroll
      for (int e = 0; e < 8; ++e) { pg[e] *= fp; pv[e] *= fp; }
      const v4u a2 = *(const v4u*)(ug + (size_t)row0 * ldu), b2 = *(const v4u*)(uv + (size_t)row0 * ldu); cvt8(a2, cg); cvt8(b2, cv); }
    const float fn = nrow >= 0 ? 1.f : 0.f; const int nr = nrow >= 0 ? nrow : row0;
    for (int blk = 0; blk < NR / 4; ++blk) {
        v4u rg[4], rv[4];
#pragma unroll
        for (int i = 0; i < 4; ++i) { const int r = 4 * blk + 1 + i; const int rr = r < NR ? row0 + r : nr;
            rg[i] = *(const v4u*)(ug + (size_t)rr * ldu); rv[i] = *(const v4u*)(uv + (size_t)rr * ldu); }
#pragma unroll
        for (int i = 0; i < 4; ++i) {
            float ng[8], nv[8]; cvt8(rg[i], ng); cvt8(rv[i], nv);
            if (i == 3) { const float f = (4 * blk + 4 < NR) ? 1.f : fn;
#pragma unroll
                for (int e = 0; e < 8; ++e) { ng[e] *= f; nv[e] *= f; } }
            float o[8];
#pragma unroll
            for (int e = 0; e < 8; ++e) { const float g = wg[0][e] * pg[e] + wg[1][e] * cg[e] + wg[2][e] * ng[e], v = wv[0][e] * pv[e] + wv[1][e] * cv[e] + wv[2][e] * nv[e]; o[e] = siluf_(g) * v; }
            v4u w; w.x = pk2(o[0], o[1]); w.y = pk2(o[2], o[3]); w.z = pk2(o[4], o[5]); w.w = pk2(o[6], o[7]);
            *(v4u*)(Go + (size_t)(4 * blk + i) * DFF) = w;
#pragma unroll
            for (int e = 0; e < 8; ++e) { pg[e] = cg[e]; pv[e] = cv[e]; cg[e] = ng[e]; cv[e] = nv[e]; }
        }
    }
}
__device__ __forceinline__ void ffn_gate_ctx_phase(CArgs a, int tid) {
    const bf16* UC = (const bf16*)(a->ws + WS_UC);
    bf16* G = (bf16*)(a->ws + WS_G);
    const float* cw = a->in[I_FCONV];
    constexpr int NC8 = DFF / 8;
    constexpr int NIT = 8 * NC8 * 4, PER = (NIT + 255) / 256;
    for (int it = blockIdx.x * PER + tid; tid < PER && it < NIT; it += gridDim.x * PER) {
        const int q4 = it & 3, rest = it >> 2, c8 = rest % NC8, blk = rest / NC8, ch = c8 * 8;
        const int p0 = (blk & 3) * 64 + q4 * 16, lrow0 = (blk >> 2) * CTXL + p0;
        const bf16* ug = UC + 256 * (ch >> 7) + (ch & 127);
        ffn_gate_slide<16>(ug, ug + 128, DFF2, G + (size_t)(ML + lrow0) * DFF + ch, cw + ch, cw + DFF + ch, lrow0, p0 > 0 ? lrow0 - 1 : -1, p0 + 16 < CTXL ? lrow0 + 16 : -1);
    }
}

__device__ __forceinline__ int chunk_row0(int dir, int b, int c) {
    if (dir == 0) return c < 2 ? ML + b * CTXL + 128 * c : b * SEQ + 128 * (c - 2);
    return c < 2 ? ML + b * CTXL + 128 * (1 - c) : b * SEQ + 128 * (63 - (c - 2));
}
__device__ __forceinline__ float wave_incl_sum(float v, int lane) {
#pragma unroll
    for (int o = 1; o < 64; o <<= 1) { const float t = __shfl_up(v, o); if (lane >= o) v += t; }
    return v;
}
__device__ __forceinline__ float wave_incl_max(float v, int lane) {
#pragma unroll
    for (int o = 1; o < 64; o <<= 1) { const float t = __shfl_up(v, o); if (lane >= o) v = fmaxf(v, t); }
    return v;
}
__device__ __forceinline__ bf16x8 tr_frag(LAS unsigned char* T, int pitch, int k0, int col0, int lane) {
    const int g = lane >> 4, q = (lane & 15) >> 2, p = lane & 3;
    LAS unsigned char* p0 = T + (k0 + 8 * g + q) * pitch + (col0 + 4 * p) * 2;
    const s16x4 lo = __builtin_amdgcn_ds_read_tr16_b64_v4i16((LAS s16x4*)p0);
    const s16x4 hi = __builtin_amdgcn_ds_read_tr16_b64_v4i16((LAS s16x4*)(p0 + 4 * pitch));
    bf16x8 r; r[0] = lo[0]; r[1] = lo[1]; r[2] = lo[2]; r[3] = lo[3]; r[4] = hi[0]; r[5] = hi[1]; r[6] = hi[2]; r[7] = hi[3];
    return r;
}
#ifndef SCAN_REP
#define SCAN_REP 1
#endif
#define MFMA16(y, x, acc) __builtin_amdgcn_mfma_f32_16x16x32_bf16((y), (x), (acc), 0, 0, 0)

constexpr int SK_PITCH = 528;

constexpr size_t WS_SPP = WS_Y;
constexpr size_t WS_DEN = WS_Y + 64 * MiB;
static_assert((size_t)32 * 64 * 128 * 128 * 2 <= 64 * MiB && WS_DEN + (size_t)32 * 64 * 128 * 4 <= WS_HS, "scan scratch");
__device__ __forceinline__ void chunk_scalars(CArgs a, int dir, int b, int h, int c, LAS float* sAl, LAS float* sPl, int lane) {
    const float* GT = (const float*)(a->ws + WS_GATES);
    float* SCP = (float*)(a->ws + WS_SCP); float* SCG = (float*)(a->ws + WS_SCC);
    const int chain = dir * 16 + b * 8 + h, R0 = chunk_row0(dir, b, c);
    const float bi = a->in[I_MBG][dir * 16 + h], bf = a->in[I_MBG][dir * 16 + 8 + h];
    const int r0 = dir ? 127 - lane : lane, r1 = dir ? 63 - lane : 64 + lane;
    const float i0 = GT[(size_t)(R0 + r0) * 32 + dir * 16 + h] + bi, i1 = GT[(size_t)(R0 + r1) * 32 + dir * 16 + h] + bi;
    const float x0 = GT[(size_t)(R0 + r0) * 32 + dir * 16 + 8 + h] + bf, x1 = GT[(size_t)(R0 + r1) * 32 + dir * 16 + 8 + h] + bf;
    const float f0 = fminf(x0, 0.f) - log1pf(__expf(-fabsf(x0))), f1 = fminf(x1, 0.f) - log1pf(__expf(-fabsf(x1)));
    const float s0 = wave_incl_sum(f0, lane); const float tot0 = __shfl(s0, 63);
    const float s1 = wave_incl_sum(f1, lane) + tot0;
    const float a0 = i0 - s0, a1 = i1 - s1;
    const float p0 = wave_incl_max(a0, lane); const float pm0 = __shfl(p0, 63);
    const float p1 = fmaxf(wave_incl_max(a1, lane), pm0);
    float* o = SCP + ((size_t)chain * NCH + c) * 384;
    o[r0] = a0; o[128 + r0] = p0; o[256 + r0] = s0;
    o[r1] = a1; o[128 + r1] = p1; o[256 + r1] = s1;
    if (sAl) { sAl[r0] = a0; sAl[r1] = a1; }
    if (lane == 63) { SCG[((size_t)chain * NCH + c) * 2] = s1; SCG[((size_t)chain * NCH + c) * 2 + 1] = p1; if (sPl) sPl[0] = p1; }
}
__device__ __forceinline__ void scan_pre_phase(CArgs a, LAS unsigned char* lds, int tid, int lane, int wave) {
    const bf16* QK = (const bf16*)(a->ws + WS_U);
    bf16* SPP = (bf16*)(a->ws + WS_SPP); float* DEN = (float*)(a->ws + WS_DEN);
    LAS unsigned char* Kl = lds; LAS float* sA0 = (LAS float*)(lds + 67584); LAS float* sA1 = sA0 + 128; LAS float* sPt = sA0 + 256;
    const int g = lane >> 4, l15 = lane & 15;
    for (int unit = blockIdx.x; unit < 1024 + 64; unit += gridDim.x) {
        if (unit >= 1024) { if (wave == 0) { const int u = unit - 1024, chain = u >> 1, c = u & 1; chunk_scalars(a, chain >> 4, (chain >> 3) & 1, chain & 7, c, nullptr, nullptr, lane); } continue; }
        const int bh = unit >> 6, j = unit & 63, b = bh >> 3, h = bh & 7;
        const int R0 = b * SEQ + 128 * j, c0 = 2 + j, c1 = 2 + (63 - j);
        const int tl = 16 * wave + l15;
#pragma unroll
        for (int i = 0; i < 8; ++i) { const int idx = tid + NTHREADS * i, r = idx >> 5, ch = idx & 31;
            const v4u v = *(const v4u*)(QK + (size_t)(R0 + r) * QKVO + 2048 + h * DQK + ch * 8);
            *(LAS v4u*)(Kl + r * SK_PITCH + ch * 16) = v; }
        bf16x8 qf[8];
#pragma unroll
        for (int kk = 0; kk < 8; ++kk) qf[kk] = *(const bf16x8*)(QK + (size_t)(R0 + tl) * QKVO + h * DQK + 32 * kk + 8 * g);
        if (wave == 0) chunk_scalars(a, 0, b, h, c0, sA0, sPt, lane);
        if (wave == 1) chunk_scalars(a, 1, b, h, c1, sA1, sPt + 1, lane);
        __syncthreads();
        {
            const float pt0 = sPt[0], pt1 = sPt[1];
            float dp0 = 0.f, dp1 = 0.f;
            int tlv = tl, gv = 4 * g; asm volatile("" : "+v"(tlv), "+v"(gv));
            bf16* sp0 = SPP + ((size_t)((0 * 16 + bh) * 64 + (c0 - 2)) * 128 + tl) * 128;
            bf16* sp1 = SPP + ((size_t)((1 * 16 + bh) * 64 + (c1 - 2)) * 128 + tl) * 128;
#pragma unroll
            for (int nh = 0; nh < 2; ++nh) {
                f32x4 sacc[4];
#pragma unroll
                for (int n = 0; n < 4; ++n) sacc[n] = (f32x4){0.f, 0.f, 0.f, 0.f};
#pragma unroll
                for (int kk = 0; kk < 8; ++kk)
#pragma unroll
                    for (int n = 0; n < 4; ++n) { const bf16x8 yf = *(const LAS bf16x8*)(Kl + (16 * (4 * nh + n) + l15) * SK_PITCH + (32 * kk + 8 * g) * 2); sacc[n] = MFMA16(yf, qf[kk], sacc[n]); }
#pragma unroll
                for (int n = 0; n < 4; ++n) { float sv0[4], sv1[4]; const int n8 = 4 * nh + n;
#pragma unroll
                    for (int r = 0; r < 4; ++r) { const int sl = 16 * n8 + 4 * g + r; const int sidx = gv + (16 * n8 + r);
                        const float qk = sacc[n][r] * 0.0625f;
                        sv0[r] = (sidx <= tlv) ? qk * __expf(sA0[sl] - pt0) : 0.f; dp0 += sv0[r];
                        sv1[r] = (sidx >= tlv) ? qk * __expf(sA1[sl] - pt1) : 0.f; dp1 += sv1[r]; }
                    v2u w0; w0.x = pk2(sv0[0], sv0[1]); w0.y = pk2(sv0[2], sv0[3]); *(v2u*)(sp0 + 16 * n8 + 4 * g) = w0;
                    v2u w1; w1.x = pk2(sv1[0], sv1[1]); w1.y = pk2(sv1[2], sv1[3]); *(v2u*)(sp1 + 16 * n8 + 4 * g) = w1; }
                asm volatile("" ::: "memory");
            }
            dp0 += __shfl_xor(dp0, 16); dp0 += __shfl_xor(dp0, 32); dp1 += __shfl_xor(dp1, 16); dp1 += __shfl_xor(dp1, 32);
            if (g == 0) { DEN[(size_t)((0 * 16 + bh) * 64 + (c0 - 2)) * 128 + tl] = dp0; DEN[(size_t)((1 * 16 + bh) * 64 + (c1 - 2)) * 128 + tl] = dp1; }
        }
        __syncthreads();
    }
}

constexpr int S2V_PITCH = 160;
constexpr int S2K_PITCH = 544;
__device__ __forceinline__ int s2_sigma(int r) { return (r & ~12) | ((r & 4) << 1) | ((r & 8) >> 1); }
__device__ __forceinline__ bf16x8 tr_frag_sw(LAS unsigned char* T, int pitch, int k0, int col0, int lane) {
    const int g = lane >> 4, q = (lane & 15) >> 2, p = lane & 3;
    LAS unsigned char* p0 = T + (k0 + 16 * (g >> 1) + 4 * (g & 1) + q) * pitch + (col0 + 4 * p) * 2;
    const s16x4 lo = __builtin_amdgcn_ds_read_tr16_b64_v4i16((LAS s16x4*)p0);
    const s16x4 hi = __builtin_amdgcn_ds_read_tr16_b64_v4i16((LAS s16x4*)(p0 + 8 * pitch));
    bf16x8 r; r[0] = lo[0]; r[1] = lo[1]; r[2] = lo[2]; r[3] = lo[3]; r[4] = hi[0]; r[5] = hi[1]; r[6] = hi[2]; r[7] = hi[3];
    return r;
}
constexpr int S2K_OFF = 0, S2V_OFF = 128 * S2K_PITCH, S2S_OFF = S2V_OFF + 128 * S2V_PITCH, S2C_OFF = S2S_OFF + 128 * S2V_PITCH, S2M_OFF = S2C_OFF + 80 * SK_PITCH;
static_assert(S2M_OFF + 4 * 272 <= MISC_OFF, "scan v2 LDS map");
#define SCHED_FENCE() do { } while (0)
#define LDS_BARRIER() do { asm volatile("s_waitcnt lgkmcnt(0)" ::: "memory"); __builtin_amdgcn_s_barrier(); asm volatile("" ::: "memory"); } while (0)
__device__ __forceinline__ void scan_seq_phase(CArgs a, LAS unsigned char* lds, int tid, int lane, int wave) {
    const bf16* QK = (const bf16*)(a->ws + WS_U);
    const float* SCP = (const float*)(a->ws + WS_SCP); const float* SCG = (const float*)(a->ws + WS_SCC);
    const bf16* SPP = (const bf16*)(a->ws + WS_SPP); const float* DEN = (const float*)(a->ws + WS_DEN);
    bf16* HS = (bf16*)(a->ws + WS_HS);
    LAS unsigned char* Kl = lds + S2K_OFF; LAS unsigned char* Vl = lds + S2V_OFF; LAS unsigned char* Vs = lds + S2S_OFF; LAS unsigned char* Cl = lds + S2C_OFF;
    LAS float* mp = (LAS float*)(lds + S2M_OFF); LAS float* ml = mp + 68; LAS float* pt = mp + 136; LAS float* gl = mp + 204;
    for (int unit_ = blockIdx.x; unit_ < 256 * SCAN_REP; unit_ += gridDim.x) { const int u0 = unit_ & 255, unit = ((u0 & 7) << 5) | (u0 >> 3);
        const int chain = unit >> 3, slice = unit & 7, dir = chain >> 4, b = (chain >> 3) & 1, h = chain & 7;
        int tid_u = tid; asm volatile("" : "+v"(tid_u));
        if (tid < NCH) { gl[tid] = SCG[((size_t)chain * NCH + tid) * 2]; pt[tid] = SCG[((size_t)chain * NCH + tid) * 2 + 1]; }
        for (int i = tid_u; i < 80 * SK_PITCH / 4; i += NTHREADS) ((LAS unsigned*)Cl)[i] = 0u;
        for (int i = tid_u; i < 128 * 8; i += NTHREADS) { const int r = i >> 3, w = i & 7; ((LAS unsigned*)(Vs + r * S2V_PITCH + 128))[w] = 0u; }
        __syncthreads();
        if (tid == 0) { float m = 0.f; for (int c = 0; c < NCH; ++c) { const float mx = fmaxf(m, pt[c]); mp[c] = m; ml[c] = mx; m = gl[c] + mx; } }
        __syncthreads();
        f32x4 cacc[5][2];
#pragma unroll
        for (int mt = 0; mt < 5; ++mt)
#pragma unroll
            for (int nt = 0; nt < 2; ++nt) cacc[mt][nt] = (f32x4){0.f, 0.f, 0.f, 0.f};
        v4u kreg[8], vreg[2]; float areg[2];
#define S2_LOAD(cc, T) do { const unsigned koff = (unsigned)((((T) >> 5) * QKVO + ((T) & 31) * 8) * 2), voff = (unsigned)((((T) >> 3) * QKVO + ((T) & 7) * 8) * 2); const int R1_ = chunk_row0(dir, b, (cc)); const char* kb_ = (const char*)(QK + (size_t)R1_ * QKVO + 2048 + h * DQK); const char* vb_ = (const char*)(QK + (size_t)R1_ * QKVO + 4096 + h * DV + slice * 64); \
            const float* ab_ = SCP + ((size_t)chain * NCH + (cc)) * 384; \
            _Pragma("unroll") for (int i = 0; i < 8; ++i) kreg[i] = *(const v4u*)(kb_ + (koff + (unsigned)(i * 16 * QKVO * 2))); \
            _Pragma("unroll") for (int i = 0; i < 2; ++i) { vreg[i] = *(const v4u*)(vb_ + (voff + (unsigned)(i * 64 * QKVO * 2))); areg[i] = ab_[((T) >> 3) + 64 * i]; } } while (0)
#define S2_STORE(cc, T) do { const float mlc_ = ml[(cc)]; \
            _Pragma("unroll") for (int i = 0; i < 8; ++i) { const int idx = (T) + NTHREADS * i, r = idx >> 5, ch = idx & 31; *(LAS v4u*)(Kl + s2_sigma(r) * S2K_PITCH + ch * 16) = kreg[i]; } \
            _Pragma("unroll") for (int i = 0; i < 2; ++i) { const int idx = (T) + NTHREADS * i, r = idx >> 3, ch = idx & 7; const float ws_ = __expf(areg[i] - mlc_) * 0.0625f;     \
                *(LAS v4u*)(Vl + s2_sigma(r) * S2V_PITCH + ch * 16) = vreg[i]; \
                v4u sc_; sc_.x = pk2(bflo(vreg[i].x) * ws_, bfhi(vreg[i].x) * ws_); sc_.y = pk2(bflo(vreg[i].y) * ws_, bfhi(vreg[i].y) * ws_); sc_.z = pk2(bflo(vreg[i].z) * ws_, bfhi(vreg[i].z) * ws_); sc_.w = pk2(bflo(vreg[i].w) * ws_, bfhi(vreg[i].w) * ws_); \
                *(LAS v4u*)(Vs + s2_sigma(r) * S2V_PITCH + ch * 16) = sc_; \
                if (ch == 0) *(LAS unsigned*)(Vs + s2_sigma(r) * S2V_PITCH + 128) = f2bf(ws_); } } while (0)
        S2_LOAD(0, tid_u); S2_STORE(0, tid_u);
        __syncthreads();
#define S2_OUTP false
        for (int c = 0; c < 2; ++c) {
            const int R0 = chunk_row0(dir, b, c);
            const float m_prev = mp[c], m_last = ml[c], ptot = pt[c];
            constexpr bool outp = S2_OUTP; const bool more = (c + 1 < NCH);
            int tid_o = tid; asm volatile("" : "+v"(tid_o));
            const int lane_o = tid_o & 63, g = lane_o >> 4, l15 = lane_o & 15, tl = 16 * wave + l15;
            bf16x8 qf[8], sf[4]; float pv = 0.f, bv = 0.f, dn = 0.f;
            v2u hw[4] = {{0u, 0u}, {0u, 0u}, {0u, 0u}, {0u, 0u}}; v4u hv[2] = {{0u, 0u, 0u, 0u}, {0u, 0u, 0u, 0u}};
            if (outp) {
                const char* qb = (const char*)(QK + (size_t)R0 * QKVO + h * DQK); const unsigned qoff = (unsigned)((tl * QKVO + 8 * g) * 2);
#pragma unroll
                for (int kk = 0; kk < 8; ++kk) qf[kk] = *(const bf16x8*)(qb + (qoff + (unsigned)(kk * 64)));
                const float* scp = SCP + ((size_t)chain * NCH + c) * 384;
                pv = scp[128 + tl]; bv = scp[256 + tl]; dn = DEN[(size_t)(chain * 64 + (c - 2)) * 128 + tl];
            }
            SCHED_FENCE();
            const float w_old = __expf(m_prev - m_last);
#pragma unroll
            for (int mt = 0; mt < 5; ++mt)
#pragma unroll
                for (int nt = 0; nt < 2; ++nt) cacc[mt][nt] = cacc[mt][nt] * w_old;
#pragma unroll
            for (int kk = 0; kk < 4; ++kk) {
                bf16x8 yf[2], xf[5];
#pragma unroll
                for (int nt = 0; nt < 2; ++nt) yf[nt] = tr_frag_sw(Kl, S2K_PITCH, 32 * kk, 32 * wave + 16 * nt, lane_o);
#pragma unroll
                for (int mt = 0; mt < 5; ++mt) xf[mt] = tr_frag_sw(Vs, S2V_PITCH, 32 * kk, 16 * mt, lane_o);
                SCHED_FENCE();
#pragma unroll
                for (int mt = 0; mt < 5; ++mt)
#pragma unroll
                    for (int nt = 0; nt < 2; ++nt) cacc[mt][nt] = MFMA16(yf[nt], xf[mt], cacc[mt][nt]);
                SCHED_FENCE();
            }
            if (outp) { const char* sb = (const char*)(SPP + (size_t)(chain * 64 + (c - 2)) * 128 * 128); const unsigned soff = (unsigned)((tl * 128 + 8 * g) * 2);
#pragma unroll
                for (int kk = 0; kk < 4; ++kk) sf[kk] = *(const bf16x8*)(sb + (soff + (unsigned)(kk * 64))); }
            if (more) S2_LOAD(c + 1, tid_o);
            SCHED_FENCE();
            if (outp) {
                f32x4 qacc[5];
#pragma unroll
                for (int n = 0; n < 5; ++n) qacc[n] = (f32x4){0.f, 0.f, 0.f, 0.f};
#pragma unroll
                for (int kk = 0; kk < 8; ++kk) {
                    bf16x8 cf[5];
#pragma unroll
                    for (int n = 0; n < 5; ++n) cf[n] = *(const LAS bf16x8*)(Cl + (16 * n + l15) * SK_PITCH + (32 * kk + 8 * g) * 2);
                    SCHED_FENCE();
#pragma unroll
                    for (int n = 0; n < 5; ++n) qacc[n] = MFMA16(cf[n], qf[kk], qacc[n]);
                    SCHED_FENCE();
                }
                f32x4 nacc[4];
#pragma unroll
                for (int n = 0; n < 4; ++n) nacc[n] = (f32x4){0.f, 0.f, 0.f, 0.f};
#pragma unroll
                for (int k2 = 0; k2 < 4; k2 += 2) {
                    bf16x8 vf[2][4];
#pragma unroll
                    for (int u = 0; u < 2; ++u)
#pragma unroll
                        for (int n = 0; n < 4; ++n) vf[u][n] = tr_frag_sw(Vl, S2V_PITCH, 32 * (k2 + u), 16 * n, lane_o);
                    SCHED_FENCE();
#pragma unroll
                    for (int u = 0; u < 2; ++u)
#pragma unroll
                        for (int n = 0; n < 4; ++n) nacc[n] = MFMA16(vf[u][n], sf[k2 + u], nacc[n]);
                    SCHED_FENCE();
                }
                const float mxt = fmaxf(m_prev, pv), rowfac = __expf(ptot - mxt), winter = __expf(m_prev - mxt);
                const float nq = __shfl(qacc[4][0], l15);
                const float den = rowfac * dn + winter * nq;
                const float inv = 1.0f / fmaxf(fabsf(den), __expf(-bv - mxt));
#pragma unroll
                for (int n = 0; n < 4; ++n) { const f32x4 o = (nacc[n] * rowfac + qacc[n] * winter) * inv; hw[n].x = pk2(o.x, o.y); hw[n].y = pk2(o.z, o.w); }
                bf16* hp = HS + ((size_t)dir * ML + R0 + tl) * D + h * DV + slice * 64 + 8 * g;
                const int src0 = l15 + 16 * (2 * (g & 1)), src1 = src0 + 16; const bool hi_n = (g >> 1) != 0;
#pragma unroll
                for (int k = 0; k < 2; ++k) {
                    const unsigned a0x = __shfl(hw[2 * k].x, src0), a0y = __shfl(hw[2 * k].y, src0), a1x = __shfl(hw[2 * k].x, src1), a1y = __shfl(hw[2 * k].y, src1);
                    const unsigned b0x = __shfl(hw[2 * k + 1].x, src0), b0y = __shfl(hw[2 * k + 1].y, src0), b1x = __shfl(hw[2 * k + 1].x, src1), b1y = __shfl(hw[2 * k + 1].y, src1);
                    hv[k].x = hi_n ? b0x : a0x; hv[k].y = hi_n ? b0y : a0y; hv[k].z = hi_n ? b1x : a1x; hv[k].w = hi_n ? b1y : a1y;
                    *(v4u*)(hp + 32 * k) = hv[k]; }
            }
            LDS_BARRIER();
#pragma unroll
            for (int mt = 0; mt < 5; ++mt)
#pragma unroll
                for (int nt = 0; nt < 2; ++nt) { v2u w; w.x = pk2(cacc[mt][nt][0], cacc[mt][nt][1]); w.y = pk2(cacc[mt][nt][2], cacc[mt][nt][3]);
                    *(LAS v2u*)(Cl + (16 * mt + l15) * SK_PITCH + (32 * wave + 16 * nt + 4 * g) * 2) = w; }
            if (more) S2_STORE(c + 1, tid_o);
            asm volatile("" :: "v"(hv[0]), "v"(hv[1]));
            LDS_BARRIER();
                }
#undef S2_OUTP
#define S2_OUTP true
        for (int c = 2; c < NCH; ++c) {
            const int R0 = chunk_row0(dir, b, c);
            const float m_prev = mp[c], m_last = ml[c], ptot = pt[c];
            constexpr bool outp = S2_OUTP; const bool more = (c + 1 < NCH);
            int tid_o = tid; asm volatile("" : "+v"(tid_o));
            const int lane_o = tid_o & 63, g = lane_o >> 4, l15 = lane_o & 15, tl = 16 * wave + l15;
            bf16x8 qf[8], sf[4]; float pv = 0.f, bv = 0.f, dn = 0.f;
            v2u hw[4] = {{0u, 0u}, {0u, 0u}, {0u, 0u}, {0u, 0u}}; v4u hv[2] = {{0u, 0u, 0u, 0u}, {0u, 0u, 0u, 0u}};
            if (outp) {
                const char* qb = (const char*)(QK + (size_t)R0 * QKVO + h * DQK); const unsigned qoff = (unsigned)((tl * QKVO + 8 * g) * 2);
#pragma unroll
                for (int kk = 0; kk < 8; ++kk) qf[kk] = *(const bf16x8*)(qb + (qoff + (unsigned)(kk * 64)));
                const float* scp = SCP + ((size_t)chain * NCH + c) * 384;
                pv = scp[128 + tl]; bv = scp[256 + tl]; dn = DEN[(size_t)(chain * 64 + (c - 2)) * 128 + tl];
            }
            SCHED_FENCE();
            const float w_old = __expf(m_prev - m_last);
#pragma unroll
            for (int mt = 0; mt < 5; ++mt)
#pragma unroll
                for (int nt = 0; nt < 2; ++nt) cacc[mt][nt] = cacc[mt][nt] * w_old;
#pragma unroll
            for (int kk = 0; kk < 4; ++kk) {
                bf16x8 yf[2], xf[5];
#pragma unroll
                for (int nt = 0; nt < 2; ++nt) yf[nt] = tr_frag_sw(Kl, S2K_PITCH, 32 * kk, 32 * wave + 16 * nt, lane_o);
#pragma unroll
                for (int mt = 0; mt < 5; ++mt) xf[mt] = tr_frag_sw(Vs, S2V_PITCH, 32 * kk, 16 * mt, lane_o);
                SCHED_FENCE();
#pragma unroll
                for (int mt = 0; mt < 5; ++mt)
#pragma unroll
                    for (int nt = 0; nt < 2; ++nt) cacc[mt][nt] = MFMA16(yf[nt], xf[mt], cacc[mt][nt]);
                SCHED_FENCE();
            }
            if (outp) { const char* sb = (const char*)(SPP + (size_t)(chain * 64 + (c - 2)) * 128 * 128); const unsigned soff = (unsigned)((tl * 128 + 8 * g) * 2);
#pragma unroll
                for (int kk = 0; kk < 4; ++kk) sf[kk] = *(const bf16x8*)(sb + (soff + (unsigned)(kk * 64))); }
            if (more) S2_LOAD(c + 1, tid_o);
            SCHED_FENCE();
            if (outp) {
                f32x4 qacc[5];
#pragma unroll
                for (int n = 0; n < 5; ++n) qacc[n] = (f32x4){0.f, 0.f, 0.f, 0.f};
#pragma unroll
                for (int kk = 0; kk < 8; ++kk) {
                    bf16x8 cf[5];
#pragma unroll
                    for (int n = 0; n < 5; ++n) cf[n] = *(const LAS bf16x8*)(Cl + (16 * n + l15) * SK_PITCH + (32 * kk + 8 * g) * 2);
                    SCHED_FENCE();
#pragma unroll
                    for (int n = 0; n < 5; ++n) qacc[n] = MFMA16(cf[n], qf[kk], qacc[n]);
                    SCHED_FENCE();
                }
                f32x4 nacc[4];
#pragma unroll
                for (int n = 0; n < 4; ++n) nacc[n] = (f32x4){0.f, 0.f, 0.f, 0.f};
#pragma unroll
                for (int k2 = 0; k2 < 4; k2 += 2) {
                    bf16x8 vf[2][4];
#pragma unroll
                    for (int u = 0; u < 2; ++u)
#pragma unroll
                        for (int n = 0; n < 4; ++n) vf[u][n] = tr_frag_sw(Vl, S2V_PITCH, 32 * (k2 + u), 16 * n, lane_o);
                    SCHED_FENCE();
#pragma unroll
                    for (int u = 0; u < 2; ++u)
#pragma unroll
                        for (int n = 0; n < 4; ++n) nacc[n] = MFMA16(vf[u][n], sf[k2 + u], nacc[n]);
                    SCHED_FENCE();
                }
                const float mxt = fmaxf(m_prev, pv), rowfac = __expf(ptot - mxt), winter = __expf(m_prev - mxt);
                const float nq = __shfl(qacc[4][0], l15);
                const float den = rowfac * dn + winter * nq;
                const float inv = 1.0f / fmaxf(fabsf(den), __expf(-bv - mxt));
#pragma unroll
                for (int n = 0; n < 4; ++n) { const f32x4 o = (nacc[n] * rowfac + qacc[n] * winter) * inv; hw[n].x = pk2(o.x, o.y); hw[n].y = pk2(o.z, o.w); }
                bf16* hp = HS + ((size_t)dir * ML + R0 + tl) * D + h * DV + slice * 64 + 8 * g;
                const int src0 = l15 + 16 * (2 * (g & 1)), src1 = src0 + 16; const bool hi_n = (g >> 1) != 0;
#pragma unroll
                for (int k = 0; k < 2; ++k) {
                    const unsigned a0x = __shfl(hw[2 * k].x, src0), a0y = __shfl(hw[2 * k].y, src0), a1x = __shfl(hw[2 * k].x, src1), a1y = __shfl(hw[2 * k].y, src1);
                    const unsigned b0x = __shfl(hw[2 * k + 1].x, src0), b0y = __shfl(hw[2 * k + 1].y, src0), b1x = __shfl(hw[2 * k + 1].x, src1), b1y = __shfl(hw[2 * k + 1].y, src1);
                    hv[k].x = hi_n ? b0x : a0x; hv[k].y = hi_n ? b0y : a0y; hv[k].z = hi_n ? b1x : a1x; hv[k].w = hi_n ? b1y : a1y;
                    *(v4u*)(hp + 32 * k) = hv[k]; }
            }
            LDS_BARRIER();
#pragma unroll
            for (int mt = 0; mt < 5; ++mt)
#pragma unroll
                for (int nt = 0; nt < 2; ++nt) { v2u w; w.x = pk2(cacc[mt][nt][0], cacc[mt][nt][1]); w.y = pk2(cacc[mt][nt][2], cacc[mt][nt][3]);
                    *(LAS v2u*)(Cl + (16 * mt + l15) * SK_PITCH + (32 * wave + 16 * nt + 4 * g) * 2) = w; }
            if (more) S2_STORE(c + 1, tid_o);
            asm volatile("" :: "v"(hv[0]), "v"(hv[1]));
            LDS_BARRIER();
                }
#undef S2_OUTP
#undef S2_LOAD
#undef S2_STORE
    }
}

__device__ __forceinline__ void scan_out_phase(CArgs a, LAS unsigned char* lds, int tid, int lane, int wave) {
    const bf16* HS = (const bf16*)(a->ws + WS_HS);
    const bf16* QK = (const bf16*)(a->ws + WS_U);
    bf16* A2 = (bf16*)(a->ws + WS_G);
    LAS f32x4* pg = (LAS f32x4*)lds;
    for (int i = tid; i < 1024; i += NTHREADS) pg[i] = ((const f32x4*)a->in[I_MHNG])[i];
    __syncthreads();
    const int G = gridDim.x, rpw = (ML + G - 1) / G, r0 = (int)blockIdx.x * rpw, r1 = (r0 + rpw < ML) ? r0 + rpw : ML;
    for (int row = r0 + wave; row < r1; row += NWAVES) {
#pragma unroll 2
        for (int h = 0; h < HEADS; ++h) {
            f32x4 v[2]; float s = 0.f;
#pragma unroll
            for (int j = 0; j < 2; ++j) { const int o = h * DV + j * 256 + lane * 4;
                const v2u hf = *(const v2u*)(HS + (size_t)row * D + o), hb = *(const v2u*)(HS + ((size_t)ML + row) * D + o);
                v[j] = (f32x4){bflo(hf.x) + bflo(hb.x), bfhi(hf.x) + bfhi(hb.x), bflo(hf.y) + bflo(hb.y), bfhi(hf.y) + bfhi(hb.y)};
                s += (v[j].x * v[j].x + v[j].y * v[j].y) + (v[j].z * v[j].z + v[j].w * v[j].w); }
            const float rstd = 1.0f / sqrtf(wave_sum(s) * (1.0f / DV) + EPS);
#pragma unroll
            for (int j = 0; j < 2; ++j) { const int o = h * DV + j * 256 + lane * 4;
                const f32x4 gg = pg[(h * DV + j * 256) / 4 + lane];
                const v2u ov = *(const v2u*)(QK + (size_t)row * QKVO + 8192 + o);
                const f32x4 y = (v[j] * rstd) * gg;
                v2u w; w.x = pk2(y.x * sigmoidf_(bflo(ov.x)), y.y * sigmoidf_(bfhi(ov.x))); w.y = pk2(y.z * sigmoidf_(bflo(ov.y)), y.w * sigmoidf_(bfhi(ov.y)));
                *(v2u*)(A2 + (size_t)row * D + o) = w; }
        }
    }
}

constexpr int NPHASES = 21;
__global__ void __launch_bounds__(NTHREADS, 2) fwd_kernel(Args args_unused) {
    extern __shared__ __attribute__((aligned(16))) unsigned char lds_raw[];
    LAS unsigned char* lds = (LAS unsigned char*)lds_raw;
    const int wave_s = __builtin_amdgcn_readfirstlane((int)threadIdx.x >> 6);
    { const int tid = threadIdx.x; volatile LAS unsigned* MISC = (volatile LAS unsigned*)(lds + MISC_OFF);
      if (tid < 16) MISC[tid] = 0u;
      __syncthreads();
      if (!MK_PER_PHASE) (void)xcd_barrier_post((unsigned*)(get_args()->ws + WS_CTL) + CW_BAR, MISC); }
#define PH_IDS for (int tid = opaque_tid(wave_s), lane = tid & 63, wave = __builtin_amdgcn_readfirstlane(tid >> 6), once_ = 1; once_; once_ = 0)
#if MK_PER_PHASE
#define IN(k) (get_args()->ph_lo == (k)) PH_IDS if (true
#define SEAM(k) do { } while (0)
#else
#ifndef PROBE_PHASE
#define PROBE_PHASE -1
#endif
#define IN(k) true) for (int rep_ = 0; rep_ < ((k) == PROBE_PHASE ? 2 : 1); ++rep_) PH_IDS if (true
#define SEAM(k) do { XcdBarrier b_; b_.bar = (unsigned*)(get_args()->ws + WS_CTL) + CW_BAR; b_.x = xb_xcc_id(); b_.st = (volatile LAS unsigned*)(lds + MISC_OFF); xcd_barrier(b_); } while (0)
#endif
#define WSP(off) (get_args()->ws + (off))
#define MODP(layer) ((const float*)WSP(WS_MOD) + (layer) * 3 * NMODC)
#define NGP(i) (get_args()->in[I_NORMG] + (i) * D)

#define GEMM_PHASE(EPI, A_, B_, M_, N_, K_, EINIT, HAS_SIDE, SIDE) { const int nwg_ = ((M_) / 256) * ((N_) / 256), gg_ = (HAS_SIDE) ? gemm_wgs(nwg_) : (int)gridDim.x; \
        if ((int)blockIdx.x < gg_) { pg8::Gemm g{A_, B_, M_, N_, K_}; pg8::StaticOrder S; S.init(M_, N_, gg_, blockIdx.x); EPI E EINIT; pg8::gemm_phase<EPI, pg8::StaticOrder, true, true>(lds, g, S, E, tid); } \
          \
        const int t0_ = (HAS_SIDE) ? gg_ : ((nwg_ % (int)gridDim.x) ? nwg_ % (int)gridDim.x : (int)gridDim.x); \
        if (!PROBE_E1 && (int)blockIdx.x >= t0_) { const int si_ = (int)blockIdx.x - t0_, ns_ = (int)gridDim.x - t0_, sf_ = si_ * NWAVES + wave, sn_ = ns_ * NWAVES; (void)si_; (void)ns_; (void)sf_; (void)sn_; SIDE } }

    if (IN(0)) { p0_prologue(get_args(), lds, tid, lane, wave); __syncthreads(); } SEAM(0);
    if (IN(1)) { CArgs a = get_args(); row_phase<false, true>(lds, MT, a->in[I_X], a->in[I_CTX], nullptr, nullptr, nullptr, nullptr, nullptr, 0, NGP(0), MODP(0), 0, 1, (bf16*)WSP(WS_H), tid, lane, wave); }
    SEAM(1);
    if (IN(2)) GEMM_PHASE(pg8::EpiAB, (const bf16*)WSP(WS_H), (const bf16*)WSP(WS_WABIN), MT, ABIN, D, ({(bf16*)WSP(WS_U)}), false,
                          conv_matrix<CV_ABOUT>(get_args(), lds, sf_, sn_, lane, wave);)
    SEAM(2);
    if (IN(3)) mixer_conv_phase(get_args(), lds, tid, lane);
    SEAM(3);
    if (IN(4)) mixer_ln_phase(get_args(), lds, tid, lane, wave);
    SEAM(4);
    if (IN(5)) GEMM_PHASE(pg8::EpiBf16, (const bf16*)WSP(WS_G), (const bf16*)WSP(WS_WABOUT), MT, D, D, ({(bf16*)WSP(WS_Y), D}), true,
                          conv_matrix<CV_UP0>(get_args(), lds, sf_, sn_, lane, wave);)
    SEAM(5);
    if (IN(6)) { CArgs a = get_args(); row_phase<true, true>(lds, MT, a->in[I_X], a->in[I_CTX], a->out, (float*)WSP(WS_CTXS), (const bf16*)WSP(WS_Y), NGP(1), MODP(0), 2, NGP(2), MODP(0), 3, 4, (bf16*)WSP(WS_H), tid, lane, wave); }
    SEAM(6);
    if (IN(7)) GEMM_PHASE(pg8::EpiGate, (const bf16*)WSP(WS_H), (const bf16*)WSP(WS_WUP0), MT, DFF2, D, ({(bf16*)WSP(WS_G), (bf16*)WSP(WS_UC), get_args()->in[I_FCONV]}), false,
                          conv_matrix<CV_DN0>(get_args(), lds, sf_, sn_, lane, wave);)
    SEAM(7);
    if (IN(8)) ffn_gate_ctx_phase(get_args(), tid);
    SEAM(8);
    if (IN(9)) GEMM_PHASE(pg8::EpiBf16, (const bf16*)WSP(WS_G), (const bf16*)WSP(WS_WDN0), MT, D, DFF, ({(bf16*)WSP(WS_Y), D}), true,
                          gemv_units(get_args(), lds, 1, si_, ns_, tid, lane, wave);
                          conv_matrix<CV_MIN>(get_args(), lds, sf_, sn_, lane, wave); conv_matrix<CV_MOUT>(get_args(), lds, sf_, sn_, lane, wave);
                          conv_matrix<CV_UP1>(get_args(), lds, sf_, sn_, lane, wave);)
    SEAM(9);
    if (IN(10)) { CArgs a = get_args(); float* ct = (float*)WSP(WS_CTXS); row_phase<true, true>(lds, MT, a->out, ct, a->out, ct, (const bf16*)WSP(WS_Y), NGP(3), MODP(0), 5, NGP(4), MODP(1), 0, 1, (bf16*)WSP(WS_H), tid, lane, wave); }
    SEAM(10);
    if (IN(11)) GEMM_PHASE(pg8::EpiMIn, (const bf16*)WSP(WS_H), (const bf16*)WSP(WS_WMIN), MT, CINP, D, ({(bf16*)WSP(WS_U), QKVO, (float*)WSP(WS_GATES)}), false,
                           conv_matrix<CV_DN1>(get_args(), lds, sf_, sn_, lane, wave);)
    SEAM(11);
    if (IN(12)) scan_pre_phase(get_args(), lds, tid, lane, wave);
    SEAM(12);
    if (IN(13)) scan_seq_phase(get_args(), lds, tid, lane, wave);
    SEAM(13);
    if (IN(14)) scan_out_phase(get_args(), lds, tid, lane, wave);
    SEAM(14);
    if (IN(15)) GEMM_PHASE(pg8::EpiBf16, (const bf16*)WSP(WS_G), (const bf16*)WSP(WS_WMOUT), ML, D, D, ({(bf16*)WSP(WS_Y), D}), false, ;)
    SEAM(15);
    if (IN(16)) { CArgs a = get_args(); float* ct = (float*)WSP(WS_CTXS); row_phase<true, true>(lds, ML, a->out, ct, a->out, ct, (const bf16*)WSP(WS_Y), NGP(5), MODP(1), 2, NGP(6), MODP(1), 3, 4, (bf16*)WSP(WS_H), tid, lane, wave); }
    SEAM(16);
    if (IN(17)) GEMM_PHASE(pg8::EpiGate, (const bf16*)WSP(WS_H), (const bf16*)WSP(WS_WUP0 + 172 * MiB), ML, DFF2, D, ({(bf16*)WSP(WS_G), (bf16*)WSP(WS_UC), get_args()->in[I_FCONV] + 3 * DFF2}), false, ;)
    SEAM(17);
    if (IN(19)) GEMM_PHASE(pg8::EpiBf16, (const bf16*)WSP(WS_G), (const bf16*)WSP(WS_WDN0 + 86 * MiB), ML, D, DFF, ({(bf16*)WSP(WS_Y), D}), false, ;)
    SEAM(19);
    if (IN(20)) { CArgs a = get_args(); float* ct = (float*)WSP(WS_CTXS); row_phase<true, false>(lds, ML, a->out, ct, a->out, ct, (const bf16*)WSP(WS_Y), NGP(7), MODP(1), 5, nullptr, nullptr, 0, 0, nullptr, tid, lane, wave); }
#undef IN
#undef SEAM
}

extern "C" void kernel_launch(void* const* d_in, const int* in_sizes, int n_in, void* d_out, int out_size, void* d_ws, size_t ws_size, hipStream_t stream) {
    static int grid = 0;
    if (grid == 0) {
        if (n_in != 21 || out_size != ML * D || ws_size < WS_END) { fprintf(stderr, "kernel_launch: unexpected problem (n_in %d, out %d, ws %zu < %zu); nothing launched\n", n_in, out_size, ws_size, (size_t)WS_END); grid = -1; return; }
        int dev = 0, cus = 0, per_cu = 0;
        if (hipGetDevice(&dev) != hipSuccess || hipDeviceGetAttribute(&cus, hipDeviceAttributeMultiprocessorCount, dev) != hipSuccess) { grid = -1; return; }
        if (hipFuncSetAttribute((const void*)fwd_kernel, hipFuncAttributeMaxDynamicSharedMemorySize, LDS_BYTES) != hipSuccess) { fprintf(stderr, "kernel_launch: hipFuncSetAttribute failed\n"); grid = -1; return; }
        if (hipOccupancyMaxActiveBlocksPerMultiprocessor(&per_cu, (const void*)fwd_kernel, NTHREADS, LDS_BYTES) != hipSuccess || per_cu < 1)
            fprintf(stderr, "kernel_launch: occupancy query reports %d workgroups per CU\n", per_cu);
        (void)hipGetLastError();
        grid = cus;
    }
    if (grid < 0) return;
    if (hipMemsetAsync((char*)d_ws + WS_CTL, 0, CTL_ZERO_BYTES, stream) != hipSuccess) return;
    Args a{};
    for (int i = 0; i < 21; ++i) a.in[i] = (const float*)d_in[i];
    a.out = (float*)d_out; a.ws = (unsigned char*)d_ws;
#if MK_PER_PHASE
    for (int p = 0; p < NPHASES; ++p) { a.ph_lo = p; a.ph_hi = p + 1; hipLaunchKernelGGL(fwd_kernel, dim3(grid), dim3(NTHREADS), LDS_BYTES, stream, a); }
#else
    a.ph_lo = 0; a.ph_hi = NPHASES;
    hipLaunchKernelGGL(fwd_kernel, dim3(grid), dim3(NTHREADS), LDS_BYTES, stream, a);
#endif
}
```

```cpp
#include <hip/hip_runtime.h>
#include <cstdio>
#include <cstdint>

#ifndef PROBE_E1
#define PROBE_E1 0
#endif
#ifndef MK_PER_PHASE
#define MK_PER_PHASE 0
#endif

namespace pg8 {
#define PG8_LAS __attribute__((address_space(3)))
typedef unsigned short bf16_t;
typedef short bf16x8 __attribute__((ext_vector_type(8)));
typedef float f32x4 __attribute__((ext_vector_type(4)));
typedef unsigned u32x4 __attribute__((ext_vector_type(4)));
constexpr int BM = 256, BK = 64, HALF = 128, HTB = HALF * BK * 2, STAGE_BYTES = 8 * HTB, NXCD = 8, WGM = 4;

__host__ __device__ __forceinline__ int lds_byte(int r, int c) { const int st = (r >> 4) * 2 + (c >> 5), rr = r & 15, cc = c & 31, ob = rr * 64 + cc * 2; return st * 1024 + (ob ^ (((ob >> 9) & 1) << 5)); }
__host__ __device__ __forceinline__ void stage_rc(int b, int& R, int& C) { const int st = b / 1024, sb = b % 1024, swz = sb ^ (((sb >> 9) & 1) << 5); R = (st >> 1) * 16 + swz / 64; C = (st & 1) * 32 + (swz % 64) / 2; }
__host__ __device__ __forceinline__ int perm32(int rho) { const int n = rho >> 4, i = rho & 15; return 8 * (i >> 2) + 4 * n + (i & 3); }

struct Unit { int pm, pn; };
struct Gemm { const bf16_t* A; const bf16_t* Bt; int M, N, K; };

struct StaticOrder {
    int nM, nN, nwg, G, c;
    __host__ __device__ void init(int M, int N, int G_, int c_) { nM = M / BM; nN = N / BM; nwg = nM * nN; G = G_; c = c_; }
    __host__ __device__ bool next(int i, Unit& u) const {
        const long L = (long)i * G + c; if (L >= nwg) return false;
        int wgid = (int)L; { const int q = nwg / NXCD, r = nwg % NXCD, xcd = wgid % NXCD, off = wgid / NXCD; wgid = (xcd < r ? xcd * (q + 1) : r * (q + 1) + (xcd - r) * q) + off; }
        const int nig = WGM * nN, gid = wgid / nig, fm = gid * WGM, gsz = (nM - fm) < WGM ? (nM - fm) : WGM;
        u.pm = fm + ((wgid % nig) % gsz); u.pn = (wgid % nig) / gsz; return true;
    }
    __device__ __forceinline__ void a_ready(const Unit&) const {}
    __device__ __forceinline__ void done(const Unit&) const {}
};

__device__ __forceinline__ unsigned cvt_pk_bf16(float lo, float hi) { unsigned r; asm volatile("v_cvt_pk_bf16_f32 %0, %1, %2" : "=v"(r) : "v"(lo), "v"(hi)); return r; }

struct EpiBf16 {
    static constexpr bool PERM = true, AFTER_DRAIN = false, PERM_A = false;
    bf16_t* O; int ldc;
    __device__ __forceinline__ void operator()(const f32x4 (&acc)[2][2][4][2], const Unit& u, int wr, int wc, int fr, int fq) const {
        const int row0 = u.pm * BM + wr * 64 + fr, col0 = u.pn * BM + wc * 32 + 8 * fq;
#pragma unroll
        for (int ai = 0; ai < 2; ++ai)
#pragma unroll
            for (int m = 0; m < 4; ++m) { bf16_t* rowp = O + (size_t)(row0 + ai * HALF + m * 16) * ldc + col0;
#pragma unroll
                for (int bj = 0; bj < 2; ++bj) { const f32x4 v0 = acc[ai][bj][m][0], v1 = acc[ai][bj][m][1];
                    u32x4 w; w.x = cvt_pk_bf16(v0[0], v0[1]); w.y = cvt_pk_bf16(v0[2], v0[3]); w.z = cvt_pk_bf16(v1[0], v1[1]); w.w = cvt_pk_bf16(v1[2], v1[3]);
                    *(u32x4*)(rowp + bj * HALF) = w; } }
    }
};
struct EpiAB {
    static constexpr bool PERM = true, AFTER_DRAIN = false, PERM_A = false;
    bf16_t* O;
    __device__ __forceinline__ void operator()(const f32x4 (&acc)[2][2][4][2], const Unit& u, int wr, int wc, int fr, int fq) const {
        const int row0 = u.pm * BM + wr * 64 + fr;
        if (u.pn >= 16 && u.pn < 24) {
            const int col0 = 2048 + (u.pn - 16) * BM + wc * 32 + 8 * fq;
#pragma unroll
            for (int ai = 0; ai < 2; ++ai)
#pragma unroll
                for (int m = 0; m < 4; ++m) { bf16_t* rowp = O + (size_t)(row0 + ai * HALF + m * 16) * 6144 + col0;
#pragma unroll
                    for (int bj = 0; bj < 2; ++bj) { const f32x4 v0 = acc[ai][bj][m][0], v1 = acc[ai][bj][m][1];
                        u32x4 w; w.x = cvt_pk_bf16(v0[0], v0[1]); w.y = cvt_pk_bf16(v0[2], v0[3]); w.z = cvt_pk_bf16(v1[0], v1[1]); w.w = cvt_pk_bf16(v1[2], v1[3]);
                        *(u32x4*)(rowp + bj * HALF) = w; } }
            return;
        }
        const bool glu = u.pn < 16;
        const int col0 = (glu ? u.pn * 128 : 4096 + (u.pn - 24) * 128) + wc * 32 + 8 * fq;
#pragma unroll
        for (int ai = 0; ai < 2; ++ai)
#pragma unroll
            for (int m = 0; m < 4; ++m) { float o[8];
#pragma unroll
                for (int n = 0; n < 2; ++n)
#pragma unroll
                    for (int j = 0; j < 4; ++j) { const float x = acc[ai][0][m][n][j], y = acc[ai][1][m][n][j];
                        o[4 * n + j] = glu ? x * __builtin_amdgcn_rcpf(1.0f + __expf(-y)) : x * y; }
                u32x4 w; w.x = cvt_pk_bf16(o[0], o[1]); w.y = cvt_pk_bf16(o[2], o[3]); w.z = cvt_pk_bf16(o[4], o[5]); w.w = cvt_pk_bf16(o[6], o[7]);
                *(u32x4*)(O + (size_t)(row0 + ai * HALF + m * 16) * 6144 + col0) = w; }
    }
};
struct EpiMIn {
    static constexpr bool PERM = true, AFTER_DRAIN = false, PERM_A = false;
    bf16_t* O; int ldc; float* gates; bf16_t* QT;
    __device__ __forceinline__ void operator()(const f32x4 (&acc)[2][2][4][2], const Unit& u, int wr, int wc, int fr, int fq) const {
        const int row0 = u.pm * BM + wr * 64 + fr;
        if (u.pn < 8) {
#pragma unroll
            for (int ai = 0; ai < 2; ++ai)
#pragma unroll
                for (int m = 0; m < 4; ++m) { const int rb = (u.pm * BM + wr * 64 + ai * HALF + m * 16) >> 4;
#pragma unroll
                    for (int bj = 0; bj < 2; ++bj) { const f32x4 v0 = acc[ai][bj][m][0], v1 = acc[ai][bj][m][1];
                        u32x4 w; w.x = cvt_pk_bf16(v0[0], v0[1]); w.y = cvt_pk_bf16(v0[2], v0[3]); w.z = cvt_pk_bf16(v1[0], v1[1]); w.w = cvt_pk_bf16(v1[2], v1[3]);
                        *(u32x4*)(QT + ((size_t)rb * 64 + (u.pn * 8 + bj * 4 + wc)) * 512 + (fr + 16 * fq) * 8) = w; } }
        } else if (u.pn < 48) {
            const int col0 = u.pn * BM + wc * 32 + 8 * fq;
#pragma unroll
            for (int ai = 0; ai < 2; ++ai)
#pragma unroll
                for (int m = 0; m < 4; ++m) { bf16_t* rowp = O + (size_t)(row0 + ai * HALF + m * 16) * ldc + col0;
#pragma unroll
                    for (int bj = 0; bj < 2; ++bj) { const f32x4 v0 = acc[ai][bj][m][0], v1 = acc[ai][bj][m][1];
                        u32x4 w; w.x = cvt_pk_bf16(v0[0], v0[1]); w.y = cvt_pk_bf16(v0[2], v0[3]); w.z = cvt_pk_bf16(v1[0], v1[1]); w.w = cvt_pk_bf16(v1[2], v1[3]);
                        *(u32x4*)(rowp + bj * HALF) = w; } }
        } else if (wc == 0) {
#pragma unroll
            for (int ai = 0; ai < 2; ++ai)
#pragma unroll
                for (int m = 0; m < 4; ++m) { float* rowp = gates + (size_t)(row0 + ai * HALF + m * 16) * 32 + 8 * fq;
#pragma unroll
                    for (int n = 0; n < 2; ++n) *(f32x4*)(rowp + 4 * n) = acc[ai][0][m][n]; }
        }
    }
};

__device__ __forceinline__ float dpp_ror1(float v) { return __builtin_bit_cast(float, __builtin_amdgcn_update_dpp(0, __builtin_bit_cast(int, v), 0x121, 0xf, 0xf, false)); }
__device__ __forceinline__ float dpp_rol1(float v) { return __builtin_bit_cast(float, __builtin_amdgcn_update_dpp(0, __builtin_bit_cast(int, v), 0x12F, 0xf, 0xf, false)); }
template <bool NOLOAD = false, bool NOSTORE = false> struct EpiGateT {
    static constexpr bool PERM = true, AFTER_DRAIN = false, PERM_A = true;
    bf16_t* G; bf16_t* UC; const float* cw;
    __device__ __forceinline__ static float shr1(float v) { return __builtin_bit_cast(float, __builtin_amdgcn_update_dpp(0, __builtin_bit_cast(int, v), 0x111, 0xf, 0xf, true)); }
    __device__ __forceinline__ static float shl1(float v) { return __builtin_bit_cast(float, __builtin_amdgcn_update_dpp(0, __builtin_bit_cast(int, v), 0x101, 0xf, 0xf, true)); }
    __device__ __forceinline__ void operator()(const f32x4 (&acc)[2][2][4][2], const Unit& u, int wr, int wc, int fr, int fq) const {
        const int row0 = u.pm * BM + wr * 64 + 4 * fr;
        if (u.pm >= 64) {
            const int col0 = u.pn * BM + wc * 32 + 8 * fq;
#pragma unroll
            for (int ai = 0; ai < 2; ++ai)
#pragma unroll
                for (int m = 0; m < 4; ++m) { bf16_t* rowp = UC + (size_t)(row0 - 64 * BM + ai * HALF + m) * 22016 + col0;
#pragma unroll
                    for (int bj = 0; bj < 2; ++bj) { const f32x4 v0 = acc[ai][bj][m][0], v1 = acc[ai][bj][m][1];
                        u32x4 w; w.x = cvt_pk_bf16(v0[0], v0[1]); w.y = cvt_pk_bf16(v0[2], v0[3]); w.z = cvt_pk_bf16(v1[0], v1[1]); w.w = cvt_pk_bf16(v1[2], v1[3]);
                        *(u32x4*)(rowp + bj * HALF) = w; } }
            return;
        }
        const int ch = u.pn * 128 + wc * 32 + 8 * fq;
        typedef unsigned u32x2 __attribute__((ext_vector_type(2)));
#pragma unroll
        for (int n = 0; n < 2; ++n) {
            f32x4 wg[3], wv[3];
#pragma unroll
            for (int k = 0; k < 3; ++k) { if (NOLOAD) { wg[k] = (f32x4){0.3f, 0.4f, 0.5f, 0.6f}; wv[k] = (f32x4){0.6f, 0.5f, 0.4f, 0.3f}; } else { wg[k] = *(const f32x4*)(cw + k * 22016 + ch + 4 * n); wv[k] = *(const f32x4*)(cw + k * 22016 + 11008 + ch + 4 * n); } }
#pragma unroll
            for (int ai = 0; ai < 2; ++ai) {
                float o[4][4];
#pragma unroll
                for (int j = 0; j < 4; ++j) {
                    const float gp = shr1(acc[ai][0][3][n][j]), gn = shl1(acc[ai][0][0][n][j]), vp = shr1(acc[ai][1][3][n][j]), vn = shl1(acc[ai][1][0][n][j]);
#pragma unroll
                    for (int m = 0; m < 4; ++m) {
                        const float gL = m > 0 ? acc[ai][0][m - 1][n][j] : gp, gR = m < 3 ? acc[ai][0][m + 1][n][j] : gn;
                        const float vL = m > 0 ? acc[ai][1][m - 1][n][j] : vp, vR = m < 3 ? acc[ai][1][m + 1][n][j] : vn;
                        const float g = wg[0][j] * gL + wg[1][j] * acc[ai][0][m][n][j] + wg[2][j] * gR;
                        const float v = wv[0][j] * vL + wv[1][j] * acc[ai][1][m][n][j] + wv[2][j] * vR;
                        o[m][j] = g * __builtin_amdgcn_rcpf(1.0f + __expf(-g)) * v; }
                }
#pragma unroll
                for (int m = 0; m < 4; ++m) { u32x2 w; w.x = cvt_pk_bf16(o[m][0], o[m][1]); w.y = cvt_pk_bf16(o[m][2], o[m][3]);
                    if (NOSTORE) asm volatile("" :: "v"(w)); else *(u32x2*)(G + (size_t)(row0 + ai * HALF + m) * 11008 + ch + 4 * n) = w; }
                __builtin_amdgcn_sched_barrier(0);
            }
        }
    }
};
typedef EpiGateT<false, false> EpiGate;

template <class Epi, class Sched, bool ALIGN_EPI = false, bool SP2 = false>
__device__ __forceinline__ void gemm_phase(PG8_LAS unsigned char* lds, const Gemm g, const Sched& S, const Epi& E, const int tid) {
    const int wid = __builtin_amdgcn_readfirstlane(tid >> 6), lane = tid & 63, wr = wid >> 2, wc = wid & 3, fr = lane & 15, fq = lane >> 4;
    const int K = g.K, nt = K / BK;
    unsigned voffA[2], voffB[2];
#pragma unroll
    for (int i = 0; i < 2; ++i) { int R, C; stage_rc(tid * 16 + i * 8192, R, C); const int Rb = Epi::PERM ? ((R & ~31) + perm32(R & 31)) : R;
        const int Ra = Epi::PERM_A ? ((R & ~63) + 4 * (R & 15) + ((R >> 4) & 3)) : R;
        voffA[i] = (unsigned)(Ra * K + C) * 2u; voffB[i] = (unsigned)(Rb * K + C) * 2u; }
    const size_t kstep = (size_t)(BK * 2);
    const size_t hstep = (size_t)HALF * K * 2;
    const size_t tstep = 2 * hstep;
    const unsigned ldsw = (unsigned)wid * 1024u;
    const int aoff = lds_byte(wr * 64 + fr, fq * 8), boff = lds_byte(wc * 32 + fr, fq * 8);
#define PG8_SA(b, h) (((b) * 2 + (h)) * HTB)
#define PG8_SB(b, h) ((4 + (b) * 2 + (h)) * HTB)
#define PG8_STAGE(bufoff, gbase, voff) do { _Pragma("unroll") for (int _i = 0; _i < 2; ++_i) \
        __builtin_amdgcn_global_load_lds((const unsigned*)((const char*)(gbase) + (voff)[_i]), (PG8_LAS unsigned*)(lds + (bufoff) + ldsw + _i * 8192), 16, 0, 0); } while (0)
#define PG8_LDA(dst, b, h) do { _Pragma("unroll") for (int m = 0; m < 4; ++m) _Pragma("unroll") for (int k = 0; k < 2; ++k) dst[m][k] = *(const PG8_LAS bf16x8*)(lds + PG8_SA(b, h) + aoff + m * 2048 + k * 1024); } while (0)
#define PG8_LDB(dst, b, h) do { _Pragma("unroll") for (int n = 0; n < 2; ++n) _Pragma("unroll") for (int k = 0; k < 2; ++k) dst[n][k] = *(const PG8_LAS bf16x8*)(lds + PG8_SB(b, h) + boff + n * 2048 + k * 1024); } while (0)
#define PG8_MMA(ai, bj, At, Bt) do { __builtin_amdgcn_s_setprio(1); _Pragma("unroll") for (int m = 0; m < 4; ++m) _Pragma("unroll") for (int n = 0; n < 2; ++n) _Pragma("unroll") for (int k = 0; k < 2; ++k) \
        acc[ai][bj][m][n] = __builtin_amdgcn_mfma_f32_16x16x32_bf16(Bt[n][k], At[m][k], acc[ai][bj][m][n], 0, 0, 0); __builtin_amdgcn_s_setprio(0); } while (0)
#define PG8_WAIT_V(n) asm volatile("s_waitcnt vmcnt(" #n ")" ::: "memory")
#define PG8_WAIT_L(n) asm volatile("s_waitcnt lgkmcnt(" #n ")" ::: "memory")
#define PG8_BAR __builtin_amdgcn_s_barrier()
#define PG8_SCHED __builtin_amdgcn_sched_barrier(0)
    Unit cur, nxt; int ui = 0;
    if (!S.next(0, cur)) return;
    f32x4 acc[2][2][4][2];
#pragma unroll
    for (int a = 0; a < 2; ++a)
#pragma unroll
        for (int b = 0; b < 2; ++b)
#pragma unroll
            for (int m = 0; m < 4; ++m)
#pragma unroll
                for (int n = 0; n < 2; ++n) acc[a][b][m][n] = (f32x4){0.f, 0.f, 0.f, 0.f};
    bf16x8 At[4][2], B0[2][2], B1[2][2];
    const char* cA = (const char*)g.A + (size_t)cur.pm * tstep; const char* cB = (const char*)g.Bt + (size_t)cur.pn * tstep;
    S.a_ready(cur);
    if constexpr (SP2) {
        PG8_STAGE(PG8_SB(0, 0), cB, voffB); PG8_STAGE(PG8_SB(0, 1), cB + hstep, voffB); PG8_STAGE(PG8_SA(0, 0), cA, voffA); PG8_STAGE(PG8_SA(0, 1), cA + hstep, voffA);
        if (wr == 1) PG8_BAR;
        PG8_WAIT_V(2); PG8_BAR;
        PG8_STAGE(PG8_SB(1, 0), cB + kstep, voffB); PG8_STAGE(PG8_SA(1, 0), cA + kstep, voffA); PG8_STAGE(PG8_SB(1, 1), cB + hstep + kstep, voffB);
        PG8_WAIT_V(6); PG8_BAR;
    } else {
        PG8_STAGE(PG8_SB(0, 0), cB, voffB); PG8_STAGE(PG8_SA(0, 0), cA, voffA); PG8_STAGE(PG8_SB(0, 1), cB + hstep, voffB); PG8_STAGE(PG8_SA(0, 1), cA + hstep, voffA);
        if (wr == 1) PG8_BAR;
        PG8_WAIT_V(4); PG8_BAR;
        PG8_STAGE(PG8_SB(1, 0), cB + kstep, voffB); PG8_STAGE(PG8_SA(1, 0), cA + kstep, voffA); PG8_STAGE(PG8_SB(1, 1), cB + hstep + kstep, voffB);
        PG8_WAIT_V(6); PG8_BAR;
    }
    for (;;) {
        const bool has_next = S.next(ui + 1, nxt);
        const char* nA = has_next ? (const char*)g.A + (size_t)nxt.pm * tstep : cA; const char* nB = has_next ? (const char*)g.Bt + (size_t)nxt.pn * tstep : cB;
        for (int t = 0; t < nt; t += 2) {
            const bool last = (t == nt - 2);
            const char* a1 = cA + (size_t)(t + 1) * kstep;
            const char* a2 = last ? nA : cA + (size_t)(t + 2) * kstep; const char* b2 = last ? nB : cB + (size_t)(t + 2) * kstep;
            const char* a3 = a2 + kstep; const char* b3 = b2 + kstep;
            if (last && has_next) S.a_ready(nxt);
            if constexpr (SP2) {
            PG8_LDB(B0, 0, 0); PG8_LDB(B1, 0, 1); PG8_SCHED; PG8_LDA(At, 0, 0); PG8_STAGE(PG8_SA(1, 1), a1 + hstep, voffA);
            PG8_WAIT_V(8); PG8_WAIT_L(0); PG8_BAR; PG8_MMA(0, 0, At, B0); PG8_MMA(0, 1, At, B1); PG8_BAR; PG8_SCHED;
            PG8_LDA(At, 0, 1); PG8_STAGE(PG8_SB(0, 0), b2, voffB); PG8_STAGE(PG8_SB(0, 1), b2 + hstep, voffB); PG8_STAGE(PG8_SA(0, 0), a2, voffA);
            PG8_WAIT_V(8); PG8_WAIT_L(0); PG8_BAR; PG8_MMA(1, 0, At, B0); PG8_MMA(1, 1, At, B1); PG8_BAR; PG8_SCHED;
            PG8_LDB(B0, 1, 0); PG8_LDB(B1, 1, 1); PG8_SCHED; PG8_LDA(At, 1, 0); PG8_STAGE(PG8_SA(0, 1), a2 + hstep, voffA);
            PG8_WAIT_V(8); PG8_WAIT_L(0); PG8_BAR; PG8_MMA(0, 0, At, B0); PG8_MMA(0, 1, At, B1); PG8_BAR; PG8_SCHED;
            PG8_LDA(At, 1, 1); PG8_STAGE(PG8_SB(1, 0), b3, voffB); PG8_STAGE(PG8_SB(1, 1), b3 + hstep, voffB); PG8_STAGE(PG8_SA(1, 0), a3, voffA);
            PG8_WAIT_V(8); PG8_WAIT_L(0); PG8_BAR; PG8_MMA(1, 0, At, B0); PG8_MMA(1, 1, At, B1); PG8_BAR; PG8_SCHED;
            } else {
            PG8_LDB(B0, 0, 0); PG8_SCHED; PG8_LDA(At, 0, 0); PG8_STAGE(PG8_SA(1, 1), a1 + hstep, voffA);
            PG8_WAIT_L(8); PG8_BAR; PG8_WAIT_L(0); PG8_MMA(0, 0, At, B0); PG8_BAR; PG8_SCHED;
            PG8_LDB(B1, 0, 1); PG8_STAGE(PG8_SB(0, 0), b2, voffB);
            PG8_BAR; PG8_WAIT_L(0); PG8_MMA(0, 1, At, B1); PG8_BAR;
            PG8_LDA(At, 0, 1); PG8_STAGE(PG8_SA(0, 0), a2, voffA);
            PG8_BAR; PG8_WAIT_L(0); PG8_MMA(1, 0, At, B0); PG8_BAR; PG8_SCHED;
            PG8_STAGE(PG8_SB(0, 1), b2 + hstep, voffB);
            PG8_WAIT_V(6); PG8_BAR; PG8_MMA(1, 1, At, B1); PG8_BAR;
            PG8_LDB(B0, 1, 0); PG8_SCHED; PG8_LDA(At, 1, 0); PG8_STAGE(PG8_SA(0, 1), a2 + hstep, voffA);
            PG8_WAIT_L(8); PG8_BAR; PG8_WAIT_L(0); PG8_MMA(0, 0, At, B0); PG8_BAR; PG8_SCHED;
            PG8_LDB(B1, 1, 1); PG8_STAGE(PG8_SB(1, 0), b3, voffB);
            PG8_BAR; PG8_WAIT_L(0); PG8_MMA(0, 1, At, B1); PG8_BAR;
            PG8_LDA(At, 1, 1); PG8_STAGE(PG8_SA(1, 0), a3, voffA);
            PG8_BAR; PG8_WAIT_L(0); PG8_MMA(1, 0, At, B0); PG8_BAR; PG8_SCHED;
            PG8_STAGE(PG8_SB(1, 1), b3 + hstep, voffB);
            PG8_WAIT_V(6); PG8_BAR; PG8_MMA(1, 1, At, B1); PG8_BAR;
            }
        }
        if constexpr (ALIGN_EPI) { if (wr == 0) PG8_BAR; }
        if constexpr (!Epi::AFTER_DRAIN) { E(acc, cur, wr, wc, fr, fq); S.done(cur); }
        if (!has_next) break;
#pragma unroll
        for (int a = 0; a < 2; ++a)
#pragma unroll
            for (int b = 0; b < 2; ++b)
#pragma unroll
                for (int m = 0; m < 4; ++m)
#pragma unroll
                    for (int n = 0; n < 2; ++n) acc[a][b][m][n] = (f32x4){0.f, 0.f, 0.f, 0.f};
        cur = nxt; cA = nA; cB = nB; ++ui;
        if constexpr (ALIGN_EPI) { if (wr == 1) PG8_BAR; }
    }
    PG8_WAIT_V(0);
    if constexpr (!ALIGN_EPI) { if (wr == 0) PG8_BAR; }
    PG8_BAR;
#undef PG8_SA
#undef PG8_SB
#undef PG8_STAGE
#undef PG8_LDA
#undef PG8_LDB
#undef PG8_MMA
#undef PG8_WAIT_V
#undef PG8_WAIT_L
#undef PG8_BAR
#undef PG8_SCHED
}
}

constexpr int NWAVES = 8, NTHREADS = 512;
constexpr int D = 4096, BATCH = 2, SEQ = 8192, CTXL = 256;
constexpr int ML = BATCH * SEQ;
constexpr int MC = BATCH * CTXL;
constexpr int MT = ML + MC;
constexpr int NMODC = 6 * D;
constexpr int WA = 2048, ABIN = 10240, ABU = 6144, ACONV = 31;
constexpr int HEADS = 8, DQK = 256, DV = 512;
constexpr int QKVO = 12288, CIN = 12320, CINP = 12544;
constexpr int DFF = 11008, DFF2 = 22016;
constexpr int NCH = 66;
constexpr float EPS = 1e-6f;

constexpr size_t MiB = 1u << 20;
constexpr size_t WS_CTL = 0, CTL_ZERO_BYTES = 1 * MiB;
constexpr size_t WS_MOD = 1 * MiB;
constexpr size_t WS_SCP = 2 * MiB;
constexpr size_t WS_SCC = 7 * MiB;
constexpr size_t WS_GATES = 8 * MiB;
constexpr size_t WS_CTXS = 12 * MiB;
constexpr size_t WS_WABIN = 20 * MiB;
constexpr size_t WS_WABOUT = 100 * MiB;
constexpr size_t WS_WMIN = 132 * MiB;
constexpr size_t WS_WMOUT = 230 * MiB;
constexpr size_t WS_WUP0 = 262 * MiB;
constexpr size_t WS_WDN0 = 606 * MiB;
constexpr size_t WS_H = 778 * MiB;
constexpr size_t WS_U = 910 * MiB;
constexpr size_t WS_UC = 1590 * MiB;
constexpr size_t WS_G = 1620 * MiB;
constexpr size_t WS_Y = 1975 * MiB;
constexpr size_t WS_HS = 2239 * MiB;
constexpr size_t WS_END = 2751 * MiB;
static_assert(WS_WUP0 + 2 * 172 * MiB == WS_WDN0 && WS_WDN0 + 2 * 86 * MiB <= WS_H, "ws map");
static_assert((size_t)DFF2 * D * 2 <= 172 * MiB && (size_t)D * DFF * 2 <= 86 * MiB && (size_t)CINP * D * 2 <= 98 * MiB, "ws map");
static_assert(WS_H + (size_t)MT * D * 2 <= WS_U && WS_U + (size_t)MT * DFF2 * 2 <= WS_G && WS_G + (size_t)MT * DFF * 2 <= WS_Y && WS_Y + (size_t)MT * D * 4 <= WS_HS && WS_HS + (size_t)2 * ML * D * 4 <= WS_END, "ws map");
static_assert(WS_SCP + (size_t)32 * NCH * 3 * 128 * 4 <= WS_SCC && WS_GATES + (size_t)MT * 32 * 4 <= WS_CTXS && WS_CTXS + (size_t)MC * D * 4 <= WS_WABIN, "ws map");

constexpr int CW_BAR = 4096;
constexpr int LDS_BYTES = 163840;
constexpr int MISC_OFF = LDS_BYTES - 64;

#define LAS __attribute__((address_space(3)))
typedef unsigned short bf16;
typedef unsigned v4u __attribute__((ext_vector_type(4)));
typedef unsigned v2u __attribute__((ext_vector_type(2)));
typedef float f32x4 __attribute__((ext_vector_type(4)));
typedef float f32x2 __attribute__((ext_vector_type(2)));
typedef short bf16x8 __attribute__((ext_vector_type(8)));
typedef short s16x4 __attribute__((ext_vector_type(4)));
#define LDS_WAIT() asm volatile("s_waitcnt lgkmcnt(0)" ::: "memory")

__device__ __forceinline__ unsigned f2bf(float f) { unsigned u = __builtin_bit_cast(unsigned, f); return (u + 0x7fffu + ((u >> 16) & 1u)) >> 16; }
__device__ __forceinline__ unsigned pk2(float lo, float hi) { unsigned r; asm("v_cvt_pk_bf16_f32 %0, %1, %2" : "=v"(r) : "v"(lo), "v"(hi)); return r; }
__device__ __forceinline__ float bflo(unsigned w) { return __builtin_bit_cast(float, w << 16); }
__device__ __forceinline__ float bfhi(unsigned w) { return __builtin_bit_cast(float, w & 0xffff0000u); }
__device__ __forceinline__ float bf1(unsigned short h) { return __builtin_bit_cast(float, ((unsigned)h) << 16); }
__device__ __forceinline__ void cvt8(const v4u r, float (&f)[8]) {
    f[0] = bflo(r.x); f[1] = bfhi(r.x); f[2] = bflo(r.y); f[3] = bfhi(r.y); f[4] = bflo(r.z); f[5] = bfhi(r.z); f[6] = bflo(r.w); f[7] = bfhi(r.w);
}
__device__ __forceinline__ float sigmoidf_(float x) { return __builtin_amdgcn_rcpf(1.0f + __expf(-x)); }
__device__ __forceinline__ float siluf_(float x) { return x * sigmoidf_(x); }
__device__ __forceinline__ float wave_sum(float v) {
#pragma unroll
    for (int o = 1; o < 64; o <<= 1) v += __shfl_xor(v, o);
    return v;
}

#define XB_TMO      128
#define XB_XCNT(j)  (256  + 64 * (j))
#define XB_XSUB(j)  (1280 + 64 * (j))
#define XB_XGEN(j)  (2304 + 64 * (j))
#define XB_TOP      3328
#define XB_TOPGEN   3392
#define XCD_BAR_WORDS 3456
#define XB_SPIN_CAP (1u << 22)

__device__ __forceinline__ unsigned xb_ld(unsigned* p)              { return __hip_atomic_load(p, __ATOMIC_RELAXED, __HIP_MEMORY_SCOPE_AGENT); }
__device__ __forceinline__ unsigned xb_add(unsigned* p, unsigned v) { return __hip_atomic_fetch_add(p, v, __ATOMIC_RELAXED, __HIP_MEMORY_SCOPE_AGENT); }
__device__ __forceinline__ unsigned xb_xcc_id() { return (unsigned)__builtin_amdgcn_s_getreg((3 << 11) | 20) & 0xFu; }
#define XB_SPIN(cond, bar) do { unsigned _sp = 0; while (cond) { __builtin_amdgcn_s_sleep(1); \
    if ((++_sp & 255u) == 0u) { if (xb_ld(&(bar)[XB_TMO])) break; if (_sp > XB_SPIN_CAP) { atomicAdd(&(bar)[XB_TMO], 1u); break; } } } } while (0)

struct XcdBarrier { unsigned* bar; unsigned x; volatile LAS unsigned* st; };

__device__ __forceinline__ XcdBarrier xcd_barrier_post(unsigned* bar, volatile LAS unsigned* st) {
    XcdBarrier b; b.bar = bar; b.x = xb_xcc_id(); b.st = st;
    if (threadIdx.x == 0) (void)xb_add(&bar[XB_XCNT(b.x)], 1u);
    return b;
}
__device__ __forceinline__ void xcd_barrier_complete(unsigned* bar, unsigned x, unsigned& nloc, unsigned& nx) {
    const unsigned G = gridDim.x * gridDim.y * gridDim.z;
    unsigned sum, cnt, mine, sp = 0u;
    for (;;) {
        sum = 0u; cnt = 0u; mine = 0u;
#pragma unroll
        for (unsigned j = 0; j < 16; ++j) { const unsigned c = xb_ld(&bar[XB_XCNT(j)]); sum += c; cnt += (c > 0u) ? 1u : 0u; mine = (j == x) ? c : mine; }
        if (sum == G) break;
        __builtin_amdgcn_s_sleep(1);
        if ((++sp & 255u) == 0u) { if (xb_ld(&bar[XB_TMO])) break; if (sp > XB_SPIN_CAP) { atomicAdd(&bar[XB_TMO], 1u); break; } }
    }
    nloc = mine > 0u ? mine : 1u; nx = cnt > 0u ? cnt : 1u;
}
__device__ __forceinline__ void xcd_barrier(const XcdBarrier& b) {
    asm volatile("s_waitcnt vmcnt(0)" ::: "memory");
    __syncthreads();
    if (threadIdx.x == 0) {
        unsigned* bar = b.bar;
        __builtin_amdgcn_s_waitcnt(0);
        unsigned nloc = b.st[0], nx = b.st[1];
        if (nloc == 0u) { xcd_barrier_complete(bar, b.x, nloc, nx); b.st[0] = nloc; b.st[1] = nx; }
        const unsigned old = xb_add(&bar[XB_XSUB(b.x)], 1u);
        const unsigned gen = old / nloc;
        if (old + 1u == (gen + 1u) * nloc) {
            __builtin_amdgcn_fence(__ATOMIC_RELEASE, "agent");
            asm volatile("s_waitcnt vmcnt(0)" ::: "memory");
            const unsigned og = xb_add(&bar[XB_TOP], 1u);
            const unsigned tg = og / nx;
            if (og + 1u == (tg + 1u) * nx) xb_add(&bar[XB_TOPGEN], 1u);
            else XB_SPIN(xb_ld(&bar[XB_TOPGEN]) == tg, bar);
            __builtin_amdgcn_fence(__ATOMIC_ACQUIRE, "agent");
            xb_add(&bar[XB_XGEN(b.x)], 1u);
            asm volatile("s_waitcnt vmcnt(0)" ::: "memory");
        } else {
            XB_SPIN(xb_ld(&bar[XB_XGEN(b.x)]) == gen, bar);
            __builtin_amdgcn_fence(__ATOMIC_ACQUIRE, "agent");
            asm volatile("s_waitcnt vmcnt(0)" ::: "memory");
        }
    }
    __syncthreads();
}

struct Args { const float* in[21]; float* out; unsigned char* ws; int ph_lo, ph_hi; };
typedef const __attribute__((address_space(4))) Args* CArgs;
__device__ __forceinline__ int opaque_tid(int wave_s) { int t = wave_s * 64 + (int)__builtin_amdgcn_mbcnt_hi(~0u, __builtin_amdgcn_mbcnt_lo(~0u, 0u)); asm volatile("" : "+v"(t)); return t; }
__device__ __forceinline__ CArgs get_args() { CArgs p = (CArgs)__builtin_amdgcn_kernarg_segment_ptr(); asm volatile("" : "+s"(p)); return p; }
enum { I_X = 0, I_C, I_CTX, I_CCTX, I_ADAW, I_ADAB, I_NORMG, I_ABWIN, I_ACONVW, I_ACONVB, I_ALNG, I_ALNB, I_BCONVW, I_ABWOUT, I_MWIN, I_MBG, I_MHNG, I_MWOUT, I_FUP, I_FCONV, I_FDN };

template <int MODE> __device__ __forceinline__ int perm_row(int n0) {
    if (MODE == 1) return n0 < DFF ? 256 * (n0 / 128) + (n0 % 128) : 256 * ((n0 - DFF) / 128) + 128 + ((n0 - DFF) % 128);
    if (MODE == 2) { if (n0 < 4096) { const int ch = n0 & 2047, hi = n0 >> 11; return 256 * (ch / 128) + 128 * hi + (ch % 128); }
                     if (n0 < 6144) return n0;
                     const int j = n0 - 6144, ch = j & 2047, hi = j >> 11; return 6144 + 256 * (ch / 128) + 128 * hi + (ch % 128); }
    return n0;
}
template <int GATE_PERM = 0>
__device__ __forceinline__ void p0_transpose_item(const float* W, int K, int N, bf16* WT, LAS float* scr, int item, int lane) {
    const int nblk = N / 32, kb = item / nblk, nb = item % nblk, k0 = 64 * kb, n0 = 32 * nb;
    const int r0 = perm_row<GATE_PERM>(n0);
#pragma unroll 8
    for (int i = 0; i < 32; ++i) { const int kk = 2 * i + (lane >> 5); scr[kk * 33 + (lane & 31)] = W[(size_t)(k0 + kk) * N + n0 + (lane & 31)]; }
    LDS_WAIT(); asm volatile("" ::: "memory");
    const int c = lane & 7;
#pragma unroll
    for (int j = 0; j < 4; ++j) { const int n = (lane >> 3) + 8 * j; const LAS float* s = scr + (8 * c) * 33 + n;
        v4u o; o.x = pk2(s[0 * 33], s[1 * 33]); o.y = pk2(s[2 * 33], s[3 * 33]); o.z = pk2(s[4 * 33], s[5 * 33]); o.w = pk2(s[6 * 33], s[7 * 33]);
        __builtin_nontemporal_store(o, (v4u*)(WT + (size_t)(r0 + n) * K + k0 + 8 * c)); }
    LDS_WAIT(); asm volatile("" ::: "memory");
}

__device__ __forceinline__ void gemv_units(CArgs a, LAS unsigned char* lds, int layer, int first, int stride, int tid, int lane, int wave) {
    float* MOD = (float*)(a->ws + WS_MOD);
    LAS float* sv = (LAS float*)lds;
    LAS float* red = (LAS float*)(lds + 49152);
    for (int i = tid; i < 3 * D; i += NTHREADS) { const int r = i / D, k = i % D; const float v = (r < 2) ? a->in[I_C][r * D + k] : a->in[I_CCTX][k]; sv[i] = siluf_(v); }
    __syncthreads();
    for (int unit = first; unit < 768; unit += stride) {
        const int n0 = unit * 32;
        const int kg = wave * 8 + (lane >> 3), c4 = (lane & 7) * 4;
        const float* W = a->in[I_ADAW] + (size_t)layer * D * NMODC + (size_t)(kg * 64) * NMODC + n0 + c4;
        f32x4 a0 = {0.f, 0.f, 0.f, 0.f}, a1 = a0, a2 = a0;
        for (int k = 0; k < 64; k += 16) {
            f32x4 w[16];
#pragma unroll
            for (int j = 0; j < 16; ++j) w[j] = __builtin_nontemporal_load((const f32x4*)(W + (size_t)(k + j) * NMODC));
#pragma unroll
            for (int j = 0; j < 16; ++j) { const int kk = kg * 64 + k + j; a0 += w[j] * sv[kk]; a1 += w[j] * sv[D + kk]; a2 += w[j] * sv[2 * D + kk]; }
        }
        *(LAS f32x4*)(red + (kg * 3 + 0) * 32 + c4) = a0; *(LAS f32x4*)(red + (kg * 3 + 1) * 32 + c4) = a1; *(LAS f32x4*)(red + (kg * 3 + 2) * 32 + c4) = a2;
        __syncthreads();
        if (tid < 96) { const int r = tid >> 5, cc = tid & 31; float s = 0.f;
#pragma unroll 8
            for (int g = 0; g < 64; ++g) s += red[(g * 3 + r) * 32 + cc];
            MOD[((size_t)layer * 3 + r) * NMODC + n0 + cc] = s + a->in[I_ADAB][(size_t)layer * NMODC + n0 + cc]; }
        __syncthreads();
    }
}
template <int GATE_PERM>
__device__ __forceinline__ void transpose_item64(const float* W, int K, int N, bf16* WT, LAS float* scr, int item, int lane, int nblk) {
    const int kb = item / nblk, nb = item % nblk, k0 = 64 * kb, n0 = 64 * nb;
    const int r0 = perm_row<GATE_PERM>(n0);
    const int kq = lane >> 4, j4 = (lane & 15) * 4;
    f32x4 v[16];
#pragma unroll
    for (int i = 0; i < 16; ++i) v[i] = __builtin_nontemporal_load((const f32x4*)(W + (size_t)(k0 + 4 * i + kq) * N + n0 + j4));
#pragma unroll
    for (int i = 0; i < 16; ++i) { LAS float* p = scr + (4 * i + kq) * 65 + j4; p[0] = v[i].x; p[1] = v[i].y; p[2] = v[i].z; p[3] = v[i].w; }
    LDS_WAIT(); asm volatile("" ::: "memory");
    const int c = lane & 7;
#pragma unroll
    for (int j = 0; j < 8; ++j) { const int n = (lane >> 3) + 8 * j; const LAS float* p = scr + (8 * c) * 65 + n;
        v4u o; o.x = pk2(p[0 * 65], p[1 * 65]); o.y = pk2(p[2 * 65], p[3 * 65]); o.z = pk2(p[4 * 65], p[5 * 65]); o.w = pk2(p[6 * 65], p[7 * 65]);
        __builtin_nontemporal_store(o, (v4u*)(WT + (size_t)(r0 + n) * K + k0 + 8 * c)); }
    LDS_WAIT(); asm volatile("" ::: "memory");
}
template <int GATE_PERM>
__device__ __forceinline__ void conv_items(const float* W, int K, int N, bf16* WT, LAS unsigned char* lds, int first, int stride, int lane, int wave) {
    LAS float* scr = (LAS float*)(lds + wave * 16640);
    const int nb64 = N / 64, nitems = (K / 64) * nb64;
    for (int it = first; it < nitems; it += stride) transpose_item64<GATE_PERM>(W, K, N, WT, scr, it, lane, nb64);
    if (N % 64) for (int kb = first; kb < K / 64; kb += stride) p0_transpose_item<GATE_PERM>(W, K, N, WT, scr, kb * (N / 32) + (N / 32 - 1), lane);
}
enum { CV_ABIN = 0, CV_ABOUT, CV_MIN, CV_MOUT, CV_UP0, CV_UP1, CV_DN0, CV_DN1 };
template <int WHICH>
__device__ __forceinline__ void conv_matrix(CArgs a, LAS unsigned char* lds, int first, int stride, int lane, int wave) {
    unsigned char* ws = a->ws;
    if (WHICH == CV_ABIN) conv_items<2>(a->in[I_ABWIN], D, ABIN, (bf16*)(ws + WS_WABIN), lds, first, stride, lane, wave);
    if (WHICH == CV_ABOUT) conv_items<0>(a->in[I_ABWOUT], D, D, (bf16*)(ws + WS_WABOUT), lds, first, stride, lane, wave);
    if (WHICH == CV_MIN) { conv_items<0>(a->in[I_MWIN], D, CIN, (bf16*)(ws + WS_WMIN), lds, first, stride, lane, wave);
        v4u* p = (v4u*)((bf16*)(ws + WS_WMIN) + (size_t)CIN * D); const int n16 = (CINP - CIN) * D * 2 / 16;
        for (int i = first * 64 + lane; i < n16; i += stride * 64) p[i] = (v4u){0u, 0u, 0u, 0u}; }
    if (WHICH == CV_MOUT) conv_items<0>(a->in[I_MWOUT], D, D, (bf16*)(ws + WS_WMOUT), lds, first, stride, lane, wave);
    if (WHICH == CV_UP0) conv_items<1>(a->in[I_FUP], D, DFF2, (bf16*)(ws + WS_WUP0), lds, first, stride, lane, wave);
    if (WHICH == CV_UP1) conv_items<1>(a->in[I_FUP] + (size_t)D * DFF2, D, DFF2, (bf16*)(ws + WS_WUP0 + 172 * MiB), lds, first, stride, lane, wave);
    if (WHICH == CV_DN0) conv_items<0>(a->in[I_FDN], DFF, D, (bf16*)(ws + WS_WDN0), lds, first, stride, lane, wave);
    if (WHICH == CV_DN1) conv_items<0>(a->in[I_FDN] + (size_t)DFF * D, DFF, D, (bf16*)(ws + WS_WDN0 + 86 * MiB), lds, first, stride, lane, wave);
}
__device__ __forceinline__ void p0_prologue(CArgs a, LAS unsigned char* lds, int tid, int lane, int wave) {
    gemv_units(a, lds, 0, blockIdx.x, gridDim.x, tid, lane, wave);
    const int gw = blockIdx.x * NWAVES + wave, NGW = gridDim.x * NWAVES;
    conv_matrix<CV_ABIN>(a, lds, gw, NGW, lane, wave);
#if PROBE_E1
    conv_matrix<CV_ABOUT>(a, lds, gw, NGW, lane, wave);
    conv_matrix<CV_UP0>(a, lds, gw, NGW, lane, wave); conv_matrix<CV_DN0>(a, lds, gw, NGW, lane, wave); conv_matrix<CV_MIN>(a, lds, gw, NGW, lane, wave); conv_matrix<CV_MOUT>(a, lds, gw, NGW, lane, wave);
    conv_matrix<CV_UP1>(a, lds, gw, NGW, lane, wave); conv_matrix<CV_DN1>(a, lds, gw, NGW, lane, wave); __syncthreads(); gemv_units(a, lds, 1, blockIdx.x, gridDim.x, tid, lane, wave);
#endif
}
__device__ __forceinline__ int gemm_wgs(int nwg) { const int G = gridDim.x, rounds = (nwg + G - 1) / G; const int g = ((nwg + rounds - 1) / rounds + 7) & ~7; return g < G ? g : G; }

template <bool RES, bool DOH>
__device__ __forceinline__ void row_phase(LAS unsigned char* lds, int nrows, const float* xin_lat, const float* xin_ctx, float* xout_lat, float* xout_ctx,
                                          const bf16* Y, const float* gpost, const float* modres, int gate_idx,
                                          const float* gpre, const float* modh, int shift_idx, int scale_idx, bf16* H, int tid, int lane, int wave) {
    LAS f32x4* pG = (LAS f32x4*)lds; LAS f32x4* pA = pG + 1024; LAS f32x4* pB = pA + 1024;
    const int G = gridDim.x, rpw = (nrows + G - 1) / G, r0 = (int)blockIdx.x * rpw, r1 = (r0 + rpw < nrows) ? r0 + rpw : nrows;
    for (int vb = r0; vb < r1;) {
        const int mr = vb < ML ? (vb >> 13) : 2;
        const int lim = mr == 0 ? SEQ : (mr == 1 ? ML : nrows), vend = r1 < lim ? r1 : lim;
        __syncthreads();
        for (int i = tid; i < 1024; i += NTHREADS) {
            if (RES) pG[i] = ((const f32x4*)(modres + (size_t)mr * NMODC + gate_idx * D))[i] * ((const f32x4*)gpost)[i];
            if (DOH) { pA[i] = ((const f32x4*)gpre)[i] * (((const f32x4*)(modh + (size_t)mr * NMODC + scale_idx * D))[i] + 1.0f); pB[i] = ((const f32x4*)(modh + (size_t)mr * NMODC + shift_idx * D))[i]; }
        }
        __syncthreads();
        for (int row = vb + wave; row < vend; row += NWAVES) {
            const float* xr = row < ML ? xin_lat + (size_t)row * D : xin_ctx + (size_t)(row - ML) * D;
            f32x4 v[16];
            if (RES) {
                const bf16* yr = Y + (size_t)row * D; float s = 0.f;
#pragma unroll
                for (int j = 0; j < 16; ++j) { const v2u yw = *(const v2u*)(yr + j * 256 + lane * 4); v[j] = (f32x4){bflo(yw.x), bfhi(yw.x), bflo(yw.y), bfhi(yw.y)}; s += (v[j].x * v[j].x + v[j].y * v[j].y) + (v[j].z * v[j].z + v[j].w * v[j].w); }
                const float rstd = 1.0f / sqrtf(wave_sum(s) * (1.0f / D) + EPS);
                float* xo = row < ML ? xout_lat + (size_t)row * D : xout_ctx + (size_t)(row - ML) * D;
#pragma unroll
                for (int j = 0; j < 16; ++j) { const int o = j * 256 + lane * 4;
                    const f32x4 x = *(const f32x4*)(xr + o);
                    v[j] = x + (v[j] * rstd) * pG[j * 64 + lane];
                    *(f32x4*)(xo + o) = v[j];
                    if ((j & 3) == 3) asm volatile("" ::: "memory"); }
            } else {
#pragma unroll
                for (int j = 0; j < 16; ++j) v[j] = *(const f32x4*)(xr + j * 256 + lane * 4);
            }
            if (DOH) {
                float s = 0.f;
#pragma unroll
                for (int j = 0; j < 16; ++j) s += (v[j].x * v[j].x + v[j].y * v[j].y) + (v[j].z * v[j].z + v[j].w * v[j].w);
                const float rstd = 1.0f / sqrtf(wave_sum(s) * (1.0f / D) + EPS);
                bf16* hr = H + (size_t)row * D;
#pragma unroll
                for (int j = 0; j < 16; ++j) { const int o = j * 256 + lane * 4;
                    const f32x4 h = (v[j] * rstd) * pA[j * 64 + lane] + pB[j * 64 + lane];
                    v2u w; w.x = pk2(h.x, h.y); w.y = pk2(h.z, h.w);
                    *(v2u*)(hr + o) = w; }
            }
        }
        vb = vend;
    }
}

__device__ __forceinline__ void mixer_conv_phase(CArgs a, LAS unsigned char* lds, int tid, int lane) {
    const bf16* U = (const bf16*)(a->ws + WS_U);
    bf16* T1 = (bf16*)(a->ws + WS_Y);
    bf16* V = (bf16*)(a->ws + WS_G);
    LAS float* tile = (LAS float*)lds;
    const float* cw = a->in[I_ACONVW]; const float* cb = a->in[I_ACONVB];
    v4u rva[6]; f32x2 w[ACONV]; f32x2 bias = {0.f, 0.f}; int cc_w = -1;
#define MX_ROW(tb_, j_) ((tb_) < 256 ? (((j_) >= 15 && (j_) < 79) ? (tb_) * 64 + ((j_) - 15) : -1) \
        : ((((tb_) - 256) & 3) * 64 + ((j_) - 15) >= 0 && (((tb_) - 256) & 3) * 64 + ((j_) - 15) < CTXL ? ML + (((tb_) - 256) >> 2) * CTXL + (((tb_) - 256) & 3) * 64 + ((j_) - 15) : -1))
#define MX_LOAD(unit_) do { const int tb_ = (unit_) >> 3, cc_ = (unit_) & 7; \
        _Pragma("unroll") for (int q = 0; q < 6; ++q) { const int it = tid + NTHREADS * q; const int j = it >> 5, ch8 = it & 31; const int row = it < 94 * 32 ? MX_ROW(tb_, j) : -1; \
            const size_t o_ = (size_t)(row >= 0 ? row : 0) * ABU + cc_ * 256 + ch8 * 8; rva[q] = *(const v4u*)(U + o_); } } while (0)
    if ((int)blockIdx.x < 264 * 8) MX_LOAD(blockIdx.x);
    for (int unit = blockIdx.x; unit < 264 * 8; unit += gridDim.x) {
        const int tb = unit >> 3, cc = unit & 7;
#pragma unroll
        for (int q = 0; q < 6; ++q) { const int it = tid + NTHREADS * q; const int j = it >> 5, ch8 = it & 31;
            if (it < 94 * 32) { const int row = MX_ROW(tb, j); const float f = row >= 0 ? 1.f : 0.f; const v4u va = rva[q]; f32x4 g0, g1;
                g0.x = f * bflo(va.x); g0.y = f * bfhi(va.x); g0.z = f * bflo(va.y); g0.w = f * bfhi(va.y);
                g1.x = f * bflo(va.z); g1.y = f * bfhi(va.z); g1.z = f * bflo(va.w); g1.w = f * bfhi(va.w);
                *(LAS f32x4*)(tile + j * 256 + ch8 * 8) = g0; *(LAS f32x4*)(tile + j * 256 + ch8 * 8 + 4) = g1; } }
        __syncthreads();
        if (unit + (int)gridDim.x < 264 * 8) MX_LOAD(unit + (int)gridDim.x);
        {
            const int cp = tid & 127, tg = tid >> 7, c = cc * 256 + 2 * cp;
            if (cc != cc_w) { cc_w = cc;
#pragma unroll
                for (int k = 0; k < ACONV; ++k) w[k] = *(const f32x2*)(cw + k * WA + c);
                bias = *(const f32x2*)(cb + c); }
            f32x2 acc[16];
#pragma unroll
            for (int i = 0; i < 16; ++i) acc[i] = (f32x2){0.f, 0.f};
#pragma unroll
            for (int jj = 0; jj < 46; ++jj) {
                const f32x2 g = *(const LAS f32x2*)(tile + (16 * tg + jj) * 256 + 2 * cp);
#pragma unroll
                for (int i = 0; i < 16; ++i) { const int k = jj - i; if (k >= 0 && k < ACONV) acc[i] += w[k] * g; }
            }
            int row0;
            if (tb < 256) row0 = tb * 64 + 16 * tg; else { const int cbk = tb - 256; row0 = ML + (cbk >> 2) * CTXL + (cbk & 3) * 64 + 16 * tg; }
#pragma unroll
            for (int i = 0; i < 16; ++i) { const f32x2 o = acc[i] + bias; *(unsigned*)(T1 + (size_t)(row0 + i) * WA + c) = pk2(o.x, o.y); }
        }
        __syncthreads();
    }
#undef MX_ROW
#undef MX_LOAD
    const float* bw = a->in[I_BCONVW];
    constexpr int NSEG_L = 2 * 64 * 16, NIT_L = NSEG_L * 256, NIT_C = 2 * 32 * 256;
    for (int it = blockIdx.x * NTHREADS + tid; it < NIT_L + NIT_C; it += gridDim.x * NTHREADS) {
        int row0, stride, prow, nrow, c;
        if (it < NIT_L) { const int c8 = it & 255, r = it >> 8, x = r & 63, seg = (r >> 6) & 15, b = r >> 10;
            c = c8 * 8; stride = 64; row0 = b * SEQ + (seg * 8) * 64 + x; prow = seg > 0 ? row0 - 64 : -1; nrow = seg < 15 ? row0 + 8 * 64 : -1; }
        else { const int j = it - NIT_L, c8 = j & 255, r = j >> 8, seg = r & 31, b = r >> 5;
            c = c8 * 8; stride = 1; row0 = ML + b * CTXL + seg * 8; prow = seg > 0 ? row0 - 1 : -1; nrow = seg < 31 ? row0 + 8 : -1; }
        float w[3][8];
#pragma unroll
        for (int k = 0; k < 3; ++k) { const f32x4 w0 = *(const f32x4*)(bw + k * 2048 + c), w1 = *(const f32x4*)(bw + k * 2048 + c + 4);
            w[k][0] = w0.x; w[k][1] = w0.y; w[k][2] = w0.z; w[k][3] = w0.w; w[k][4] = w1.x; w[k][5] = w1.y; w[k][6] = w1.z; w[k][7] = w1.w; }
        const bf16* uz = U + 4096 + c; const bf16* ub = U + 2048 + c;
        v4u rc[10], rb[8];
#pragma unroll
        for (int i = 0; i < 10; ++i) { const int rr = i == 0 ? (prow >= 0 ? prow : row0) : (i == 9 ? (nrow >= 0 ? nrow : row0) : row0 + (i - 1) * stride);
            rc[i] = *(const v4u*)(uz + (size_t)rr * ABU); }
#pragma unroll
        for (int i = 0; i < 8; ++i) rb[i] = *(const v4u*)(ub + (size_t)(row0 + i * stride) * ABU);
        float pp[8], pc[8];
        { float a8[8]; cvt8(rc[0], a8); const float f = prow >= 0 ? 1.f : 0.f;
#pragma unroll
          for (int e = 0; e < 8; ++e) pp[e] = a8[e] * f;
          cvt8(rc[1], pc); }
#pragma unroll
        for (int i = 0; i < 8; ++i) {
            float pn[8], bb[8]; cvt8(rc[i + 2], pn); cvt8(rb[i], bb);
            const float f = (i == 7 && nrow < 0) ? 0.f : 1.f;
#pragma unroll
            for (int e = 0; e < 8; ++e) pn[e] *= f;
            float o[8];
#pragma unroll
            for (int e = 0; e < 8; ++e) o[e] = bb[e] * (w[0][e] * pp[e] + w[1][e] * pc[e] + w[2][e] * pn[e]);
            v4u ov; ov.x = pk2(o[0], o[1]); ov.y = pk2(o[2], o[3]); ov.z = pk2(o[4], o[5]); ov.w = pk2(o[6], o[7]);
            *(v4u*)(V + (size_t)(row0 + i * stride) * D + WA + c) = ov;
#pragma unroll
            for (int e = 0; e < 8; ++e) { pp[e] = pc[e]; pc[e] = pn[e]; }
        }
    }
}
__device__ __forceinline__ void mixer_ln_phase(CArgs a, LAS unsigned char* lds, int tid, int lane, int wave) {
    const bf16* T1 = (const bf16*)(a->ws + WS_Y);
    bf16* V = (bf16*)(a->ws + WS_G);
    LAS f32x4* pg = (LAS f32x4*)lds; LAS f32x4* pb = pg + 512;
    for (int i = tid; i < 512; i += NTHREADS) { pg[i] = ((const f32x4*)a->in[I_ALNG])[i]; pb[i] = ((const f32x4*)a->in[I_ALNB])[i]; }
    __syncthreads();
    const int G = gridDim.x, rpw = (MT + G - 1) / G, r0 = (int)blockIdx.x * rpw, r1 = (r0 + rpw < MT) ? r0 + rpw : MT;
    for (int row = r0 + wave; row < r1; row += NWAVES) {
        f32x4 v[8]; float s = 0.f;
#pragma unroll
        for (int j = 0; j < 8; ++j) { const v2u tw = *(const v2u*)(T1 + (size_t)row * WA + j * 256 + lane * 4); v[j] = (f32x4){bflo(tw.x), bfhi(tw.x), bflo(tw.y), bfhi(tw.y)}; s += (v[j].x + v[j].y) + (v[j].z + v[j].w); }
        const float mu = wave_sum(s) * (1.0f / WA); float q = 0.f;
#pragma unroll
        for (int j = 0; j < 8; ++j) { v[j] = v[j] - mu; q += (v[j].x * v[j].x + v[j].y * v[j].y) + (v[j].z * v[j].z + v[j].w * v[j].w); }
        const float rstd = 1.0f / sqrtf(wave_sum(q) * (1.0f / WA) + EPS);
#pragma unroll
        for (int j = 0; j < 8; ++j) { const int o = j * 256 + lane * 4;
            const f32x4 y = (v[j] * rstd) * pg[j * 64 + lane] + pb[j * 64 + lane];
            v2u w; w.x = pk2(siluf_(y.x), siluf_(y.y)); w.y = pk2(siluf_(y.z), siluf_(y.w));
            *(v2u*)(V + (size_t)row * D + o) = w; }
    }
}

template <int NR>
__device__ __forceinline__ void ffn_gate_slide(const bf16* ug, const bf16* uv, int ldu, bf16* Go, const float* cwg, const float* cwv, int row0, int prow, int nrow) {
    float wg[3][8], wv[3][8];
#pragma unroll
    for (int k = 0; k < 3; ++k) {
        const f32x4 a0 = *(const f32x4*)(cwg + k * DFF2), a1 = *(const f32x4*)(cwg + k * DFF2 + 4), b0 = *(const f32x4*)(cwv + k * DFF2), b1 = *(const f32x4*)(cwv + k * DFF2 + 4);
        wg[k][0] = a0.x; wg[k][1] = a0.y; wg[k][2] = a0.z; wg[k][3] = a0.w; wg[k][4] = a1.x; wg[k][5] = a1.y; wg[k][6] = a1.z; wg[k][7] = a1.w;
        wv[k][0] = b0.x; wv[k][1] = b0.y; wv[k][2] = b0.z; wv[k][3] = b0.w; wv[k][4] = b1.x; wv[k][5] = b1.y; wv[k][6] = b1.z; wv[k][7] = b1.w;
    }
    float pg[8], pv[8], cg[8], cv[8];
    { const float fp = prow >= 0 ? 1.f : 0.f; const int pr = prow >= 0 ? prow : row0;
      const v4u a = *(const v4u*)(ug + (size_t)pr * ldu), b = *(const v4u*)(uv + (size_t)pr * ldu); cvt8(a, pg); cvt8(b, pv);
#pragma unroll
      for (int e = 0; e < 8; ++e) { pg[e] *= fp; pv[e] *= fp; }
      const v4u a2 = *(const v4u*)(ug + (size_t)row0 * ldu), b2 = *(const v4u*)(uv + (size_t)row0 * ldu); cvt8(a2, cg); cvt8(b2, cv); }
    const float fn = nrow >= 0 ? 1.f : 0.f; const int nr = nrow >= 0 ? nrow : row0;
    for (int blk = 0; blk < NR / 4; ++blk) {
        v4u rg[4], rv[4];
#pragma unroll
        for (int i = 0; i < 4; ++i) { const int r = 4 * blk + 1 + i; const int rr = r < NR ? row0 + r : nr;
            rg[i] = *(const v4u*)(ug + (size_t)rr * ldu); rv[i] = *(const v4u*)(uv + (size_t)rr * ldu); }
#pragma unroll
        for (int i = 0; i < 4; ++i) {
            float ng[8], nv[8]; cvt8(rg[i], ng); cvt8(rv[i], nv);
            if (i == 3) { const float f = (4 * blk + 4 < NR) ? 1.f : fn;
#pragma unroll
                for (int e = 0; e < 8; ++e) { ng[e] *= f; nv[e] *= f; } }
            float o[8];
#pragma unroll
            for (int e = 0; e < 8; ++e) { const float g = wg[0][e] * pg[e] + wg[1][e] * cg[e] + wg[2][e] * ng[e], v = wv[0][e] * pv[e] + wv[1][e] * cv[e] + wv[2][e] * nv[e]; o[e] = siluf_(g) * v; }
            v4u w; w.x = pk2(o[0], o[1]); w.y = pk2(o[2], o[3]); w.z = pk2(o[4], o[5]); w.w = pk2(o[6], o[7]);
            *(v4u*)(Go + (size_t)(4 * blk + i) * DFF) = w;
#pragma unroll
            for (int e = 0; e < 8; ++e) { pg[e] = cg[e]; pv[e] = cv[e]; cg[e] = ng[e]; cv[e] = nv[e]; }
        }
    }
}
__device__ __forceinline__ void ffn_gate_ctx_phase(CArgs a, int tid) {
    const bf16* UC = (const bf16*)(a->ws + WS_UC);
    bf16* G = (bf16*)(a->ws + WS_G);
    const float* cw = a->in[I_FCONV];
    constexpr int NC8 = DFF / 8;
    constexpr int NIT = 8 * NC8 * 4, PER = (NIT + 255) / 256;
    for (int it = blockIdx.x * PER + tid; tid < PER && it < NIT; it += gridDim.x * PER) {
        const int q4 = it & 3, rest = it >> 2, c8 = rest % NC8, blk = rest / NC8, ch = c8 * 8;
        const int p0 = (blk & 3) * 64 + q4 * 16, lrow0 = (blk >> 2) * CTXL + p0;
        const bf16* ug = UC + 256 * (ch >> 7) + (ch & 127);
        ffn_gate_slide<16>(ug, ug + 128, DFF2, G + (size_t)(ML + lrow0) * DFF + ch, cw + ch, cw + DFF + ch, lrow0, p0 > 0 ? lrow0 - 1 : -1, p0 + 16 < CTXL ? lrow0 + 16 : -1);
    }
}

__device__ __forceinline__ int chunk_row0(int dir, int b, int c) {
    if (dir == 0) return c < 2 ? ML + b * CTXL + 128 * c : b * SEQ + 128 * (c - 2);
    return c < 2 ? ML + b * CTXL + 128 * (1 - c) : b * SEQ + 128 * (63 - (c - 2));
}
__device__ __forceinline__ float wave_incl_sum(float v, int lane) {
#pragma unroll
    for (int o = 1; o < 64; o <<= 1) { const float t = __shfl_up(v, o); if (lane >= o) v += t; }
    return v;
}
__device__ __forceinline__ float wave_incl_max(float v, int lane) {
#pragma unroll
    for (int o = 1; o < 64; o <<= 1) { const float t = __shfl_up(v, o); if (lane >= o) v = fmaxf(v, t); }
    return v;
}
__device__ __forceinline__ bf16x8 tr_frag(LAS unsigned char* T, int pitch, int k0, int col0, int lane) {
    const int g = lane >> 4, q = (lane & 15) >> 2, p = lane & 3;
    LAS unsigned char* p0 = T + (k0 + 8 * g + q) * pitch + (col0 + 4 * p) * 2;
    const s16x4 lo = __builtin_amdgcn_ds_read_tr16_b64_v4i16((LAS s16x4*)p0);
    const s16x4 hi = __builtin_amdgcn_ds_read_tr16_b64_v4i16((LAS s16x4*)(p0 + 4 * pitch));
    bf16x8 r; r[0] = lo[0]; r[1] = lo[1]; r[2] = lo[2]; r[3] = lo[3]; r[4] = hi[0]; r[5] = hi[1]; r[6] = hi[2]; r[7] = hi[3];
    return r;
}
#ifndef SCAN_REP
#define SCAN_REP 1
#endif
#define MFMA16(y, x, acc) __builtin_amdgcn_mfma_f32_16x16x32_bf16((y), (x), (acc), 0, 0, 0)

constexpr int SK_PITCH = 528;

constexpr size_t WS_QT = WS_G;
constexpr size_t WS_SPP = WS_Y;
constexpr size_t WS_DEN = WS_Y + 64 * MiB;
static_assert((size_t)32 * 64 * 128 * 128 * 2 <= 64 * MiB && WS_DEN + (size_t)32 * 64 * 128 * 4 <= WS_HS, "scan scratch");
__device__ __forceinline__ void chunk_scalars(CArgs a, int dir, int b, int h, int c, LAS float* sAl, LAS float* sPl, int lane) {
    const float* GT = (const float*)(a->ws + WS_GATES);
    float* SCP = (float*)(a->ws + WS_SCP); float* SCG = (float*)(a->ws + WS_SCC);
    const int chain = dir * 16 + b * 8 + h, R0 = chunk_row0(dir, b, c);
    const float bi = a->in[I_MBG][dir * 16 + h], bf = a->in[I_MBG][dir * 16 + 8 + h];
    const int r0 = dir ? 127 - lane : lane, r1 = dir ? 63 - lane : 64 + lane;
    const float i0 = GT[(size_t)(R0 + r0) * 32 + dir * 16 + h] + bi, i1 = GT[(size_t)(R0 + r1) * 32 + dir * 16 + h] + bi;
    const float x0 = GT[(size_t)(R0 + r0) * 32 + dir * 16 + 8 + h] + bf, x1 = GT[(size_t)(R0 + r1) * 32 + dir * 16 + 8 + h] + bf;
    const float f0 = fminf(x0, 0.f) - log1pf(__expf(-fabsf(x0))), f1 = fminf(x1, 0.f) - log1pf(__expf(-fabsf(x1)));
    const float s0 = wave_incl_sum(f0, lane); const float tot0 = __shfl(s0, 63);
    const float s1 = wave_incl_sum(f1, lane) + tot0;
    const float a0 = i0 - s0, a1 = i1 - s1;
    const float p0 = wave_incl_max(a0, lane); const float pm0 = __shfl(p0, 63);
    const float p1 = fmaxf(wave_incl_max(a1, lane), pm0);
    float* o = SCP + ((size_t)chain * NCH + c) * 384;
    o[r0] = a0; o[128 + r0] = p0; o[256 + r0] = s0;
    o[r1] = a1; o[128 + r1] = p1; o[256 + r1] = s1;
    if (sAl) { sAl[r0] = a0; sAl[r1] = a1; }
    if (lane == 63) { SCG[((size_t)chain * NCH + c) * 2] = s1; SCG[((size_t)chain * NCH + c) * 2 + 1] = p1; if (sPl) sPl[0] = p1; }
}
__device__ __forceinline__ void scan_pre_phase(CArgs a, LAS unsigned char* lds, int tid, int lane, int wave) {
    const bf16* QK = (const bf16*)(a->ws + WS_U);
    bf16* SPP = (bf16*)(a->ws + WS_SPP); float* DEN = (float*)(a->ws + WS_DEN); const bf16* QT = (const bf16*)(a->ws + WS_QT);
    LAS unsigned char* Kl = lds; LAS float* sA0 = (LAS float*)(lds + 67584); LAS float* sA1 = sA0 + 128; LAS float* sPt = sA0 + 256;
    const int g = lane >> 4, l15 = lane & 15;
    for (int unit = blockIdx.x; unit < 1024 + 64; unit += gridDim.x) {
        if (unit >= 1024) { if (wave == 0) { const int u = unit - 1024, chain = u >> 1, c = u & 1; chunk_scalars(a, chain >> 4, (chain >> 3) & 1, chain & 7, c, nullptr, nullptr, lane); } continue; }
        const int bh = unit >> 6, j = unit & 63, b = bh >> 3, h = bh & 7;
        const int R0 = b * SEQ + 128 * j, c0 = 2 + j, c1 = 2 + (63 - j);
        const int tl = 16 * wave + l15;
#pragma unroll
        for (int i = 0; i < 8; ++i) { const int idx = tid + NTHREADS * i, r = idx >> 5, ch = idx & 31;
            const v4u v = *(const v4u*)(QK + (size_t)(R0 + r) * QKVO + 2048 + h * DQK + ch * 8);
            *(LAS v4u*)(Kl + r * SK_PITCH + ch * 16) = v; }
        bf16x8 qf[8];
#pragma unroll
        for (int kk = 0; kk < 8; ++kk) qf[kk] = *(const bf16x8*)(QT + ((size_t)((R0 >> 4) + wave) * 64 + 8 * h + kk) * 512 + lane * 8);
        if (wave == 0) chunk_scalars(a, 0, b, h, c0, sA0, sPt, lane);
        if (wave == 1) chunk_scalars(a, 1, b, h, c1, sA1, sPt + 1, lane);
        __syncthreads();
        {
            const float pt0 = sPt[0], pt1 = sPt[1];
            float dp0 = 0.f, dp1 = 0.f;
            int tlv = tl, gv = 4 * g; asm volatile("" : "+v"(tlv), "+v"(gv));
            bf16* sp0 = SPP + (size_t)((0 * 16 + bh) * 64 + (c0 - 2)) * 16384 + (size_t)wave * 2048 + (l15 + 16 * (g >> 1)) * 8 + 4 * (g & 1);
            bf16* sp1 = SPP + (size_t)((1 * 16 + bh) * 64 + (c1 - 2)) * 16384 + (size_t)wave * 2048 + (l15 + 16 * (g >> 1)) * 8 + 4 * (g & 1);
#pragma unroll
            for (int nh = 0; nh < 2; ++nh) {
                f32x4 sacc[4];
#pragma unroll
                for (int n = 0; n < 4; ++n) sacc[n] = (f32x4){0.f, 0.f, 0.f, 0.f};
#pragma unroll
                for (int kk = 0; kk < 8; ++kk)
#pragma unroll
                    for (int n = 0; n < 4; ++n) { const bf16x8 yf = *(const LAS bf16x8*)(Kl + (16 * (4 * nh + n) + l15) * SK_PITCH + (32 * kk + 8 * g) * 2); sacc[n] = MFMA16(yf, qf[kk], sacc[n]); }
#pragma unroll
                for (int n = 0; n < 4; ++n) { float sv0[4], sv1[4]; const int n8 = 4 * nh + n;
#pragma unroll
                    for (int r = 0; r < 4; ++r) { const int sl = 16 * n8 + 4 * g + r; const int sidx = gv + (16 * n8 + r);
                        const float qk = sacc[n][r] * 0.0625f;
                        sv0[r] = (sidx <= tlv) ? qk * __expf(sA0[sl] - pt0) : 0.f; dp0 += sv0[r];
                        sv1[r] = (sidx >= tlv) ? qk * __expf(sA1[sl] - pt1) : 0.f; dp1 += sv1[r]; }
                    v2u w0; w0.x = pk2(sv0[0], sv0[1]); w0.y = pk2(sv0[2], sv0[3]); *(v2u*)(sp0 + (n8 >> 1) * 512 + (n8 & 1) * 256) = w0;
                    v2u w1; w1.x = pk2(sv1[0], sv1[1]); w1.y = pk2(sv1[2], sv1[3]); *(v2u*)(sp1 + (n8 >> 1) * 512 + (n8 & 1) * 256) = w1; }
                asm volatile("" ::: "memory");
            }
            dp0 += __shfl_xor(dp0, 16); dp0 += __shfl_xor(dp0, 32); dp1 += __shfl_xor(dp1, 16); dp1 += __shfl_xor(dp1, 32);
            if (g == 0) { DEN[(size_t)((0 * 16 + bh) * 64 + (c0 - 2)) * 128 + tl] = dp0; DEN[(size_t)((1 * 16 + bh) * 64 + (c1 - 2)) * 128 + tl] = dp1; }
        }
        __syncthreads();
    }
}

constexpr int S2V_PITCH = 160;
constexpr int S2K_PITCH = 544;
__device__ __forceinline__ int s2_sigma(int r) { return (r & ~12) | ((r & 4) << 1) | ((r & 8) >> 1); }
__device__ __forceinline__ bf16x8 tr_frag_sw(LAS unsigned char* T, int pitch, int k0, int col0, int lane) {
    const int g = lane >> 4, q = (lane & 15) >> 2, p = lane & 3;
    LAS unsigned char* p0 = T + (k0 + 16 * (g >> 1) + 4 * (g & 1) + q) * pitch + (col0 + 4 * p) * 2;
    const s16x4 lo = __builtin_amdgcn_ds_read_tr16_b64_v4i16((LAS s16x4*)p0);
    const s16x4 hi = __builtin_amdgcn_ds_read_tr16_b64_v4i16((LAS s16x4*)(p0 + 8 * pitch));
    bf16x8 r; r[0] = lo[0]; r[1] = lo[1]; r[2] = lo[2]; r[3] = lo[3]; r[4] = hi[0]; r[5] = hi[1]; r[6] = hi[2]; r[7] = hi[3];
    return r;
}
constexpr int S2K_OFF = 0, S2V_OFF = 128 * S2K_PITCH, S2S_OFF = S2V_OFF + 128 * S2V_PITCH, S2C_OFF = S2S_OFF + 128 * S2V_PITCH, S2M_OFF = S2C_OFF + 80 * SK_PITCH;
static_assert(S2M_OFF + 4 * 272 <= MISC_OFF, "scan v2 LDS map");
#define SCHED_FENCE() do { } while (0)
#define LDS_BARRIER() do { asm volatile("s_waitcnt lgkmcnt(0)" ::: "memory"); __builtin_amdgcn_s_barrier(); asm volatile("" ::: "memory"); } while (0)
__device__ __forceinline__ void scan_seq_phase(CArgs a, LAS unsigned char* lds, int tid, int lane, int wave) {
    const bf16* QK = (const bf16*)(a->ws + WS_U);
    const float* SCP = (const float*)(a->ws + WS_SCP); const float* SCG = (const float*)(a->ws + WS_SCC);
    const bf16* SPP = (const bf16*)(a->ws + WS_SPP); const float* DEN = (const float*)(a->ws + WS_DEN); const bf16* QT = (const bf16*)(a->ws + WS_QT);
    bf16* HS = (bf16*)(a->ws + WS_HS);
    LAS unsigned char* Kl = lds + S2K_OFF; LAS unsigned char* Vl = lds + S2V_OFF; LAS unsigned char* Vs = lds + S2S_OFF; LAS unsigned char* Cl = lds + S2C_OFF;
    LAS float* mp = (LAS float*)(lds + S2M_OFF); LAS float* ml = mp + 68; LAS float* pt = mp + 136; LAS float* gl = mp + 204;
    for (int unit_ = blockIdx.x; unit_ < 256 * SCAN_REP; unit_ += gridDim.x) { const int u0 = unit_ & 255, unit = ((u0 & 7) << 5) | (u0 >> 3);
        const int chain = unit >> 3, slice = unit & 7, dir = chain >> 4, b = (chain >> 3) & 1, h = chain & 7;
        int tid_u = tid; asm volatile("" : "+v"(tid_u));
        if (tid < NCH) { gl[tid] = SCG[((size_t)chain * NCH + tid) * 2]; pt[tid] = SCG[((size_t)chain * NCH + tid) * 2 + 1]; }
        for (int i = tid_u; i < 80 * SK_PITCH / 4; i += NTHREADS) ((LAS unsigned*)Cl)[i] = 0u;
        for (int i = tid_u; i < 128 * 8; i += NTHREADS) { const int r = i >> 3, w = i & 7; ((LAS unsigned*)(Vs + r * S2V_PITCH + 128))[w] = 0u; }
        __syncthreads();
        if (tid == 0) { float m = 0.f; for (int c = 0; c < NCH; ++c) { const float mx = fmaxf(m, pt[c]); mp[c] = m; ml[c] = mx; m = gl[c] + mx; } }
        __syncthreads();
        f32x4 cacc[5][2];
#pragma unroll
        for (int mt = 0; mt < 5; ++mt)
#pragma unroll
            for (int nt = 0; nt < 2; ++nt) cacc[mt][nt] = (f32x4){0.f, 0.f, 0.f, 0.f};
        v4u kreg[8], vreg[2]; float areg[2];
#define S2_LOAD(cc, T) do { const unsigned koff = (unsigned)((((T) >> 5) * QKVO + ((T) & 31) * 8) * 2), voff = (unsigned)((((T) >> 3) * QKVO + ((T) & 7) * 8) * 2); const int R1_ = chunk_row0(dir, b, (cc)); const char* kb_ = (const char*)(QK + (size_t)R1_ * QKVO + 2048 + h * DQK); const char* vb_ = (const char*)(QK + (size_t)R1_ * QKVO + 4096 + h * DV + slice * 64); \
            const float* ab_ = SCP + ((size_t)chain * NCH + (cc)) * 384; \
            _Pragma("unroll") for (int i = 0; i < 8; ++i) kreg[i] = *(const v4u*)(kb_ + (koff + (unsigned)(i * 16 * QKVO * 2))); \
            _Pragma("unroll") for (int i = 0; i < 2; ++i) { vreg[i] = *(const v4u*)(vb_ + (voff + (unsigned)(i * 64 * QKVO * 2))); areg[i] = ab_[((T) >> 3) + 64 * i]; } } while (0)
#define S2_STORE(cc, T) do { const float mlc_ = ml[(cc)]; \
            _Pragma("unroll") for (int i = 0; i < 8; ++i) { const int idx = (T) + NTHREADS * i, r = idx >> 5, ch = idx & 31; *(LAS v4u*)(Kl + s2_sigma(r) * S2K_PITCH + ch * 16) = kreg[i]; } \
            _Pragma("unroll") for (int i = 0; i < 2; ++i) { const int idx = (T) + NTHREADS * i, r = idx >> 3, ch = idx & 7; const float ws_ = __expf(areg[i] - mlc_) * 0.0625f;     \
                *(LAS v4u*)(Vl + s2_sigma(r) * S2V_PITCH + ch * 16) = vreg[i]; \
                v4u sc_; sc_.x = pk2(bflo(vreg[i].x) * ws_, bfhi(vreg[i].x) * ws_); sc_.y = pk2(bflo(vreg[i].y) * ws_, bfhi(vreg[i].y) * ws_); sc_.z = pk2(bflo(vreg[i].z) * ws_, bfhi(vreg[i].z) * ws_); sc_.w = pk2(bflo(vreg[i].w) * ws_, bfhi(vreg[i].w) * ws_); \
                *(LAS v4u*)(Vs + s2_sigma(r) * S2V_PITCH + ch * 16) = sc_; \
                if (ch == 0) *(LAS unsigned*)(Vs + s2_sigma(r) * S2V_PITCH + 128) = f2bf(ws_); } } while (0)
        S2_LOAD(0, tid_u); S2_STORE(0, tid_u);
        __syncthreads();
#define S2_OUTP false
        for (int c = 0; c < 2; ++c) {
            const int R0 = chunk_row0(dir, b, c);
            const float m_prev = mp[c], m_last = ml[c], ptot = pt[c];
            constexpr bool outp = S2_OUTP; const bool more = (c + 1 < NCH);
            int tid_o = tid; asm volatile("" : "+v"(tid_o));
            const int lane_o = tid_o & 63, g = lane_o >> 4, l15 = lane_o & 15, tl = 16 * wave + l15;
            bf16x8 qf[8], sf[4]; float pv = 0.f, bv = 0.f, dn = 0.f;
            v2u hw[4] = {{0u, 0u}, {0u, 0u}, {0u, 0u}, {0u, 0u}}; v4u hv[2] = {{0u, 0u, 0u, 0u}, {0u, 0u, 0u, 0u}};
            if (outp) {
                const char* qb = (const char*)(QT + ((size_t)((R0 >> 4) + wave) * 64 + 8 * h) * 512); const unsigned qoff = (unsigned)(lane_o * 16);
#pragma unroll
                for (int kk = 0; kk < 8; ++kk) qf[kk] = *(const bf16x8*)(qb + (qoff + (unsigned)(kk * 1024)));
                const float* scp = SCP + ((size_t)chain * NCH + c) * 384;
                pv = scp[128 + tl]; bv = scp[256 + tl]; dn = DEN[(size_t)(chain * 64 + (c - 2)) * 128 + tl];
            }
            SCHED_FENCE();
            const float w_old = __expf(m_prev - m_last);
#pragma unroll
            for (int mt = 0; mt < 5; ++mt)
#pragma unroll
                for (int nt = 0; nt < 2; ++nt) cacc[mt][nt] = cacc[mt][nt] * w_old;
#pragma unroll
            for (int kk = 0; kk < 4; ++kk) {
                bf16x8 yf[2], xf[5];
#pragma unroll
                for (int nt = 0; nt < 2; ++nt) yf[nt] = tr_frag_sw(Kl, S2K_PITCH, 32 * kk, 32 * wave + 16 * nt, lane_o);
#pragma unroll
                for (int mt = 0; mt < 5; ++mt) xf[mt] = tr_frag_sw(Vs, S2V_PITCH, 32 * kk, 16 * mt, lane_o);
                SCHED_FENCE();
#pragma unroll
                for (int mt = 0; mt < 5; ++mt)
#pragma unroll
                    for (int nt = 0; nt < 2; ++nt) cacc[mt][nt] = MFMA16(yf[nt], xf[mt], cacc[mt][nt]);
                SCHED_FENCE();
            }
            if (outp) { const char* sb = (const char*)(SPP + (size_t)(chain * 64 + (c - 2)) * 16384 + (size_t)wave * 2048); const unsigned soff = (unsigned)(lane_o * 16);
#pragma unroll
                for (int kk = 0; kk < 4; ++kk) sf[kk] = *(const bf16x8*)(sb + (soff + (unsigned)(kk * 1024))); }
            if (more) S2_LOAD(c + 1, tid_o);
            SCHED_FENCE();
            if (outp) {
                f32x4 qacc[5];
#pragma unroll
                for (int n = 0; n < 5; ++n) qacc[n] = (f32x4){0.f, 0.f, 0.f, 0.f};
#pragma unroll
                for (int kk = 0; kk < 8; ++kk) {
                    bf16x8 cf[5];
#pragma unroll
                    for (int n = 0; n < 5; ++n) cf[n] = *(const LAS bf16x8*)(Cl + (16 * n + l15) * SK_PITCH + (32 * kk + 8 * g) * 2);
                    SCHED_FENCE();
#pragma unroll
                    for (int n = 0; n < 5; ++n) qacc[n] = MFMA16(cf[n], qf[kk], qacc[n]);
                    SCHED_FENCE();
                }
                f32x4 nacc[4];
#pragma unroll
                for (int n = 0; n < 4; ++n) nacc[n] = (f32x4){0.f, 0.f, 0.f, 0.f};
#pragma unroll
                for (int k2 = 0; k2 < 4; k2 += 2) {
                    bf16x8 vf[2][4];
#pragma unroll
                    for (int u = 0; u < 2; ++u)
#pragma unroll
                        for (int n = 0; n < 4; ++n) vf[u][n] = tr_frag_sw(Vl, S2V_PITCH, 32 * (k2 + u), 16 * n, lane_o);
                    SCHED_FENCE();
#pragma unroll
                    for (int u = 0; u < 2; ++u)
#pragma unroll
                        for (int n = 0; n < 4; ++n) nacc[n] = MFMA16(vf[u][n], sf[k2 + u], nacc[n]);
                    SCHED_FENCE();
                }
                const float mxt = fmaxf(m_prev, pv), rowfac = __expf(ptot - mxt), winter = __expf(m_prev - mxt);
                const float nq = __shfl(qacc[4][0], l15);
                const float den = rowfac * dn + winter * nq;
                const float inv = 1.0f / fmaxf(fabsf(den), __expf(-bv - mxt));
#pragma unroll
                for (int n = 0; n < 4; ++n) { const f32x4 o = (nacc[n] * rowfac + qacc[n] * winter) * inv; hw[n].x = pk2(o.x, o.y); hw[n].y = pk2(o.z, o.w); }
                bf16* hp = HS + ((size_t)dir * ML + R0 + tl) * D + h * DV + slice * 64 + 8 * g;
                const int src0 = l15 + 16 * (2 * (g & 1)), src1 = src0 + 16; const bool hi_n = (g >> 1) != 0;
#pragma unroll
                for (int k = 0; k < 2; ++k) {
                    const unsigned a0x = __shfl(hw[2 * k].x, src0), a0y = __shfl(hw[2 * k].y, src0), a1x = __shfl(hw[2 * k].x, src1), a1y = __shfl(hw[2 * k].y, src1);
                    const unsigned b0x = __shfl(hw[2 * k + 1].x, src0), b0y = __shfl(hw[2 * k + 1].y, src0), b1x = __shfl(hw[2 * k + 1].x, src1), b1y = __shfl(hw[2 * k + 1].y, src1);
                    hv[k].x = hi_n ? b0x : a0x; hv[k].y = hi_n ? b0y : a0y; hv[k].z = hi_n ? b1x : a1x; hv[k].w = hi_n ? b1y : a1y;
                    *(v4u*)(hp + 32 * k) = hv[k]; }
            }
            LDS_BARRIER();
#pragma unroll
            for (int mt = 0; mt < 5; ++mt)
#pragma unroll
                for (int nt = 0; nt < 2; ++nt) { v2u w; w.x = pk2(cacc[mt][nt][0], cacc[mt][nt][1]); w.y = pk2(cacc[mt][nt][2], cacc[mt][nt][3]);
                    *(LAS v2u*)(Cl + (16 * mt + l15) * SK_PITCH + (32 * wave + 16 * nt + 4 * g) * 2) = w; }
            if (more) S2_STORE(c + 1, tid_o);
            asm volatile("" :: "v"(hv[0]), "v"(hv[1]));
            LDS_BARRIER();
                }
#undef S2_OUTP
#define S2_OUTP true
        for (int c = 2; c < NCH; ++c) {
            const int R0 = chunk_row0(dir, b, c);
            const float m_prev = mp[c], m_last = ml[c], ptot = pt[c];
            constexpr bool outp = S2_OUTP; const bool more = (c + 1 < NCH);
            int tid_o = tid; asm volatile("" : "+v"(tid_o));
            const int lane_o = tid_o & 63, g = lane_o >> 4, l15 = lane_o & 15, tl = 16 * wave + l15;
            bf16x8 qf[8], sf[4]; float pv = 0.f, bv = 0.f, dn = 0.f;
            v2u hw[4] = {{0u, 0u}, {0u, 0u}, {0u, 0u}, {0u, 0u}}; v4u hv[2] = {{0u, 0u, 0u, 0u}, {0u, 0u, 0u, 0u}};
            if (outp) {
                const char* qb = (const char*)(QT + ((size_t)((R0 >> 4) + wave) * 64 + 8 * h) * 512); const unsigned qoff = (unsigned)(lane_o * 16);
#pragma unroll
                for (int kk = 0; kk < 8; ++kk) qf[kk] = *(const bf16x8*)(qb + (qoff + (unsigned)(kk * 1024)));
                const float* scp = SCP + ((size_t)chain * NCH + c) * 384;
                pv = scp[128 + tl]; bv = scp[256 + tl]; dn = DEN[(size_t)(chain * 64 + (c - 2)) * 128 + tl];
            }
            SCHED_FENCE();
            const float w_old = __expf(m_prev - m_last);
#pragma unroll
            for (int mt = 0; mt < 5; ++mt)
#pragma unroll
                for (int nt = 0; nt < 2; ++nt) cacc[mt][nt] = cacc[mt][nt] * w_old;
#pragma unroll
            for (int kk = 0; kk < 4; ++kk) {
                bf16x8 yf[2], xf[5];
#pragma unroll
                for (int nt = 0; nt < 2; ++nt) yf[nt] = tr_frag_sw(Kl, S2K_PITCH, 32 * kk, 32 * wave + 16 * nt, lane_o);
#pragma unroll
                for (int mt = 0; mt < 5; ++mt) xf[mt] = tr_frag_sw(Vs, S2V_PITCH, 32 * kk, 16 * mt, lane_o);
                SCHED_FENCE();
#pragma unroll
                for (int mt = 0; mt < 5; ++mt)
#pragma unroll
                    for (int nt = 0; nt < 2; ++nt) cacc[mt][nt] = MFMA16(yf[nt], xf[mt], cacc[mt][nt]);
                SCHED_FENCE();
            }
            if (outp) { const char* sb = (const char*)(SPP + (size_t)(chain * 64 + (c - 2)) * 16384 + (size_t)wave * 2048); const unsigned soff = (unsigned)(lane_o * 16);
#pragma unroll
                for (int kk = 0; kk < 4; ++kk) sf[kk] = *(const bf16x8*)(sb + (soff + (unsigned)(kk * 1024))); }
            if (more) S2_LOAD(c + 1, tid_o);
            SCHED_FENCE();
            if (outp) {
                f32x4 qacc[5];
#pragma unroll
                for (int n = 0; n < 5; ++n) qacc[n] = (f32x4){0.f, 0.f, 0.f, 0.f};
#pragma unroll
                for (int kk = 0; kk < 8; ++kk) {
                    bf16x8 cf[5];
#pragma unroll
                    for (int n = 0; n < 5; ++n) cf[n] = *(const LAS bf16x8*)(Cl + (16 * n + l15) * SK_PITCH + (32 * kk + 8 * g) * 2);
                    SCHED_FENCE();
#pragma unroll
                    for (int n = 0; n < 5; ++n) qacc[n] = MFMA16(cf[n], qf[kk], qacc[n]);
                    SCHED_FENCE();
                }
                f32x4 nacc[4];
#pragma unroll
                for (int n = 0; n < 4; ++n) nacc[n] = (f32x4){0.f, 0.f, 0.f, 0.f};
#pragma unroll
                for (int k2 = 0; k2 < 4; k2 += 2) {
                    bf16x8 vf[2][4];
#pragma unroll
                    for (int u = 0; u < 2; ++u)
#pragma unroll
                        for (int n = 0; n < 4; ++n) vf[u][n] = tr_frag_sw(Vl, S2V_PITCH, 32 * (k2 + u), 16 * n, lane_o);
                    SCHED_FENCE();
#pragma unroll
                    for (int u = 0; u < 2; ++u)
#pragma unroll
                        for (int n = 0; n < 4; ++n) nacc[n] = MFMA16(vf[u][n], sf[k2 + u], nacc[n]);
                    SCHED_FENCE();
                }
                const float mxt = fmaxf(m_prev, pv), rowfac = __expf(ptot - mxt), winter = __expf(m_prev - mxt);
                const float nq = __shfl(qacc[4][0], l15);
                const float den = rowfac * dn + winter * nq;
                const float inv = 1.0f / fmaxf(fabsf(den), __expf(-bv - mxt));
#pragma unroll
                for (int n = 0; n < 4; ++n) { const f32x4 o = (nacc[n] * rowfac + qacc[n] * winter) * inv; hw[n].x = pk2(o.x, o.y); hw[n].y = pk2(o.z, o.w); }
                bf16* hp = HS + ((size_t)dir * ML + R0 + tl) * D + h * DV + slice * 64 + 8 * g;
                const int src0 = l15 + 16 * (2 * (g & 1)), src1 = src0 + 16; const bool hi_n = (g >> 1) != 0;
#pragma unroll
                for (int k = 0; k < 2; ++k) {
                    const unsigned a0x = __shfl(hw[2 * k].x, src0), a0y = __shfl(hw[2 * k].y, src0), a1x = __shfl(hw[2 * k].x, src1), a1y = __shfl(hw[2 * k].y, src1);
                    const unsigned b0x = __shfl(hw[2 * k + 1].x, src0), b0y = __shfl(hw[2 * k + 1].y, src0), b1x = __shfl(hw[2 * k + 1].x, src1), b1y = __shfl(hw[2 * k + 1].y, src1);
                    hv[k].x = hi_n ? b0x : a0x; hv[k].y = hi_n ? b0y : a0y; hv[k].z = hi_n ? b1x : a1x; hv[k].w = hi_n ? b1y : a1y;
                    *(v4u*)(hp + 32 * k) = hv[k]; }
            }
            LDS_BARRIER();
#pragma unroll
            for (int mt = 0; mt < 5; ++mt)
#pragma unroll
                for (int nt = 0; nt < 2; ++nt) { v2u w; w.x = pk2(cacc[mt][nt][0], cacc[mt][nt][1]); w.y = pk2(cacc[mt][nt][2], cacc[mt][nt][3]);
                    *(LAS v2u*)(Cl + (16 * mt + l15) * SK_PITCH + (32 * wave + 16 * nt + 4 * g) * 2) = w; }
            if (more) S2_STORE(c + 1, tid_o);
            asm volatile("" :: "v"(hv[0]), "v"(hv[1]));
            LDS_BARRIER();
                }
#undef S2_OUTP
#undef S2_LOAD
#undef S2_STORE
    }
}

__device__ __forceinline__ void scan_out_phase(CArgs a, LAS unsigned char* lds, int tid, int lane, int wave) {
    const bf16* HS = (const bf16*)(a->ws + WS_HS);
    const bf16* QK = (const bf16*)(a->ws + WS_U);
    bf16* A2 = (bf16*)(a->ws + WS_G);
    LAS f32x4* pg = (LAS f32x4*)lds;
    for (int i = tid; i < 1024; i += NTHREADS) pg[i] = ((const f32x4*)a->in[I_MHNG])[i];
    __syncthreads();
    const int G = gridDim.x, rpw = (ML + G - 1) / G, r0 = (int)blockIdx.x * rpw, r1 = (r0 + rpw < ML) ? r0 + rpw : ML;
    for (int row = r0 + wave; row < r1; row += NWAVES) {
#pragma unroll 2
        for (int h = 0; h < HEADS; ++h) {
            f32x4 v[2]; float s = 0.f;
#pragma unroll
            for (int j = 0; j < 2; ++j) { const int o = h * DV + j * 256 + lane * 4;
                const v2u hf = *(const v2u*)(HS + (size_t)row * D + o), hb = *(const v2u*)(HS + ((size_t)ML + row) * D + o);
                v[j] = (f32x4){bflo(hf.x) + bflo(hb.x), bfhi(hf.x) + bfhi(hb.x), bflo(hf.y) + bflo(hb.y), bfhi(hf.y) + bfhi(hb.y)};
                s += (v[j].x * v[j].x + v[j].y * v[j].y) + (v[j].z * v[j].z + v[j].w * v[j].w); }
            const float rstd = 1.0f / sqrtf(wave_sum(s) * (1.0f / DV) + EPS);
#pragma unroll
            for (int j = 0; j < 2; ++j) { const int o = h * DV + j * 256 + lane * 4;
                const f32x4 gg = pg[(h * DV + j * 256) / 4 + lane];
                const v2u ov = *(const v2u*)(QK + (size_t)row * QKVO + 8192 + o);
                const f32x4 y = (v[j] * rstd) * gg;
                v2u w; w.x = pk2(y.x * sigmoidf_(bflo(ov.x)), y.y * sigmoidf_(bfhi(ov.x))); w.y = pk2(y.z * sigmoidf_(bflo(ov.y)), y.w * sigmoidf_(bfhi(ov.y)));
                *(v2u*)(A2 + (size_t)row * D + o) = w; }
        }
    }
}

constexpr int NPHASES = 21;
__global__ void __launch_bounds__(NTHREADS, 2) fwd_kernel(Args args_unused) {
    extern __shared__ __attribute__((aligned(16))) unsigned char lds_raw[];
    LAS unsigned char* lds = (LAS unsigned char*)lds_raw;
    const int wave_s = __builtin_amdgcn_readfirstlane((int)threadIdx.x >> 6);
    { const int tid = threadIdx.x; volatile LAS unsigned* MISC = (volatile LAS unsigned*)(lds + MISC_OFF);
      if (tid < 16) MISC[tid] = 0u;
      __syncthreads();
      if (!MK_PER_PHASE) (void)xcd_barrier_post((unsigned*)(get_args()->ws + WS_CTL) + CW_BAR, MISC); }
#define PH_IDS for (int tid = opaque_tid(wave_s), lane = tid & 63, wave = __builtin_amdgcn_readfirstlane(tid >> 6), once_ = 1; once_; once_ = 0)
#if MK_PER_PHASE
#define IN(k) (get_args()->ph_lo == (k)) PH_IDS if (true
#define SEAM(k) do { } while (0)
#else
#ifndef PROBE_PHASE
#define PROBE_PHASE -1
#endif
#define IN(k) true) for (int rep_ = 0; rep_ < ((k) == PROBE_PHASE ? 2 : 1); ++rep_) PH_IDS if (true
#define SEAM(k) do { XcdBarrier b_; b_.bar = (unsigned*)(get_args()->ws + WS_CTL) + CW_BAR; b_.x = xb_xcc_id(); b_.st = (volatile LAS unsigned*)(lds + MISC_OFF); xcd_barrier(b_); } while (0)
#endif
#define WSP(off) (get_args()->ws + (off))
#define MODP(layer) ((const float*)WSP(WS_MOD) + (layer) * 3 * NMODC)
#define NGP(i) (get_args()->in[I_NORMG] + (i) * D)

#define GEMM_PHASE(EPI, A_, B_, M_, N_, K_, EINIT, HAS_SIDE, SIDE) { const int nwg_ = ((M_) / 256) * ((N_) / 256), gg_ = (HAS_SIDE) ? gemm_wgs(nwg_) : (int)gridDim.x; \
        if ((int)blockIdx.x < gg_) { pg8::Gemm g{A_, B_, M_, N_, K_}; pg8::StaticOrder S; S.init(M_, N_, gg_, blockIdx.x); EPI E EINIT; pg8::gemm_phase<EPI, pg8::StaticOrder, true, true>(lds, g, S, E, tid); } \
          \
        const int t0_ = (HAS_SIDE) ? gg_ : ((nwg_ % (int)gridDim.x) ? nwg_ % (int)gridDim.x : (int)gridDim.x); \
        if (!PROBE_E1 && (int)blockIdx.x >= t0_) { const int si_ = (int)blockIdx.x - t0_, ns_ = (int)gridDim.x - t0_, sf_ = si_ * NWAVES + wave, sn_ = ns_ * NWAVES; (void)si_; (void)ns_; (void)sf_; (void)sn_; SIDE } }

    if (IN(0)) { p0_prologue(get_args(), lds, tid, lane, wave); __syncthreads(); } SEAM(0);
    if (IN(1)) { CArgs a = get_args(); row_phase<false, true>(lds, MT, a->in[I_X], a->in[I_CTX], nullptr, nullptr, nullptr, nullptr, nullptr, 0, NGP(0), MODP(0), 0, 1, (bf16*)WSP(WS_H), tid, lane, wave); }
    SEAM(1);
    if (IN(2)) GEMM_PHASE(pg8::EpiAB, (const bf16*)WSP(WS_H), (const bf16*)WSP(WS_WABIN), MT, ABIN, D, ({(bf16*)WSP(WS_U)}), false,
                          conv_matrix<CV_ABOUT>(get_args(), lds, sf_, sn_, lane, wave);)
    SEAM(2);
    if (IN(3)) mixer_conv_phase(get_args(), lds, tid, lane);
    SEAM(3);
    if (IN(4)) mixer_ln_phase(get_args(), lds, tid, lane, wave);
    SEAM(4);
    if (IN(5)) GEMM_PHASE(pg8::EpiBf16, (const bf16*)WSP(WS_G), (const bf16*)WSP(WS_WABOUT), MT, D, D, ({(bf16*)WSP(WS_Y), D}), true,
                          conv_matrix<CV_UP0>(get_args(), lds, sf_, sn_, lane, wave);)
    SEAM(5);
    if (IN(6)) { CArgs a = get_args(); row_phase<true, true>(lds, MT, a->in[I_X], a->in[I_CTX], a->out, (float*)WSP(WS_CTXS), (const bf16*)WSP(WS_Y), NGP(1), MODP(0), 2, NGP(2), MODP(0), 3, 4, (bf16*)WSP(WS_H), tid, lane, wave); }
    SEAM(6);
    if (IN(7)) GEMM_PHASE(pg8::EpiGate, (const bf16*)WSP(WS_H), (const bf16*)WSP(WS_WUP0), MT, DFF2, D, ({(bf16*)WSP(WS_G), (bf16*)WSP(WS_UC), get_args()->in[I_FCONV]}), false,
                          conv_matrix<CV_DN0>(get_args(), lds, sf_, sn_, lane, wave);)
    SEAM(7);
    if (IN(8)) ffn_gate_ctx_phase(get_args(), tid);
    SEAM(8);
    if (IN(9)) GEMM_PHASE(pg8::EpiBf16, (const bf16*)WSP(WS_G), (const bf16*)WSP(WS_WDN0), MT, D, DFF, ({(bf16*)WSP(WS_Y), D}), true,
                          gemv_units(get_args(), lds, 1, si_, ns_, tid, lane, wave);
                          conv_matrix<CV_MIN>(get_args(), lds, sf_, sn_, lane, wave); conv_matrix<CV_MOUT>(get_args(), lds, sf_, sn_, lane, wave);
                          conv_matrix<CV_UP1>(get_args(), lds, sf_, sn_, lane, wave);)
    SEAM(9);
    if (IN(10)) { CArgs a = get_args(); float* ct = (float*)WSP(WS_CTXS); row_phase<true, true>(lds, MT, a->out, ct, a->out, ct, (const bf16*)WSP(WS_Y), NGP(3), MODP(0), 5, NGP(4), MODP(1), 0, 1, (bf16*)WSP(WS_H), tid, lane, wave); }
    SEAM(10);
    if (IN(11)) GEMM_PHASE(pg8::EpiMIn, (const bf16*)WSP(WS_H), (const bf16*)WSP(WS_WMIN), MT, CINP, D, ({(bf16*)WSP(WS_U), QKVO, (float*)WSP(WS_GATES), (bf16*)WSP(WS_QT)}), false,
                           conv_matrix<CV_DN1>(get_args(), lds, sf_, sn_, lane, wave);)
    SEAM(11);
    if (IN(12)) scan_pre_phase(get_args(), lds, tid, lane, wave);
    SEAM(12);
    if (IN(13)) scan_seq_phase(get_args(), lds, tid, lane, wave);
    SEAM(13);
    if (IN(14)) scan_out_phase(get_args(), lds, tid, lane, wave);
    SEAM(14);
    if (IN(15)) GEMM_PHASE(pg8::EpiBf16, (const bf16*)WSP(WS_G), (const bf16*)WSP(WS_WMOUT), ML, D, D, ({(bf16*)WSP(WS_Y), D}), false, ;)
    SEAM(15);
    if (IN(16)) { CArgs a = get_args(); float* ct = (float*)WSP(WS_CTXS); row_phase<true, true>(lds, ML, a->out, ct, a->out, ct, (const bf16*)WSP(WS_Y), NGP(5), MODP(1), 2, NGP(6), MODP(1), 3, 4, (bf16*)WSP(WS_H), tid, lane, wave); }
    SEAM(16);
    if (IN(17)) GEMM_PHASE(pg8::EpiGate, (const bf16*)WSP(WS_H), (const bf16*)WSP(WS_WUP0 + 172 * MiB), ML, DFF2, D, ({(bf16*)WSP(WS_G), (bf16*)WSP(WS_UC), get_args()->in[I_FCONV] + 3 * DFF2}), false, ;)
    SEAM(17);
    if (IN(19)) GEMM_PHASE(pg8::EpiBf16, (const bf16*)WSP(WS_G), (const bf16*)WSP(WS_WDN0 + 86 * MiB), ML, D, DFF, ({(bf16*)WSP(WS_Y), D}), false, ;)
    SEAM(19);
    if (IN(20)) { CArgs a = get_args(); float* ct = (float*)WSP(WS_CTXS); row_phase<true, false>(lds, ML, a->out, ct, a->out, ct, (const bf16*)WSP(WS_Y), NGP(7), MODP(1), 5, nullptr, nullptr, 0, 0, nullptr, tid, lane, wave); }
#undef IN
#undef SEAM
}

extern "C" void kernel_launch(void* const* d_in, const int* in_sizes, int n_in, void* d_out, int out_size, void* d_ws, size_t ws_size, hipStream_t stream) {
    static int grid = 0;
    if (grid == 0) {
        if (n_in != 21 || out_size != ML * D || ws_size < WS_END) { fprintf(stderr, "kernel_launch: unexpected problem (n_in %d, out %d, ws %zu < %zu); nothing launched\n", n_in, out_size, ws_size, (size_t)WS_END); grid = -1; return; }
        int dev = 0, cus = 0, per_cu = 0;
        if (hipGetDevice(&dev) != hipSuccess || hipDeviceGetAttribute(&cus, hipDeviceAttributeMultiprocessorCount, dev) != hipSuccess) { grid = -1; return; }
        if (hipFuncSetAttribute((const void*)fwd_kernel, hipFuncAttributeMaxDynamicSharedMemorySize, LDS_BYTES) != hipSuccess) { fprintf(stderr, "kernel_launch: hipFuncSetAttribute failed\n"); grid = -1; return; }
        if (hipOccupancyMaxActiveBlocksPerMultiprocessor(&per_cu, (const void*)fwd_kernel, NTHREADS, LDS_BYTES) != hipSuccess || per_cu < 1)
            fprintf(stderr, "kernel_launch: occupancy query reports %d workgroups per CU\n", per_cu);
        (void)hipGetLastError();
        grid = cus;
    }
    if (grid < 0) return;
    if (hipMemsetAsync((char*)d_ws + WS_CTL, 0, CTL_ZERO_BYTES, stream) != hipSuccess) return;
    Args a{};
    for (int i = 0; i < 21; ++i) a.in[i] = (const float*)d_in[i];
    a.out = (float*)d_out; a.ws = (unsigned char*)d_ws;
#if MK_PER_PHASE
    for (int p = 0; p < NPHASES; ++p) { a.ph_lo = p; a.ph_hi = p + 1; hipLaunchKernelGGL(fwd_kernel, dim3(grid), dim3(NTHREADS), LDS_BYTES, stream, a); }
#else
    a.ph_lo = 0; a.ph_hi = NPHASES;
    hipLaunchKernelGGL(fwd_kernel, dim3(grid), dim3(NTHREADS), LDS_BYTES, stream, a);
#endif
}
```

```cpp
#include <hip/hip_runtime.h>
#include <cstdio>
#include <cstdint>

#ifndef PROBE_E1
#define PROBE_E1 0
#endif
#ifndef MK_PER_PHASE
#define MK_PER_PHASE 0
#endif

namespace pg8 {
#define PG8_LAS __attribute__((address_space(3)))
typedef unsigned short bf16_t;
typedef short bf16x8 __attribute__((ext_vector_type(8)));
typedef float f32x4 __attribute__((ext_vector_type(4)));
typedef unsigned u32x4 __attribute__((ext_vector_type(4)));
constexpr int BM = 256, BK = 64, HALF = 128, HTB = HALF * BK * 2, STAGE_BYTES = 8 * HTB, NXCD = 8, WGM = 4;

__host__ __device__ __forceinline__ int lds_byte(int r, int c) { const int st = (r >> 4) * 2 + (c >> 5), rr = r & 15, cc = c & 31, ob = rr * 64 + cc * 2; return st * 1024 + (ob ^ (((ob >> 9) & 1) << 5)); }
__host__ __device__ __forceinline__ void stage_rc(int b, int& R, int& C) { const int st = b / 1024, sb = b % 1024, swz = sb ^ (((sb >> 9) & 1) << 5); R = (st >> 1) * 16 + swz / 64; C = (st & 1) * 32 + (swz % 64) / 2; }
__host__ __device__ __forceinline__ int perm32(int rho) { const int n = rho >> 4, i = rho & 15; return 8 * (i >> 2) + 4 * n + (i & 3); }

struct Unit { int pm, pn; };
struct Gemm { const bf16_t* A; const bf16_t* Bt; int M, N, K; };

struct StaticOrder {
    int nM, nN, nwg, G, c;
    __host__ __device__ void init(int M, int N, int G_, int c_) { nM = M / BM; nN = N / BM; nwg = nM * nN; G = G_; c = c_; }
    __host__ __device__ bool next(int i, Unit& u) const {
        const long L = (long)i * G + c; if (L >= nwg) return false;
        int wgid = (int)L; { const int q = nwg / NXCD, r = nwg % NXCD, xcd = wgid % NXCD, off = wgid / NXCD; wgid = (xcd < r ? xcd * (q + 1) : r * (q + 1) + (xcd - r) * q) + off; }
        const int nig = WGM * nN, gid = wgid / nig, fm = gid * WGM, gsz = (nM - fm) < WGM ? (nM - fm) : WGM;
        u.pm = fm + ((wgid % nig) % gsz); u.pn = (wgid % nig) / gsz; return true;
    }
    __device__ __forceinline__ void a_ready(const Unit&) const {}
    __device__ __forceinline__ void done(const Unit&) const {}
};

__device__ __forceinline__ unsigned cvt_pk_bf16(float lo, float hi) { unsigned r; asm volatile("v_cvt_pk_bf16_f32 %0, %1, %2" : "=v"(r) : "v"(lo), "v"(hi)); return r; }

struct EpiBf16 {
    static constexpr bool PERM = true, AFTER_DRAIN = false, PERM_A = false;
    bf16_t* O; int ldc;
    __device__ __forceinline__ void operator()(const f32x4 (&acc)[2][2][4][2], const Unit& u, int wr, int wc, int fr, int fq) const {
        const int row0 = u.pm * BM + wr * 64 + fr, col0 = u.pn * BM + wc * 32 + 8 * fq;
#pragma unroll
        for (int ai = 0; ai < 2; ++ai)
#pragma unroll
            for (int m = 0; m < 4; ++m) { bf16_t* rowp = O + (size_t)(row0 + ai * HALF + m * 16) * ldc + col0;
#pragma unroll
                for (int bj = 0; bj < 2; ++bj) { const f32x4 v0 = acc[ai][bj][m][0], v1 = acc[ai][bj][m][1];
                    u32x4 w; w.x = cvt_pk_bf16(v0[0], v0[1]); w.y = cvt_pk_bf16(v0[2], v0[3]); w.z = cvt_pk_bf16(v1[0], v1[1]); w.w = cvt_pk_bf16(v1[2], v1[3]);
                    *(u32x4*)(rowp + bj * HALF) = w; } }
    }
};
struct EpiAB {
    static constexpr bool PERM = true, AFTER_DRAIN = false, PERM_A = false;
    bf16_t* O;
    __device__ __forceinline__ void operator()(const f32x4 (&acc)[2][2][4][2], const Unit& u, int wr, int wc, int fr, int fq) const {
        const int row0 = u.pm * BM + wr * 64 + fr;
        if (u.pn >= 16 && u.pn < 24) {
            const int col0 = 2048 + (u.pn - 16) * BM + wc * 32 + 8 * fq;
#pragma unroll
            for (int ai = 0; ai < 2; ++ai)
#pragma unroll
                for (int m = 0; m < 4; ++m) { bf16_t* rowp = O + (size_t)(row0 + ai * HALF + m * 16) * 6144 + col0;
#pragma unroll
                    for (int bj = 0; bj < 2; ++bj) { const f32x4 v0 = acc[ai][bj][m][0], v1 = acc[ai][bj][m][1];
                        u32x4 w; w.x = cvt_pk_bf16(v0[0], v0[1]); w.y = cvt_pk_bf16(v0[2], v0[3]); w.z = cvt_pk_bf16(v1[0], v1[1]); w.w = cvt_pk_bf16(v1[2], v1[3]);
                        *(u32x4*)(rowp + bj * HALF) = w; } }
            return;
        }
        const bool glu = u.pn < 16;
        const int col0 = (glu ? u.pn * 128 : 4096 + (u.pn - 24) * 128) + wc * 32 + 8 * fq;
#pragma unroll
        for (int ai = 0; ai < 2; ++ai)
#pragma unroll
            for (int m = 0; m < 4; ++m) { float o[8];
#pragma unroll
                for (int n = 0; n < 2; ++n)
#pragma unroll
                    for (int j = 0; j < 4; ++j) { const float x = acc[ai][0][m][n][j], y = acc[ai][1][m][n][j];
                        o[4 * n + j] = glu ? x * __builtin_amdgcn_rcpf(1.0f + __expf(-y)) : x * y; }
                u32x4 w; w.x = cvt_pk_bf16(o[0], o[1]); w.y = cvt_pk_bf16(o[2], o[3]); w.z = cvt_pk_bf16(o[4], o[5]); w.w = cvt_pk_bf16(o[6], o[7]);
                *(u32x4*)(O + (size_t)(row0 + ai * HALF + m * 16) * 6144 + col0) = w; }
    }
};
struct EpiMIn {
    static constexpr bool PERM = true, AFTER_DRAIN = false, PERM_A = false;
    bf16_t* O; int ldc; float* gates; bf16_t* QT;
    __device__ __forceinline__ void operator()(const f32x4 (&acc)[2][2][4][2], const Unit& u, int wr, int wc, int fr, int fq) const {
        const int row0 = u.pm * BM + wr * 64 + fr;
        if (u.pn < 8) {
#pragma unroll
            for (int ai = 0; ai < 2; ++ai)
#pragma unroll
                for (int m = 0; m < 4; ++m) { const int rb = (u.pm * BM + wr * 64 + ai * HALF + m * 16) >> 4;
#pragma unroll
                    for (int bj = 0; bj < 2; ++bj) { const f32x4 v0 = acc[ai][bj][m][0], v1 = acc[ai][bj][m][1];
                        u32x4 w; w.x = cvt_pk_bf16(v0[0], v0[1]); w.y = cvt_pk_bf16(v0[2], v0[3]); w.z = cvt_pk_bf16(v1[0], v1[1]); w.w = cvt_pk_bf16(v1[2], v1[3]);
                        *(u32x4*)(QT + ((size_t)rb * 64 + (u.pn * 8 + bj * 4 + wc)) * 512 + (fr + 16 * fq) * 8) = w; } }
        } else if (u.pn < 48) {
            const int col0 = u.pn * BM + wc * 32 + 8 * fq;
#pragma unroll
            for (int ai = 0; ai < 2; ++ai)
#pragma unroll
                for (int m = 0; m < 4; ++m) { bf16_t* rowp = O + (size_t)(row0 + ai * HALF + m * 16) * ldc + col0;
#pragma unroll
                    for (int bj = 0; bj < 2; ++bj) { const f32x4 v0 = acc[ai][bj][m][0], v1 = acc[ai][bj][m][1];
                        u32x4 w; w.x = cvt_pk_bf16(v0[0], v0[1]); w.y = cvt_pk_bf16(v0[2], v0[3]); w.z = cvt_pk_bf16(v1[0], v1[1]); w.w = cvt_pk_bf16(v1[2], v1[3]);
                        *(u32x4*)(rowp + bj * HALF) = w; } }
        } else if (wc == 0) {
#pragma unroll
            for (int ai = 0; ai < 2; ++ai)
#pragma unroll
                for (int m = 0; m < 4; ++m) { float* rowp = gates + (size_t)(row0 + ai * HALF + m * 16) * 32 + 8 * fq;
#pragma unroll
                    for (int n = 0; n < 2; ++n) *(f32x4*)(rowp + 4 * n) = acc[ai][0][m][n]; }
        }
    }
};

__device__ __forceinline__ float dpp_ror1(float v) { return __builtin_bit_cast(float, __builtin_amdgcn_update_dpp(0, __builtin_bit_cast(int, v), 0x121, 0xf, 0xf, false)); }
__device__ __forceinline__ float dpp_rol1(float v) { return __builtin_bit_cast(float, __builtin_amdgcn_update_dpp(0, __builtin_bit_cast(int, v), 0x12F, 0xf, 0xf, false)); }
template <bool NOLOAD = false, bool NOSTORE = false> struct EpiGateT {
    static constexpr bool PERM = true, AFTER_DRAIN = false, PERM_A = true;
    bf16_t* G; bf16_t* UC; const float* cw;
    __device__ __forceinline__ static float shr1(float v) { return __builtin_bit_cast(float, __builtin_amdgcn_update_dpp(0, __builtin_bit_cast(int, v), 0x111, 0xf, 0xf, true)); }
    __device__ __forceinline__ static float shl1(float v) { return __builtin_bit_cast(float, __builtin_amdgcn_update_dpp(0, __builtin_bit_cast(int, v), 0x101, 0xf, 0xf, true)); }
    __device__ __forceinline__ void operator()(const f32x4 (&acc)[2][2][4][2], const Unit& u, int wr, int wc, int fr, int fq) const {
        const int row0 = u.pm * BM + wr * 64 + 4 * fr;
        if (u.pm >= 64) {
            const int col0 = u.pn * BM + wc * 32 + 8 * fq;
#pragma unroll
            for (int ai = 0; ai < 2; ++ai)
#pragma unroll
                for (int m = 0; m < 4; ++m) { bf16_t* rowp = UC + (size_t)(row0 - 64 * BM + ai * HALF + m) * 22016 + col0;
#pragma unroll
                    for (int bj = 0; bj < 2; ++bj) { const f32x4 v0 = acc[ai][bj][m][0], v1 = acc[ai][bj][m][1];
                        u32x4 w; w.x = cvt_pk_bf16(v0[0], v0[1]); w.y = cvt_pk_bf16(v0[2], v0[3]); w.z = cvt_pk_bf16(v1[0], v1[1]); w.w = cvt_pk_bf16(v1[2], v1[3]);
                        *(u32x4*)(rowp + bj * HALF) = w; } }
            return;
        }
        const int ch = u.pn * 128 + wc * 32 + 8 * fq;
        typedef unsigned u32x2 __attribute__((ext_vector_type(2)));
#pragma unroll
        for (int n = 0; n < 2; ++n) {
            f32x4 wg[3], wv[3];
#pragma unroll
            for (int k = 0; k < 3; ++k) { if (NOLOAD) { wg[k] = (f32x4){0.3f, 0.4f, 0.5f, 0.6f}; wv[k] = (f32x4){0.6f, 0.5f, 0.4f, 0.3f}; } else { wg[k] = *(const f32x4*)(cw + k * 22016 + ch + 4 * n); wv[k] = *(const f32x4*)(cw + k * 22016 + 11008 + ch + 4 * n); } }
#pragma unroll
            for (int ai = 0; ai < 2; ++ai) {
                float o[4][4];
#pragma unroll
                for (int j = 0; j < 4; ++j) {
                    const float gp = shr1(acc[ai][0][3][n][j]), gn = shl1(acc[ai][0][0][n][j]), vp = shr1(acc[ai][1][3][n][j]), vn = shl1(acc[ai][1][0][n][j]);
#pragma unroll
                    for (int m = 0; m < 4; ++m) {
                        const float gL = m > 0 ? acc[ai][0][m - 1][n][j] : gp, gR = m < 3 ? acc[ai][0][m + 1][n][j] : gn;
                        const float vL = m > 0 ? acc[ai][1][m - 1][n][j] : vp, vR = m < 3 ? acc[ai][1][m + 1][n][j] : vn;
                        const float g = wg[0][j] * gL + wg[1][j] * acc[ai][0][m][n][j] + wg[2][j] * gR;
                        const float v = wv[0][j] * vL + wv[1][j] * acc[ai][1][m][n][j] + wv[2][j] * vR;
                        o[m][j] = g * __builtin_amdgcn_rcpf(1.0f + __expf(-g)) * v; }
                }
#pragma unroll
                for (int m = 0; m < 4; ++m) { u32x2 w; w.x = cvt_pk_bf16(o[m][0], o[m][1]); w.y = cvt_pk_bf16(o[m][2], o[m][3]);
                    if (NOSTORE) asm volatile("" :: "v"(w)); else *(u32x2*)(G + (size_t)(row0 + ai * HALF + m) * 11008 + ch + 4 * n) = w; }
                __builtin_amdgcn_sched_barrier(0);
            }
        }
    }
};
typedef EpiGateT<false, false> EpiGate;

template <class Epi, class Sched, bool ALIGN_EPI = false, bool SP2 = false>
__device__ __forceinline__ void gemm_phase(PG8_LAS unsigned char* lds, const Gemm g, const Sched& S, const Epi& E, const int tid) {
    const int wid = __builtin_amdgcn_readfirstlane(tid >> 6), lane = tid & 63, wr = wid >> 2, wc = wid & 3, fr = lane & 15, fq = lane >> 4;
    const int K = g.K, nt = K / BK;
    unsigned voffA[2], voffB[2];
#pragma unroll
    for (int i = 0; i < 2; ++i) { int R, C; stage_rc(tid * 16 + i * 8192, R, C); const int Rb = Epi::PERM ? ((R & ~31) + perm32(R & 31)) : R;
        const int Ra = Epi::PERM_A ? ((R & ~63) + 4 * (R & 15) + ((R >> 4) & 3)) : R;
        voffA[i] = (unsigned)(Ra * K + C) * 2u; voffB[i] = (unsigned)(Rb * K + C) * 2u; }
    const size_t kstep = (size_t)(BK * 2);
    const size_t hstep = (size_t)HALF * K * 2;
    const size_t tstep = 2 * hstep;
    const unsigned ldsw = (unsigned)wid * 1024u;
    const int aoff = lds_byte(wr * 64 + fr, fq * 8), boff = lds_byte(wc * 32 + fr, fq * 8);
#define PG8_SA(b, h) (((b) * 2 + (h)) * HTB)
#define PG8_SB(b, h) ((4 + (b) * 2 + (h)) * HTB)
#define PG8_STAGE(bufoff, gbase, voff) do { _Pragma("unroll") for (int _i = 0; _i < 2; ++_i) \
        __builtin_amdgcn_global_load_lds((const unsigned*)((const char*)(gbase) + (voff)[_i]), (PG8_LAS unsigned*)(lds + (bufoff) + ldsw + _i * 8192), 16, 0, 0); } while (0)
#define PG8_LDA(dst, b, h) do { _Pragma("unroll") for (int m = 0; m < 4; ++m) _Pragma("unroll") for (int k = 0; k < 2; ++k) dst[m][k] = *(const PG8_LAS bf16x8*)(lds + PG8_SA(b, h) + aoff + m * 2048 + k * 1024); } while (0)
#define PG8_LDB(dst, b, h) do { _Pragma("unroll") for (int n = 0; n < 2; ++n) _Pragma("unroll") for (int k = 0; k < 2; ++k) dst[n][k] = *(const PG8_LAS bf16x8*)(lds + PG8_SB(b, h) + boff + n * 2048 + k * 1024); } while (0)
#define PG8_MMA(ai, bj, At, Bt) do { __builtin_amdgcn_s_setprio(1); _Pragma("unroll") for (int m = 0; m < 4; ++m) _Pragma("unroll") for (int n = 0; n < 2; ++n) _Pragma("unroll") for (int k = 0; k < 2; ++k) \
        acc[ai][bj][m][n] = __builtin_amdgcn_mfma_f32_16x16x32_bf16(Bt[n][k], At[m][k], acc[ai][bj][m][n], 0, 0, 0); __builtin_amdgcn_s_setprio(0); } while (0)
#define PG8_WAIT_V(n) asm volatile("s_waitcnt vmcnt(" #n ")" ::: "memory")
#define PG8_WAIT_L(n) asm volatile("s_waitcnt lgkmcnt(" #n ")" ::: "memory")
#define PG8_BAR __builtin_amdgcn_s_barrier()
#define PG8_SCHED __builtin_amdgcn_sched_barrier(0)
    Unit cur, nxt; int ui = 0;
    if (!S.next(0, cur)) return;
    f32x4 acc[2][2][4][2];
#pragma unroll
    for (int a = 0; a < 2; ++a)
#pragma unroll
        for (int b = 0; b < 2; ++b)
#pragma unroll
            for (int m = 0; m < 4; ++m)
#pragma unroll
                for (int n = 0; n < 2; ++n) acc[a][b][m][n] = (f32x4){0.f, 0.f, 0.f, 0.f};
    bf16x8 At[4][2], B0[2][2], B1[2][2];
    const char* cA = (const char*)g.A + (size_t)cur.pm * tstep; const char* cB = (const char*)g.Bt + (size_t)cur.pn * tstep;
    S.a_ready(cur);
    if constexpr (SP2) {
        PG8_STAGE(PG8_SB(0, 0), cB, voffB); PG8_STAGE(PG8_SB(0, 1), cB + hstep, voffB); PG8_STAGE(PG8_SA(0, 0), cA, voffA); PG8_STAGE(PG8_SA(0, 1), cA + hstep, voffA);
        if (wr == 1) PG8_BAR;
        PG8_WAIT_V(2); PG8_BAR;
        PG8_STAGE(PG8_SB(1, 0), cB + kstep, voffB); PG8_STAGE(PG8_SA(1, 0), cA + kstep, voffA); PG8_STAGE(PG8_SB(1, 1), cB + hstep + kstep, voffB);
        PG8_WAIT_V(6); PG8_BAR;
    } else {
        PG8_STAGE(PG8_SB(0, 0), cB, voffB); PG8_STAGE(PG8_SA(0, 0), cA, voffA); PG8_STAGE(PG8_SB(0, 1), cB + hstep, voffB); PG8_STAGE(PG8_SA(0, 1), cA + hstep, voffA);
        if (wr == 1) PG8_BAR;
        PG8_WAIT_V(4); PG8_BAR;
        PG8_STAGE(PG8_SB(1, 0), cB + kstep, voffB); PG8_STAGE(PG8_SA(1, 0), cA + kstep, voffA); PG8_STAGE(PG8_SB(1, 1), cB + hstep + kstep, voffB);
        PG8_WAIT_V(6); PG8_BAR;
    }
    for (;;) {
        const bool has_next = S.next(ui + 1, nxt);
        const char* nA = has_next ? (const char*)g.A + (size_t)nxt.pm * tstep : cA; const char* nB = has_next ? (const char*)g.Bt + (size_t)nxt.pn * tstep : cB;
        for (int t = 0; t < nt; t += 2) {
            const bool last = (t == nt - 2);
            const char* a1 = cA + (size_t)(t + 1) * kstep;
            const char* a2 = last ? nA : cA + (size_t)(t + 2) * kstep; const char* b2 = last ? nB : cB + (size_t)(t + 2) * kstep;
            const char* a3 = a2 + kstep; const char* b3 = b2 + kstep;
            if (last && has_next) S.a_ready(nxt);
            if constexpr (SP2) {
            PG8_LDB(B0, 0, 0); PG8_LDB(B1, 0, 1); PG8_SCHED; PG8_LDA(At, 0, 0); PG8_STAGE(PG8_SA(1, 1), a1 + hstep, voffA);
            PG8_WAIT_V(8); PG8_WAIT_L(0); PG8_BAR; PG8_MMA(0, 0, At, B0); PG8_MMA(0, 1, At, B1); PG8_BAR; PG8_SCHED;
            PG8_LDA(At, 0, 1); PG8_STAGE(PG8_SB(0, 0), b2, voffB); PG8_STAGE(PG8_SB(0, 1), b2 + hstep, voffB); PG8_STAGE(PG8_SA(0, 0), a2, voffA);
            PG8_WAIT_V(8); PG8_WAIT_L(0); PG8_BAR; PG8_MMA(1, 0, At, B0); PG8_MMA(1, 1, At, B1); PG8_BAR; PG8_SCHED;
            PG8_LDB(B0, 1, 0); PG8_LDB(B1, 1, 1); PG8_SCHED; PG8_LDA(At, 1, 0); PG8_STAGE(PG8_SA(0, 1), a2 + hstep, voffA);
            PG8_WAIT_V(8); PG8_WAIT_L(0); PG8_BAR; PG8_MMA(0, 0, At, B0); PG8_MMA(0, 1, At, B1); PG8_BAR; PG8_SCHED;
            PG8_LDA(At, 1, 1); PG8_STAGE(PG8_SB(1, 0), b3, voffB); PG8_STAGE(PG8_SB(1, 1), b3 + hstep, voffB); PG8_STAGE(PG8_SA(1, 0), a3, voffA);
            PG8_WAIT_V(8); PG8_WAIT_L(0); PG8_BAR; PG8_MMA(1, 0, At, B0); PG8_MMA(1, 1, At, B1); PG8_BAR; PG8_SCHED;
            } else {
            PG8_LDB(B0, 0, 0); PG8_SCHED; PG8_LDA(At, 0, 0); PG8_STAGE(PG8_SA(1, 1), a1 + hstep, voffA);
            PG8_WAIT_L(8); PG8_BAR; PG8_WAIT_L(0); PG8_MMA(0, 0, At, B0); PG8_BAR; PG8_SCHED;
            PG8_LDB(B1, 0, 1); PG8_STAGE(PG8_SB(0, 0), b2, voffB);
            PG8_BAR; PG8_WAIT_L(0); PG8_MMA(0, 1, At, B1); PG8_BAR;
            PG8_LDA(At, 0, 1); PG8_STAGE(PG8_SA(0, 0), a2, voffA);
            PG8_BAR; PG8_WAIT_L(0); PG8_MMA(1, 0, At, B0); PG8_BAR; PG8_SCHED;
            PG8_STAGE(PG8_SB(0, 1), b2 + hstep, voffB);
            PG8_WAIT_V(6); PG8_BAR; PG8_MMA(1, 1, At, B1); PG8_BAR;
            PG8_LDB(B0, 1, 0); PG8_SCHED; PG8_LDA(At, 1, 0); PG8_STAGE(PG8_SA(0, 1), a2 + hstep, voffA);
            PG8_WAIT_L(8); PG8_BAR; PG8_WAIT_L(0); PG8_MMA(0, 0, At, B0); PG8_BAR; PG8_SCHED;
            PG8_LDB(B1, 1, 1); PG8_STAGE(PG8_SB(1, 0), b3, voffB);
            PG8_BAR; PG8_WAIT_L(0); PG8_MMA(0, 1, At, B1); PG8_BAR;
            PG8_LDA(At, 1, 1); PG8_STAGE(PG8_SA(1, 0), a3, voffA);
            PG8_BAR; PG8_WAIT_L(0); PG8_MMA(1, 0, At, B0); PG8_BAR; PG8_SCHED;
            PG8_STAGE(PG8_SB(1, 1), b3 + hstep, voffB);
            PG8_WAIT_V(6); PG8_BAR; PG8_MMA(1, 1, At, B1); PG8_BAR;
            }
        }
        if constexpr (ALIGN_EPI) { if (wr == 0) PG8_BAR; }
        if constexpr (!Epi::AFTER_DRAIN) { E(acc, cur, wr, wc, fr, fq); S.done(cur); }
        if (!has_next) break;
#pragma unroll
        for (int a = 0; a < 2; ++a)
#pragma unroll
            for (int b = 0; b < 2; ++b)
#pragma unroll
                for (int m = 0; m < 4; ++m)
#pragma unroll
                    for (int n = 0; n < 2; ++n) acc[a][b][m][n] = (f32x4){0.f, 0.f, 0.f, 0.f};
        cur = nxt; cA = nA; cB = nB; ++ui;
        if constexpr (ALIGN_EPI) { if (wr == 1) PG8_BAR; }
    }
    PG8_WAIT_V(0);
    if constexpr (!ALIGN_EPI) { if (wr == 0) PG8_BAR; }
    PG8_BAR;
#undef PG8_SA
#undef PG8_SB
#undef PG8_STAGE
#undef PG8_LDA
#undef PG8_LDB
#undef PG8_MMA
#undef PG8_WAIT_V
#undef PG8_WAIT_L
#undef PG8_BAR
#undef PG8_SCHED
}
}

constexpr int NWAVES = 8, NTHREADS = 512;
constexpr int D = 4096, BATCH = 2, SEQ = 8192, CTXL = 256;
constexpr int ML = BATCH * SEQ;
constexpr int MC = BATCH * CTXL;
constexpr int MT = ML + MC;
constexpr int NMODC = 6 * D;
constexpr int WA = 2048, ABIN = 10240, ABU = 6144, ACONV = 31;
constexpr int HEADS = 8, DQK = 256, DV = 512;
constexpr int QKVO = 12288, CIN = 12320, CINP = 12544;
constexpr int DFF = 11008, DFF2 = 22016;
constexpr int NCH = 66;
constexpr float EPS = 1e-6f;

constexpr size_t MiB = 1u << 20;
constexpr size_t WS_CTL = 0, CTL_ZERO_BYTES = 1 * MiB;
constexpr size_t WS_MOD = 1 * MiB;
constexpr size_t WS_SCP = 2 * MiB;
constexpr size_t WS_SCC = 7 * MiB;
constexpr size_t WS_GATES = 8 * MiB;
constexpr size_t WS_CTXS = 12 * MiB;
constexpr size_t WS_WABIN = 20 * MiB;
constexpr size_t WS_WABOUT = 100 * MiB;
constexpr size_t WS_WMIN = 132 * MiB;
constexpr size_t WS_WMOUT = 230 * MiB;
constexpr size_t WS_WUP0 = 262 * MiB;
constexpr size_t WS_WDN0 = 606 * MiB;
constexpr size_t WS_H = 778 * MiB;
constexpr size_t WS_U = 910 * MiB;
constexpr size_t WS_UC = 1590 * MiB;
constexpr size_t WS_G = 1620 * MiB;
constexpr size_t WS_Y = 1975 * MiB;
constexpr size_t WS_HS = 2239 * MiB;
constexpr size_t WS_END = 2751 * MiB;
static_assert(WS_WUP0 + 2 * 172 * MiB == WS_WDN0 && WS_WDN0 + 2 * 86 * MiB <= WS_H, "ws map");
static_assert((size_t)DFF2 * D * 2 <= 172 * MiB && (size_t)D * DFF * 2 <= 86 * MiB && (size_t)CINP * D * 2 <= 98 * MiB, "ws map");
static_assert(WS_H + (size_t)MT * D * 2 <= WS_U && WS_U + (size_t)MT * DFF2 * 2 <= WS_G && WS_G + (size_t)MT * DFF * 2 <= WS_Y && WS_Y + (size_t)MT * D * 4 <= WS_HS && WS_HS + (size_t)2 * ML * D * 4 <= WS_END, "ws map");
static_assert(WS_SCP + (size_t)32 * NCH * 3 * 128 * 4 <= WS_SCC && WS_GATES + (size_t)MT * 32 * 4 <= WS_CTXS && WS_CTXS + (size_t)MC * D * 4 <= WS_WABIN, "ws map");

constexpr int CW_BAR = 4096;
constexpr int LDS_BYTES = 163840;
constexpr int MISC_OFF = LDS_BYTES - 64;

#define LAS __attribute__((address_space(3)))
typedef unsigned short bf16;
typedef unsigned v4u __attribute__((ext_vector_type(4)));
typedef unsigned v2u __attribute__((ext_vector_type(2)));
typedef float f32x4 __attribute__((ext_vector_type(4)));
typedef float f32x2 __attribute__((ext_vector_type(2)));
typedef short bf16x8 __attribute__((ext_vector_type(8)));
typedef short s16x4 __attribute__((ext_vector_type(4)));
#define LDS_WAIT() asm volatile("s_waitcnt lgkmcnt(0)" ::: "memory")

__device__ __forceinline__ unsigned f2bf(float f) { unsigned u = __builtin_bit_cast(unsigned, f); return (u + 0x7fffu + ((u >> 16) & 1u)) >> 16; }
__device__ __forceinline__ unsigned pk2(float lo, float hi) { unsigned r; asm("v_cvt_pk_bf16_f32 %0, %1, %2" : "=v"(r) : "v"(lo), "v"(hi)); return r; }
__device__ __forceinline__ float bflo(unsigned w) { return __builtin_bit_cast(float, w << 16); }
__device__ __forceinline__ float bfhi(unsigned w) { return __builtin_bit_cast(float, w & 0xffff0000u); }
__device__ __forceinline__ float bf1(unsigned short h) { return __builtin_bit_cast(float, ((unsigned)h) << 16); }
__device__ __forceinline__ void cvt8(const v4u r, float (&f)[8]) {
    f[0] = bflo(r.x); f[1] = bfhi(r.x); f[2] = bflo(r.y); f[3] = bfhi(r.y); f[4] = bflo(r.z); f[5] = bfhi(r.z); f[6] = bflo(r.w); f[7] = bfhi(r.w);
}
__device__ __forceinline__ float sigmoidf_(float x) { return __builtin_amdgcn_rcpf(1.0f + __expf(-x)); }
__device__ __forceinline__ float siluf_(float x) { return x * sigmoidf_(x); }
__device__ __forceinline__ float wave_sum(float v) {
#pragma unroll
    for (int o = 1; o < 64; o <<= 1) v += __shfl_xor(v, o);
    return v;
}

#define XB_TMO      128
#define XB_XCNT(j)  (256  + 64 * (j))
#define XB_XSUB(j)  (1280 + 64 * (j))
#define XB_XGEN(j)  (2304 + 64 * (j))
#define XB_TOP      3328
#define XB_TOPGEN   3392
#define XCD_BAR_WORDS 3456
#define XB_SPIN_CAP (1u << 22)

__device__ __forceinline__ unsigned xb_ld(unsigned* p)              { return __hip_atomic_load(p, __ATOMIC_RELAXED, __HIP_MEMORY_SCOPE_AGENT); }
__device__ __forceinline__ unsigned xb_add(unsigned* p, unsigned v) { return __hip_atomic_fetch_add(p, v, __ATOMIC_RELAXED, __HIP_MEMORY_SCOPE_AGENT); }
__device__ __forceinline__ unsigned xb_xcc_id() { return (unsigned)__builtin_amdgcn_s_getreg((3 << 11) | 20) & 0xFu; }
#define XB_SPIN(cond, bar) do { unsigned _sp = 0; while (cond) { __builtin_amdgcn_s_sleep(1); \
    if ((++_sp & 255u) == 0u) { if (xb_ld(&(bar)[XB_TMO])) break; if (_sp > XB_SPIN_CAP) { atomicAdd(&(bar)[XB_TMO], 1u); break; } } } } while (0)

struct XcdBarrier { unsigned* bar; unsigned x; volatile LAS unsigned* st; };

__device__ __forceinline__ XcdBarrier xcd_barrier_post(unsigned* bar, volatile LAS unsigned* st) {
    XcdBarrier b; b.bar = bar; b.x = xb_xcc_id(); b.st = st;
    if (threadIdx.x == 0) (void)xb_add(&bar[XB_XCNT(b.x)], 1u);
    return b;
}
__device__ __forceinline__ void xcd_barrier_complete(unsigned* bar, unsigned x, unsigned& nloc, unsigned& nx) {
    const unsigned G = gridDim.x * gridDim.y * gridDim.z;
    unsigned sum, cnt, mine, sp = 0u;
    for (;;) {
        sum = 0u; cnt = 0u; mine = 0u;
#pragma unroll
        for (unsigned j = 0; j < 16; ++j) { const unsigned c = xb_ld(&bar[XB_XCNT(j)]); sum += c; cnt += (c > 0u) ? 1u : 0u; mine = (j == x) ? c : mine; }
        if (sum == G) break;
        __builtin_amdgcn_s_sleep(1);
        if ((++sp & 255u) == 0u) { if (xb_ld(&bar[XB_TMO])) break; if (sp > XB_SPIN_CAP) { atomicAdd(&bar[XB_TMO], 1u); break; } }
    }
    nloc = mine > 0u ? mine : 1u; nx = cnt > 0u ? cnt : 1u;
}
__device__ __forceinline__ void xcd_barrier(const XcdBarrier& b) {
    asm volatile("s_waitcnt vmcnt(0)" ::: "memory");
    __syncthreads();
    if (threadIdx.x == 0) {
        unsigned* bar = b.bar;
        __builtin_amdgcn_s_waitcnt(0);
        unsigned nloc = b.st[0], nx = b.st[1];
        if (nloc == 0u) { xcd_barrier_complete(bar, b.x, nloc, nx); b.st[0] = nloc; b.st[1] = nx; }
        const unsigned old = xb_add(&bar[XB_XSUB(b.x)], 1u);
        const unsigned gen = old / nloc;
        if (old + 1u == (gen + 1u) * nloc) {
            __builtin_amdgcn_fence(__ATOMIC_RELEASE, "agent");
            asm volatile("s_waitcnt vmcnt(0)" ::: "memory");
            const unsigned og = xb_add(&bar[XB_TOP], 1u);
            const unsigned tg = og / nx;
            if (og + 1u == (tg + 1u) * nx) xb_add(&bar[XB_TOPGEN], 1u);
            else XB_SPIN(xb_ld(&bar[XB_TOPGEN]) == tg, bar);
            __builtin_amdgcn_fence(__ATOMIC_ACQUIRE, "agent");
            xb_add(&bar[XB_XGEN(b.x)], 1u);
            asm volatile("s_waitcnt vmcnt(0)" ::: "memory");
        } else {
            XB_SPIN(xb_ld(&bar[XB_XGEN(b.x)]) == gen, bar);
            __builtin_amdgcn_fence(__ATOMIC_ACQUIRE, "agent");
            asm volatile("s_waitcnt vmcnt(0)" ::: "memory");
        }
    }
    __syncthreads();
}

struct Args { const float* in[21]; float* out; unsigned char* ws; int ph_lo, ph_hi; };
typedef const __attribute__((address_space(4))) Args* CArgs;
__device__ __forceinline__ int opaque_tid(int wave_s) { int t = wave_s * 64 + (int)__builtin_amdgcn_mbcnt_hi(~0u, __builtin_amdgcn_mbcnt_lo(~0u, 0u)); asm volatile("" : "+v"(t)); return t; }
__device__ __forceinline__ CArgs get_args() { CArgs p = (CArgs)__builtin_amdgcn_kernarg_segment_ptr(); asm volatile("" : "+s"(p)); return p; }
enum { I_X = 0, I_C, I_CTX, I_CCTX, I_ADAW, I_ADAB, I_NORMG, I_ABWIN, I_ACONVW, I_ACONVB, I_ALNG, I_ALNB, I_BCONVW, I_ABWOUT, I_MWIN, I_MBG, I_MHNG, I_MWOUT, I_FUP, I_FCONV, I_FDN };

template <int MODE> __device__ __forceinline__ int perm_row(int n0) {
    if (MODE == 1) return n0 < DFF ? 256 * (n0 / 128) + (n0 % 128) : 256 * ((n0 - DFF) / 128) + 128 + ((n0 - DFF) % 128);
    if (MODE == 2) { if (n0 < 4096) { const int ch = n0 & 2047, hi = n0 >> 11; return 256 * (ch / 128) + 128 * hi + (ch % 128); }
                     if (n0 < 6144) return n0;
                     const int j = n0 - 6144, ch = j & 2047, hi = j >> 11; return 6144 + 256 * (ch / 128) + 128 * hi + (ch % 128); }
    return n0;
}
template <int GATE_PERM = 0>
__device__ __forceinline__ void p0_transpose_item(const float* W, int K, int N, bf16* WT, LAS float* scr, int item, int lane) {
    const int nblk = N / 32, kb = item / nblk, nb = item % nblk, k0 = 64 * kb, n0 = 32 * nb;
    const int r0 = perm_row<GATE_PERM>(n0);
#pragma unroll 8
    for (int i = 0; i < 32; ++i) { const int kk = 2 * i + (lane >> 5); scr[kk * 33 + (lane & 31)] = W[(size_t)(k0 + kk) * N + n0 + (lane & 31)]; }
    LDS_WAIT(); asm volatile("" ::: "memory");
    const int c = lane & 7;
#pragma unroll
    for (int j = 0; j < 4; ++j) { const int n = (lane >> 3) + 8 * j; const LAS float* s = scr + (8 * c) * 33 + n;
        v4u o; o.x = pk2(s[0 * 33], s[1 * 33]); o.y = pk2(s[2 * 33], s[3 * 33]); o.z = pk2(s[4 * 33], s[5 * 33]); o.w = pk2(s[6 * 33], s[7 * 33]);
        __builtin_nontemporal_store(o, (v4u*)(WT + (size_t)(r0 + n) * K + k0 + 8 * c)); }
    LDS_WAIT(); asm volatile("" ::: "memory");
}

__device__ __forceinline__ void gemv_units(CArgs a, LAS unsigned char* lds, int layer, int first, int stride, int tid, int lane, int wave) {
    float* MOD = (float*)(a->ws + WS_MOD);
    LAS float* sv = (LAS float*)lds;
    LAS float* red = (LAS float*)(lds + 49152);
    for (int i = tid; i < 3 * D; i += NTHREADS) { const int r = i / D, k = i % D; const float v = (r < 2) ? a->in[I_C][r * D + k] : a->in[I_CCTX][k]; sv[i] = siluf_(v); }
    __syncthreads();
    for (int unit = first; unit < 768; unit += stride) {
        const int n0 = unit * 32;
        const int kg = wave * 8 + (lane >> 3), c4 = (lane & 7) * 4;
        const float* W = a->in[I_ADAW] + (size_t)layer * D * NMODC + (size_t)(kg * 64) * NMODC + n0 + c4;
        f32x4 a0 = {0.f, 0.f, 0.f, 0.f}, a1 = a0, a2 = a0;
        for (int k = 0; k < 64; k += 16) {
            f32x4 w[16];
#pragma unroll
            for (int j = 0; j < 16; ++j) w[j] = __builtin_nontemporal_load((const f32x4*)(W + (size_t)(k + j) * NMODC));
#pragma unroll
            for (int j = 0; j < 16; ++j) { const int kk = kg * 64 + k + j; a0 += w[j] * sv[kk]; a1 += w[j] * sv[D + kk]; a2 += w[j] * sv[2 * D + kk]; }
        }
        *(LAS f32x4*)(red + (kg * 3 + 0) * 32 + c4) = a0; *(LAS f32x4*)(red + (kg * 3 + 1) * 32 + c4) = a1; *(LAS f32x4*)(red + (kg * 3 + 2) * 32 + c4) = a2;
        __syncthreads();
        if (tid < 96) { const int r = tid >> 5, cc = tid & 31; float s = 0.f;
#pragma unroll 8
            for (int g = 0; g < 64; ++g) s += red[(g * 3 + r) * 32 + cc];
            MOD[((size_t)layer * 3 + r) * NMODC + n0 + cc] = s + a->in[I_ADAB][(size_t)layer * NMODC + n0 + cc]; }
        __syncthreads();
    }
}
template <int GATE_PERM>
__device__ __forceinline__ void transpose_item64(const float* W, int K, int N, bf16* WT, LAS float* scr, int item, int lane, int nblk) {
    const int kb = item / nblk, nb = item % nblk, k0 = 64 * kb, n0 = 64 * nb;
    const int r0 = perm_row<GATE_PERM>(n0);
    const int kq = lane >> 4, j4 = (lane & 15) * 4;
    f32x4 v[16];
#pragma unroll
    for (int i = 0; i < 16; ++i) v[i] = __builtin_nontemporal_load((const f32x4*)(W + (size_t)(k0 + 4 * i + kq) * N + n0 + j4));
#pragma unroll
    for (int i = 0; i < 16; ++i) { LAS float* p = scr + (4 * i + kq) * 65 + j4; p[0] = v[i].x; p[1] = v[i].y; p[2] = v[i].z; p[3] = v[i].w; }
    LDS_WAIT(); asm volatile("" ::: "memory");
    const int c = lane & 7;
#pragma unroll
    for (int j = 0; j < 8; ++j) { const int n = (lane >> 3) + 8 * j; const LAS float* p = scr + (8 * c) * 65 + n;
        v4u o; o.x = pk2(p[0 * 65], p[1 * 65]); o.y = pk2(p[2 * 65], p[3 * 65]); o.z = pk2(p[4 * 65], p[5 * 65]); o.w = pk2(p[6 * 65], p[7 * 65]);
        __builtin_nontemporal_store(o, (v4u*)(WT + (size_t)(r0 + n) * K + k0 + 8 * c)); }
    LDS_WAIT(); asm volatile("" ::: "memory");
}
template <int GATE_PERM>
__device__ __forceinline__ void conv_items(const float* W, int K, int N, bf16* WT, LAS unsigned char* lds, int first, int stride, int lane, int wave) {
    LAS float* scr = (LAS float*)(lds + wave * 16640);
    const int nb64 = N / 64, nitems = (K / 64) * nb64;
    for (int it = first; it < nitems; it += stride) transpose_item64<GATE_PERM>(W, K, N, WT, scr, it, lane, nb64);
    if (N % 64) for (int kb = first; kb < K / 64; kb += stride) p0_transpose_item<GATE_PERM>(W, K, N, WT, scr, kb * (N / 32) + (N / 32 - 1), lane);
}
enum { CV_ABIN = 0, CV_ABOUT, CV_MIN, CV_MOUT, CV_UP0, CV_UP1, CV_DN0, CV_DN1 };
template <int WHICH>
__device__ __forceinline__ void conv_matrix(CArgs a, LAS unsigned char* lds, int first, int stride, int lane, int wave) {
    unsigned char* ws = a->ws;
    if (WHICH == CV_ABIN) conv_items<2>(a->in[I_ABWIN], D, ABIN, (bf16*)(ws + WS_WABIN), lds, first, stride, lane, wave);
    if (WHICH == CV_ABOUT) conv_items<0>(a->in[I_ABWOUT], D, D, (bf16*)(ws + WS_WABOUT), lds, first, stride, lane, wave);
    if (WHICH == CV_MIN) { conv_items<0>(a->in[I_MWIN], D, CIN, (bf16*)(ws + WS_WMIN), lds, first, stride, lane, wave);
        v4u* p = (v4u*)((bf16*)(ws + WS_WMIN) + (size_t)CIN * D); const int n16 = (CINP - CIN) * D * 2 / 16;
        for (int i = first * 64 + lane; i < n16; i += stride * 64) p[i] = (v4u){0u, 0u, 0u, 0u}; }
    if (WHICH == CV_MOUT) conv_items<0>(a->in[I_MWOUT], D, D, (bf16*)(ws + WS_WMOUT), lds, first, stride, lane, wave);
    if (WHICH == CV_UP0) conv_items<1>(a->in[I_FUP], D, DFF2, (bf16*)(ws + WS_WUP0), lds, first, stride, lane, wave);
    if (WHICH == CV_UP1) conv_items<1>(a->in[I_FUP] + (size_t)D * DFF2, D, DFF2, (bf16*)(ws + WS_WUP0 + 172 * MiB), lds, first, stride, lane, wave);
    if (WHICH == CV_DN0) conv_items<0>(a->in[I_FDN], DFF, D, (bf16*)(ws + WS_WDN0), lds, first, stride, lane, wave);
    if (WHICH == CV_DN1) conv_items<0>(a->in[I_FDN] + (size_t)DFF * D, DFF, D, (bf16*)(ws + WS_WDN0 + 86 * MiB), lds, first, stride, lane, wave);
}
__device__ __forceinline__ void p0_prologue(CArgs a, LAS unsigned char* lds, int tid, int lane, int wave) {
    gemv_units(a, lds, 0, blockIdx.x, gridDim.x, tid, lane, wave);
    const int gw = blockIdx.x * NWAVES + wave, NGW = gridDim.x * NWAVES;
    conv_matrix<CV_ABIN>(a, lds, gw, NGW, lane, wave);
#if PROBE_E1
    conv_matrix<CV_ABOUT>(a, lds, gw, NGW, lane, wave);
    conv_matrix<CV_UP0>(a, lds, gw, NGW, lane, wave); conv_matrix<CV_DN0>(a, lds, gw, NGW, lane, wave); conv_matrix<CV_MIN>(a, lds, gw, NGW, lane, wave); conv_matrix<CV_MOUT>(a, lds, gw, NGW, lane, wave);
    conv_matrix<CV_UP1>(a, lds, gw, NGW, lane, wave); conv_matrix<CV_DN1>(a, lds, gw, NGW, lane, wave); __syncthreads(); gemv_units(a, lds, 1, blockIdx.x, gridDim.x, tid, lane, wave);
#endif
}
__device__ __forceinline__ int gemm_wgs(int nwg) { const int G = gridDim.x, rounds = (nwg + G - 1) / G; const int g = ((nwg + rounds - 1) / rounds + 7) & ~7; return g < G ? g : G; }

template <bool RES, bool DOH>
__device__ __forceinline__ void row_phase(LAS unsigned char* lds, int nrows, const float* xin_lat, const float* xin_ctx, float* xout_lat, float* xout_ctx,
                                          const bf16* Y, const float* gpost, const float* modres, int gate_idx,
                                          const float* gpre, const float* modh, int shift_idx, int scale_idx, bf16* H, int tid, int lane, int wave) {
    LAS f32x4* pG = (LAS f32x4*)lds; LAS f32x4* pA = pG + 1024; LAS f32x4* pB = pA + 1024;
    const int G = gridDim.x, rpw = (nrows + G - 1) / G, r0 = (int)blockIdx.x * rpw, r1 = (r0 + rpw < nrows) ? r0 + rpw : nrows;
    for (int vb = r0; vb < r1;) {
        const int mr = vb < ML ? (vb >> 13) : 2;
        const int lim = mr == 0 ? SEQ : (mr == 1 ? ML : nrows), vend = r1 < lim ? r1 : lim;
        __syncthreads();
        for (int i = tid; i < 1024; i += NTHREADS) {
            if (RES) pG[i] = ((const f32x4*)(modres + (size_t)mr * NMODC + gate_idx * D))[i] * ((const f32x4*)gpost)[i];
            if (DOH) { pA[i] = ((const f32x4*)gpre)[i] * (((const f32x4*)(modh + (size_t)mr * NMODC + scale_idx * D))[i] + 1.0f); pB[i] = ((const f32x4*)(modh + (size_t)mr * NMODC + shift_idx * D))[i]; }
        }
        __syncthreads();
        for (int row = vb + wave; row < vend; row += NWAVES) {
            const float* xr = row < ML ? xin_lat + (size_t)row * D : xin_ctx + (size_t)(row - ML) * D;
            f32x4 v[16];
            if (RES) {
                const bf16* yr = Y + (size_t)row * D; float s = 0.f;
#pragma unroll
                for (int j = 0; j < 16; ++j) { const v2u yw = *(const v2u*)(yr + j * 256 + lane * 4); v[j] = (f32x4){bflo(yw.x), bfhi(yw.x), bflo(yw.y), bfhi(yw.y)}; s += (v[j].x * v[j].x + v[j].y * v[j].y) + (v[j].z * v[j].z + v[j].w * v[j].w); }
                const float rstd = 1.0f / sqrtf(wave_sum(s) * (1.0f / D) + EPS);
                float* xo = row < ML ? xout_lat + (size_t)row * D : xout_ctx + (size_t)(row - ML) * D;
#pragma unroll
                for (int j = 0; j < 16; ++j) { const int o = j * 256 + lane * 4;
                    const f32x4 x = *(const f32x4*)(xr + o);
                    v[j] = x + (v[j] * rstd) * pG[j * 64 + lane];
                    *(f32x4*)(xo + o) = v[j];
                    if ((j & 3) == 3) asm volatile("" ::: "memory"); }
            } else {
#pragma unroll
                for (int j = 0; j < 16; ++j) v[j] = *(const f32x4*)(xr + j * 256 + lane * 4);
            }
            if (DOH) {
                float s = 0.f;
#pragma unroll
                for (int j = 0; j < 16; ++j) s += (v[j].x * v[j].x + v[j].y * v[j].y) + (v[j].z * v[j].z + v[j].w * v[j].w);
                const float rstd = 1.0f / sqrtf(wave_sum(s) * (1.0f / D) + EPS);
                bf16* hr = H + (size_t)row * D;
#pragma unroll
                for (int j = 0; j < 16; ++j) { const int o = j * 256 + lane * 4;
                    const f32x4 h = (v[j] * rstd) * pA[j * 64 + lane] + pB[j * 64 + lane];
                    v2u w; w.x = pk2(h.x, h.y); w.y = pk2(h.z, h.w);
                    *(v2u*)(hr + o) = w; }
            }
        }
        vb = vend;
    }
}

__device__ __forceinline__ void mixer_conv_phase(CArgs a, LAS unsigned char* lds, int tid, int lane) {
    const bf16* U = (const bf16*)(a->ws + WS_U);
    bf16* T1 = (bf16*)(a->ws + WS_Y);
    bf16* V = (bf16*)(a->ws + WS_G);
    LAS float* tile = (LAS float*)lds;
    const float* cw = a->in[I_ACONVW]; const float* cb = a->in[I_ACONVB];
    v4u rva[6]; f32x2 w[ACONV]; f32x2 bias = {0.f, 0.f}; int cc_w = -1;
#define MX_ROW(tb_, j_) ((tb_) < 256 ? (((j_) >= 15 && (j_) < 79) ? (tb_) * 64 + ((j_) - 15) : -1) \
        : ((((tb_) - 256) & 3) * 64 + ((j_) - 15) >= 0 && (((tb_) - 256) & 3) * 64 + ((j_) - 15) < CTXL ? ML + (((tb_) - 256) >> 2) * CTXL + (((tb_) - 256) & 3) * 64 + ((j_) - 15) : -1))
#define MX_LOAD(unit_) do { const int tb_ = (unit_) >> 3, cc_ = (unit_) & 7; \
        _Pragma("unroll") for (int q = 0; q < 6; ++q) { const int it = tid + NTHREADS * q; const int j = it >> 5, ch8 = it & 31; const int row = it < 94 * 32 ? MX_ROW(tb_, j) : -1; \
            const size_t o_ = (size_t)(row >= 0 ? row : 0) * ABU + cc_ * 256 + ch8 * 8; rva[q] = *(const v4u*)(U + o_); } } while (0)
    if ((int)blockIdx.x < 264 * 8) MX_LOAD(blockIdx.x);
    for (int unit = blockIdx.x; unit < 264 * 8; unit += gridDim.x) {
        const int tb = unit >> 3, cc = unit & 7;
#pragma unroll
        for (int q = 0; q < 6; ++q) { const int it = tid + NTHREADS * q; const int j = it >> 5, ch8 = it & 31;
            if (it < 94 * 32) { const int row = MX_ROW(tb, j); const float f = row >= 0 ? 1.f : 0.f; const v4u va = rva[q]; f32x4 g0, g1;
                g0.x = f * bflo(va.x); g0.y = f * bfhi(va.x); g0.z = f * bflo(va.y); g0.w = f * bfhi(va.y);
                g1.x = f * bflo(va.z); g1.y = f * bfhi(va.z); g1.z = f * bflo(va.w); g1.w = f * bfhi(va.w);
                *(LAS f32x4*)(tile + j * 256 + ch8 * 8) = g0; *(LAS f32x4*)(tile + j * 256 + ch8 * 8 + 4) = g1; } }
        __syncthreads();
        if (unit + (int)gridDim.x < 264 * 8) MX_LOAD(unit + (int)gridDim.x);
        {
            const int cp = tid & 127, tg = tid >> 7, c = cc * 256 + 2 * cp;
            if (cc != cc_w) { cc_w = cc;
#pragma unroll
                for (int k = 0; k < ACONV; ++k) w[k] = *(const f32x2*)(cw + k * WA + c);
                bias = *(const f32x2*)(cb + c); }
            f32x2 acc[16];
#pragma unroll
            for (int i = 0; i < 16; ++i) acc[i] = (f32x2){0.f, 0.f};
#pragma unroll
            for (int jj = 0; jj < 46; ++jj) {
                const f32x2 g = *(const LAS f32x2*)(tile + (16 * tg + jj) * 256 + 2 * cp);
#pragma unroll
                for (int i = 0; i < 16; ++i) { const int k = jj - i; if (k >= 0 && k < ACONV) acc[i] += w[k] * g; }
            }
            int row0;
            if (tb < 256) row0 = tb * 64 + 16 * tg; else { const int cbk = tb - 256; row0 = ML + (cbk >> 2) * CTXL + (cbk & 3) * 64 + 16 * tg; }
#pragma unroll
            for (int i = 0; i < 16; ++i) { const f32x2 o = acc[i] + bias; *(unsigned*)(T1 + (size_t)(row0 + i) * WA + c) = pk2(o.x, o.y); }
        }
        __syncthreads();
    }
#undef MX_ROW
#undef MX_LOAD
    const float* bw = a->in[I_BCONVW];
    constexpr int NSEG_L = 2 * 64 * 16, NIT_L = NSEG_L * 256, NIT_C = 2 * 32 * 256;
    for (int it = blockIdx.x * NTHREADS + tid; it < NIT_L + NIT_C; it += gridDim.x * NTHREADS) {
        int row0, stride, prow, nrow, c;
        if (it < NIT_L) { const int c8 = it & 255, r = it >> 8, x = r & 63, seg = (r >> 6) & 15, b = r >> 10;
            c = c8 * 8; stride = 64; row0 = b * SEQ + (seg * 8) * 64 + x; prow = seg > 0 ? row0 - 64 : -1; nrow = seg < 15 ? row0 + 8 * 64 : -1; }
        else { const int j = it - NIT_L, c8 = j & 255, r = j >> 8, seg = r & 31, b = r >> 5;
            c = c8 * 8; stride = 1; row0 = ML + b * CTXL + seg * 8; prow = seg > 0 ? row0 - 1 : -1; nrow = seg < 31 ? row0 + 8 : -1; }
        float w[3][8];
#pragma unroll
        for (int k = 0; k < 3; ++k) { const f32x4 w0 = *(const f32x4*)(bw + k * 2048 + c), w1 = *(const f32x4*)(bw + k * 2048 + c + 4);
            w[k][0] = w0.x; w[k][1] = w0.y; w[k][2] = w0.z; w[k][3] = w0.w; w[k][4] = w1.x; w[k][5] = w1.y; w[k][6] = w1.z; w[k][7] = w1.w; }
        const bf16* uz = U + 4096 + c; const bf16* ub = U + 2048 + c;
        v4u rc[10], rb[8];
#pragma unroll
        for (int i = 0; i < 10; ++i) { const int rr = i == 0 ? (prow >= 0 ? prow : row0) : (i == 9 ? (nrow >= 0 ? nrow : row0) : row0 + (i - 1) * stride);
            rc[i] = *(const v4u*)(uz + (size_t)rr * ABU); }
#pragma unroll
        for (int i = 0; i < 8; ++i) rb[i] = *(const v4u*)(ub + (size_t)(row0 + i * stride) * ABU);
        float pp[8], pc[8];
        { float a8[8]; cvt8(rc[0], a8); const float f = prow >= 0 ? 1.f : 0.f;
#pragma unroll
          for (int e = 0; e < 8; ++e) pp[e] = a8[e] * f;
          cvt8(rc[1], pc); }
#pragma unroll
        for (int i = 0; i < 8; ++i) {
            float pn[8], bb[8]; cvt8(rc[i + 2], pn); cvt8(rb[i], bb);
            const float f = (i == 7 && nrow < 0) ? 0.f : 1.f;
#pragma unroll
            for (int e = 0; e < 8; ++e) pn[e] *= f;
            float o[8];
#pragma unroll
            for (int e = 0; e < 8; ++e) o[e] = bb[e] * (w[0][e] * pp[e] + w[1][e] * pc[e] + w[2][e] * pn[e]);
            v4u ov; ov.x = pk2(o[0], o[1]); ov.y = pk2(o[2], o[3]); ov.z = pk2(o[4], o[5]); ov.w = pk2(o[6], o[7]);
            *(v4u*)(V + (size_t)(row0 + i * stride) * D + WA + c) = ov;
#pragma unroll
            for (int e = 0; e < 8; ++e) { pp[e] = pc[e]; pc[e] = pn[e]; }
        }
    }
}
__device__ __forceinline__ void mixer_ln_phase(CArgs a, LAS unsigned char* lds, int tid, int lane, int wave) {
    const bf16* T1 = (const bf16*)(a->ws + WS_Y);
    bf16* V = (bf16*)(a->ws + WS_G);
    LAS f32x4* pg = (LAS f32x4*)lds; LAS f32x4* pb = pg + 512;
    for (int i = tid; i < 512; i += NTHREADS) { pg[i] = ((const f32x4*)a->in[I_ALNG])[i]; pb[i] = ((const f32x4*)a->in[I_ALNB])[i]; }
    __syncthreads();
    const int G = gridDim.x, rpw = (MT + G - 1) / G, r0 = (int)blockIdx.x * rpw, r1 = (r0 + rpw < MT) ? r0 + rpw : MT;
    for (int row = r0 + wave; row < r1; row += NWAVES) {
        f32x4 v[8]; float s = 0.f;
#pragma unroll
        for (int j = 0; j < 8; ++j) { const v2u tw = *(const v2u*)(T1 + (size_t)row * WA + j * 256 + lane * 4); v[j] = (f32x4){bflo(tw.x), bfhi(tw.x), bflo(tw.y), bfhi(tw.y)}; s += (v[j].x + v[j].y) + (v[j].z + v[j].w); }
        const float mu = wave_sum(s) * (1.0f / WA); float q = 0.f;
#pragma unroll
        for (int j = 0; j < 8; ++j) { v[j] = v[j] - mu; q += (v[j].x * v[j].x + v[j].y * v[j].y) + (v[j].z * v[j].z + v[j].w * v[j].w); }
        const float rstd = 1.0f / sqrtf(wave_sum(q) * (1.0f / WA) + EPS);
#pragma unroll
        for (int j = 0; j < 8; ++j) { const int o = j * 256 + lane * 4;
            const f32x4 y = (v[j] * rstd) * pg[j * 64 + lane] + pb[j * 64 + lane];
            v2u w; w.x = pk2(siluf_(y.x), siluf_(y.y)); w.y = pk2(siluf_(y.z), siluf_(y.w));
            *(v2u*)(V + (size_t)row * D + o) = w; }
    }
}

template <int NR>
__device__ __forceinline__ void ffn_gate_slide(const bf16* ug, const bf16* uv, int ldu, bf16* Go, const float* cwg, const float* cwv, int row0, int prow, int nrow) {
    float wg[3][8], wv[3][8];
#pragma unroll
    for (int k = 0; k < 3; ++k) {
        const f32x4 a0 = *(const f32x4*)(cwg + k * DFF2), a1 = *(const f32x4*)(cwg + k * DFF2 + 4), b0 = *(const f32x4*)(cwv + k * DFF2), b1 = *(const f32x4*)(cwv + k * DFF2 + 4);
        wg[k][0] = a0.x; wg[k][1] = a0.y; wg[k][2] = a0.z; wg[k][3] = a0.w; wg[k][4] = a1.x; wg[k][5] = a1.y; wg[k][6] = a1.z; wg[k][7] = a1.w;
        wv[k][0] = b0.x; wv[k][1] = b0.y; wv[k][2] = b0.z; wv[k][3] = b0.w; wv[k][4] = b1.x; wv[k][5] = b1.y; wv[k][6] = b1.z; wv[k][7] = b1.w;
    }
    float pg[8], pv[8], cg[8], cv[8];
    { const float fp = prow >= 0 ? 1.f : 0.f; const int pr = prow >= 0 ? prow : row0;
      const v4u a = *(const v4u*)(ug + (size_t)pr * ldu), b = *(const v4u*)(uv + (size_t)pr * ldu); cvt8(a, pg); cvt8(b, pv);
#pragma unroll
      for (int e = 0; e < 8; ++e) { pg[e] *= fp; pv[e] *= fp; }
      const v4u a2 = *(const v4u*)(ug + (size_t)row0 * ldu), b2 = *(const v4u*)(uv + (size_t)row0 * ldu); cvt8(a2, cg); cvt8(b2, cv); }
    const float fn = nrow >= 0 ? 1.f : 0.f; const int nr = nrow >= 0 ? nrow : row0;
    for (int blk = 0; blk < NR / 4; ++blk) {
        v4u rg[4], rv[4];
#pragma unroll
        for (int i = 0; i < 4; ++i) { const int r = 4 * blk + 1 + i; const int rr = r < NR ? row0 + r : nr;
            rg[i] = *(const v4u*)(ug + (size_t)rr * ldu); rv[i] = *(const v4u*)(uv + (size_t)rr * ldu); }
#pragma unroll
        for (int i = 0; i < 4; ++i) {
            float ng[8], nv[8]; cvt8(rg[i], ng); cvt8(rv[i], nv);
            if (i == 3) { const float f = (4 * blk + 4 < NR) ? 1.f : fn;
#pragma unroll
                for (int e = 0; e < 8; ++e) { ng[e] *= f; nv[e] *= f; } }
            float o[8];
#pragma unroll
            for (int e = 0; e < 8; ++e) { const float g = wg[0][e] * pg[e] + wg[1][e] * cg[e] + wg[2][e] * ng[e], v = wv[0][e] * pv[e] + wv[1][e] * cv[e] + wv[2][e] * nv[e]; o[e] = siluf_(g) * v; }
            v4u w; w.x = pk2(o[0], o[1]); w.y = pk2(o[2], o[3]); w.z = pk2(o[4], o[5]); w.w = pk2(o[6], o[7]);
            *(v4u*)(Go + (size_t)(4 * blk + i) * DFF) = w;
#pragma unroll
            for (int e = 0; e < 8; ++e) { pg[e] = cg[e]; pv[e] = cv[e]; cg[e] = ng[e]; cv[e] = nv[e]; }
        }
    }
}
__device__ __forceinline__ void ffn_gate_ctx_phase(CArgs a, int tid) {
    const bf16* UC = (const bf16*)(a->ws + WS_UC);
    bf16* G = (bf16*)(a->ws + WS_G);
    const float* cw = a->in[I_FCONV];
    constexpr int NC8 = DFF / 8;
    constexpr int NIT = 8 * NC8 * 4, PER = (NIT + 255) / 256;
    for (int it = blockIdx.x * PER + tid; tid < PER && it < NIT; it += gridDim.x * PER) {
        const int q4 = it & 3, rest = it >> 2, c8 = rest % NC8, blk = rest / NC8, ch = c8 * 8;
        const int p0 = (blk & 3) * 64 + q4 * 16, lrow0 = (blk >> 2) * CTXL + p0;
        const bf16* ug = UC + 256 * (ch >> 7) + (ch & 127);
        ffn_gate_slide<16>(ug, ug + 128, DFF2, G + (size_t)(ML + lrow0) * DFF + ch, cw + ch, cw + DFF + ch, lrow0, p0 > 0 ? lrow0 - 1 : -1, p0 + 16 < CTXL ? lrow0 + 16 : -1);
    }
}

__device__ __forceinline__ int chunk_row0(int dir, int b, int c) {
    if (dir == 0) return c < 2 ? ML + b * CTXL + 128 * c : b * SEQ + 128 * (c - 2);
    return c < 2 ? ML + b * CTXL + 128 * (1 - c) : b * SEQ + 128 * (63 - (c - 2));
}
__device__ __forceinline__ float wave_incl_sum(float v, int lane) {
#pragma unroll
    for (int o = 1; o < 64; o <<= 1) { const float t = __shfl_up(v, o); if (lane >= o) v += t; }
    return v;
}
__device__ __forceinline__ float wave_incl_max(float v, int lane) {
#pragma unroll
    for (int o = 1; o < 64; o <<= 1) { const float t = __shfl_up(v, o); if (lane >= o) v = fmaxf(v, t); }
    return v;
}
__device__ __forceinline__ bf16x8 tr_frag(LAS unsigned char* T, int pitch, int k0, int col0, int lane) {
    const int g = lane >> 4, q = (lane & 15) >> 2, p = lane & 3;
    LAS unsigned char* p0 = T + (k0 + 8 * g + q) * pitch + (col0 + 4 * p) * 2;
    const s16x4 lo = __builtin_amdgcn_ds_read_tr16_b64_v4i16((LAS s16x4*)p0);
    const s16x4 hi = __builtin_amdgcn_ds_read_tr16_b64_v4i16((LAS s16x4*)(p0 + 4 * pitch));
    bf16x8 r; r[0] = lo[0]; r[1] = lo[1]; r[2] = lo[2]; r[3] = lo[3]; r[4] = hi[0]; r[5] = hi[1]; r[6] = hi[2]; r[7] = hi[3];
    return r;
}
#ifndef SCAN_REP
#define SCAN_REP 1
#endif
#define MFMA16(y, x, acc) __builtin_amdgcn_mfma_f32_16x16x32_bf16((y), (x), (acc), 0, 0, 0)

constexpr int SK_PITCH = 528;

constexpr size_t WS_QT = WS_G;
constexpr size_t WS_SPP = WS_Y;
constexpr size_t WS_DEN = WS_Y + 64 * MiB;
static_assert((size_t)32 * 64 * 128 * 128 * 2 <= 64 * MiB && WS_DEN + (size_t)32 * 64 * 128 * 4 <= WS_HS, "scan scratch");
__device__ __forceinline__ void chunk_scalars(CArgs a, int dir, int b, int h, int c, LAS float* sAl, LAS float* sPl, int lane) {
    const float* GT = (const float*)(a->ws + WS_GATES);
    float* SCP = (float*)(a->ws + WS_SCP); float* SCG = (float*)(a->ws + WS_SCC);
    const int chain = dir * 16 + b * 8 + h, R0 = chunk_row0(dir, b, c);
    const float bi = a->in[I_MBG][dir * 16 + h], bf = a->in[I_MBG][dir * 16 + 8 + h];
    const int r0 = dir ? 127 - lane : lane, r1 = dir ? 63 - lane : 64 + lane;
    const float i0 = GT[(size_t)(R0 + r0) * 32 + dir * 16 + h] + bi, i1 = GT[(size_t)(R0 + r1) * 32 + dir * 16 + h] + bi;
    const float x0 = GT[(size_t)(R0 + r0) * 32 + dir * 16 + 8 + h] + bf, x1 = GT[(size_t)(R0 + r1) * 32 + dir * 16 + 8 + h] + bf;
    const float f0 = fminf(x0, 0.f) - log1pf(__expf(-fabsf(x0))), f1 = fminf(x1, 0.f) - log1pf(__expf(-fabsf(x1)));
    const float s0 = wave_incl_sum(f0, lane); const float tot0 = __shfl(s0, 63);
    const float s1 = wave_incl_sum(f1, lane) + tot0;
    const float a0 = i0 - s0, a1 = i1 - s1;
    const float p0 = wave_incl_max(a0, lane); const float pm0 = __shfl(p0, 63);
    const float p1 = fmaxf(wave_incl_max(a1, lane), pm0);
    float* o = SCP + ((size_t)chain * NCH + c) * 384;
    o[r0] = a0; o[128 + r0] = p0; o[256 + r0] = s0;
    o[r1] = a1; o[128 + r1] = p1; o[256 + r1] = s1;
    if (sAl) { sAl[r0] = a0; sAl[r1] = a1; }
    if (lane == 63) { SCG[((size_t)chain * NCH + c) * 2] = s1; SCG[((size_t)chain * NCH + c) * 2 + 1] = p1; if (sPl) sPl[0] = p1; }
}
__device__ __forceinline__ void scan_pre_phase(CArgs a, LAS unsigned char* lds, int tid, int lane, int wave) {
    const bf16* QK = (const bf16*)(a->ws + WS_U);
    bf16* SPP = (bf16*)(a->ws + WS_SPP); float* DEN = (float*)(a->ws + WS_DEN); const bf16* QT = (const bf16*)(a->ws + WS_QT);
    LAS unsigned char* Kl = lds; LAS float* sA0 = (LAS float*)(lds + 67584); LAS float* sA1 = sA0 + 128; LAS float* sPt = sA0 + 256;
    const int g = lane >> 4, l15 = lane & 15;
    for (int unit = blockIdx.x; unit < 1024 + 64; unit += gridDim.x) {
        if (unit >= 1024) { if (wave == 0) { const int u = unit - 1024, chain = u >> 1, c = u & 1; chunk_scalars(a, chain >> 4, (chain >> 3) & 1, chain & 7, c, nullptr, nullptr, lane); } continue; }
        const int bh = unit >> 6, j = unit & 63, b = bh >> 3, h = bh & 7;
        const int R0 = b * SEQ + 128 * j, c0 = 2 + j, c1 = 2 + (63 - j);
        const int tl = 16 * wave + l15;
#pragma unroll
        for (int i = 0; i < 8; ++i) { const int idx = tid + NTHREADS * i, r = idx >> 5, ch = idx & 31;
            const v4u v = *(const v4u*)(QK + (size_t)(R0 + r) * QKVO + 2048 + h * DQK + ch * 8);
            *(LAS v4u*)(Kl + r * SK_PITCH + ch * 16) = v; }
        bf16x8 qf[8];
#pragma unroll
        for (int kk = 0; kk < 8; ++kk) qf[kk] = *(const bf16x8*)(QT + ((size_t)((R0 >> 4) + wave) * 64 + 8 * h + kk) * 512 + lane * 8);
        if (wave == 0) chunk_scalars(a, 0, b, h, c0, sA0, sPt, lane);
        if (wave == 1) chunk_scalars(a, 1, b, h, c1, sA1, sPt + 1, lane);
        __syncthreads();
        {
            const float pt0 = sPt[0], pt1 = sPt[1];
            float dp0 = 0.f, dp1 = 0.f;
            int tlv = tl, gv = 4 * g; asm volatile("" : "+v"(tlv), "+v"(gv));
            bf16* sp0 = SPP + (size_t)((0 * 16 + bh) * 64 + (c0 - 2)) * 16384 + (size_t)wave * 2048 + (l15 + 16 * (g >> 1)) * 8 + 4 * (g & 1);
            bf16* sp1 = SPP + (size_t)((1 * 16 + bh) * 64 + (c1 - 2)) * 16384 + (size_t)wave * 2048 + (l15 + 16 * (g >> 1)) * 8 + 4 * (g & 1);
#pragma unroll
            for (int nh = 0; nh < 2; ++nh) {
                f32x4 sacc[4];
#pragma unroll
                for (int n = 0; n < 4; ++n) sacc[n] = (f32x4){0.f, 0.f, 0.f, 0.f};
#pragma unroll
                for (int kk = 0; kk < 8; ++kk)
#pragma unroll
                    for (int n = 0; n < 4; ++n) { const bf16x8 yf = *(const LAS bf16x8*)(Kl + (16 * (4 * nh + n) + l15) * SK_PITCH + (32 * kk + 8 * g) * 2); sacc[n] = MFMA16(yf, qf[kk], sacc[n]); }
#pragma unroll
                for (int n = 0; n < 4; ++n) { float sv0[4], sv1[4]; const int n8 = 4 * nh + n;
#pragma unroll
                    for (int r = 0; r < 4; ++r) { const int sl = 16 * n8 + 4 * g + r; const int sidx = gv + (16 * n8 + r);
                        const float qk = sacc[n][r] * 0.0625f;
                        sv0[r] = (sidx <= tlv) ? qk * __expf(sA0[sl] - pt0) : 0.f; dp0 += sv0[r];
                        sv1[r] = (sidx >= tlv) ? qk * __expf(sA1[sl] - pt1) : 0.f; dp1 += sv1[r]; }
                    v2u w0; w0.x = pk2(sv0[0], sv0[1]); w0.y = pk2(sv0[2], sv0[3]); *(v2u*)(sp0 + (n8 >> 1) * 512 + (n8 & 1) * 256) = w0;
                    v2u w1; w1.x = pk2(sv1[0], sv1[1]); w1.y = pk2(sv1[2], sv1[3]); *(v2u*)(sp1 + (n8 >> 1) * 512 + (n8 & 1) * 256) = w1; }
                asm volatile("" ::: "memory");
            }
            dp0 += __shfl_xor(dp0, 16); dp0 += __shfl_xor(dp0, 32); dp1 += __shfl_xor(dp1, 16); dp1 += __shfl_xor(dp1, 32);
            if (g == 0) { DEN[(size_t)((0 * 16 + bh) * 64 + (c0 - 2)) * 128 + tl] = dp0; DEN[(size_t)((1 * 16 + bh) * 64 + (c1 - 2)) * 128 + tl] = dp1; }
        }
        __syncthreads();
    }
}

constexpr int S2V_PITCH = 160;
constexpr int S2K_PITCH = 544;
__device__ __forceinline__ int s2_sigma(int r) { return (r & ~12) | ((r & 4) << 1) | ((r & 8) >> 1); }
__device__ __forceinline__ bf16x8 tr_frag_sw(LAS unsigned char* T, int pitch, int k0, int col0, int lane) {
    const int g = lane >> 4, q = (lane & 15) >> 2, p = lane & 3;
    LAS unsigned char* p0 = T + (k0 + 16 * (g >> 1) + 4 * (g & 1) + q) * pitch + (col0 + 4 * p) * 2;
    const s16x4 lo = __builtin_amdgcn_ds_read_tr16_b64_v4i16((LAS s16x4*)p0);
    const s16x4 hi = __builtin_amdgcn_ds_read_tr16_b64_v4i16((LAS s16x4*)(p0 + 8 * pitch));
    bf16x8 r; r[0] = lo[0]; r[1] = lo[1]; r[2] = lo[2]; r[3] = lo[3]; r[4] = hi[0]; r[5] = hi[1]; r[6] = hi[2]; r[7] = hi[3];
    return r;
}
constexpr int S2K_OFF = 0, S2V_OFF = 128 * S2K_PITCH, S2S_OFF = S2V_OFF + 128 * S2V_PITCH, S2C_OFF = S2S_OFF + 128 * S2V_PITCH, S2M_OFF = S2C_OFF + 80 * SK_PITCH;
static_assert(S2M_OFF + 4 * 272 <= MISC_OFF, "scan v2 LDS map");
#define SCHED_FENCE() do { } while (0)
#define LDS_BARRIER() do { asm volatile("s_waitcnt lgkmcnt(0)" ::: "memory"); __builtin_amdgcn_s_barrier(); asm volatile("" ::: "memory"); } while (0)
__device__ __forceinline__ void scan_seq_phase(CArgs a, LAS unsigned char* lds, int tid, int lane, int wave) {
    const bf16* QK = (const bf16*)(a->ws + WS_U);
    const float* SCP = (const float*)(a->ws + WS_SCP); const float* SCG = (const float*)(a->ws + WS_SCC);
    const bf16* SPP = (const bf16*)(a->ws + WS_SPP); const float* DEN = (const float*)(a->ws + WS_DEN); const bf16* QT = (const bf16*)(a->ws + WS_QT);
    bf16* HS = (bf16*)(a->ws + WS_HS);
    LAS unsigned char* Kl = lds + S2K_OFF; LAS unsigned char* Vl = lds + S2V_OFF; LAS unsigned char* Vs = lds + S2S_OFF; LAS unsigned char* Cl = lds + S2C_OFF;
    LAS float* mp = (LAS float*)(lds + S2M_OFF); LAS float* ml = mp + 68; LAS float* pt = mp + 136; LAS float* gl = mp + 204;
    for (int unit_ = blockIdx.x; unit_ < 256 * SCAN_REP; unit_ += gridDim.x) { const int u0 = unit_ & 255, unit = ((u0 & 7) << 5) | (u0 >> 3);
        const int chain = unit >> 3, slice = unit & 7, dir = chain >> 4, b = (chain >> 3) & 1, h = chain & 7;
        int tid_u = tid; asm volatile("" : "+v"(tid_u));
        if (tid < NCH) { gl[tid] = SCG[((size_t)chain * NCH + tid) * 2]; pt[tid] = SCG[((size_t)chain * NCH + tid) * 2 + 1]; }
        for (int i = tid_u; i < 80 * SK_PITCH / 4; i += NTHREADS) ((LAS unsigned*)Cl)[i] = 0u;
        for (int i = tid_u; i < 128 * 8; i += NTHREADS) { const int r = i >> 3, w = i & 7; ((LAS unsigned*)(Vs + r * S2V_PITCH + 128))[w] = 0u; }
        __syncthreads();
        if (tid == 0) { float m = 0.f; for (int c = 0; c < NCH; ++c) { const float mx = fmaxf(m, pt[c]); mp[c] = m; ml[c] = mx; m = gl[c] + mx; } }
        __syncthreads();
        f32x4 cacc[5][2];
#pragma unroll
        for (int mt = 0; mt < 5; ++mt)
#pragma unroll
            for (int nt = 0; nt < 2; ++nt) cacc[mt][nt] = (f32x4){0.f, 0.f, 0.f, 0.f};
        v4u kreg[8], vreg[2]; float areg[2];
#define S2_LOAD(cc, T) do { const unsigned koff = (unsigned)((((T) >> 5) * QKVO + ((T) & 31) * 8) * 2), voff = (unsigned)((((T) >> 3) * QKVO + ((T) & 7) * 8) * 2); const int R1_ = chunk_row0(dir, b, (cc)); const char* kb_ = (const char*)(QK + (size_t)R1_ * QKVO + 2048 + h * DQK); const char* vb_ = (const char*)(QK + (size_t)R1_ * QKVO + 4096 + h * DV + slice * 64); \
            const float* ab_ = SCP + ((size_t)chain * NCH + (cc)) * 384; \
            _Pragma("unroll") for (int i = 0; i < 8; ++i) kreg[i] = *(const v4u*)(kb_ + (koff + (unsigned)(i * 16 * QKVO * 2))); \
            _Pragma("unroll") for (int i = 0; i < 2; ++i) { vreg[i] = *(const v4u*)(vb_ + (voff + (unsigned)(i * 64 * QKVO * 2))); areg[i] = ab_[((T) >> 3) + 64 * i]; } } while (0)
#define S2_STORE(cc, T) do { const float mlc_ = ml[(cc)]; \
            _Pragma("unroll") for (int i = 0; i < 8; ++i) { const int idx = (T) + NTHREADS * i, r = idx >> 5, ch = idx & 31; *(LAS v4u*)(Kl + s2_sigma(r) * S2K_PITCH + ch * 16) = kreg[i]; } \
            _Pragma("unroll") for (int i = 0; i < 2; ++i) { const int idx = (T) + NTHREADS * i, r = idx >> 3, ch = idx & 7; const float ws_ = __expf(areg[i] - mlc_) * 0.0625f;     \
                *(LAS v4u*)(Vl + s2_sigma(r) * S2V_PITCH + ch * 16) = vreg[i]; \
                v4u sc_; sc_.x = pk2(bflo(vreg[i].x) * ws_, bfhi(vreg[i].x) * ws_); sc_.y = pk2(bflo(vreg[i].y) * ws_, bfhi(vreg[i].y) * ws_); sc_.z = pk2(bflo(vreg[i].z) * ws_, bfhi(vreg[i].z) * ws_); sc_.w = pk2(bflo(vreg[i].w) * ws_, bfhi(vreg[i].w) * ws_); \
                *(LAS v4u*)(Vs + s2_sigma(r) * S2V_PITCH + ch * 16) = sc_; \
                if (ch == 0) *(LAS unsigned*)(Vs + s2_sigma(r) * S2V_PITCH + 128) = f2bf(ws_); } } while (0)
        S2_LOAD(0, tid_u); S2_STORE(0, tid_u);
        __syncthreads();
#define S2_OUTP false
        for (int c = 0; c < 2; ++c) {
            const int R0 = chunk_row0(dir, b, c);
            const float m_prev = mp[c], m_last = ml[c], ptot = pt[c];
            constexpr bool outp = S2_OUTP; const bool more = (c + 1 < NCH);
            int tid_o = tid; asm volatile("" : "+v"(tid_o));
            const int lane_o = tid_o & 63, g = lane_o >> 4, l15 = lane_o & 15, tl = 16 * wave + l15;
            bf16x8 qf[8], sf[4]; float pv = 0.f, bv = 0.f, dn = 0.f;
            v2u hw[4] = {{0u, 0u}, {0u, 0u}, {0u, 0u}, {0u, 0u}}; v4u hv[2] = {{0u, 0u, 0u, 0u}, {0u, 0u, 0u, 0u}};
            if (outp) {
                const char* qb = (const char*)(QT + ((size_t)((R0 >> 4) + wave) * 64 + 8 * h) * 512); const unsigned qoff = (unsigned)(lane_o * 16);
#pragma unroll
                for (int kk = 0; kk < 8; ++kk) qf[kk] = *(const bf16x8*)(qb + (qoff + (unsigned)(kk * 1024)));
                const float* scp = SCP + ((size_t)chain * NCH + c) * 384;
                pv = scp[128 + tl]; bv = scp[256 + tl]; dn = DEN[(size_t)(chain * 64 + (c - 2)) * 128 + tl];
            }
            SCHED_FENCE();
            const float w_old = __expf(m_prev - m_last);
#pragma unroll
            for (int mt = 0; mt < 5; ++mt)
#pragma unroll
                for (int nt = 0; nt < 2; ++nt) cacc[mt][nt] = cacc[mt][nt] * w_old;
#pragma unroll
            for (int kk = 0; kk < 4; ++kk) {
                bf16x8 yf[2], xf[5];
#pragma unroll
                for (int nt = 0; nt < 2; ++nt) yf[nt] = tr_frag_sw(Kl, S2K_PITCH, 32 * kk, 32 * wave + 16 * nt, lane_o);
#pragma unroll
                for (int mt = 0; mt < 5; ++mt) xf[mt] = tr_frag_sw(Vs, S2V_PITCH, 32 * kk, 16 * mt, lane_o);
                SCHED_FENCE();
#pragma unroll
                for (int mt = 0; mt < 5; ++mt)
#pragma unroll
                    for (int nt = 0; nt < 2; ++nt) cacc[mt][nt] = MFMA16(yf[nt], xf[mt], cacc[mt][nt]);
                SCHED_FENCE();
            }
            if (outp) { const char* sb = (const char*)(SPP + (size_t)(chain * 64 + (c - 2)) * 16384 + (size_t)wave * 2048); const unsigned soff = (unsigned)(lane_o * 16);
#pragma unroll
                for (int kk = 0; kk < 4; ++kk) sf[kk] = *(const bf16x8*)(sb + (soff + (unsigned)(kk * 1024))); }
            if (more) S2_LOAD(c + 1, tid_o);
            SCHED_FENCE();
            if (outp) {
                f32x4 qacc[5];
#pragma unroll
                for (int n = 0; n < 5; ++n) qacc[n] = (f32x4){0.f, 0.f, 0.f, 0.f};
#pragma unroll
                for (int kk = 0; kk < 8; ++kk) {
                    bf16x8 cf[5];
#pragma unroll
                    for (int n = 0; n < 5; ++n) cf[n] = *(const LAS bf16x8*)(Cl + (16 * n + l15) * SK_PITCH + (32 * kk + 8 * g) * 2);
                    SCHED_FENCE();
#pragma unroll
                    for (int n = 0; n < 5; ++n) qacc[n] = MFMA16(cf[n], qf[kk], qacc[n]);
                    SCHED_FENCE();
                }
                f32x4 nacc[4];
#pragma unroll
                for (int n = 0; n < 4; ++n) nacc[n] = (f32x4){0.f, 0.f, 0.f, 0.f};
#pragma unroll
                for (int k2 = 0; k2 < 4; k2 += 2) {
                    bf16x8 vf[2][4];
#pragma unroll
                    for (int u = 0; u < 2; ++u)
#pragma unroll
                        for (int n = 0; n < 4; ++n) vf[u][n] = tr_frag_sw(Vl, S2V_PITCH, 32 * (k2 + u), 16 * n, lane_o);
                    SCHED_FENCE();
#pragma unroll
                    for (int u = 0; u < 2; ++u)
#pragma unroll
                        for (int n = 0; n < 4; ++n) nacc[n] = MFMA16(vf[u][n], sf[k2 + u], nacc[n]);
                    SCHED_FENCE();
                }
                const float mxt = fmaxf(m_prev, pv), rowfac = __expf(ptot - mxt), winter = __expf(m_prev - mxt);
                const float nq = __shfl(qacc[4][0], l15);
                const float den = rowfac * dn + winter * nq;
                const float inv = 1.0f / fmaxf(fabsf(den), __expf(-bv - mxt));
#pragma unroll
                for (int n = 0; n < 4; ++n) { const f32x4 o = (nacc[n] * rowfac + qacc[n] * winter) * inv; hw[n].x = pk2(o.x, o.y); hw[n].y = pk2(o.z, o.w); }
                bf16* hp = HS + ((size_t)dir * ML + R0 + tl) * D + h * DV + slice * 64 + 8 * g;
                const int src0 = l15 + 16 * (2 * (g & 1)), src1 = src0 + 16; const bool hi_n = (g >> 1) != 0;
#pragma unroll
                for (int k = 0; k < 2; ++k) {
                    const unsigned a0x = __shfl(hw[2 * k].x, src0), a0y = __shfl(hw[2 * k].y, src0), a1x = __shfl(hw[2 * k].x, src1), a1y = __shfl(hw[2 * k].y, src1);
                    const unsigned b0x = __shfl(hw[2 * k + 1].x, src0), b0y = __shfl(hw[2 * k + 1].y, src0), b1x = __shfl(hw[2 * k + 1].x, src1), b1y = __shfl(hw[2 * k + 1].y, src1);
                    hv[k].x = hi_n ? b0x : a0x; hv[k].y = hi_n ? b0y : a0y; hv[k].z = hi_n ? b1x : a1x; hv[k].w = hi_n ? b1y : a1y;
                    *(v4u*)(hp + 32 * k) = hv[k]; }
            }
            LDS_BARRIER();
#pragma unroll
            for (int mt = 0; mt < 5; ++mt)
#pragma unroll
                for (int nt = 0; nt < 2; ++nt) { v2u w; w.x = pk2(cacc[mt][nt][0], cacc[mt][nt][1]); w.y = pk2(cacc[mt][nt][2], cacc[mt][nt][3]);
                    *(LAS v2u*)(Cl + (16 * mt + l15) * SK_PITCH + (32 * wave + 16 * nt + 4 * g) * 2) = w; }
            if (more) S2_STORE(c + 1, tid_o);
            asm volatile("" :: "v"(hv[0]), "v"(hv[1]));
            LDS_BARRIER();
                }
#undef S2_OUTP
#define S2_OUTP true
        for (int c = 2; c < NCH; ++c) {
            const int R0 = chunk_row0(dir, b, c);
            const float m_prev = mp[c], m_last = ml[c], ptot = pt[c];
            constexpr bool outp = S2_OUTP; const bool more = (c + 1 < NCH);
            int tid_o = tid; asm volatile("" : "+v"(tid_o));
            const int lane_o = tid_o & 63, g = lane_o >> 4, l15 = lane_o & 15, tl = 16 * wave + l15;
            bf16x8 qf[8], sf[4]; float pv = 0.f, bv = 0.f, dn = 0.f;
            v2u hw[4] = {{0u, 0u}, {0u, 0u}, {0u, 0u}, {0u, 0u}}; v4u hv[2] = {{0u, 0u, 0u, 0u}, {0u, 0u, 0u, 0u}};
            if (outp) {
                const char* qb = (const char*)(QT + ((size_t)((R0 >> 4) + wave) * 64 + 8 * h) * 512); const unsigned qoff = (unsigned)(lane_o * 16);
#pragma unroll
                for (int kk = 0; kk < 8; ++kk) qf[kk] = *(const bf16x8*)(qb + (qoff + (unsigned)(kk * 1024)));
                const float* scp = SCP + ((size_t)chain * NCH + c) * 384;
                pv = scp[128 + tl]; bv = scp[256 + tl]; dn = DEN[(size_t)(chain * 64 + (c - 2)) * 128 + tl];
            }
            SCHED_FENCE();
            const float w_old = __expf(m_prev - m_last);
#pragma unroll
            for (int mt = 0; mt < 5; ++mt)
#pragma unroll
                for (int nt = 0; nt < 2; ++nt) cacc[mt][nt] = cacc[mt][nt] * w_old;
#pragma unroll
            for (int kk = 0; kk < 4; ++kk) {
                bf16x8 yf[2], xf[5];
#pragma unroll
                for (int nt = 0; nt < 2; ++nt) yf[nt] = tr_frag_sw(Kl, S2K_PITCH, 32 * kk, 32 * wave + 16 * nt, lane_o);
#pragma unroll
                for (int mt = 0; mt < 5; ++mt) xf[mt] = tr_frag_sw(Vs, S2V_PITCH, 32 * kk, 16 * mt, lane_o);
                SCHED_FENCE();
#pragma unroll
                for (int mt = 0; mt < 5; ++mt)
#pragma unroll
                    for (int nt = 0; nt < 2; ++nt) cacc[mt][nt] = MFMA16(yf[nt], xf[mt], cacc[mt][nt]);
                SCHED_FENCE();
            }
            if (outp) { const char* sb = (const char*)(SPP + (size_t)(chain * 64 + (c - 2)) * 16384 + (size_t)wave * 2048); const unsigned soff = (unsigned)(lane_o * 16);
#pragma unroll
                for (int kk = 0; kk < 4; ++kk) sf[kk] = *(const bf16x8*)(sb + (soff + (unsigned)(kk * 1024))); }
            if (more) S2_LOAD(c + 1, tid_o);
            SCHED_FENCE();
            if (outp) {
                f32x4 qacc[5];
#pragma unroll
                for (int n = 0; n < 5; ++n) qacc[n] = (f32x4){0.f, 0.f, 0.f, 0.f};
#pragma unroll
                for (int kk = 0; kk < 8; ++kk) {
                    bf16x8 cf[5];
#pragma unroll
                    for (int n = 0; n < 5; ++n) cf[n] = *(const LAS bf16x8*)(Cl + (16 * n + l15) * SK_PITCH + (32 * kk + 8 * g) * 2);
                    SCHED_FENCE();
#pragma unroll
                    for (int n = 0; n < 5; ++n) qacc[n] = MFMA16(cf[n], qf[kk], qacc[n]);
                    SCHED_FENCE();
                }
                f32x4 nacc[4];
#pragma unroll
                for (int n = 0; n < 4; ++n) nacc[n] = (f32x4){0.f, 0.f, 0.f, 0.f};
#pragma unroll
                for (int k2 = 0; k2 < 4; k2 += 2) {
                    bf16x8 vf[2][4];
#pragma unroll
                    for (int u = 0; u < 2; ++u)
#pragma unroll
                        for (int n = 0; n < 4; ++n) vf[u][n] = tr_frag_sw(Vl, S2V_PITCH, 32 * (k2 + u), 16 * n, lane_o);
                    SCHED_FENCE();
#pragma unroll
                    for (int u = 0; u < 2; ++u)
#pragma unroll
                        for (int n = 0; n < 4; ++n) nacc[n] = MFMA16(vf[u][n], sf[k2 + u], nacc[n]);
                    SCHED_FENCE();
                }
                const float mxt = fmaxf(m_prev, pv), rowfac = __expf(ptot - mxt), winter = __expf(m_prev - mxt);
                const float nq = __shfl(qacc[4][0], l15);
                const float den = rowfac * dn + winter * nq;
                const float inv = 1.0f / fmaxf(fabsf(den), __expf(-bv - mxt));
#pragma unroll
                for (int n = 0; n < 4; ++n) { const f32x4 o = (nacc[n] * rowfac + qacc[n] * winter) * inv; hw[n].x = pk2(o.x, o.y); hw[n].y = pk2(o.z, o.w); }
                bf16* hp = HS + ((size_t)dir * ML + R0 + tl) * D + h * DV + slice * 64 + 8 * g;
                const int src0 = l15 + 16 * (2 * (g & 1)), src1 = src0 + 16; const bool hi_n = (g >> 1) != 0;
#pragma unroll
                for (int k = 0; k < 2; ++k) {
                    const unsigned a0x = __shfl(hw[2 * k].x, src0), a0y = __shfl(hw[2 * k].y, src0), a1x = __shfl(hw[2 * k].x, src1), a1y = __shfl(hw[2 * k].y, src1);
                    const unsigned b0x = __shfl(hw[2 * k + 1].x, src0), b0y = __shfl(hw[2 * k + 1].y, src0), b1x = __shfl(hw[2 * k + 1].x, src1), b1y = __shfl(hw[2 * k + 1].y, src1);
                    hv[k].x = hi_n ? b0x : a0x; hv[k].y = hi_n ? b0y : a0y; hv[k].z = hi_n ? b1x : a1x; hv[k].w = hi_n ? b1y : a1y;
                    *(v4u*)(hp + 32 * k) = hv[k]; }
            }
            LDS_BARRIER();
#pragma unroll
            for (int mt = 0; mt < 5; ++mt)
#pragma unroll
                for (int nt = 0; nt < 2; ++nt) { v2u w; w.x = pk2(cacc[mt][nt][0], cacc[mt][nt][1]); w.y = pk2(cacc[mt][nt][2], cacc[mt][nt][3]);
                    *(LAS v2u*)(Cl + (16 * mt + l15) * SK_PITCH + (32 * wave + 16 * nt + 4 * g) * 2) = w; }
            if (more) S2_STORE(c + 1, tid_o);
            asm volatile("" :: "v"(hv[0]), "v"(hv[1]));
            LDS_BARRIER();
                }
#undef S2_OUTP
#undef S2_LOAD
#undef S2_STORE
    }
}

__device__ __forceinline__ void scan_out_phase(CArgs a, LAS unsigned char* lds, int tid, int lane, int wave) {
    const bf16* HS = (const bf16*)(a->ws + WS_HS);
    const bf16* QK = (const bf16*)(a->ws + WS_U);
    bf16* A2 = (bf16*)(a->ws + WS_G);
    LAS f32x4* pg = (LAS f32x4*)lds;
    for (int i = tid; i < 1024; i += NTHREADS) pg[i] = ((const f32x4*)a->in[I_MHNG])[i];
    __syncthreads();
    const int G = gridDim.x, rpw = (ML + G - 1) / G, r0 = (int)blockIdx.x * rpw, r1 = (r0 + rpw < ML) ? r0 + rpw : ML;
    for (int row = r0 + wave; row < r1; row += NWAVES) {
        const bf16* hfp = HS + (size_t)row * D + lane * 8; const bf16* hbp = hfp + (size_t)ML * D; const bf16* op = QK + (size_t)row * QKVO + 8192 + lane * 8; bf16* ap = A2 + (size_t)row * D + lane * 8;
#pragma unroll 1
        for (int hb4 = 0; hb4 < HEADS; hb4 += 4) {
            v4u hf[4], hb[4], ov[4];
#pragma unroll
            for (int i = 0; i < 4; ++i) { hf[i] = *(const v4u*)(hfp + (hb4 + i) * DV); hb[i] = *(const v4u*)(hbp + (hb4 + i) * DV); ov[i] = *(const v4u*)(op + (hb4 + i) * DV); }
#pragma unroll
            for (int i = 0; i < 4; ++i) {
                const f32x4 va = {bflo(hf[i].x) + bflo(hb[i].x), bfhi(hf[i].x) + bfhi(hb[i].x), bflo(hf[i].y) + bflo(hb[i].y), bfhi(hf[i].y) + bfhi(hb[i].y)};
                const f32x4 vb = {bflo(hf[i].z) + bflo(hb[i].z), bfhi(hf[i].z) + bfhi(hb[i].z), bflo(hf[i].w) + bflo(hb[i].w), bfhi(hf[i].w) + bfhi(hb[i].w)};
                const float s = ((va.x * va.x + va.y * va.y) + (va.z * va.z + va.w * va.w)) + ((vb.x * vb.x + vb.y * vb.y) + (vb.z * vb.z + vb.w * vb.w));
                const float rstd = 1.0f / sqrtf(wave_sum(s) * (1.0f / DV) + EPS);
                const f32x4 ga = pg[((hb4 + i) * DV) / 4 + lane * 2], gb = pg[((hb4 + i) * DV) / 4 + lane * 2 + 1];
                const f32x4 ya = (va * rstd) * ga, yb = (vb * rstd) * gb;
                v4u w; w.x = pk2(ya.x * sigmoidf_(bflo(ov[i].x)), ya.y * sigmoidf_(bfhi(ov[i].x))); w.y = pk2(ya.z * sigmoidf_(bflo(ov[i].y)), ya.w * sigmoidf_(bfhi(ov[i].y)));
                w.z = pk2(yb.x * sigmoidf_(bflo(ov[i].z)), yb.y * sigmoidf_(bfhi(ov[i].z))); w.w = pk2(yb.z * sigmoidf_(bflo(ov[i].w)), yb.w * sigmoidf_(bfhi(ov[i].w)));
                *(v4u*)(ap + (hb4 + i) * DV) = w; }
        }
    }
}

constexpr int NPHASES = 21;
__global__ void __launch_bounds__(NTHREADS, 2) fwd_kernel(Args args_unused) {
    extern __shared__ __attribute__((aligned(16))) unsigned char lds_raw[];
    LAS unsigned char* lds = (LAS unsigned char*)lds_raw;
    const int wave_s = __builtin_amdgcn_readfirstlane((int)threadIdx.x >> 6);
    { const int tid = threadIdx.x; volatile LAS unsigned* MISC = (volatile LAS unsigned*)(lds + MISC_OFF);
      if (tid < 16) MISC[tid] = 0u;
      __syncthreads();
      if (!MK_PER_PHASE) (void)xcd_barrier_post((unsigned*)(get_args()->ws + WS_CTL) + CW_BAR, MISC); }
#define PH_IDS for (int tid = opaque_tid(wave_s), lane = tid & 63, wave = __builtin_amdgcn_readfirstlane(tid >> 6), once_ = 1; once_; once_ = 0)
#if MK_PER_PHASE
#define IN(k) (get_args()->ph_lo == (k)) PH_IDS if (true
#define SEAM(k) do { } while (0)
#else
#ifndef PROBE_PHASE
#define PROBE_PHASE -1
#endif
#define IN(k) true) for (int rep_ = 0; rep_ < ((k) == PROBE_PHASE ? 2 : 1); ++rep_) PH_IDS if (true
#define SEAM(k) do { XcdBarrier b_; b_.bar = (unsigned*)(get_args()->ws + WS_CTL) + CW_BAR; b_.x = xb_xcc_id(); b_.st = (volatile LAS unsigned*)(lds + MISC_OFF); xcd_barrier(b_); } while (0)
#endif
#define WSP(off) (get_args()->ws + (off))
#define MODP(layer) ((const float*)WSP(WS_MOD) + (layer) * 3 * NMODC)
#define NGP(i) (get_args()->in[I_NORMG] + (i) * D)

#define GEMM_PHASE(EPI, A_, B_, M_, N_, K_, EINIT, HAS_SIDE, SIDE) { const int nwg_ = ((M_) / 256) * ((N_) / 256), gg_ = (HAS_SIDE) ? gemm_wgs(nwg_) : (int)gridDim.x; \
        if ((int)blockIdx.x < gg_) { pg8::Gemm g{A_, B_, M_, N_, K_}; pg8::StaticOrder S; S.init(M_, N_, gg_, blockIdx.x); EPI E EINIT; pg8::gemm_phase<EPI, pg8::StaticOrder, true, true>(lds, g, S, E, tid); } \
          \
        const int t0_ = (HAS_SIDE) ? gg_ : ((nwg_ % (int)gridDim.x) ? nwg_ % (int)gridDim.x : (int)gridDim.x); \
        if (!PROBE_E1 && (int)blockIdx.x >= t0_) { const int si_ = (int)blockIdx.x - t0_, ns_ = (int)gridDim.x - t0_, sf_ = si_ * NWAVES + wave, sn_ = ns_ * NWAVES; (void)si_; (void)ns_; (void)sf_; (void)sn_; SIDE } }

    if (IN(0)) { p0_prologue(get_args(), lds, tid, lane, wave); __syncthreads(); } SEAM(0);
    if (IN(1)) { CArgs a = get_args(); row_phase<false, true>(lds, MT, a->in[I_X], a->in[I_CTX], nullptr, nullptr, nullptr, nullptr, nullptr, 0, NGP(0), MODP(0), 0, 1, (bf16*)WSP(WS_H), tid, lane, wave); }
    SEAM(1);
    if (IN(2)) GEMM_PHASE(pg8::EpiAB, (const bf16*)WSP(WS_H), (const bf16*)WSP(WS_WABIN), MT, ABIN, D, ({(bf16*)WSP(WS_U)}), false,
                          conv_matrix<CV_ABOUT>(get_args(), lds, sf_, sn_, lane, wave);)
    SEAM(2);
    if (IN(3)) mixer_conv_phase(get_args(), lds, tid, lane);
    SEAM(3);
    if (IN(4)) mixer_ln_phase(get_args(), lds, tid, lane, wave);
    SEAM(4);
    if (IN(5)) GEMM_PHASE(pg8::EpiBf16, (const bf16*)WSP(WS_G), (const bf16*)WSP(WS_WABOUT), MT, D, D, ({(bf16*)WSP(WS_Y), D}), true,
                          conv_matrix<CV_UP0>(get_args(), lds, sf_, sn_, lane, wave);)
    SEAM(5);
    if (IN(6)) { CArgs a = get_args(); row_phase<true, true>(lds, MT, a->in[I_X], a->in[I_CTX], a->out, (float*)WSP(WS_CTXS), (const bf16*)WSP(WS_Y), NGP(1), MODP(0), 2, NGP(2), MODP(0), 3, 4, (bf16*)WSP(WS_H), tid, lane, wave); }
    SEAM(6);
    if (IN(7)) GEMM_PHASE(pg8::EpiGate, (const bf16*)WSP(WS_H), (const bf16*)WSP(WS_WUP0), MT, DFF2, D, ({(bf16*)WSP(WS_G), (bf16*)WSP(WS_UC), get_args()->in[I_FCONV]}), false,
                          conv_matrix<CV_DN0>(get_args(), lds, sf_, sn_, lane, wave);)
    SEAM(7);
    if (IN(8)) ffn_gate_ctx_phase(get_args(), tid);
    SEAM(8);
    if (IN(9)) GEMM_PHASE(pg8::EpiBf16, (const bf16*)WSP(WS_G), (const bf16*)WSP(WS_WDN0), MT, D, DFF, ({(bf16*)WSP(WS_Y), D}), true,
                          gemv_units(get_args(), lds, 1, si_, ns_, tid, lane, wave);
                          conv_matrix<CV_MIN>(get_args(), lds, sf_, sn_, lane, wave); conv_matrix<CV_MOUT>(get_args(), lds, sf_, sn_, lane, wave);
                          conv_matrix<CV_UP1>(get_args(), lds, sf_, sn_, lane, wave);)
    SEAM(9);
    if (IN(10)) { CArgs a = get_args(); float* ct = (float*)WSP(WS_CTXS); row_phase<true, true>(lds, MT, a->out, ct, a->out, ct, (const bf16*)WSP(WS_Y), NGP(3), MODP(0), 5, NGP(4), MODP(1), 0, 1, (bf16*)WSP(WS_H), tid, lane, wave); }
    SEAM(10);
    if (IN(11)) GEMM_PHASE(pg8::EpiMIn, (const bf16*)WSP(WS_H), (const bf16*)WSP(WS_WMIN), MT, CINP, D, ({(bf16*)WSP(WS_U), QKVO, (float*)WSP(WS_GATES), (bf16*)WSP(WS_QT)}), false,
                           conv_matrix<CV_DN1>(get_args(), lds, sf_, sn_, lane, wave);)
    SEAM(11);
    if (IN(12)) scan_pre_phase(get_args(), lds, tid, lane, wave);
    SEAM(12);
    if (IN(13)) scan_seq_phase(get_args(), lds, tid, lane, wave);
    SEAM(13);
    if (IN(14)) scan_out_phase(get_args(), lds, tid, lane, wave);
    SEAM(14);
    if (IN(15)) GEMM_PHASE(pg8::EpiBf16, (const bf16*)WSP(WS_G), (const bf16*)WSP(WS_WMOUT), ML, D, D, ({(bf16*)WSP(WS_Y), D}), false, ;)
    SEAM(15);
    if (IN(16)) { CArgs a = get_args(); float* ct = (float*)WSP(WS_CTXS); row_phase<true, true>(lds, ML, a->out, ct, a->out, ct, (const bf16*)WSP(WS_Y), NGP(5), MODP(1), 2, NGP(6), MODP(1), 3, 4, (bf16*)WSP(WS_H), tid, lane, wave); }
    SEAM(16);
    if (IN(17)) GEMM_PHASE(pg8::EpiGate, (const bf16*)WSP(WS_H), (const bf16*)WSP(WS_WUP0 + 172 * MiB), ML, DFF2, D, ({(bf16*)WSP(WS_G), (bf16*)WSP(WS_UC), get_args()->in[I_FCONV] + 3 * DFF2}), false, ;)
    SEAM(17);
    if (IN(19)) GEMM_PHASE(pg8::EpiBf16, (const bf16*)WSP(WS_G), (const bf16*)WSP(WS_WDN0 + 86 * MiB), ML, D, DFF, ({(bf16*)WSP(WS_Y), D}), false, ;)
    SEAM(19);
    if (IN(20)) { CArgs a = get_args(); float* ct = (float*)WSP(WS_CTXS); row_phase<true, false>(lds, ML, a->out, ct, a->out, ct, (const bf16*)WSP(WS_Y), NGP(7), MODP(1), 5, nullptr, nullptr, 0, 0, nullptr, tid, lane, wave); }
#undef IN
#undef SEAM
}

extern "C" void kernel_launch(void* const* d_in, const int* in_sizes, int n_in, void* d_out, int out_size, void* d_ws, size_t ws_size, hipStream_t stream) {
    static int grid = 0;
    if (grid == 0) {
        if (n_in != 21 || out_size != ML * D || ws_size < WS_END) { fprintf(stderr, "kernel_launch: unexpected problem (n_in %d, out %d, ws %zu < %zu); nothing launched\n", n_in, out_size, ws_size, (size_t)WS_END); grid = -1; return; }
        int dev = 0, cus = 0, per_cu = 0;
        if (hipGetDevice(&dev) != hipSuccess || hipDeviceGetAttribute(&cus, hipDeviceAttributeMultiprocessorCount, dev) != hipSuccess) { grid = -1; return; }
        if (hipFuncSetAttribute((const void*)fwd_kernel, hipFuncAttributeMaxDynamicSharedMemorySize, LDS_BYTES) != hipSuccess) { fprintf(stderr, "kernel_launch: hipFuncSetAttribute failed\n"); grid = -1; return; }
        if (hipOccupancyMaxActiveBlocksPerMultiprocessor(&per_cu, (const void*)fwd_kernel, NTHREADS, LDS_BYTES) != hipSuccess || per_cu < 1)
            fprintf(stderr, "kernel_launch: occupancy query reports %d workgroups per CU\n", per_cu);
        (void)hipGetLastError();
        grid = cus;
    }
    if (grid < 0) return;
    if (hipMemsetAsync((char*)d_ws + WS_CTL, 0, CTL_ZERO_BYTES, stream) != hipSuccess) return;
    Args a{};
    for (int i = 0; i < 21; ++i) a.in[i] = (const float*)d_in[i];
    a.out = (float*)d_out; a.ws = (unsigned char*)d_ws;
#if MK_PER_PHASE
    for (int p = 0; p < NPHASES; ++p) { a.ph_lo = p; a.ph_hi = p + 1; hipLaunchKernelGGL(fwd_kernel, dim3(grid), dim3(NTHREADS), LDS_BYTES, stream, a); }
#else
    a.ph_lo = 0; a.ph_hi = NPHASES;
    hipLaunchKernelGGL(fwd_kernel, dim3(grid), dim3(NTHREADS), LDS_BYTES, stream, a);
#endif
}
```

```cpp
#include <hip/hip_runtime.h>
#include <cstdio>
#include <cstdint>

#ifndef PROBE_E1
#define PROBE_E1 0
#endif
#ifndef MK_PER_PHASE
#define MK_PER_PHASE 0
#endif

namespace pg8 {
#define PG8_LAS __attribute__((address_space(3)))
typedef unsigned short bf16_t;
typedef short bf16x8 __attribute__((ext_vector_type(8)));
typedef float f32x4 __attribute__((ext_vector_type(4)));
typedef unsigned u32x4 __attribute__((ext_vector_type(4)));
constexpr int BM = 256, BK = 64, HALF = 128, HTB = HALF * BK * 2, STAGE_BYTES = 8 * HTB, NXCD = 8, WGM = 4;

__host__ __device__ __forceinline__ int lds_byte(int r, int c) { const int st = (r >> 4) * 2 + (c >> 5), rr = r & 15, cc = c & 31, ob = rr * 64 + cc * 2; return st * 1024 + (ob ^ (((ob >> 9) & 1) << 5)); }
__host__ __device__ __forceinline__ void stage_rc(int b, int& R, int& C) { const int st = b / 1024, sb = b % 1024, swz = sb ^ (((sb >> 9) & 1) << 5); R = (st >> 1) * 16 + swz / 64; C = (st & 1) * 32 + (swz % 64) / 2; }
__host__ __device__ __forceinline__ int perm32(int rho) { const int n = rho >> 4, i = rho & 15; return 8 * (i >> 2) + 4 * n + (i & 3); }

struct Unit { int pm, pn; };
struct Gemm { const bf16_t* A; const bf16_t* Bt; int M, N, K; };

struct StaticOrder {
    int nM, nN, nwg, G, c;
    __host__ __device__ void init(int M, int N, int G_, int c_) { nM = M / BM; nN = N / BM; nwg = nM * nN; G = G_; c = c_; }
    __host__ __device__ bool next(int i, Unit& u) const {
        const long L = (long)i * G + c; if (L >= nwg) return false;
        int wgid = (int)L; { const int q = nwg / NXCD, r = nwg % NXCD, xcd = wgid % NXCD, off = wgid / NXCD; wgid = (xcd < r ? xcd * (q + 1) : r * (q + 1) + (xcd - r) * q) + off; }
        const int nig = WGM * nN, gid = wgid / nig, fm = gid * WGM, gsz = (nM - fm) < WGM ? (nM - fm) : WGM;
        u.pm = fm + ((wgid % nig) % gsz); u.pn = (wgid % nig) / gsz; return true;
    }
    __device__ __forceinline__ void a_ready(const Unit&) const {}
    __device__ __forceinline__ void done(const Unit&) const {}
};

__device__ __forceinline__ unsigned cvt_pk_bf16(float lo, float hi) { unsigned r; asm volatile("v_cvt_pk_bf16_f32 %0, %1, %2" : "=v"(r) : "v"(lo), "v"(hi)); return r; }

struct EpiBf16 {
    static constexpr bool PERM = true, AFTER_DRAIN = false, PERM_A = false;
    bf16_t* O; int ldc;
    __device__ __forceinline__ void operator()(const f32x4 (&acc)[2][2][4][2], const Unit& u, int wr, int wc, int fr, int fq) const {
        const int row0 = u.pm * BM + wr * 64 + fr, col0 = u.pn * BM + wc * 32 + 8 * fq;
#pragma unroll
        for (int ai = 0; ai < 2; ++ai)
#pragma unroll
            for (int m = 0; m < 4; ++m) { bf16_t* rowp = O + (size_t)(row0 + ai * HALF + m * 16) * ldc + col0;
#pragma unroll
                for (int bj = 0; bj < 2; ++bj) { const f32x4 v0 = acc[ai][bj][m][0], v1 = acc[ai][bj][m][1];
                    u32x4 w; w.x = cvt_pk_bf16(v0[0], v0[1]); w.y = cvt_pk_bf16(v0[2], v0[3]); w.z = cvt_pk_bf16(v1[0], v1[1]); w.w = cvt_pk_bf16(v1[2], v1[3]);
                    *(u32x4*)(rowp + bj * HALF) = w; } }
    }
};
struct EpiAB {
    static constexpr bool PERM = true, AFTER_DRAIN = false, PERM_A = false;
    bf16_t* O;
    __device__ __forceinline__ void operator()(const f32x4 (&acc)[2][2][4][2], const Unit& u, int wr, int wc, int fr, int fq) const {
        const int row0 = u.pm * BM + wr * 64 + fr;
        if (u.pn >= 16 && u.pn < 24) {
            const int col0 = 2048 + (u.pn - 16) * BM + wc * 32 + 8 * fq;
#pragma unroll
            for (int ai = 0; ai < 2; ++ai)
#pragma unroll
                for (int m = 0; m < 4; ++m) { bf16_t* rowp = O + (size_t)(row0 + ai * HALF + m * 16) * 6144 + col0;
#pragma unroll
                    for (int bj = 0; bj < 2; ++bj) { const f32x4 v0 = acc[ai][bj][m][0], v1 = acc[ai][bj][m][1];
                        u32x4 w; w.x = cvt_pk_bf16(v0[0], v0[1]); w.y = cvt_pk_bf16(v0[2], v0[3]); w.z = cvt_pk_bf16(v1[0], v1[1]); w.w = cvt_pk_bf16(v1[2], v1[3]);
                        *(u32x4*)(rowp + bj * HALF) = w; } }
            return;
        }
        const bool glu = u.pn < 16;
        const int col0 = (glu ? u.pn * 128 : 4096 + (u.pn - 24) * 128) + wc * 32 + 8 * fq;
#pragma unroll
        for (int ai = 0; ai < 2; ++ai)
#pragma unroll
            for (int m = 0; m < 4; ++m) { float o[8];
#pragma unroll
                for (int n = 0; n < 2; ++n)
#pragma unroll
                    for (int j = 0; j < 4; ++j) { const float x = acc[ai][0][m][n][j], y = acc[ai][1][m][n][j];
                        o[4 * n + j] = glu ? x * __builtin_amdgcn_rcpf(1.0f + __expf(-y)) : x * y; }
                u32x4 w; w.x = cvt_pk_bf16(o[0], o[1]); w.y = cvt_pk_bf16(o[2], o[3]); w.z = cvt_pk_bf16(o[4], o[5]); w.w = cvt_pk_bf16(o[6], o[7]);
                *(u32x4*)(O + (size_t)(row0 + ai * HALF + m * 16) * 6144 + col0) = w; }
    }
};
struct EpiMIn {
    static constexpr bool PERM = true, AFTER_DRAIN = false, PERM_A = false;
    bf16_t* O; int ldc; float* gates; bf16_t* QT;
    __device__ __forceinline__ void operator()(const f32x4 (&acc)[2][2][4][2], const Unit& u, int wr, int wc, int fr, int fq) const {
        const int row0 = u.pm * BM + wr * 64 + fr;
        if (u.pn < 8) {
#pragma unroll
            for (int ai = 0; ai < 2; ++ai)
#pragma unroll
                for (int m = 0; m < 4; ++m) { const int rb = (u.pm * BM + wr * 64 + ai * HALF + m * 16) >> 4;
#pragma unroll
                    for (int bj = 0; bj < 2; ++bj) { const f32x4 v0 = acc[ai][bj][m][0], v1 = acc[ai][bj][m][1];
                        u32x4 w; w.x = cvt_pk_bf16(v0[0], v0[1]); w.y = cvt_pk_bf16(v0[2], v0[3]); w.z = cvt_pk_bf16(v1[0], v1[1]); w.w = cvt_pk_bf16(v1[2], v1[3]);
                        *(u32x4*)(QT + ((size_t)rb * 64 + (u.pn * 8 + bj * 4 + wc)) * 512 + (fr + 16 * fq) * 8) = w; } }
        } else if (u.pn < 48) {
            const int col0 = u.pn * BM + wc * 32 + 8 * fq;
#pragma unroll
            for (int ai = 0; ai < 2; ++ai)
#pragma unroll
                for (int m = 0; m < 4; ++m) { bf16_t* rowp = O + (size_t)(row0 + ai * HALF + m * 16) * ldc + col0;
#pragma unroll
                    for (int bj = 0; bj < 2; ++bj) { const f32x4 v0 = acc[ai][bj][m][0], v1 = acc[ai][bj][m][1];
                        u32x4 w; w.x = cvt_pk_bf16(v0[0], v0[1]); w.y = cvt_pk_bf16(v0[2], v0[3]); w.z = cvt_pk_bf16(v1[0], v1[1]); w.w = cvt_pk_bf16(v1[2], v1[3]);
                        *(u32x4*)(rowp + bj * HALF) = w; } }
        } else if (wc == 0) {
#pragma unroll
            for (int ai = 0; ai < 2; ++ai)
#pragma unroll
                for (int m = 0; m < 4; ++m) { float* rowp = gates + (size_t)(row0 + ai * HALF + m * 16) * 32 + 8 * fq;
#pragma unroll
                    for (int n = 0; n < 2; ++n) *(f32x4*)(rowp + 4 * n) = acc[ai][0][m][n]; }
        }
    }
};

__device__ __forceinline__ float dpp_ror1(float v) { return __builtin_bit_cast(float, __builtin_amdgcn_update_dpp(0, __builtin_bit_cast(int, v), 0x121, 0xf, 0xf, false)); }
__device__ __forceinline__ float dpp_rol1(float v) { return __builtin_bit_cast(float, __builtin_amdgcn_update_dpp(0, __builtin_bit_cast(int, v), 0x12F, 0xf, 0xf, false)); }
template <bool NOLOAD = false, bool NOSTORE = false> struct EpiGateT {
    static constexpr bool PERM = true, AFTER_DRAIN = false, PERM_A = true;
    bf16_t* G; bf16_t* UC; const float* cw;
    __device__ __forceinline__ static float shr1(float v) { return __builtin_bit_cast(float, __builtin_amdgcn_update_dpp(0, __builtin_bit_cast(int, v), 0x111, 0xf, 0xf, true)); }
    __device__ __forceinline__ static float shl1(float v) { return __builtin_bit_cast(float, __builtin_amdgcn_update_dpp(0, __builtin_bit_cast(int, v), 0x101, 0xf, 0xf, true)); }
    __device__ __forceinline__ void operator()(const f32x4 (&acc)[2][2][4][2], const Unit& u, int wr, int wc, int fr, int fq) const {
        const int row0 = u.pm * BM + wr * 64 + 4 * fr;
        if (u.pm >= 64) {
            const int col0 = u.pn * BM + wc * 32 + 8 * fq;
#pragma unroll
            for (int ai = 0; ai < 2; ++ai)
#pragma unroll
                for (int m = 0; m < 4; ++m) { bf16_t* rowp = UC + (size_t)(row0 - 64 * BM + ai * HALF + m) * 22016 + col0;
#pragma unroll
                    for (int bj = 0; bj < 2; ++bj) { const f32x4 v0 = acc[ai][bj][m][0], v1 = acc[ai][bj][m][1];
                        u32x4 w; w.x = cvt_pk_bf16(v0[0], v0[1]); w.y = cvt_pk_bf16(v0[2], v0[3]); w.z = cvt_pk_bf16(v1[0], v1[1]); w.w = cvt_pk_bf16(v1[2], v1[3]);
                        *(u32x4*)(rowp + bj * HALF) = w; } }
            return;
        }
        const int ch = u.pn * 128 + wc * 32 + 8 * fq;
        typedef unsigned u32x2 __attribute__((ext_vector_type(2)));
#pragma unroll
        for (int n = 0; n < 2; ++n) {
            f32x4 wg[3], wv[3];
#pragma unroll
            for (int k = 0; k < 3; ++k) { if (NOLOAD) { wg[k] = (f32x4){0.3f, 0.4f, 0.5f, 0.6f}; wv[k] = (f32x4){0.6f, 0.5f, 0.4f, 0.3f}; } else { wg[k] = *(const f32x4*)(cw + k * 22016 + ch + 4 * n); wv[k] = *(const f32x4*)(cw + k * 22016 + 11008 + ch + 4 * n); } }
#pragma unroll
            for (int ai = 0; ai < 2; ++ai) {
                float o[4][4];
#pragma unroll
                for (int j = 0; j < 4; ++j) {
                    const float gp = shr1(acc[ai][0][3][n][j]), gn = shl1(acc[ai][0][0][n][j]), vp = shr1(acc[ai][1][3][n][j]), vn = shl1(acc[ai][1][0][n][j]);
#pragma unroll
                    for (int m = 0; m < 4; ++m) {
                        const float gL = m > 0 ? acc[ai][0][m - 1][n][j] : gp, gR = m < 3 ? acc[ai][0][m + 1][n][j] : gn;
                        const float vL = m > 0 ? acc[ai][1][m - 1][n][j] : vp, vR = m < 3 ? acc[ai][1][m + 1][n][j] : vn;
                        const float g = wg[0][j] * gL + wg[1][j] * acc[ai][0][m][n][j] + wg[2][j] * gR;
                        const float v = wv[0][j] * vL + wv[1][j] * acc[ai][1][m][n][j] + wv[2][j] * vR;
                        o[m][j] = g * __builtin_amdgcn_rcpf(1.0f + __expf(-g)) * v; }
                }
#pragma unroll
                for (int m = 0; m < 4; ++m) { u32x2 w; w.x = cvt_pk_bf16(o[m][0], o[m][1]); w.y = cvt_pk_bf16(o[m][2], o[m][3]);
                    if (NOSTORE) asm volatile("" :: "v"(w)); else *(u32x2*)(G + (size_t)(row0 + ai * HALF + m) * 11008 + ch + 4 * n) = w; }
                __builtin_amdgcn_sched_barrier(0);
            }
        }
    }
};
typedef EpiGateT<false, false> EpiGate;

template <class Epi, class Sched, bool ALIGN_EPI = false, bool SP2 = false>
__device__ __forceinline__ void gemm_phase(PG8_LAS unsigned char* lds, const Gemm g, const Sched& S, const Epi& E, const int tid) {
    const int wid = __builtin_amdgcn_readfirstlane(tid >> 6), lane = tid & 63, wr = wid >> 2, wc = wid & 3, fr = lane & 15, fq = lane >> 4;
    const int K = g.K, nt = K / BK;
    unsigned voffA[2], voffB[2];
#pragma unroll
    for (int i = 0; i < 2; ++i) { int R, C; stage_rc(tid * 16 + i * 8192, R, C); const int Rb = Epi::PERM ? ((R & ~31) + perm32(R & 31)) : R;
        const int Ra = Epi::PERM_A ? ((R & ~63) + 4 * (R & 15) + ((R >> 4) & 3)) : R;
        voffA[i] = (unsigned)(Ra * K + C) * 2u; voffB[i] = (unsigned)(Rb * K + C) * 2u; }
    const size_t kstep = (size_t)(BK * 2);
    const size_t hstep = (size_t)HALF * K * 2;
    const size_t tstep = 2 * hstep;
    const unsigned ldsw = (unsigned)wid * 1024u;
    const int aoff = lds_byte(wr * 64 + fr, fq * 8), boff = lds_byte(wc * 32 + fr, fq * 8);
#define PG8_SA(b, h) (((b) * 2 + (h)) * HTB)
#define PG8_SB(b, h) ((4 + (b) * 2 + (h)) * HTB)
#define PG8_STAGE(bufoff, gbase, voff) do { _Pragma("unroll") for (int _i = 0; _i < 2; ++_i) \
        __builtin_amdgcn_global_load_lds((const unsigned*)((const char*)(gbase) + (voff)[_i]), (PG8_LAS unsigned*)(lds + (bufoff) + ldsw + _i * 8192), 16, 0, 0); } while (0)
#define PG8_LDA(dst, b, h) do { _Pragma("unroll") for (int m = 0; m < 4; ++m) _Pragma("unroll") for (int k = 0; k < 2; ++k) dst[m][k] = *(const PG8_LAS bf16x8*)(lds + PG8_SA(b, h) + aoff + m * 2048 + k * 1024); } while (0)
#define PG8_LDB(dst, b, h) do { _Pragma("unroll") for (int n = 0; n < 2; ++n) _Pragma("unroll") for (int k = 0; k < 2; ++k) dst[n][k] = *(const PG8_LAS bf16x8*)(lds + PG8_SB(b, h) + boff + n * 2048 + k * 1024); } while (0)
#define PG8_MMA(ai, bj, At, Bt) do { __builtin_amdgcn_s_setprio(1); _Pragma("unroll") for (int m = 0; m < 4; ++m) _Pragma("unroll") for (int n = 0; n < 2; ++n) _Pragma("unroll") for (int k = 0; k < 2; ++k) \
        acc[ai][bj][m][n] = __builtin_amdgcn_mfma_f32_16x16x32_bf16(Bt[n][k], At[m][k], acc[ai][bj][m][n], 0, 0, 0); __builtin_amdgcn_s_setprio(0); } while (0)
#define PG8_WAIT_V(n) asm volatile("s_waitcnt vmcnt(" #n ")" ::: "memory")
#define PG8_WAIT_L(n) asm volatile("s_waitcnt lgkmcnt(" #n ")" ::: "memory")
#define PG8_BAR __builtin_amdgcn_s_barrier()
#define PG8_SCHED __builtin_amdgcn_sched_barrier(0)
    Unit cur, nxt; int ui = 0;
    if (!S.next(0, cur)) return;
    f32x4 acc[2][2][4][2];
#pragma unroll
    for (int a = 0; a < 2; ++a)
#pragma unroll
        for (int b = 0; b < 2; ++b)
#pragma unroll
            for (int m = 0; m < 4; ++m)
#pragma unroll
                for (int n = 0; n < 2; ++n) acc[a][b][m][n] = (f32x4){0.f, 0.f, 0.f, 0.f};
    bf16x8 At[4][2], B0[2][2], B1[2][2];
    const char* cA = (const char*)g.A + (size_t)cur.pm * tstep; const char* cB = (const char*)g.Bt + (size_t)cur.pn * tstep;
    S.a_ready(cur);
    if constexpr (SP2) {
        PG8_STAGE(PG8_SB(0, 0), cB, voffB); PG8_STAGE(PG8_SB(0, 1), cB + hstep, voffB); PG8_STAGE(PG8_SA(0, 0), cA, voffA); PG8_STAGE(PG8_SA(0, 1), cA + hstep, voffA);
        if (wr == 1) PG8_BAR;
        PG8_WAIT_V(2); PG8_BAR;
        PG8_STAGE(PG8_SB(1, 0), cB + kstep, voffB); PG8_STAGE(PG8_SA(1, 0), cA + kstep, voffA); PG8_STAGE(PG8_SB(1, 1), cB + hstep + kstep, voffB);
        PG8_WAIT_V(6); PG8_BAR;
    } else {
        PG8_STAGE(PG8_SB(0, 0), cB, voffB); PG8_STAGE(PG8_SA(0, 0), cA, voffA); PG8_STAGE(PG8_SB(0, 1), cB + hstep, voffB); PG8_STAGE(PG8_SA(0, 1), cA + hstep, voffA);
        if (wr == 1) PG8_BAR;
        PG8_WAIT_V(4); PG8_BAR;
        PG8_STAGE(PG8_SB(1, 0), cB + kstep, voffB); PG8_STAGE(PG8_SA(1, 0), cA + kstep, voffA); PG8_STAGE(PG8_SB(1, 1), cB + hstep + kstep, voffB);
        PG8_WAIT_V(6); PG8_BAR;
    }
    for (;;) {
        const bool has_next = S.next(ui + 1, nxt);
        const char* nA = has_next ? (const char*)g.A + (size_t)nxt.pm * tstep : cA; const char* nB = has_next ? (const char*)g.Bt + (size_t)nxt.pn * tstep : cB;
        for (int t = 0; t < nt; t += 2) {
            const bool last = (t == nt - 2);
            const char* a1 = cA + (size_t)(t + 1) * kstep;
            const char* a2 = last ? nA : cA + (size_t)(t + 2) * kstep; const char* b2 = last ? nB : cB + (size_t)(t + 2) * kstep;
            const char* a3 = a2 + kstep; const char* b3 = b2 + kstep;
            if (last && has_next) S.a_ready(nxt);
            if constexpr (SP2) {
            PG8_LDB(B0, 0, 0); PG8_LDB(B1, 0, 1); PG8_SCHED; PG8_LDA(At, 0, 0); PG8_STAGE(PG8_SA(1, 1), a1 + hstep, voffA);
            PG8_WAIT_V(8); PG8_WAIT_L(0); PG8_BAR; PG8_MMA(0, 0, At, B0); PG8_MMA(0, 1, At, B1); PG8_BAR; PG8_SCHED;
            PG8_LDA(At, 0, 1); PG8_STAGE(PG8_SB(0, 0), b2, voffB); PG8_STAGE(PG8_SB(0, 1), b2 + hstep, voffB); PG8_STAGE(PG8_SA(0, 0), a2, voffA);
            PG8_WAIT_V(8); PG8_WAIT_L(0); PG8_BAR; PG8_MMA(1, 0, At, B0); PG8_MMA(1, 1, At, B1); PG8_BAR; PG8_SCHED;
            PG8_LDB(B0, 1, 0); PG8_LDB(B1, 1, 1); PG8_SCHED; PG8_LDA(At, 1, 0); PG8_STAGE(PG8_SA(0, 1), a2 + hstep, voffA);
            PG8_WAIT_V(8); PG8_WAIT_L(0); PG8_BAR; PG8_MMA(0, 0, At, B0); PG8_MMA(0, 1, At, B1); PG8_BAR; PG8_SCHED;
            PG8_LDA(At, 1, 1); PG8_STAGE(PG8_SB(1, 0), b3, voffB); PG8_STAGE(PG8_SB(1, 1), b3 + hstep, voffB); PG8_STAGE(PG8_SA(1, 0), a3, voffA);
            PG8_WAIT_V(8); PG8_WAIT_L(0); PG8_BAR; PG8_MMA(1, 0, At, B0); PG8_MMA(1, 1, At, B1); PG8_BAR; PG8_SCHED;
            } else {
            PG8_LDB(B0, 0, 0); PG8_SCHED; PG8_LDA(At, 0, 0); PG8_STAGE(PG8_SA(1, 1), a1 + hstep, voffA);
            PG8_WAIT_L(8); PG8_BAR; PG8_WAIT_L(0); PG8_MMA(0, 0, At, B0); PG8_BAR; PG8_SCHED;
            PG8_LDB(B1, 0, 1); PG8_STAGE(PG8_SB(0, 0), b2, voffB);
            PG8_BAR; PG8_WAIT_L(0); PG8_MMA(0, 1, At, B1); PG8_BAR;
            PG8_LDA(At, 0, 1); PG8_STAGE(PG8_SA(0, 0), a2, voffA);
            PG8_BAR; PG8_WAIT_L(0); PG8_MMA(1, 0, At, B0); PG8_BAR; PG8_SCHED;
            PG8_STAGE(PG8_SB(0, 1), b2 + hstep, voffB);
            PG8_WAIT_V(6); PG8_BAR; PG8_MMA(1, 1, At, B1); PG8_BAR;
            PG8_LDB(B0, 1, 0); PG8_SCHED; PG8_LDA(At, 1, 0); PG8_STAGE(PG8_SA(0, 1), a2 + hstep, voffA);
            PG8_WAIT_L(8); PG8_BAR; PG8_WAIT_L(0); PG8_MMA(0, 0, At, B0); PG8_BAR; PG8_SCHED;
            PG8_LDB(B1, 1, 1); PG8_STAGE(PG8_SB(1, 0), b3, voffB);
            PG8_BAR; PG8_WAIT_L(0); PG8_MMA(0, 1, At, B1); PG8_BAR;
            PG8_LDA(At, 1, 1); PG8_STAGE(PG8_SA(1, 0), a3, voffA);
            PG8_BAR; PG8_WAIT_L(0); PG8_MMA(1, 0, At, B0); PG8_BAR; PG8_SCHED;
            PG8_STAGE(PG8_SB(1, 1), b3 + hstep, voffB);
            PG8_WAIT_V(6); PG8_BAR; PG8_MMA(1, 1, At, B1); PG8_BAR;
            }
        }
        if constexpr (ALIGN_EPI) { if (wr == 0) PG8_BAR; }
        if constexpr (!Epi::AFTER_DRAIN) { E(acc, cur, wr, wc, fr, fq); S.done(cur); }
        if (!has_next) break;
#pragma unroll
        for (int a = 0; a < 2; ++a)
#pragma unroll
            for (int b = 0; b < 2; ++b)
#pragma unroll
                for (int m = 0; m < 4; ++m)
#pragma unroll
                    for (int n = 0; n < 2; ++n) acc[a][b][m][n] = (f32x4){0.f, 0.f, 0.f, 0.f};
        cur = nxt; cA = nA; cB = nB; ++ui;
        if constexpr (ALIGN_EPI) { if (wr == 1) PG8_BAR; }
    }
    PG8_WAIT_V(0);
    if constexpr (!ALIGN_EPI) { if (wr == 0) PG8_BAR; }
    PG8_BAR;
#undef PG8_SA
#undef PG8_SB
#undef PG8_STAGE
#undef PG8_LDA
#undef PG8_LDB
#undef PG8_MMA
#undef PG8_WAIT_V
#undef PG8_WAIT_L
#undef PG8_BAR
#undef PG8_SCHED
}
}

constexpr int NWAVES = 8, NTHREADS = 512;
constexpr int D = 4096, BATCH = 2, SEQ = 8192, CTXL = 256;
constexpr int ML = BATCH * SEQ;
constexpr int MC = BATCH * CTXL;
constexpr int MT = ML + MC;
constexpr int NMODC = 6 * D;
constexpr int WA = 2048, ABIN = 10240, ABU = 6144, ACONV = 31;
constexpr int HEADS = 8, DQK = 256, DV = 512;
constexpr int QKVO = 12288, CIN = 12320, CINP = 12544;
constexpr int DFF = 11008, DFF2 = 22016;
constexpr int NCH = 66;
constexpr float EPS = 1e-6f;

constexpr size_t MiB = 1u << 20;
constexpr size_t WS_CTL = 0, CTL_ZERO_BYTES = 1 * MiB;
constexpr size_t WS_MOD = 1 * MiB;
constexpr size_t WS_SCP = 2 * MiB;
constexpr size_t WS_SCC = 7 * MiB;
constexpr size_t WS_GATES = 8 * MiB;
constexpr size_t WS_CTXS = 12 * MiB;
constexpr size_t WS_WABIN = 20 * MiB;
constexpr size_t WS_WABOUT = 100 * MiB;
constexpr size_t WS_WMIN = 132 * MiB;
constexpr size_t WS_WMOUT = 230 * MiB;
constexpr size_t WS_WUP0 = 262 * MiB;
constexpr size_t WS_WDN0 = 606 * MiB;
constexpr size_t WS_H = 778 * MiB;
constexpr size_t WS_U = 910 * MiB;
constexpr size_t WS_UC = 1590 * MiB;
constexpr size_t WS_G = 1620 * MiB;
constexpr size_t WS_Y = 1975 * MiB;
constexpr size_t WS_HS = 2239 * MiB;
constexpr size_t WS_XB = 2751 * MiB;
constexpr size_t WS_END = 2883 * MiB;
static_assert(WS_WUP0 + 2 * 172 * MiB == WS_WDN0 && WS_WDN0 + 2 * 86 * MiB <= WS_H, "ws map");
static_assert((size_t)DFF2 * D * 2 <= 172 * MiB && (size_t)D * DFF * 2 <= 86 * MiB && (size_t)CINP * D * 2 <= 98 * MiB, "ws map");
static_assert(WS_H + (size_t)MT * D * 2 <= WS_U && WS_U + (size_t)MT * DFF2 * 2 <= WS_G && WS_G + (size_t)MT * DFF * 2 <= WS_Y && WS_Y + (size_t)MT * D * 4 <= WS_HS && WS_HS + (size_t)2 * ML * D * 4 <= WS_XB && WS_XB + (size_t)MT * D * 2 <= WS_END, "ws map");
static_assert(WS_SCP + (size_t)32 * NCH * 3 * 128 * 4 <= WS_SCC && WS_GATES + (size_t)MT * 32 * 4 <= WS_CTXS && WS_CTXS + (size_t)MC * D * 4 <= WS_WABIN, "ws map");

constexpr int CW_BAR = 4096;
constexpr int LDS_BYTES = 163840;
constexpr int MISC_OFF = LDS_BYTES - 64;

#define LAS __attribute__((address_space(3)))
typedef unsigned short bf16;
typedef unsigned v4u __attribute__((ext_vector_type(4)));
typedef unsigned v2u __attribute__((ext_vector_type(2)));
typedef float f32x4 __attribute__((ext_vector_type(4)));
typedef float f32x2 __attribute__((ext_vector_type(2)));
typedef short bf16x8 __attribute__((ext_vector_type(8)));
typedef short s16x4 __attribute__((ext_vector_type(4)));
#define LDS_WAIT() asm volatile("s_waitcnt lgkmcnt(0)" ::: "memory")

__device__ __forceinline__ unsigned f2bf(float f) { unsigned u = __builtin_bit_cast(unsigned, f); return (u + 0x7fffu + ((u >> 16) & 1u)) >> 16; }
__device__ __forceinline__ unsigned pk2(float lo, float hi) { unsigned r; asm("v_cvt_pk_bf16_f32 %0, %1, %2" : "=v"(r) : "v"(lo), "v"(hi)); return r; }
__device__ __forceinline__ float bflo(unsigned w) { return __builtin_bit_cast(float, w << 16); }
__device__ __forceinline__ float bfhi(unsigned w) { return __builtin_bit_cast(float, w & 0xffff0000u); }
__device__ __forceinline__ float bf1(unsigned short h) { return __builtin_bit_cast(float, ((unsigned)h) << 16); }
__device__ __forceinline__ void cvt8(const v4u r, float (&f)[8]) {
    f[0] = bflo(r.x); f[1] = bfhi(r.x); f[2] = bflo(r.y); f[3] = bfhi(r.y); f[4] = bflo(r.z); f[5] = bfhi(r.z); f[6] = bflo(r.w); f[7] = bfhi(r.w);
}
__device__ __forceinline__ float sigmoidf_(float x) { return __builtin_amdgcn_rcpf(1.0f + __expf(-x)); }
__device__ __forceinline__ float siluf_(float x) { return x * sigmoidf_(x); }
__device__ __forceinline__ float wave_sum(float v) {
#pragma unroll
    for (int o = 1; o < 64; o <<= 1) v += __shfl_xor(v, o);
    return v;
}

#define XB_TMO      128
#define XB_XCNT(j)  (256  + 64 * (j))
#define XB_XSUB(j)  (1280 + 64 * (j))
#define XB_XGEN(j)  (2304 + 64 * (j))
#define XB_TOP      3328
#define XB_TOPGEN   3392
#define XCD_BAR_WORDS 3456
#define XB_SPIN_CAP (1u << 22)

__device__ __forceinline__ unsigned xb_ld(unsigned* p)              { return __hip_atomic_load(p, __ATOMIC_RELAXED, __HIP_MEMORY_SCOPE_AGENT); }
__device__ __forceinline__ unsigned xb_add(unsigned* p, unsigned v) { return __hip_atomic_fetch_add(p, v, __ATOMIC_RELAXED, __HIP_MEMORY_SCOPE_AGENT); }
__device__ __forceinline__ unsigned xb_xcc_id() { return (unsigned)__builtin_amdgcn_s_getreg((3 << 11) | 20) & 0xFu; }
#define XB_SPIN(cond, bar) do { unsigned _sp = 0; while (cond) { __builtin_amdgcn_s_sleep(1); \
    if ((++_sp & 255u) == 0u) { if (xb_ld(&(bar)[XB_TMO])) break; if (_sp > XB_SPIN_CAP) { atomicAdd(&(bar)[XB_TMO], 1u); break; } } } } while (0)

struct XcdBarrier { unsigned* bar; unsigned x; volatile LAS unsigned* st; };

__device__ __forceinline__ XcdBarrier xcd_barrier_post(unsigned* bar, volatile LAS unsigned* st) {
    XcdBarrier b; b.bar = bar; b.x = xb_xcc_id(); b.st = st;
    if (threadIdx.x == 0) (void)xb_add(&bar[XB_XCNT(b.x)], 1u);
    return b;
}
__device__ __forceinline__ void xcd_barrier_complete(unsigned* bar, unsigned x, unsigned& nloc, unsigned& nx) {
    const unsigned G = gridDim.x * gridDim.y * gridDim.z;
    unsigned sum, cnt, mine, sp = 0u;
    for (;;) {
        sum = 0u; cnt = 0u; mine = 0u;
#pragma unroll
        for (unsigned j = 0; j < 16; ++j) { const unsigned c = xb_ld(&bar[XB_XCNT(j)]); sum += c; cnt += (c > 0u) ? 1u : 0u; mine = (j == x) ? c : mine; }
        if (sum == G) break;
        __builtin_amdgcn_s_sleep(1);
        if ((++sp & 255u) == 0u) { if (xb_ld(&bar[XB_TMO])) break; if (sp > XB_SPIN_CAP) { atomicAdd(&bar[XB_TMO], 1u); break; } }
    }
    nloc = mine > 0u ? mine : 1u; nx = cnt > 0u ? cnt : 1u;
}
__device__ __forceinline__ void xcd_barrier(const XcdBarrier& b) {
    asm volatile("s_waitcnt vmcnt(0)" ::: "memory");
    __syncthreads();
    if (threadIdx.x == 0) {
        unsigned* bar = b.bar;
        __builtin_amdgcn_s_waitcnt(0);
        unsigned nloc = b.st[0], nx = b.st[1];
        if (nloc == 0u) { xcd_barrier_complete(bar, b.x, nloc, nx); b.st[0] = nloc; b.st[1] = nx; }
        const unsigned old = xb_add(&bar[XB_XSUB(b.x)], 1u);
        const unsigned gen = old / nloc;
        if (old + 1u == (gen + 1u) * nloc) {
            __builtin_amdgcn_fence(__ATOMIC_RELEASE, "agent");
            asm volatile("s_waitcnt vmcnt(0)" ::: "memory");
            const unsigned og = xb_add(&bar[XB_TOP], 1u);
            const unsigned tg = og / nx;
            if (og + 1u == (tg + 1u) * nx) xb_add(&bar[XB_TOPGEN], 1u);
            else XB_SPIN(xb_ld(&bar[XB_TOPGEN]) == tg, bar);
            __builtin_amdgcn_fence(__ATOMIC_ACQUIRE, "agent");
            xb_add(&bar[XB_XGEN(b.x)], 1u);
            asm volatile("s_waitcnt vmcnt(0)" ::: "memory");
        } else {
            XB_SPIN(xb_ld(&bar[XB_XGEN(b.x)]) == gen, bar);
            __builtin_amdgcn_fence(__ATOMIC_ACQUIRE, "agent");
            asm volatile("s_waitcnt vmcnt(0)" ::: "memory");
        }
    }
    __syncthreads();
}

struct Args { const float* in[21]; float* out; unsigned char* ws; int ph_lo, ph_hi; };
typedef const __attribute__((address_space(4))) Args* CArgs;
__device__ __forceinline__ int opaque_tid(int wave_s) { int t = wave_s * 64 + (int)__builtin_amdgcn_mbcnt_hi(~0u, __builtin_amdgcn_mbcnt_lo(~0u, 0u)); asm volatile("" : "+v"(t)); return t; }
__device__ __forceinline__ CArgs get_args() { CArgs p = (CArgs)__builtin_amdgcn_kernarg_segment_ptr(); asm volatile("" : "+s"(p)); return p; }
enum { I_X = 0, I_C, I_CTX, I_CCTX, I_ADAW, I_ADAB, I_NORMG, I_ABWIN, I_ACONVW, I_ACONVB, I_ALNG, I_ALNB, I_BCONVW, I_ABWOUT, I_MWIN, I_MBG, I_MHNG, I_MWOUT, I_FUP, I_FCONV, I_FDN };

template <int MODE> __device__ __forceinline__ int perm_row(int n0) {
    if (MODE == 1) return n0 < DFF ? 256 * (n0 / 128) + (n0 % 128) : 256 * ((n0 - DFF) / 128) + 128 + ((n0 - DFF) % 128);
    if (MODE == 2) { if (n0 < 4096) { const int ch = n0 & 2047, hi = n0 >> 11; return 256 * (ch / 128) + 128 * hi + (ch % 128); }
                     if (n0 < 6144) return n0;
                     const int j = n0 - 6144, ch = j & 2047, hi = j >> 11; return 6144 + 256 * (ch / 128) + 128 * hi + (ch % 128); }
    return n0;
}
template <int GATE_PERM = 0>
__device__ __forceinline__ void p0_transpose_item(const float* W, int K, int N, bf16* WT, LAS float* scr, int item, int lane) {
    const int nblk = N / 32, kb = item / nblk, nb = item % nblk, k0 = 64 * kb, n0 = 32 * nb;
    const int r0 = perm_row<GATE_PERM>(n0);
#pragma unroll 8
    for (int i = 0; i < 32; ++i) { const int kk = 2 * i + (lane >> 5); scr[kk * 33 + (lane & 31)] = W[(size_t)(k0 + kk) * N + n0 + (lane & 31)]; }
    LDS_WAIT(); asm volatile("" ::: "memory");
    const int c = lane & 7;
#pragma unroll
    for (int j = 0; j < 4; ++j) { const int n = (lane >> 3) + 8 * j; const LAS float* s = scr + (8 * c) * 33 + n;
        v4u o; o.x = pk2(s[0 * 33], s[1 * 33]); o.y = pk2(s[2 * 33], s[3 * 33]); o.z = pk2(s[4 * 33], s[5 * 33]); o.w = pk2(s[6 * 33], s[7 * 33]);
        __builtin_nontemporal_store(o, (v4u*)(WT + (size_t)(r0 + n) * K + k0 + 8 * c)); }
    LDS_WAIT(); asm volatile("" ::: "memory");
}

__device__ __forceinline__ void gemv_units(CArgs a, LAS unsigned char* lds, int layer, int first, int stride, int tid, int lane, int wave) {
    float* MOD = (float*)(a->ws + WS_MOD);
    LAS float* sv = (LAS float*)lds;
    LAS float* red = (LAS float*)(lds + 49152);
    for (int i = tid; i < 3 * D; i += NTHREADS) { const int r = i / D, k = i % D; const float v = (r < 2) ? a->in[I_C][r * D + k] : a->in[I_CCTX][k]; sv[i] = siluf_(v); }
    __syncthreads();
    for (int unit = first; unit < 768; unit += stride) {
        const int n0 = unit * 32;
        const int kg = wave * 8 + (lane >> 3), c4 = (lane & 7) * 4;
        const float* W = a->in[I_ADAW] + (size_t)layer * D * NMODC + (size_t)(kg * 64) * NMODC + n0 + c4;
        f32x4 a0 = {0.f, 0.f, 0.f, 0.f}, a1 = a0, a2 = a0;
        for (int k = 0; k < 64; k += 16) {
            f32x4 w[16];
#pragma unroll
            for (int j = 0; j < 16; ++j) w[j] = __builtin_nontemporal_load((const f32x4*)(W + (size_t)(k + j) * NMODC));
#pragma unroll
            for (int j = 0; j < 16; ++j) { const int kk = kg * 64 + k + j; a0 += w[j] * sv[kk]; a1 += w[j] * sv[D + kk]; a2 += w[j] * sv[2 * D + kk]; }
        }
        *(LAS f32x4*)(red + (kg * 3 + 0) * 32 + c4) = a0; *(LAS f32x4*)(red + (kg * 3 + 1) * 32 + c4) = a1; *(LAS f32x4*)(red + (kg * 3 + 2) * 32 + c4) = a2;
        __syncthreads();
        if (tid < 96) { const int r = tid >> 5, cc = tid & 31; float s = 0.f;
#pragma unroll 8
            for (int g = 0; g < 64; ++g) s += red[(g * 3 + r) * 32 + cc];
            MOD[((size_t)layer * 3 + r) * NMODC + n0 + cc] = s + a->in[I_ADAB][(size_t)layer * NMODC + n0 + cc]; }
        __syncthreads();
    }
}
template <int GATE_PERM>
__device__ __forceinline__ void transpose_item64(const float* W, int K, int N, bf16* WT, LAS float* scr, int item, int lane, int nblk) {
    const int kb = item / nblk, nb = item % nblk, k0 = 64 * kb, n0 = 64 * nb;
    const int r0 = perm_row<GATE_PERM>(n0);
    const int kq = lane >> 4, j4 = (lane & 15) * 4;
    f32x4 v[16];
#pragma unroll
    for (int i = 0; i < 16; ++i) v[i] = __builtin_nontemporal_load((const f32x4*)(W + (size_t)(k0 + 4 * i + kq) * N + n0 + j4));
#pragma unroll
    for (int i = 0; i < 16; ++i) { LAS float* p = scr + (4 * i + kq) * 65 + j4; p[0] = v[i].x; p[1] = v[i].y; p[2] = v[i].z; p[3] = v[i].w; }
    LDS_WAIT(); asm volatile("" ::: "memory");
    const int c = lane & 7;
#pragma unroll
    for (int j = 0; j < 8; ++j) { const int n = (lane >> 3) + 8 * j; const LAS float* p = scr + (8 * c) * 65 + n;
        v4u o; o.x = pk2(p[0 * 65], p[1 * 65]); o.y = pk2(p[2 * 65], p[3 * 65]); o.z = pk2(p[4 * 65], p[5 * 65]); o.w = pk2(p[6 * 65], p[7 * 65]);
        __builtin_nontemporal_store(o, (v4u*)(WT + (size_t)(r0 + n) * K + k0 + 8 * c)); }
    LDS_WAIT(); asm volatile("" ::: "memory");
}
template <int GATE_PERM>
__device__ __forceinline__ void conv_items(const float* W, int K, int N, bf16* WT, LAS unsigned char* lds, int first, int stride, int lane, int wave) {
    LAS float* scr = (LAS float*)(lds + wave * 16640);
    const int nb64 = N / 64, nitems = (K / 64) * nb64;
    for (int it = first; it < nitems; it += stride) transpose_item64<GATE_PERM>(W, K, N, WT, scr, it, lane, nb64);
    if (N % 64) for (int kb = first; kb < K / 64; kb += stride) p0_transpose_item<GATE_PERM>(W, K, N, WT, scr, kb * (N / 32) + (N / 32 - 1), lane);
}
enum { CV_ABIN = 0, CV_ABOUT, CV_MIN, CV_MOUT, CV_UP0, CV_UP1, CV_DN0, CV_DN1 };
template <int WHICH>
__device__ __forceinline__ void conv_matrix(CArgs a, LAS unsigned char* lds, int first, int stride, int lane, int wave) {
    unsigned char* ws = a->ws;
    if (WHICH == CV_ABIN) conv_items<2>(a->in[I_ABWIN], D, ABIN, (bf16*)(ws + WS_WABIN), lds, first, stride, lane, wave);
    if (WHICH == CV_ABOUT) conv_items<0>(a->in[I_ABWOUT], D, D, (bf16*)(ws + WS_WABOUT), lds, first, stride, lane, wave);
    if (WHICH == CV_MIN) { conv_items<0>(a->in[I_MWIN], D, CIN, (bf16*)(ws + WS_WMIN), lds, first, stride, lane, wave);
        v4u* p = (v4u*)((bf16*)(ws + WS_WMIN) + (size_t)CIN * D); const int n16 = (CINP - CIN) * D * 2 / 16;
        for (int i = first * 64 + lane; i < n16; i += stride * 64) p[i] = (v4u){0u, 0u, 0u, 0u}; }
    if (WHICH == CV_MOUT) conv_items<0>(a->in[I_MWOUT], D, D, (bf16*)(ws + WS_WMOUT), lds, first, stride, lane, wave);
    if (WHICH == CV_UP0) conv_items<1>(a->in[I_FUP], D, DFF2, (bf16*)(ws + WS_WUP0), lds, first, stride, lane, wave);
    if (WHICH == CV_UP1) conv_items<1>(a->in[I_FUP] + (size_t)D * DFF2, D, DFF2, (bf16*)(ws + WS_WUP0 + 172 * MiB), lds, first, stride, lane, wave);
    if (WHICH == CV_DN0) conv_items<0>(a->in[I_FDN], DFF, D, (bf16*)(ws + WS_WDN0), lds, first, stride, lane, wave);
    if (WHICH == CV_DN1) conv_items<0>(a->in[I_FDN] + (size_t)DFF * D, DFF, D, (bf16*)(ws + WS_WDN0 + 86 * MiB), lds, first, stride, lane, wave);
}
__device__ __forceinline__ void p0_prologue(CArgs a, LAS unsigned char* lds, int tid, int lane, int wave) {
    gemv_units(a, lds, 0, blockIdx.x, gridDim.x, tid, lane, wave);
    const int gw = blockIdx.x * NWAVES + wave, NGW = gridDim.x * NWAVES;
    conv_matrix<CV_ABIN>(a, lds, gw, NGW, lane, wave);
#if PROBE_E1
    conv_matrix<CV_ABOUT>(a, lds, gw, NGW, lane, wave);
    conv_matrix<CV_UP0>(a, lds, gw, NGW, lane, wave); conv_matrix<CV_DN0>(a, lds, gw, NGW, lane, wave); conv_matrix<CV_MIN>(a, lds, gw, NGW, lane, wave); conv_matrix<CV_MOUT>(a, lds, gw, NGW, lane, wave);
    conv_matrix<CV_UP1>(a, lds, gw, NGW, lane, wave); conv_matrix<CV_DN1>(a, lds, gw, NGW, lane, wave); __syncthreads(); gemv_units(a, lds, 1, blockIdx.x, gridDim.x, tid, lane, wave);
#endif
}
__device__ __forceinline__ int gemm_wgs(int nwg) { const int G = gridDim.x, rounds = (nwg + G - 1) / G; const int g = ((nwg + rounds - 1) / rounds + 7) & ~7; return g < G ? g : G; }

template <bool RES, bool DOH, bool XIN_BF, bool XOUT_BF>
__device__ __forceinline__ void row_phase(LAS unsigned char* lds, int nrows, const void* xin_lat, const void* xin_ctx, void* xout_lat, void* xout_ctx,
                                          const bf16* Y, const float* gpost, const float* modres, int gate_idx,
                                          const float* gpre, const float* modh, int shift_idx, int scale_idx, bf16* H, int tid, int lane, int wave) {
    LAS f32x4* pG = (LAS f32x4*)lds; LAS f32x4* pA = pG + 1024; LAS f32x4* pB = pA + 1024;
    const int G = gridDim.x, rpw = (nrows + G - 1) / G, r0 = (int)blockIdx.x * rpw, r1 = (r0 + rpw < nrows) ? r0 + rpw : nrows;
    for (int vb = r0; vb < r1;) {
        const int mr = vb < ML ? (vb >> 13) : 2;
        const int lim = mr == 0 ? SEQ : (mr == 1 ? ML : nrows), vend = r1 < lim ? r1 : lim;
        __syncthreads();
        for (int i = tid; i < 1024; i += NTHREADS) {
            if (RES) pG[i] = ((const f32x4*)(modres + (size_t)mr * NMODC + gate_idx * D))[i] * ((const f32x4*)gpost)[i];
            if (DOH) { pA[i] = ((const f32x4*)gpre)[i] * (((const f32x4*)(modh + (size_t)mr * NMODC + scale_idx * D))[i] + 1.0f); pB[i] = ((const f32x4*)(modh + (size_t)mr * NMODC + shift_idx * D))[i]; }
        }
        __syncthreads();
        for (int row = vb + wave; row < vend; row += NWAVES) {
            const float* xr = XIN_BF ? nullptr : (row < ML ? (const float*)xin_lat + (size_t)row * D : (const float*)xin_ctx + (size_t)(row - ML) * D);
            const bf16* xrb = XIN_BF ? (const bf16*)xin_lat + (size_t)row * D : nullptr;
            f32x4 v[16];
            if (RES) {
                const bf16* yr = Y + (size_t)row * D; float s = 0.f;
#pragma unroll
                for (int j = 0; j < 16; ++j) { const v2u yw = *(const v2u*)(yr + j * 256 + lane * 4); v[j] = (f32x4){bflo(yw.x), bfhi(yw.x), bflo(yw.y), bfhi(yw.y)}; s += (v[j].x * v[j].x + v[j].y * v[j].y) + (v[j].z * v[j].z + v[j].w * v[j].w); }
                const float rstd = 1.0f / sqrtf(wave_sum(s) * (1.0f / D) + EPS);
                float* xo = XOUT_BF ? nullptr : (row < ML ? (float*)xout_lat + (size_t)row * D : (float*)xout_ctx + (size_t)(row - ML) * D);
                bf16* xob = XOUT_BF ? (bf16*)xout_lat + (size_t)row * D : nullptr;
#pragma unroll
                for (int j = 0; j < 16; ++j) { const int o = j * 256 + lane * 4;
                    f32x4 x;
                    if (XIN_BF) { const v2u xw = *(const v2u*)(xrb + o); x = (f32x4){bflo(xw.x), bfhi(xw.x), bflo(xw.y), bfhi(xw.y)}; } else x = *(const f32x4*)(xr + o);
                    v[j] = x + (v[j] * rstd) * pG[j * 64 + lane];
                    if (XOUT_BF) { v2u w; w.x = pk2(v[j].x, v[j].y); w.y = pk2(v[j].z, v[j].w); *(v2u*)(xob + o) = w; } else *(f32x4*)(xo + o) = v[j];
                    if ((j & 3) == 3) asm volatile("" ::: "memory"); }
            } else {
#pragma unroll
                for (int j = 0; j < 16; ++j) v[j] = *(const f32x4*)(xr + j * 256 + lane * 4);
            }
            if (DOH) {
                float s = 0.f;
#pragma unroll
                for (int j = 0; j < 16; ++j) s += (v[j].x * v[j].x + v[j].y * v[j].y) + (v[j].z * v[j].z + v[j].w * v[j].w);
                const float rstd = 1.0f / sqrtf(wave_sum(s) * (1.0f / D) + EPS);
                bf16* hr = H + (size_t)row * D;
#pragma unroll
                for (int j = 0; j < 16; ++j) { const int o = j * 256 + lane * 4;
                    const f32x4 h = (v[j] * rstd) * pA[j * 64 + lane] + pB[j * 64 + lane];
                    v2u w; w.x = pk2(h.x, h.y); w.y = pk2(h.z, h.w);
                    *(v2u*)(hr + o) = w; }
            }
        }
        vb = vend;
    }
}

__device__ __forceinline__ void mixer_conv_phase(CArgs a, LAS unsigned char* lds, int tid, int lane) {
    const bf16* U = (const bf16*)(a->ws + WS_U);
    bf16* T1 = (bf16*)(a->ws + WS_Y);
    bf16* V = (bf16*)(a->ws + WS_G);
    LAS float* tile = (LAS float*)lds;
    const float* cw = a->in[I_ACONVW]; const float* cb = a->in[I_ACONVB];
    v4u rva[6]; f32x2 w[ACONV]; f32x2 bias = {0.f, 0.f}; int cc_w = -1;
#define MX_ROW(tb_, j_) ((tb_) < 256 ? (((j_) >= 15 && (j_) < 79) ? (tb_) * 64 + ((j_) - 15) : -1) \
        : ((((tb_) - 256) & 3) * 64 + ((j_) - 15) >= 0 && (((tb_) - 256) & 3) * 64 + ((j_) - 15) < CTXL ? ML + (((tb_) - 256) >> 2) * CTXL + (((tb_) - 256) & 3) * 64 + ((j_) - 15) : -1))
#define MX_LOAD(unit_) do { const int tb_ = (unit_) >> 3, cc_ = (unit_) & 7; \
        _Pragma("unroll") for (int q = 0; q < 6; ++q) { const int it = tid + NTHREADS * q; const int j = it >> 5, ch8 = it & 31; const int row = it < 94 * 32 ? MX_ROW(tb_, j) : -1; \
            const size_t o_ = (size_t)(row >= 0 ? row : 0) * ABU + cc_ * 256 + ch8 * 8; rva[q] = *(const v4u*)(U + o_); } } while (0)
    if ((int)blockIdx.x < 264 * 8) MX_LOAD(blockIdx.x);
    for (int unit = blockIdx.x; unit < 264 * 8; unit += gridDim.x) {
        const int tb = unit >> 3, cc = unit & 7;
#pragma unroll
        for (int q = 0; q < 6; ++q) { const int it = tid + NTHREADS * q; const int j = it >> 5, ch8 = it & 31;
            if (it < 94 * 32) { const int row = MX_ROW(tb, j); const float f = row >= 0 ? 1.f : 0.f; const v4u va = rva[q]; f32x4 g0, g1;
                g0.x = f * bflo(va.x); g0.y = f * bfhi(va.x); g0.z = f * bflo(va.y); g0.w = f * bfhi(va.y);
                g1.x = f * bflo(va.z); g1.y = f * bfhi(va.z); g1.z = f * bflo(va.w); g1.w = f * bfhi(va.w);
                *(LAS f32x4*)(tile + j * 256 + ch8 * 8) = g0; *(LAS f32x4*)(tile + j * 256 + ch8 * 8 + 4) = g1; } }
        __syncthreads();
        if (unit + (int)gridDim.x < 264 * 8) MX_LOAD(unit + (int)gridDim.x);
        {
            const int cp = tid & 127, tg = tid >> 7, c = cc * 256 + 2 * cp;
            if (cc != cc_w) { cc_w = cc;
#pragma unroll
                for (int k = 0; k < ACONV; ++k) w[k] = *(const f32x2*)(cw + k * WA + c);
                bias = *(const f32x2*)(cb + c); }
            f32x2 acc[16];
#pragma unroll
            for (int i = 0; i < 16; ++i) acc[i] = (f32x2){0.f, 0.f};
#pragma unroll
            for (int jj = 0; jj < 46; ++jj) {
                const f32x2 g = *(const LAS f32x2*)(tile + (16 * tg + jj) * 256 + 2 * cp);
#pragma unroll
                for (int i = 0; i < 16; ++i) { const int k = jj - i; if (k >= 0 && k < ACONV) acc[i] += w[k] * g; }
            }
            int row0;
            if (tb < 256) row0 = tb * 64 + 16 * tg; else { const int cbk = tb - 256; row0 = ML + (cbk >> 2) * CTXL + (cbk & 3) * 64 + 16 * tg; }
#pragma unroll
            for (int i = 0; i < 16; ++i) { const f32x2 o = acc[i] + bias; *(unsigned*)(T1 + (size_t)(row0 + i) * WA + c) = pk2(o.x, o.y); }
        }
        __syncthreads();
    }
#undef MX_ROW
#undef MX_LOAD
    const float* bw = a->in[I_BCONVW];
    constexpr int NSEG_L = 2 * 64 * 16, NIT_L = NSEG_L * 256, NIT_C = 2 * 32 * 256;
    for (int it = blockIdx.x * NTHREADS + tid; it < NIT_L + NIT_C; it += gridDim.x * NTHREADS) {
        int row0, stride, prow, nrow, c;
        if (it < NIT_L) { const int c8 = it & 255, r = it >> 8, x = r & 63, seg = (r >> 6) & 15, b = r >> 10;
            c = c8 * 8; stride = 64; row0 = b * SEQ + (seg * 8) * 64 + x; prow = seg > 0 ? row0 - 64 : -1; nrow = seg < 15 ? row0 + 8 * 64 : -1; }
        else { const int j = it - NIT_L, c8 = j & 255, r = j >> 8, seg = r & 31, b = r >> 5;
            c = c8 * 8; stride = 1; row0 = ML + b * CTXL + seg * 8; prow = seg > 0 ? row0 - 1 : -1; nrow = seg < 31 ? row0 + 8 : -1; }
        float w[3][8];
#pragma unroll
        for (int k = 0; k < 3; ++k) { const f32x4 w0 = *(const f32x4*)(bw + k * 2048 + c), w1 = *(const f32x4*)(bw + k * 2048 + c + 4);
            w[k][0] = w0.x; w[k][1] = w0.y; w[k][2] = w0.z; w[k][3] = w0.w; w[k][4] = w1.x; w[k][5] = w1.y; w[k][6] = w1.z; w[k][7] = w1.w; }
        const bf16* uz = U + 4096 + c; const bf16* ub = U + 2048 + c;
        v4u rc[10], rb[8];
#pragma unroll
        for (int i = 0; i < 10; ++i) { const int rr = i == 0 ? (prow >= 0 ? prow : row0) : (i == 9 ? (nrow >= 0 ? nrow : row0) : row0 + (i - 1) * stride);
            rc[i] = *(const v4u*)(uz + (size_t)rr * ABU); }
#pragma unroll
        for (int i = 0; i < 8; ++i) rb[i] = *(const v4u*)(ub + (size_t)(row0 + i * stride) * ABU);
        float pp[8], pc[8];
        { float a8[8]; cvt8(rc[0], a8); const float f = prow >= 0 ? 1.f : 0.f;
#pragma unroll
          for (int e = 0; e < 8; ++e) pp[e] = a8[e] * f;
          cvt8(rc[1], pc); }
#pragma unroll
        for (int i = 0; i < 8; ++i) {
            float pn[8], bb[8]; cvt8(rc[i + 2], pn); cvt8(rb[i], bb);
            const float f = (i == 7 && nrow < 0) ? 0.f : 1.f;
#pragma unroll
            for (int e = 0; e < 8; ++e) pn[e] *= f;
            float o[8];
#pragma unroll
            for (int e = 0; e < 8; ++e) o[e] = bb[e] * (w[0][e] * pp[e] + w[1][e] * pc[e] + w[2][e] * pn[e]);
            v4u ov; ov.x = pk2(o[0], o[1]); ov.y = pk2(o[2], o[3]); ov.z = pk2(o[4], o[5]); ov.w = pk2(o[6], o[7]);
            *(v4u*)(V + (size_t)(row0 + i * stride) * D + WA + c) = ov;
#pragma unroll
            for (int e = 0; e < 8; ++e) { pp[e] = pc[e]; pc[e] = pn[e]; }
        }
    }
}
__device__ __forceinline__ void mixer_ln_phase(CArgs a, LAS unsigned char* lds, int tid, int lane, int wave) {
    const bf16* T1 = (const bf16*)(a->ws + WS_Y);
    bf16* V = (bf16*)(a->ws + WS_G);
    LAS f32x4* pg = (LAS f32x4*)lds; LAS f32x4* pb = pg + 512;
    for (int i = tid; i < 512; i += NTHREADS) { pg[i] = ((const f32x4*)a->in[I_ALNG])[i]; pb[i] = ((const f32x4*)a->in[I_ALNB])[i]; }
    __syncthreads();
    const int G = gridDim.x, rpw = (MT + G - 1) / G, r0 = (int)blockIdx.x * rpw, r1 = (r0 + rpw < MT) ? r0 + rpw : MT;
    for (int row = r0 + wave; row < r1; row += NWAVES) {
        f32x4 v[8]; float s = 0.f;
#pragma unroll
        for (int j = 0; j < 8; ++j) { const v2u tw = *(const v2u*)(T1 + (size_t)row * WA + j * 256 + lane * 4); v[j] = (f32x4){bflo(tw.x), bfhi(tw.x), bflo(tw.y), bfhi(tw.y)}; s += (v[j].x + v[j].y) + (v[j].z + v[j].w); }
        const float mu = wave_sum(s) * (1.0f / WA); float q = 0.f;
#pragma unroll
        for (int j = 0; j < 8; ++j) { v[j] = v[j] - mu; q += (v[j].x * v[j].x + v[j].y * v[j].y) + (v[j].z * v[j].z + v[j].w * v[j].w); }
        const float rstd = 1.0f / sqrtf(wave_sum(q) * (1.0f / WA) + EPS);
#pragma unroll
        for (int j = 0; j < 8; ++j) { const int o = j * 256 + lane * 4;
            const f32x4 y = (v[j] * rstd) * pg[j * 64 + lane] + pb[j * 64 + lane];
            v2u w; w.x = pk2(siluf_(y.x), siluf_(y.y)); w.y = pk2(siluf_(y.z), siluf_(y.w));
            *(v2u*)(V + (size_t)row * D + o) = w; }
    }
}

template <int NR>
__device__ __forceinline__ void ffn_gate_slide(const bf16* ug, const bf16* uv, int ldu, bf16* Go, const float* cwg, const float* cwv, int row0, int prow, int nrow) {
    float wg[3][8], wv[3][8];
#pragma unroll
    for (int k = 0; k < 3; ++k) {
        const f32x4 a0 = *(const f32x4*)(cwg + k * DFF2), a1 = *(const f32x4*)(cwg + k * DFF2 + 4), b0 = *(const f32x4*)(cwv + k * DFF2), b1 = *(const f32x4*)(cwv + k * DFF2 + 4);
        wg[k][0] = a0.x; wg[k][1] = a0.y; wg[k][2] = a0.z; wg[k][3] = a0.w; wg[k][4] = a1.x; wg[k][5] = a1.y; wg[k][6] = a1.z; wg[k][7] = a1.w;
        wv[k][0] = b0.x; wv[k][1] = b0.y; wv[k][2] = b0.z; wv[k][3] = b0.w; wv[k][4] = b1.x; wv[k][5] = b1.y; wv[k][6] = b1.z; wv[k][7] = b1.w;
    }
    float pg[8], pv[8], cg[8], cv[8];
    { const float fp = prow >= 0 ? 1.f : 0.f; const int pr = prow >= 0 ? prow : row0;
      const v4u a = *(const v4u*)(ug + (size_t)pr * ldu), b = *(const v4u*)(uv + (size_t)pr * ldu); cvt8(a, pg); cvt8(b, pv);
#pragma unroll
      for (int e = 0; e < 8; ++e) { pg[e] *= fp; pv[e] *= fp; }
      const v4u a2 = *(const v4u*)(ug + (size_t)row0 * ldu), b2 = *(const v4u*)(uv + (size_t)row0 * ldu); cvt8(a2, cg); cvt8(b2, cv); }
    const float fn = nrow >= 0 ? 1.f : 0.f; const int nr = nrow >= 0 ? nrow : row0;
    for (int blk = 0; blk < NR / 4; ++blk) {
        v4u rg[4], rv[4];
#pragma unroll
        for (int i = 0; i < 4; ++i) { const int r = 4 * blk + 1 + i; const int rr = r < NR ? row0 + r : nr;
            rg[i] = *(const v4u*)(ug + (size_t)rr * ldu); rv[i] = *(const v4u*)(uv + (size_t)rr * ldu); }
#pragma unroll
        for (int i = 0; i < 4; ++i) {
            float ng[8], nv[8]; cvt8(rg[i], ng); cvt8(rv[i], nv);
            if (i == 3) { const float f = (4 * blk + 4 < NR) ? 1.f : fn;
#pragma unroll
                for (int e = 0; e < 8; ++e) { ng[e] *= f; nv[e] *= f; } }
            float o[8];
#pragma unroll
            for (int e = 0; e < 8; ++e) { const float g = wg[0][e] * pg[e] + wg[1][e] * cg[e] + wg[2][e] * ng[e], v = wv[0][e] * pv[e] + wv[1][e] * cv[e] + wv[2][e] * nv[e]; o[e] = siluf_(g) * v; }
            v4u w; w.x = pk2(o[0], o[1]); w.y = pk2(o[2], o[3]); w.z = pk2(o[4], o[5]); w.w = pk2(o[6], o[7]);
            *(v4u*)(Go + (size_t)(4 * blk + i) * DFF) = w;
#pragma unroll
            for (int e = 0; e < 8; ++e) { pg[e] = cg[e]; pv[e] = cv[e]; cg[e] = ng[e]; cv[e] = nv[e]; }
        }
    }
}
__device__ __forceinline__ void ffn_gate_ctx_phase(CArgs a, int tid) {
    const bf16* UC = (const bf16*)(a->ws + WS_UC);
    bf16* G = (bf16*)(a->ws + WS_G);
    const float* cw = a->in[I_FCONV];
    constexpr int NC8 = DFF / 8;
    constexpr int NIT = 8 * NC8 * 4, PER = (NIT + 255) / 256;
    for (int it = blockIdx.x * PER + tid; tid < PER && it < NIT; it += gridDim.x * PER) {
        const int q4 = it & 3, rest = it >> 2, c8 = rest % NC8, blk = rest / NC8, ch = c8 * 8;
        const int p0 = (blk & 3) * 64 + q4 * 16, lrow0 = (blk >> 2) * CTXL + p0;
        const bf16* ug = UC + 256 * (ch >> 7) + (ch & 127);
        ffn_gate_slide<16>(ug, ug + 128, DFF2, G + (size_t)(ML + lrow0) * DFF + ch, cw + ch, cw + DFF + ch, lrow0, p0 > 0 ? lrow0 - 1 : -1, p0 + 16 < CTXL ? lrow0 + 16 : -1);
    }
}

__device__ __forceinline__ int chunk_row0(int dir, int b, int c) {
    if (dir == 0) return c < 2 ? ML + b * CTXL + 128 * c : b * SEQ + 128 * (c - 2);
    return c < 2 ? ML + b * CTXL + 128 * (1 - c) : b * SEQ + 128 * (63 - (c - 2));
}
__device__ __forceinline__ float wave_incl_sum(float v, int lane) {
#pragma unroll
    for (int o = 1; o < 64; o <<= 1) { const float t = __shfl_up(v, o); if (lane >= o) v += t; }
    return v;
}
__device__ __forceinline__ float wave_incl_max(float v, int lane) {
#pragma unroll
    for (int o = 1; o < 64; o <<= 1) { const float t = __shfl_up(v, o); if (lane >= o) v = fmaxf(v, t); }
    return v;
}
__device__ __forceinline__ bf16x8 tr_frag(LAS unsigned char* T, int pitch, int k0, int col0, int lane) {
    const int g = lane >> 4, q = (lane & 15) >> 2, p = lane & 3;
    LAS unsigned char* p0 = T + (k0 + 8 * g + q) * pitch + (col0 + 4 * p) * 2;
    const s16x4 lo = __builtin_amdgcn_ds_read_tr16_b64_v4i16((LAS s16x4*)p0);
    const s16x4 hi = __builtin_amdgcn_ds_read_tr16_b64_v4i16((LAS s16x4*)(p0 + 4 * pitch));
    bf16x8 r; r[0] = lo[0]; r[1] = lo[1]; r[2] = lo[2]; r[3] = lo[3]; r[4] = hi[0]; r[5] = hi[1]; r[6] = hi[2]; r[7] = hi[3];
    return r;
}
#ifndef SCAN_REP
#define SCAN_REP 1
#endif
#define MFMA16(y, x, acc) __builtin_amdgcn_mfma_f32_16x16x32_bf16((y), (x), (acc), 0, 0, 0)

constexpr int SK_PITCH = 528;

constexpr size_t WS_QT = WS_G;
constexpr size_t WS_SPP = WS_Y;
constexpr size_t WS_DEN = WS_Y + 64 * MiB;
static_assert((size_t)32 * 64 * 128 * 128 * 2 <= 64 * MiB && WS_DEN + (size_t)32 * 64 * 128 * 4 <= WS_HS, "scan scratch");
__device__ __forceinline__ void chunk_scalars(CArgs a, int dir, int b, int h, int c, LAS float* sAl, LAS float* sPl, int lane) {
    const float* GT = (const float*)(a->ws + WS_GATES);
    float* SCP = (float*)(a->ws + WS_SCP); float* SCG = (float*)(a->ws + WS_SCC);
    const int chain = dir * 16 + b * 8 + h, R0 = chunk_row0(dir, b, c);
    const float bi = a->in[I_MBG][dir * 16 + h], bf = a->in[I_MBG][dir * 16 + 8 + h];
    const int r0 = dir ? 127 - lane : lane, r1 = dir ? 63 - lane : 64 + lane;
    const float i0 = GT[(size_t)(R0 + r0) * 32 + dir * 16 + h] + bi, i1 = GT[(size_t)(R0 + r1) * 32 + dir * 16 + h] + bi;
    const float x0 = GT[(size_t)(R0 + r0) * 32 + dir * 16 + 8 + h] + bf, x1 = GT[(size_t)(R0 + r1) * 32 + dir * 16 + 8 + h] + bf;
    const float f0 = fminf(x0, 0.f) - log1pf(__expf(-fabsf(x0))), f1 = fminf(x1, 0.f) - log1pf(__expf(-fabsf(x1)));
    const float s0 = wave_incl_sum(f0, lane); const float tot0 = __shfl(s0, 63);
    const float s1 = wave_incl_sum(f1, lane) + tot0;
    const float a0 = i0 - s0, a1 = i1 - s1;
    const float p0 = wave_incl_max(a0, lane); const float pm0 = __shfl(p0, 63);
    const float p1 = fmaxf(wave_incl_max(a1, lane), pm0);
    float* o = SCP + ((size_t)chain * NCH + c) * 384;
    o[r0] = a0; o[128 + r0] = p0; o[256 + r0] = s0;
    o[r1] = a1; o[128 + r1] = p1; o[256 + r1] = s1;
    if (sAl) { sAl[r0] = a0; sAl[r1] = a1; }
    if (lane == 63) { SCG[((size_t)chain * NCH + c) * 2] = s1; SCG[((size_t)chain * NCH + c) * 2 + 1] = p1; if (sPl) sPl[0] = p1; }
}
__device__ __forceinline__ void scan_pre_phase(CArgs a, LAS unsigned char* lds, int tid, int lane, int wave) {
    const bf16* QK = (const bf16*)(a->ws + WS_U);
    bf16* SPP = (bf16*)(a->ws + WS_SPP); float* DEN = (float*)(a->ws + WS_DEN); const bf16* QT = (const bf16*)(a->ws + WS_QT);
    LAS unsigned char* Kl = lds; LAS float* sA0 = (LAS float*)(lds + 67584); LAS float* sA1 = sA0 + 128; LAS float* sPt = sA0 + 256;
    const int g = lane >> 4, l15 = lane & 15;
    for (int unit = blockIdx.x; unit < 1024 + 64; unit += gridDim.x) {
        if (unit >= 1024) { if (wave == 0) { const int u = unit - 1024, chain = u >> 1, c = u & 1; chunk_scalars(a, chain >> 4, (chain >> 3) & 1, chain & 7, c, nullptr, nullptr, lane); } continue; }
        const int bh = unit >> 6, j = unit & 63, b = bh >> 3, h = bh & 7;
        const int R0 = b * SEQ + 128 * j, c0 = 2 + j, c1 = 2 + (63 - j);
        const int tl = 16 * wave + l15;
#pragma unroll
        for (int i = 0; i < 8; ++i) { const int idx = tid + NTHREADS * i, r = idx >> 5, ch = idx & 31;
            const v4u v = *(const v4u*)(QK + (size_t)(R0 + r) * QKVO + 2048 + h * DQK + ch * 8);
            *(LAS v4u*)(Kl + r * SK_PITCH + ch * 16) = v; }
        bf16x8 qf[8];
#pragma unroll
        for (int kk = 0; kk < 8; ++kk) qf[kk] = *(const bf16x8*)(QT + ((size_t)((R0 >> 4) + wave) * 64 + 8 * h + kk) * 512 + lane * 8);
        if (wave == 0) chunk_scalars(a, 0, b, h, c0, sA0, sPt, lane);
        if (wave == 1) chunk_scalars(a, 1, b, h, c1, sA1, sPt + 1, lane);
        __syncthreads();
        {
            const float pt0 = sPt[0], pt1 = sPt[1];
            float dp0 = 0.f, dp1 = 0.f;
            int tlv = tl, gv = 4 * g; asm volatile("" : "+v"(tlv), "+v"(gv));
            bf16* sp0 = SPP + (size_t)((0 * 16 + bh) * 64 + (c0 - 2)) * 16384 + (size_t)wave * 2048 + (l15 + 16 * (g >> 1)) * 8 + 4 * (g & 1);
            bf16* sp1 = SPP + (size_t)((1 * 16 + bh) * 64 + (c1 - 2)) * 16384 + (size_t)wave * 2048 + (l15 + 16 * (g >> 1)) * 8 + 4 * (g & 1);
#pragma unroll
            for (int nh = 0; nh < 2; ++nh) {
                f32x4 sacc[4];
#pragma unroll
                for (int n = 0; n < 4; ++n) sacc[n] = (f32x4){0.f, 0.f, 0.f, 0.f};
#pragma unroll
                for (int kk = 0; kk < 8; ++kk)
#pragma unroll
                    for (int n = 0; n < 4; ++n) { const bf16x8 yf = *(const LAS bf16x8*)(Kl + (16 * (4 * nh + n) + l15) * SK_PITCH + (32 * kk + 8 * g) * 2); sacc[n] = MFMA16(yf, qf[kk], sacc[n]); }
#pragma unroll
                for (int n = 0; n < 4; ++n) { float sv0[4], sv1[4]; const int n8 = 4 * nh + n;
#pragma unroll
                    for (int r = 0; r < 4; ++r) { const int sl = 16 * n8 + 4 * g + r; const int sidx = gv + (16 * n8 + r);
                        const float qk = sacc[n][r] * 0.0625f;
                        sv0[r] = (sidx <= tlv) ? qk * __expf(sA0[sl] - pt0) : 0.f; dp0 += sv0[r];
                        sv1[r] = (sidx >= tlv) ? qk * __expf(sA1[sl] - pt1) : 0.f; dp1 += sv1[r]; }
                    v2u w0; w0.x = pk2(sv0[0], sv0[1]); w0.y = pk2(sv0[2], sv0[3]); *(v2u*)(sp0 + (n8 >> 1) * 512 + (n8 & 1) * 256) = w0;
                    v2u w1; w1.x = pk2(sv1[0], sv1[1]); w1.y = pk2(sv1[2], sv1[3]); *(v2u*)(sp1 + (n8 >> 1) * 512 + (n8 & 1) * 256) = w1; }
                asm volatile("" ::: "memory");
            }
            dp0 += __shfl_xor(dp0, 16); dp0 += __shfl_xor(dp0, 32); dp1 += __shfl_xor(dp1, 16); dp1 += __shfl_xor(dp1, 32);
            if (g == 0) { DEN[(size_t)((0 * 16 + bh) * 64 + (c0 - 2)) * 128 + tl] = dp0; DEN[(size_t)((1 * 16 + bh) * 64 + (c1 - 2)) * 128 + tl] = dp1; }
        }
        __syncthreads();
    }
}

constexpr int S2V_PITCH = 160;
constexpr int S2K_PITCH = 544;
__device__ __forceinline__ int s2_sigma(int r) { return (r & ~12) | ((r & 4) << 1) | ((r & 8) >> 1); }
__device__ __forceinline__ bf16x8 tr_frag_sw(LAS unsigned char* T, int pitch, int k0, int col0, int lane) {
    const int g = lane >> 4, q = (lane & 15) >> 2, p = lane & 3;
    LAS unsigned char* p0 = T + (k0 + 16 * (g >> 1) + 4 * (g & 1) + q) * pitch + (col0 + 4 * p) * 2;
    const s16x4 lo = __builtin_amdgcn_ds_read_tr16_b64_v4i16((LAS s16x4*)p0);
    const s16x4 hi = __builtin_amdgcn_ds_read_tr16_b64_v4i16((LAS s16x4*)(p0 + 8 * pitch));
    bf16x8 r; r[0] = lo[0]; r[1] = lo[1]; r[2] = lo[2]; r[3] = lo[3]; r[4] = hi[0]; r[5] = hi[1]; r[6] = hi[2]; r[7] = hi[3];
    return r;
}
constexpr int S2K_OFF = 0, S2V_OFF = 128 * S2K_PITCH, S2S_OFF = S2V_OFF + 128 * S2V_PITCH, S2C_OFF = S2S_OFF + 128 * S2V_PITCH, S2M_OFF = S2C_OFF + 80 * SK_PITCH;
static_assert(S2M_OFF + 4 * 272 <= MISC_OFF, "scan v2 LDS map");
#define SCHED_FENCE() do { } while (0)
#define LDS_BARRIER() do { asm volatile("s_waitcnt lgkmcnt(0)" ::: "memory"); __builtin_amdgcn_s_barrier(); asm volatile("" ::: "memory"); } while (0)
__device__ __forceinline__ void scan_seq_phase(CArgs a, LAS unsigned char* lds, int tid, int lane, int wave) {
    const bf16* QK = (const bf16*)(a->ws + WS_U);
    const float* SCP = (const float*)(a->ws + WS_SCP); const float* SCG = (const float*)(a->ws + WS_SCC);
    const bf16* SPP = (const bf16*)(a->ws + WS_SPP); const float* DEN = (const float*)(a->ws + WS_DEN); const bf16* QT = (const bf16*)(a->ws + WS_QT);
    bf16* HS = (bf16*)(a->ws + WS_HS);
    LAS unsigned char* Kl = lds + S2K_OFF; LAS unsigned char* Vl = lds + S2V_OFF; LAS unsigned char* Vs = lds + S2S_OFF; LAS unsigned char* Cl = lds + S2C_OFF;
    LAS float* mp = (LAS float*)(lds + S2M_OFF); LAS float* ml = mp + 68; LAS float* pt = mp + 136; LAS float* gl = mp + 204;
    for (int unit_ = blockIdx.x; unit_ < 256 * SCAN_REP; unit_ += gridDim.x) { const int u0 = unit_ & 255, unit = ((u0 & 7) << 5) | (u0 >> 3);
        const int chain = unit >> 3, slice = unit & 7, dir = chain >> 4, b = (chain >> 3) & 1, h = chain & 7;
        int tid_u = tid; asm volatile("" : "+v"(tid_u));
        if (tid < NCH) { gl[tid] = SCG[((size_t)chain * NCH + tid) * 2]; pt[tid] = SCG[((size_t)chain * NCH + tid) * 2 + 1]; }
        for (int i = tid_u; i < 80 * SK_PITCH / 4; i += NTHREADS) ((LAS unsigned*)Cl)[i] = 0u;
        for (int i = tid_u; i < 128 * 8; i += NTHREADS) { const int r = i >> 3, w = i & 7; ((LAS unsigned*)(Vs + r * S2V_PITCH + 128))[w] = 0u; }
        __syncthreads();
        if (tid == 0) { float m = 0.f; for (int c = 0; c < NCH; ++c) { const float mx = fmaxf(m, pt[c]); mp[c] = m; ml[c] = mx; m = gl[c] + mx; } }
        __syncthreads();
        f32x4 cacc[5][2];
#pragma unroll
        for (int mt = 0; mt < 5; ++mt)
#pragma unroll
            for (int nt = 0; nt < 2; ++nt) cacc[mt][nt] = (f32x4){0.f, 0.f, 0.f, 0.f};
        v4u kreg[8], vreg[2]; float areg[2];
#define S2_LOAD(cc, T) do { const unsigned koff = (unsigned)((((T) >> 5) * QKVO + ((T) & 31) * 8) * 2), voff = (unsigned)((((T) >> 3) * QKVO + ((T) & 7) * 8) * 2); const int R1_ = chunk_row0(dir, b, (cc)); const char* kb_ = (const char*)(QK + (size_t)R1_ * QKVO + 2048 + h * DQK); const char* vb_ = (const char*)(QK + (size_t)R1_ * QKVO + 4096 + h * DV + slice * 64); \
            const float* ab_ = SCP + ((size_t)chain * NCH + (cc)) * 384; \
            _Pragma("unroll") for (int i = 0; i < 8; ++i) kreg[i] = *(const v4u*)(kb_ + (koff + (unsigned)(i * 16 * QKVO * 2))); \
            _Pragma("unroll") for (int i = 0; i < 2; ++i) { vreg[i] = *(const v4u*)(vb_ + (voff + (unsigned)(i * 64 * QKVO * 2))); areg[i] = ab_[((T) >> 3) + 64 * i]; } } while (0)
#define S2_STORE(cc, T) do { const float mlc_ = ml[(cc)]; \
            _Pragma("unroll") for (int i = 0; i < 8; ++i) { const int idx = (T) + NTHREADS * i, r = idx >> 5, ch = idx & 31; *(LAS v4u*)(Kl + s2_sigma(r) * S2K_PITCH + ch * 16) = kreg[i]; } \
            _Pragma("unroll") for (int i = 0; i < 2; ++i) { const int idx = (T) + NTHREADS * i, r = idx >> 3, ch = idx & 7; const float ws_ = __expf(areg[i] - mlc_) * 0.0625f;     \
                *(LAS v4u*)(Vl + s2_sigma(r) * S2V_PITCH + ch * 16) = vreg[i]; \
                v4u sc_; sc_.x = pk2(bflo(vreg[i].x) * ws_, bfhi(vreg[i].x) * ws_); sc_.y = pk2(bflo(vreg[i].y) * ws_, bfhi(vreg[i].y) * ws_); sc_.z = pk2(bflo(vreg[i].z) * ws_, bfhi(vreg[i].z) * ws_); sc_.w = pk2(bflo(vreg[i].w) * ws_, bfhi(vreg[i].w) * ws_); \
                *(LAS v4u*)(Vs + s2_sigma(r) * S2V_PITCH + ch * 16) = sc_; \
                if (ch == 0) *(LAS unsigned*)(Vs + s2_sigma(r) * S2V_PITCH + 128) = f2bf(ws_); } } while (0)
        S2_LOAD(0, tid_u); S2_STORE(0, tid_u);
        __syncthreads();
#define S2_OUTP false
        for (int c = 0; c < 2; ++c) {
            const int R0 = chunk_row0(dir, b, c);
            const float m_prev = mp[c], m_last = ml[c], ptot = pt[c];
            constexpr bool outp = S2_OUTP; const bool more = (c + 1 < NCH);
            int tid_o = tid; asm volatile("" : "+v"(tid_o));
            const int lane_o = tid_o & 63, g = lane_o >> 4, l15 = lane_o & 15, tl = 16 * wave + l15;
            bf16x8 qf[8], sf[4]; float pv = 0.f, bv = 0.f, dn = 0.f;
            v2u hw[4] = {{0u, 0u}, {0u, 0u}, {0u, 0u}, {0u, 0u}}; v4u hv[2] = {{0u, 0u, 0u, 0u}, {0u, 0u, 0u, 0u}};
            if (outp) {
                const char* qb = (const char*)(QT + ((size_t)((R0 >> 4) + wave) * 64 + 8 * h) * 512); const unsigned qoff = (unsigned)(lane_o * 16);
#pragma unroll
                for (int kk = 0; kk < 8; ++kk) qf[kk] = *(const bf16x8*)(qb + (qoff + (unsigned)(kk * 1024)));
                const float* scp = SCP + ((size_t)chain * NCH + c) * 384;
                pv = scp[128 + tl]; bv = scp[256 + tl]; dn = DEN[(size_t)(chain * 64 + (c - 2)) * 128 + tl];
            }
            SCHED_FENCE();
            const float w_old = __expf(m_prev - m_last);
#pragma unroll
            for (int mt = 0; mt < 5; ++mt)
#pragma unroll
                for (int nt = 0; nt < 2; ++nt) cacc[mt][nt] = cacc[mt][nt] * w_old;
#pragma unroll
            for (int kk = 0; kk < 4; ++kk) {
                bf16x8 yf[2], xf[5];
#pragma unroll
                for (int nt = 0; nt < 2; ++nt) yf[nt] = tr_frag_sw(Kl, S2K_PITCH, 32 * kk, 32 * wave + 16 * nt, lane_o);
#pragma unroll
                for (int mt = 0; mt < 5; ++mt) xf[mt] = tr_frag_sw(Vs, S2V_PITCH, 32 * kk, 16 * mt, lane_o);
                SCHED_FENCE();
#pragma unroll
                for (int mt = 0; mt < 5; ++mt)
#pragma unroll
                    for (int nt = 0; nt < 2; ++nt) cacc[mt][nt] = MFMA16(yf[nt], xf[mt], cacc[mt][nt]);
                SCHED_FENCE();
            }
            if (outp) { const char* sb = (const char*)(SPP + (size_t)(chain * 64 + (c - 2)) * 16384 + (size_t)wave * 2048); const unsigned soff = (unsigned)(lane_o * 16);
#pragma unroll
                for (int kk = 0; kk < 4; ++kk) sf[kk] = *(const bf16x8*)(sb + (soff + (unsigned)(kk * 1024))); }
            if (more) S2_LOAD(c + 1, tid_o);
            SCHED_FENCE();
            if (outp) {
                f32x4 qacc[5];
#pragma unroll
                for (int n = 0; n < 5; ++n) qacc[n] = (f32x4){0.f, 0.f, 0.f, 0.f};
#pragma unroll
                for (int kk = 0; kk < 8; ++kk) {
                    bf16x8 cf[5];
#pragma unroll
                    for (int n = 0; n < 5; ++n) cf[n] = *(const LAS bf16x8*)(Cl + (16 * n + l15) * SK_PITCH + (32 * kk + 8 * g) * 2);
                    SCHED_FENCE();
#pragma unroll
                    for (int n = 0; n < 5; ++n) qacc[n] = MFMA16(cf[n], qf[kk], qacc[n]);
                    SCHED_FENCE();
                }
                f32x4 nacc[4];
#pragma unroll
                for (int n = 0; n < 4; ++n) nacc[n] = (f32x4){0.f, 0.f, 0.f, 0.f};
#pragma unroll
                for (int k2 = 0; k2 < 4; k2 += 2) {
                    bf16x8 vf[2][4];
#pragma unroll
                    for (int u = 0; u < 2; ++u)
#pragma unroll
                        for (int n = 0; n < 4; ++n) vf[u][n] = tr_frag_sw(Vl, S2V_PITCH, 32 * (k2 + u), 16 * n, lane_o);
                    SCHED_FENCE();
#pragma unroll
                    for (int u = 0; u < 2; ++u)
#pragma unroll
                        for (int n = 0; n < 4; ++n) nacc[n] = MFMA16(vf[u][n], sf[k2 + u], nacc[n]);
                    SCHED_FENCE();
                }
                const float mxt = fmaxf(m_prev, pv), rowfac = __expf(ptot - mxt), winter = __expf(m_prev - mxt);
                const float nq = __shfl(qacc[4][0], l15);
                const float den = rowfac * dn + winter * nq;
                const float inv = 1.0f / fmaxf(fabsf(den), __expf(-bv - mxt));
#pragma unroll
                for (int n = 0; n < 4; ++n) { const f32x4 o = (nacc[n] * rowfac + qacc[n] * winter) * inv; hw[n].x = pk2(o.x, o.y); hw[n].y = pk2(o.z, o.w); }
                bf16* hp = HS + ((size_t)dir * ML + R0 + tl) * D + h * DV + slice * 64 + 8 * g;
                const int src0 = l15 + 16 * (2 * (g & 1)), src1 = src0 + 16; const bool hi_n = (g >> 1) != 0;
#pragma unroll
                for (int k = 0; k < 2; ++k) {
                    const unsigned a0x = __shfl(hw[2 * k].x, src0), a0y = __shfl(hw[2 * k].y, src0), a1x = __shfl(hw[2 * k].x, src1), a1y = __shfl(hw[2 * k].y, src1);
                    const unsigned b0x = __shfl(hw[2 * k + 1].x, src0), b0y = __shfl(hw[2 * k + 1].y, src0), b1x = __shfl(hw[2 * k + 1].x, src1), b1y = __shfl(hw[2 * k + 1].y, src1);
                    hv[k].x = hi_n ? b0x : a0x; hv[k].y = hi_n ? b0y : a0y; hv[k].z = hi_n ? b1x : a1x; hv[k].w = hi_n ? b1y : a1y;
                    *(v4u*)(hp + 32 * k) = hv[k]; }
            }
            LDS_BARRIER();
#pragma unroll
            for (int mt = 0; mt < 5; ++mt)
#pragma unroll
                for (int nt = 0; nt < 2; ++nt) { v2u w; w.x = pk2(cacc[mt][nt][0], cacc[mt][nt][1]); w.y = pk2(cacc[mt][nt][2], cacc[mt][nt][3]);
                    *(LAS v2u*)(Cl + (16 * mt + l15) * SK_PITCH + (32 * wave + 16 * nt + 4 * g) * 2) = w; }
            if (more) S2_STORE(c + 1, tid_o);
            asm volatile("" :: "v"(hv[0]), "v"(hv[1]));
            LDS_BARRIER();
                }
#undef S2_OUTP
#define S2_OUTP true
        for (int c = 2; c < NCH; ++c) {
            const int R0 = chunk_row0(dir, b, c);
            const float m_prev = mp[c], m_last = ml[c], ptot = pt[c];
            constexpr bool outp = S2_OUTP; const bool more = (c + 1 < NCH);
            int tid_o = tid; asm volatile("" : "+v"(tid_o));
            const int lane_o = tid_o & 63, g = lane_o >> 4, l15 = lane_o & 15, tl = 16 * wave + l15;
            bf16x8 qf[8], sf[4]; float pv = 0.f, bv = 0.f, dn = 0.f;
            v2u hw[4] = {{0u, 0u}, {0u, 0u}, {0u, 0u}, {0u, 0u}}; v4u hv[2] = {{0u, 0u, 0u, 0u}, {0u, 0u, 0u, 0u}};
            if (outp) {
                const char* qb = (const char*)(QT + ((size_t)((R0 >> 4) + wave) * 64 + 8 * h) * 512); const unsigned qoff = (unsigned)(lane_o * 16);
#pragma unroll
                for (int kk = 0; kk < 8; ++kk) qf[kk] = *(const bf16x8*)(qb + (qoff + (unsigned)(kk * 1024)));
                const float* scp = SCP + ((size_t)chain * NCH + c) * 384;
                pv = scp[128 + tl]; bv = scp[256 + tl]; dn = DEN[(size_t)(chain * 64 + (c - 2)) * 128 + tl];
            }
            SCHED_FENCE();
            const float w_old = __expf(m_prev - m_last);
#pragma unroll
            for (int mt = 0; mt < 5; ++mt)
#pragma unroll
                for (int nt = 0; nt < 2; ++nt) cacc[mt][nt] = cacc[mt][nt] * w_old;
#pragma unroll
            for (int kk = 0; kk < 4; ++kk) {
                bf16x8 yf[2], xf[5];
#pragma unroll
                for (int nt = 0; nt < 2; ++nt) yf[nt] = tr_frag_sw(Kl, S2K_PITCH, 32 * kk, 32 * wave + 16 * nt, lane_o);
#pragma unroll
                for (int mt = 0; mt < 5; ++mt) xf[mt] = tr_frag_sw(Vs, S2V_PITCH, 32 * kk, 16 * mt, lane_o);
                SCHED_FENCE();
#pragma unroll
                for (int mt = 0; mt < 5; ++mt)
#pragma unroll
                    for (int nt = 0; nt < 2; ++nt) cacc[mt][nt] = MFMA16(yf[nt], xf[mt], cacc[mt][nt]);
                SCHED_FENCE();
            }
            if (outp) { const char* sb = (const char*)(SPP + (size_t)(chain * 64 + (c - 2)) * 16384 + (size_t)wave * 2048); const unsigned soff = (unsigned)(lane_o * 16);
#pragma unroll
                for (int kk = 0; kk < 4; ++kk) sf[kk] = *(const bf16x8*)(sb + (soff + (unsigned)(kk * 1024))); }
            if (more) S2_LOAD(c + 1, tid_o);
            SCHED_FENCE();
            if (outp) {
                f32x4 qacc[5];
#pragma unroll
                for (int n = 0; n < 5; ++n) qacc[n] = (f32x4){0.f, 0.f, 0.f, 0.f};
#pragma unroll
                for (int kk = 0; kk < 8; ++kk) {
                    bf16x8 cf[5];
#pragma unroll
                    for (int n = 0; n < 5; ++n) cf[n] = *(const LAS bf16x8*)(Cl + (16 * n + l15) * SK_PITCH + (32 * kk + 8 * g) * 2);
                    SCHED_FENCE();
#pragma unroll
                    for (int n = 0; n < 5; ++n) qacc[n] = MFMA16(cf[n], qf[kk], qacc[n]);
                    SCHED_FENCE();
                }
                f32x4 nacc[4];
#pragma unroll
                for (int n = 0; n < 4; ++n) nacc[n] = (f32x4){0.f, 0.f, 0.f, 0.f};
#pragma unroll
                for (int k2 = 0; k2 < 4; k2 += 2) {
                    bf16x8 vf[2][4];
#pragma unroll
                    for (int u = 0; u < 2; ++u)
#pragma unroll
                        for (int n = 0; n < 4; ++n) vf[u][n] = tr_frag_sw(Vl, S2V_PITCH, 32 * (k2 + u), 16 * n, lane_o);
                    SCHED_FENCE();
#pragma unroll
                    for (int u = 0; u < 2; ++u)
#pragma unroll
                        for (int n = 0; n < 4; ++n) nacc[n] = MFMA16(vf[u][n], sf[k2 + u], nacc[n]);
                    SCHED_FENCE();
                }
                const float mxt = fmaxf(m_prev, pv), rowfac = __expf(ptot - mxt), winter = __expf(m_prev - mxt);
                const float nq = __shfl(qacc[4][0], l15);
                const float den = rowfac * dn + winter * nq;
                const float inv = 1.0f / fmaxf(fabsf(den), __expf(-bv - mxt));
#pragma unroll
                for (int n = 0; n < 4; ++n) { const f32x4 o = (nacc[n] * rowfac + qacc[n] * winter) * inv; hw[n].x = pk2(o.x, o.y); hw[n].y = pk2(o.z, o.w); }
                bf16* hp = HS + ((size_t)dir * ML + R0 + tl) * D + h * DV + slice * 64 + 8 * g;
                const int src0 = l15 + 16 * (2 * (g & 1)), src1 = src0 + 16; const bool hi_n = (g >> 1) != 0;
#pragma unroll
                for (int k = 0; k < 2; ++k) {
                    const unsigned a0x = __shfl(hw[2 * k].x, src0), a0y = __shfl(hw[2 * k].y, src0), a1x = __shfl(hw[2 * k].x, src1), a1y = __shfl(hw[2 * k].y, src1);
                    const unsigned b0x = __shfl(hw[2 * k + 1].x, src0), b0y = __shfl(hw[2 * k + 1].y, src0), b1x = __shfl(hw[2 * k + 1].x, src1), b1y = __shfl(hw[2 * k + 1].y, src1);
                    hv[k].x = hi_n ? b0x : a0x; hv[k].y = hi_n ? b0y : a0y; hv[k].z = hi_n ? b1x : a1x; hv[k].w = hi_n ? b1y : a1y;
                    *(v4u*)(hp + 32 * k) = hv[k]; }
            }
            LDS_BARRIER();
#pragma unroll
            for (int mt = 0; mt < 5; ++mt)
#pragma unroll
                for (int nt = 0; nt < 2; ++nt) { v2u w; w.x = pk2(cacc[mt][nt][0], cacc[mt][nt][1]); w.y = pk2(cacc[mt][nt][2], cacc[mt][nt][3]);
                    *(LAS v2u*)(Cl + (16 * mt + l15) * SK_PITCH + (32 * wave + 16 * nt + 4 * g) * 2) = w; }
            if (more) S2_STORE(c + 1, tid_o);
            asm volatile("" :: "v"(hv[0]), "v"(hv[1]));
            LDS_BARRIER();
                }
#undef S2_OUTP
#undef S2_LOAD
#undef S2_STORE
    }
}

__device__ __forceinline__ void scan_out_phase(CArgs a, LAS unsigned char* lds, int tid, int lane, int wave) {
    const bf16* HS = (const bf16*)(a->ws + WS_HS);
    const bf16* QK = (const bf16*)(a->ws + WS_U);
    bf16* A2 = (bf16*)(a->ws + WS_G);
    LAS f32x4* pg = (LAS f32x4*)lds;
    for (int i = tid; i < 1024; i += NTHREADS) pg[i] = ((const f32x4*)a->in[I_MHNG])[i];
    __syncthreads();
    const int G = gridDim.x, rpw = (ML + G - 1) / G, r0 = (int)blockIdx.x * rpw, r1 = (r0 + rpw < ML) ? r0 + rpw : ML;
    for (int row = r0 + wave; row < r1; row += NWAVES) {
        const bf16* hfp = HS + (size_t)row * D + lane * 8; const bf16* hbp = hfp + (size_t)ML * D; const bf16* op = QK + (size_t)row * QKVO + 8192 + lane * 8; bf16* ap = A2 + (size_t)row * D + lane * 8;
#pragma unroll 1
        for (int hb4 = 0; hb4 < HEADS; hb4 += 4) {
            v4u hf[4], hb[4], ov[4];
#pragma unroll
            for (int i = 0; i < 4; ++i) { hf[i] = *(const v4u*)(hfp + (hb4 + i) * DV); hb[i] = *(const v4u*)(hbp + (hb4 + i) * DV); ov[i] = *(const v4u*)(op + (hb4 + i) * DV); }
#pragma unroll
            for (int i = 0; i < 4; ++i) {
                const f32x4 va = {bflo(hf[i].x) + bflo(hb[i].x), bfhi(hf[i].x) + bfhi(hb[i].x), bflo(hf[i].y) + bflo(hb[i].y), bfhi(hf[i].y) + bfhi(hb[i].y)};
                const f32x4 vb = {bflo(hf[i].z) + bflo(hb[i].z), bfhi(hf[i].z) + bfhi(hb[i].z), bflo(hf[i].w) + bflo(hb[i].w), bfhi(hf[i].w) + bfhi(hb[i].w)};
                const float s = ((va.x * va.x + va.y * va.y) + (va.z * va.z + va.w * va.w)) + ((vb.x * vb.x + vb.y * vb.y) + (vb.z * vb.z + vb.w * vb.w));
                const float rstd = 1.0f / sqrtf(wave_sum(s) * (1.0f / DV) + EPS);
                const f32x4 ga = pg[((hb4 + i) * DV) / 4 + lane * 2], gb = pg[((hb4 + i) * DV) / 4 + lane * 2 + 1];
                const f32x4 ya = (va * rstd) * ga, yb = (vb * rstd) * gb;
                v4u w; w.x = pk2(ya.x * sigmoidf_(bflo(ov[i].x)), ya.y * sigmoidf_(bfhi(ov[i].x))); w.y = pk2(ya.z * sigmoidf_(bflo(ov[i].y)), ya.w * sigmoidf_(bfhi(ov[i].y)));
                w.z = pk2(yb.x * sigmoidf_(bflo(ov[i].z)), yb.y * sigmoidf_(bfhi(ov[i].z))); w.w = pk2(yb.z * sigmoidf_(bflo(ov[i].w)), yb.w * sigmoidf_(bfhi(ov[i].w)));
                *(v4u*)(ap + (hb4 + i) * DV) = w; }
        }
    }
}

constexpr int NPHASES = 21;
__global__ void __launch_bounds__(NTHREADS, 2) fwd_kernel(Args args_unused) {
    extern __shared__ __attribute__((aligned(16))) unsigned char lds_raw[];
    LAS unsigned char* lds = (LAS unsigned char*)lds_raw;
    const int wave_s = __builtin_amdgcn_readfirstlane((int)threadIdx.x >> 6);
    { const int tid = threadIdx.x; volatile LAS unsigned* MISC = (volatile LAS unsigned*)(lds + MISC_OFF);
      if (tid < 16) MISC[tid] = 0u;
      __syncthreads();
      if (!MK_PER_PHASE) (void)xcd_barrier_post((unsigned*)(get_args()->ws + WS_CTL) + CW_BAR, MISC); }
#define PH_IDS for (int tid = opaque_tid(wave_s), lane = tid & 63, wave = __builtin_amdgcn_readfirstlane(tid >> 6), once_ = 1; once_; once_ = 0)
#if MK_PER_PHASE
#define IN(k) (get_args()->ph_lo == (k)) PH_IDS if (true
#define SEAM(k) do { } while (0)
#else
#ifndef PROBE_PHASE
#define PROBE_PHASE -1
#endif
#define IN(k) true) for (int rep_ = 0; rep_ < ((k) == PROBE_PHASE ? 2 : 1); ++rep_) PH_IDS if (true
#define SEAM(k) do { XcdBarrier b_; b_.bar = (unsigned*)(get_args()->ws + WS_CTL) + CW_BAR; b_.x = xb_xcc_id(); b_.st = (volatile LAS unsigned*)(lds + MISC_OFF); xcd_barrier(b_); } while (0)
#endif
#define WSP(off) (get_args()->ws + (off))
#define MODP(layer) ((const float*)WSP(WS_MOD) + (layer) * 3 * NMODC)
#define NGP(i) (get_args()->in[I_NORMG] + (i) * D)

#define GEMM_PHASE(EPI, A_, B_, M_, N_, K_, EINIT, HAS_SIDE, SIDE) { const int nwg_ = ((M_) / 256) * ((N_) / 256), gg_ = (HAS_SIDE) ? gemm_wgs(nwg_) : (int)gridDim.x; \
        if ((int)blockIdx.x < gg_) { pg8::Gemm g{A_, B_, M_, N_, K_}; pg8::StaticOrder S; S.init(M_, N_, gg_, blockIdx.x); EPI E EINIT; pg8::gemm_phase<EPI, pg8::StaticOrder, true, true>(lds, g, S, E, tid); } \
          \
        const int t0_ = (HAS_SIDE) ? gg_ : ((nwg_ % (int)gridDim.x) ? nwg_ % (int)gridDim.x : (int)gridDim.x); \
        if (!PROBE_E1 && (int)blockIdx.x >= t0_) { const int si_ = (int)blockIdx.x - t0_, ns_ = (int)gridDim.x - t0_, sf_ = si_ * NWAVES + wave, sn_ = ns_ * NWAVES; (void)si_; (void)ns_; (void)sf_; (void)sn_; SIDE } }

    if (IN(0)) { p0_prologue(get_args(), lds, tid, lane, wave); __syncthreads(); } SEAM(0);
    if (IN(1)) { CArgs a = get_args(); row_phase<false, true, false, false>(lds, MT, a->in[I_X], a->in[I_CTX], nullptr, nullptr, nullptr, nullptr, nullptr, 0, NGP(0), MODP(0), 0, 1, (bf16*)WSP(WS_H), tid, lane, wave); }
    SEAM(1);
    if (IN(2)) GEMM_PHASE(pg8::EpiAB, (const bf16*)WSP(WS_H), (const bf16*)WSP(WS_WABIN), MT, ABIN, D, ({(bf16*)WSP(WS_U)}), false,
                          conv_matrix<CV_ABOUT>(get_args(), lds, sf_, sn_, lane, wave);)
    SEAM(2);
    if (IN(3)) mixer_conv_phase(get_args(), lds, tid, lane);
    SEAM(3);
    if (IN(4)) mixer_ln_phase(get_args(), lds, tid, lane, wave);
    SEAM(4);
    if (IN(5)) GEMM_PHASE(pg8::EpiBf16, (const bf16*)WSP(WS_G), (const bf16*)WSP(WS_WABOUT), MT, D, D, ({(bf16*)WSP(WS_Y), D}), true,
                          conv_matrix<CV_UP0>(get_args(), lds, sf_, sn_, lane, wave);)
    SEAM(5);
    if (IN(6)) { CArgs a = get_args(); row_phase<true, true, false, true>(lds, MT, a->in[I_X], a->in[I_CTX], WSP(WS_XB), nullptr, (const bf16*)WSP(WS_Y), NGP(1), MODP(0), 2, NGP(2), MODP(0), 3, 4, (bf16*)WSP(WS_H), tid, lane, wave); }
    SEAM(6);
    if (IN(7)) GEMM_PHASE(pg8::EpiGate, (const bf16*)WSP(WS_H), (const bf16*)WSP(WS_WUP0), MT, DFF2, D, ({(bf16*)WSP(WS_G), (bf16*)WSP(WS_UC), get_args()->in[I_FCONV]}), false,
                          conv_matrix<CV_DN0>(get_args(), lds, sf_, sn_, lane, wave);)
    SEAM(7);
    if (IN(8)) ffn_gate_ctx_phase(get_args(), tid);
    SEAM(8);
    if (IN(9)) GEMM_PHASE(pg8::EpiBf16, (const bf16*)WSP(WS_G), (const bf16*)WSP(WS_WDN0), MT, D, DFF, ({(bf16*)WSP(WS_Y), D}), true,
                          gemv_units(get_args(), lds, 1, si_, ns_, tid, lane, wave);
                          conv_matrix<CV_MIN>(get_args(), lds, sf_, sn_, lane, wave); conv_matrix<CV_MOUT>(get_args(), lds, sf_, sn_, lane, wave);
                          conv_matrix<CV_UP1>(get_args(), lds, sf_, sn_, lane, wave);)
    SEAM(9);
    if (IN(10)) { CArgs a = get_args(); row_phase<true, true, true, true>(lds, MT, WSP(WS_XB), nullptr, WSP(WS_XB), nullptr, (const bf16*)WSP(WS_Y), NGP(3), MODP(0), 5, NGP(4), MODP(1), 0, 1, (bf16*)WSP(WS_H), tid, lane, wave); }
    SEAM(10);
    if (IN(11)) GEMM_PHASE(pg8::EpiMIn, (const bf16*)WSP(WS_H), (const bf16*)WSP(WS_WMIN), MT, CINP, D, ({(bf16*)WSP(WS_U), QKVO, (float*)WSP(WS_GATES), (bf16*)WSP(WS_QT)}), false,
                           conv_matrix<CV_DN1>(get_args(), lds, sf_, sn_, lane, wave);)
    SEAM(11);
    if (IN(12)) scan_pre_phase(get_args(), lds, tid, lane, wave);
    SEAM(12);
    if (IN(13)) scan_seq_phase(get_args(), lds, tid, lane, wave);
    SEAM(13);
    if (IN(14)) scan_out_phase(get_args(), lds, tid, lane, wave);
    SEAM(14);
    if (IN(15)) GEMM_PHASE(pg8::EpiBf16, (const bf16*)WSP(WS_G), (const bf16*)WSP(WS_WMOUT), ML, D, D, ({(bf16*)WSP(WS_Y), D}), false, ;)
    SEAM(15);
    if (IN(16)) { CArgs a = get_args(); row_phase<true, true, true, true>(lds, ML, WSP(WS_XB), nullptr, WSP(WS_XB), nullptr, (const bf16*)WSP(WS_Y), NGP(5), MODP(1), 2, NGP(6), MODP(1), 3, 4, (bf16*)WSP(WS_H), tid, lane, wave); }
    SEAM(16);
    if (IN(17)) GEMM_PHASE(pg8::EpiGate, (const bf16*)WSP(WS_H), (const bf16*)WSP(WS_WUP0 + 172 * MiB), ML, DFF2, D, ({(bf16*)WSP(WS_G), (bf16*)WSP(WS_UC), get_args()->in[I_FCONV] + 3 * DFF2}), false, ;)
    SEAM(17);
    if (IN(19)) GEMM_PHASE(pg8::EpiBf16, (const bf16*)WSP(WS_G), (const bf16*)WSP(WS_WDN0 + 86 * MiB), ML, D, DFF, ({(bf16*)WSP(WS_Y), D}), false, ;)
    SEAM(19);
    if (IN(20)) { CArgs a = get_args(); row_phase<true, false, true, false>(lds, ML, WSP(WS_XB), nullptr, a->out, nullptr, (const bf16*)WSP(WS_Y), NGP(7), MODP(1), 5, nullptr, nullptr, 0, 0, nullptr, tid, lane, wave); }
#undef IN
#undef SEAM
}

extern "C" void kernel_launch(void* const* d_in, const int* in_sizes, int n_in, void* d_out, int out_size, void* d_ws, size_t ws_size, hipStream_t stream) {
    static int grid = 0;
    if (grid == 0) {
        if (n_in != 21 || out_size != ML * D || ws_size < WS_END) { fprintf(stderr, "kernel_launch: unexpected problem (n_in %d, out %d, ws %zu < %zu); nothing launched\n", n_in, out_size, ws_size, (size_t)WS_END); grid = -1; return; }
        int dev = 0, cus = 0, per_cu = 0;
        if (hipGetDevice(&dev) != hipSuccess || hipDeviceGetAttribute(&cus, hipDeviceAttributeMultiprocessorCount, dev) != hipSuccess) { grid = -1; return; }
        if (hipFuncSetAttribute((const void*)fwd_kernel, hipFuncAttributeMaxDynamicSharedMemorySize, LDS_BYTES) != hipSuccess) { fprintf(stderr, "kernel_launch: hipFuncSetAttribute failed\n"); grid = -1; return; }
        if (hipOccupancyMaxActiveBlocksPerMultiprocessor(&per_cu, (const void*)fwd_kernel, NTHREADS, LDS_BYTES) != hipSuccess || per_cu < 1)
            fprintf(stderr, "kernel_launch: occupancy query reports %d workgroups per CU\n", per_cu);
        (void)hipGetLastError();
        grid = cus;
    }
    if (grid < 0) return;
    if (hipMemsetAsync((char*)d_ws + WS_CTL, 0, CTL_ZERO_BYTES, stream) != hipSuccess) return;
    Args a{};
    for (int i = 0; i < 21; ++i) a.in[i] = (const float*)d_in[i];
    a.out = (float*)d_out; a.ws = (unsigned char*)d_ws;
#if MK_PER_PHASE
    for (int p = 0; p < NPHASES; ++p) { a.ph_lo = p; a.ph_hi = p + 1; hipLaunchKernelGGL(fwd_kernel, dim3(grid), dim3(NTHREADS), LDS_BYTES, stream, a); }
#else
    a.ph_lo = 0; a.ph_hi = NPHASES;
    hipLaunchKernelGGL(fwd_kernel, dim3(grid), dim3(NTHREADS), LDS_BYTES, stream, a);
#endif
}
```

```cpp
#include <hip/hip_runtime.h>
#include <cstdio>
#include <cstdint>

#ifndef PROBE_E1
#define PROBE_E1 0
#endif
#ifndef MK_PER_PHASE
#define MK_PER_PHASE 0
#endif

namespace pg8 {
#define PG8_LAS __attribute__((address_space(3)))
typedef unsigned short bf16_t;
typedef short bf16x8 __attribute__((ext_vector_type(8)));
typedef float f32x4 __attribute__((ext_vector_type(4)));
typedef unsigned u32x4 __attribute__((ext_vector_type(4)));
constexpr int BM = 256, BK = 64, HALF = 128, HTB = HALF * BK * 2, STAGE_BYTES = 8 * HTB, NXCD = 8, WGM = 4;

__host__ __device__ __forceinline__ int lds_byte(int r, int c) { const int st = (r >> 4) * 2 + (c >> 5), rr = r & 15, cc = c & 31, ob = rr * 64 + cc * 2; return st * 1024 + (ob ^ (((ob >> 9) & 1) << 5)); }
__host__ __device__ __forceinline__ void stage_rc(int b, int& R, int& C) { const int st = b / 1024, sb = b % 1024, swz = sb ^ (((sb >> 9) & 1) << 5); R = (st >> 1) * 16 + swz / 64; C = (st & 1) * 32 + (swz % 64) / 2; }
__host__ __device__ __forceinline__ int perm32(int rho) { const int n = rho >> 4, i = rho & 15; return 8 * (i >> 2) + 4 * n + (i & 3); }

struct Unit { int pm, pn; };
struct Gemm { const bf16_t* A; const bf16_t* Bt; int M, N, K; };

struct StaticOrder {
    int nM, nN, nwg, G, c;
    __host__ __device__ void init(int M, int N, int G_, int c_) { nM = M / BM; nN = N / BM; nwg = nM * nN; G = G_; c = c_; }
    __host__ __device__ bool next(int i, Unit& u) const {
        const long L = (long)i * G + c; if (L >= nwg) return false;
        int wgid = (int)L; { const int q = nwg / NXCD, r = nwg % NXCD, xcd = wgid % NXCD, off = wgid / NXCD; wgid = (xcd < r ? xcd * (q + 1) : r * (q + 1) + (xcd - r) * q) + off; }
        const int nig = WGM * nN, gid = wgid / nig, fm = gid * WGM, gsz = (nM - fm) < WGM ? (nM - fm) : WGM;
        u.pm = fm + ((wgid % nig) % gsz); u.pn = (wgid % nig) / gsz; return true;
    }
    __device__ __forceinline__ void a_ready(const Unit&) const {}
    __device__ __forceinline__ void done(const Unit&) const {}
};

__device__ __forceinline__ unsigned cvt_pk_bf16(float lo, float hi) { unsigned r; asm volatile("v_cvt_pk_bf16_f32 %0, %1, %2" : "=v"(r) : "v"(lo), "v"(hi)); return r; }

struct EpiBf16 {
    static constexpr bool PERM = true, AFTER_DRAIN = false, PERM_A = false;
    bf16_t* O; int ldc;
    __device__ __forceinline__ void operator()(const f32x4 (&acc)[2][2][4][2], const Unit& u, int wr, int wc, int fr, int fq) const {
        const int row0 = u.pm * BM + wr * 64 + fr, col0 = u.pn * BM + wc * 32 + 8 * fq;
#pragma unroll
        for (int ai = 0; ai < 2; ++ai)
#pragma unroll
            for (int m = 0; m < 4; ++m) { bf16_t* rowp = O + (size_t)(row0 + ai * HALF + m * 16) * ldc + col0;
#pragma unroll
                for (int bj = 0; bj < 2; ++bj) { const f32x4 v0 = acc[ai][bj][m][0], v1 = acc[ai][bj][m][1];
                    u32x4 w; w.x = cvt_pk_bf16(v0[0], v0[1]); w.y = cvt_pk_bf16(v0[2], v0[3]); w.z = cvt_pk_bf16(v1[0], v1[1]); w.w = cvt_pk_bf16(v1[2], v1[3]);
                    *(u32x4*)(rowp + bj * HALF) = w; } }
    }
};
struct EpiAB {
    static constexpr bool PERM = true, AFTER_DRAIN = false, PERM_A = false;
    bf16_t* O;
    __device__ __forceinline__ void operator()(const f32x4 (&acc)[2][2][4][2], const Unit& u, int wr, int wc, int fr, int fq) const {
        const int row0 = u.pm * BM + wr * 64 + fr;
        if (u.pn >= 16 && u.pn < 24) {
            const int col0 = 2048 + (u.pn - 16) * BM + wc * 32 + 8 * fq;
#pragma unroll
            for (int ai = 0; ai < 2; ++ai)
#pragma unroll
                for (int m = 0; m < 4; ++m) { bf16_t* rowp = O + (size_t)(row0 + ai * HALF + m * 16) * 6144 + col0;
#pragma unroll
                    for (int bj = 0; bj < 2; ++bj) { const f32x4 v0 = acc[ai][bj][m][0], v1 = acc[ai][bj][m][1];
                        u32x4 w; w.x = cvt_pk_bf16(v0[0], v0[1]); w.y = cvt_pk_bf16(v0[2], v0[3]); w.z = cvt_pk_bf16(v1[0], v1[1]); w.w = cvt_pk_bf16(v1[2], v1[3]);
                        *(u32x4*)(rowp + bj * HALF) = w; } }
            return;
        }
        const bool glu = u.pn < 16;
        const int col0 = (glu ? u.pn * 128 : 4096 + (u.pn - 24) * 128) + wc * 32 + 8 * fq;
#pragma unroll
        for (int ai = 0; ai < 2; ++ai)
#pragma unroll
            for (int m = 0; m < 4; ++m) { float o[8];
#pragma unroll
                for (int n = 0; n < 2; ++n)
#pragma unroll
                    for (int j = 0; j < 4; ++j) { const float x = acc[ai][0][m][n][j], y = acc[ai][1][m][n][j];
                        o[4 * n + j] = glu ? x * __builtin_amdgcn_rcpf(1.0f + __expf(-y)) : x * y; }
                u32x4 w; w.x = cvt_pk_bf16(o[0], o[1]); w.y = cvt_pk_bf16(o[2], o[3]); w.z = cvt_pk_bf16(o[4], o[5]); w.w = cvt_pk_bf16(o[6], o[7]);
                *(u32x4*)(O + (size_t)(row0 + ai * HALF + m * 16) * 6144 + col0) = w; }
    }
};
struct EpiMIn {
    static constexpr bool PERM = true, AFTER_DRAIN = false, PERM_A = false;
    bf16_t* O; int ldc; float* gates; bf16_t* QT;
    __device__ __forceinline__ void operator()(const f32x4 (&acc)[2][2][4][2], const Unit& u, int wr, int wc, int fr, int fq) const {
        const int row0 = u.pm * BM + wr * 64 + fr;
        if (u.pn < 8) {
#pragma unroll
            for (int ai = 0; ai < 2; ++ai)
#pragma unroll
                for (int m = 0; m < 4; ++m) { const int rb = (u.pm * BM + wr * 64 + ai * HALF + m * 16) >> 4;
#pragma unroll
                    for (int bj = 0; bj < 2; ++bj) { const f32x4 v0 = acc[ai][bj][m][0], v1 = acc[ai][bj][m][1];
                        u32x4 w; w.x = cvt_pk_bf16(v0[0], v0[1]); w.y = cvt_pk_bf16(v0[2], v0[3]); w.z = cvt_pk_bf16(v1[0], v1[1]); w.w = cvt_pk_bf16(v1[2], v1[3]);
                        *(u32x4*)(QT + ((size_t)rb * 64 + (u.pn * 8 + bj * 4 + wc)) * 512 + (fr + 16 * fq) * 8) = w; } }
        } else if (u.pn < 48) {
            const int col0 = u.pn * BM + wc * 32 + 8 * fq;
#pragma unroll
            for (int ai = 0; ai < 2; ++ai)
#pragma unroll
                for (int m = 0; m < 4; ++m) { bf16_t* rowp = O + (size_t)(row0 + ai * HALF + m * 16) * ldc + col0;
#pragma unroll
                    for (int bj = 0; bj < 2; ++bj) { const f32x4 v0 = acc[ai][bj][m][0], v1 = acc[ai][bj][m][1];
                        u32x4 w; w.x = cvt_pk_bf16(v0[0], v0[1]); w.y = cvt_pk_bf16(v0[2], v0[3]); w.z = cvt_pk_bf16(v1[0], v1[1]); w.w = cvt_pk_bf16(v1[2], v1[3]);
                        *(u32x4*)(rowp + bj * HALF) = w; } }
        } else if (wc == 0) {
#pragma unroll
            for (int ai = 0; ai < 2; ++ai)
#pragma unroll
                for (int m = 0; m < 4; ++m) { float* rowp = gates + (size_t)(row0 + ai * HALF + m * 16) * 32 + 8 * fq;
#pragma unroll
                    for (int n = 0; n < 2; ++n) *(f32x4*)(rowp + 4 * n) = acc[ai][0][m][n]; }
        }
    }
};

__device__ __forceinline__ float dpp_ror1(float v) { return __builtin_bit_cast(float, __builtin_amdgcn_update_dpp(0, __builtin_bit_cast(int, v), 0x121, 0xf, 0xf, false)); }
__device__ __forceinline__ float dpp_rol1(float v) { return __builtin_bit_cast(float, __builtin_amdgcn_update_dpp(0, __builtin_bit_cast(int, v), 0x12F, 0xf, 0xf, false)); }
template <bool NOLOAD = false, bool NOSTORE = false> struct EpiGateT {
    static constexpr bool PERM = true, AFTER_DRAIN = false, PERM_A = true;
    bf16_t* G; bf16_t* UC; const float* cw;
    __device__ __forceinline__ static float shr1(float v) { return __builtin_bit_cast(float, __builtin_amdgcn_update_dpp(0, __builtin_bit_cast(int, v), 0x111, 0xf, 0xf, true)); }
    __device__ __forceinline__ static float shl1(float v) { return __builtin_bit_cast(float, __builtin_amdgcn_update_dpp(0, __builtin_bit_cast(int, v), 0x101, 0xf, 0xf, true)); }
    __device__ __forceinline__ void operator()(const f32x4 (&acc)[2][2][4][2], const Unit& u, int wr, int wc, int fr, int fq) const {
        const int row0 = u.pm * BM + wr * 64 + 4 * fr;
        if (u.pm >= 64) {
            const int col0 = u.pn * BM + wc * 32 + 8 * fq;
#pragma unroll
            for (int ai = 0; ai < 2; ++ai)
#pragma unroll
                for (int m = 0; m < 4; ++m) { bf16_t* rowp = UC + (size_t)(row0 - 64 * BM + ai * HALF + m) * 22016 + col0;
#pragma unroll
                    for (int bj = 0; bj < 2; ++bj) { const f32x4 v0 = acc[ai][bj][m][0], v1 = acc[ai][bj][m][1];
                        u32x4 w; w.x = cvt_pk_bf16(v0[0], v0[1]); w.y = cvt_pk_bf16(v0[2], v0[3]); w.z = cvt_pk_bf16(v1[0], v1[1]); w.w = cvt_pk_bf16(v1[2], v1[3]);
                        *(u32x4*)(rowp + bj * HALF) = w; } }
            return;
        }
        const int ch = u.pn * 128 + wc * 32 + 8 * fq;
        typedef unsigned u32x2 __attribute__((ext_vector_type(2)));
        u32x2 pw[2][4];
#pragma unroll
        for (int n = 0; n < 2; ++n) {
            f32x4 wg[3], wv[3];
#pragma unroll
            for (int k = 0; k < 3; ++k) { if (NOLOAD) { wg[k] = (f32x4){0.3f, 0.4f, 0.5f, 0.6f}; wv[k] = (f32x4){0.6f, 0.5f, 0.4f, 0.3f}; } else { wg[k] = *(const f32x4*)(cw + k * 22016 + ch + 4 * n); wv[k] = *(const f32x4*)(cw + k * 22016 + 11008 + ch + 4 * n); } }
#pragma unroll
            for (int ai = 0; ai < 2; ++ai) {
                float o[4][4];
#pragma unroll
                for (int j = 0; j < 4; ++j) {
                    const float gp = shr1(acc[ai][0][3][n][j]), gn = shl1(acc[ai][0][0][n][j]), vp = shr1(acc[ai][1][3][n][j]), vn = shl1(acc[ai][1][0][n][j]);
#pragma unroll
                    for (int m = 0; m < 4; ++m) {
                        const float gL = m > 0 ? acc[ai][0][m - 1][n][j] : gp, gR = m < 3 ? acc[ai][0][m + 1][n][j] : gn;
                        const float vL = m > 0 ? acc[ai][1][m - 1][n][j] : vp, vR = m < 3 ? acc[ai][1][m + 1][n][j] : vn;
                        const float g = wg[0][j] * gL + wg[1][j] * acc[ai][0][m][n][j] + wg[2][j] * gR;
                        const float v = wv[0][j] * vL + wv[1][j] * acc[ai][1][m][n][j] + wv[2][j] * vR;
                        o[m][j] = g * __builtin_amdgcn_rcpf(1.0f + __expf(-g)) * v; }
                }
#pragma unroll
                for (int m = 0; m < 4; ++m) { u32x2 w; w.x = cvt_pk_bf16(o[m][0], o[m][1]); w.y = cvt_pk_bf16(o[m][2], o[m][3]);
                    if (n == 0) pw[ai][m] = w;
                    else { u32x4 w4; w4.x = pw[ai][m].x; w4.y = pw[ai][m].y; w4.z = w.x; w4.w = w.y;
                        if (NOSTORE) asm volatile("" :: "v"(w4)); else *(u32x4*)(G + (size_t)(row0 + ai * HALF + m) * 11008 + ch) = w4; } }
                __builtin_amdgcn_sched_barrier(0);
            }
        }
    }
};
typedef EpiGateT<false, false> EpiGate;

template <class Epi, class Sched, bool ALIGN_EPI = false, bool SP2 = false>
__device__ __forceinline__ void gemm_phase(PG8_LAS unsigned char* lds, const Gemm g, const Sched& S, const Epi& E, const int tid) {
    const int wid = __builtin_amdgcn_readfirstlane(tid >> 6), lane = tid & 63, wr = wid >> 2, wc = wid & 3, fr = lane & 15, fq = lane >> 4;
    const int K = g.K, nt = K / BK;
    unsigned voffA[2], voffB[2];
#pragma unroll
    for (int i = 0; i < 2; ++i) { int R, C; stage_rc(tid * 16 + i * 8192, R, C); const int Rb = Epi::PERM ? ((R & ~31) + perm32(R & 31)) : R;
        const int Ra = Epi::PERM_A ? ((R & ~63) + 4 * (R & 15) + ((R >> 4) & 3)) : R;
        voffA[i] = (unsigned)(Ra * K + C) * 2u; voffB[i] = (unsigned)(Rb * K + C) * 2u; }
    const size_t kstep = (size_t)(BK * 2);
    const size_t hstep = (size_t)HALF * K * 2;
    const size_t tstep = 2 * hstep;
    const unsigned ldsw = (unsigned)wid * 1024u;
    const int aoff = lds_byte(wr * 64 + fr, fq * 8), boff = lds_byte(wc * 32 + fr, fq * 8);
#define PG8_SA(b, h) (((b) * 2 + (h)) * HTB)
#define PG8_SB(b, h) ((4 + (b) * 2 + (h)) * HTB)
#define PG8_STAGE(bufoff, gbase, voff) do { _Pragma("unroll") for (int _i = 0; _i < 2; ++_i) \
        __builtin_amdgcn_global_load_lds((const unsigned*)((const char*)(gbase) + (voff)[_i]), (PG8_LAS unsigned*)(lds + (bufoff) + ldsw + _i * 8192), 16, 0, 0); } while (0)
#define PG8_LDA(dst, b, h) do { _Pragma("unroll") for (int m = 0; m < 4; ++m) _Pragma("unroll") for (int k = 0; k < 2; ++k) dst[m][k] = *(const PG8_LAS bf16x8*)(lds + PG8_SA(b, h) + aoff + m * 2048 + k * 1024); } while (0)
#define PG8_LDB(dst, b, h) do { _Pragma("unroll") for (int n = 0; n < 2; ++n) _Pragma("unroll") for (int k = 0; k < 2; ++k) dst[n][k] = *(const PG8_LAS bf16x8*)(lds + PG8_SB(b, h) + boff + n * 2048 + k * 1024); } while (0)
#define PG8_MMA(ai, bj, At, Bt) do { __builtin_amdgcn_s_setprio(1); _Pragma("unroll") for (int m = 0; m < 4; ++m) _Pragma("unroll") for (int n = 0; n < 2; ++n) _Pragma("unroll") for (int k = 0; k < 2; ++k) \
        acc[ai][bj][m][n] = __builtin_amdgcn_mfma_f32_16x16x32_bf16(Bt[n][k], At[m][k], acc[ai][bj][m][n], 0, 0, 0); __builtin_amdgcn_s_setprio(0); } while (0)
#define PG8_WAIT_V(n) asm volatile("s_waitcnt vmcnt(" #n ")" ::: "memory")
#define PG8_WAIT_L(n) asm volatile("s_waitcnt lgkmcnt(" #n ")" ::: "memory")
#define PG8_BAR __builtin_amdgcn_s_barrier()
#define PG8_SCHED __builtin_amdgcn_sched_barrier(0)
    Unit cur, nxt; int ui = 0;
    if (!S.next(0, cur)) return;
    f32x4 acc[2][2][4][2];
#pragma unroll
    for (int a = 0; a < 2; ++a)
#pragma unroll
        for (int b = 0; b < 2; ++b)
#pragma unroll
            for (int m = 0; m < 4; ++m)
#pragma unroll
                for (int n = 0; n < 2; ++n) acc[a][b][m][n] = (f32x4){0.f, 0.f, 0.f, 0.f};
    bf16x8 At[4][2], B0[2][2], B1[2][2];
    const char* cA = (const char*)g.A + (size_t)cur.pm * tstep; const char* cB = (const char*)g.Bt + (size_t)cur.pn * tstep;
    S.a_ready(cur);
    if constexpr (SP2) {
        PG8_STAGE(PG8_SB(0, 0), cB, voffB); PG8_STAGE(PG8_SB(0, 1), cB + hstep, voffB); PG8_STAGE(PG8_SA(0, 0), cA, voffA); PG8_STAGE(PG8_SA(0, 1), cA + hstep, voffA);
        if (wr == 1) PG8_BAR;
        PG8_WAIT_V(2); PG8_BAR;
        PG8_STAGE(PG8_SB(1, 0), cB + kstep, voffB); PG8_STAGE(PG8_SA(1, 0), cA + kstep, voffA); PG8_STAGE(PG8_SB(1, 1), cB + hstep + kstep, voffB);
        PG8_WAIT_V(6); PG8_BAR;
    } else {
        PG8_STAGE(PG8_SB(0, 0), cB, voffB); PG8_STAGE(PG8_SA(0, 0), cA, voffA); PG8_STAGE(PG8_SB(0, 1), cB + hstep, voffB); PG8_STAGE(PG8_SA(0, 1), cA + hstep, voffA);
        if (wr == 1) PG8_BAR;
        PG8_WAIT_V(4); PG8_BAR;
        PG8_STAGE(PG8_SB(1, 0), cB + kstep, voffB); PG8_STAGE(PG8_SA(1, 0), cA + kstep, voffA); PG8_STAGE(PG8_SB(1, 1), cB + hstep + kstep, voffB);
        PG8_WAIT_V(6); PG8_BAR;
    }
    for (;;) {
        const bool has_next = S.next(ui + 1, nxt);
        const char* nA = has_next ? (const char*)g.A + (size_t)nxt.pm * tstep : cA; const char* nB = has_next ? (const char*)g.Bt + (size_t)nxt.pn * tstep : cB;
        for (int t = 0; t < nt; t += 2) {
            const bool last = (t == nt - 2);
            const char* a1 = cA + (size_t)(t + 1) * kstep;
            const char* a2 = last ? nA : cA + (size_t)(t + 2) * kstep; const char* b2 = last ? nB : cB + (size_t)(t + 2) * kstep;
            const char* a3 = a2 + kstep; const char* b3 = b2 + kstep;
            if (last && has_next) S.a_ready(nxt);
            if constexpr (SP2) {
            PG8_LDB(B0, 0, 0); PG8_LDB(B1, 0, 1); PG8_SCHED; PG8_LDA(At, 0, 0); PG8_STAGE(PG8_SA(1, 1), a1 + hstep, voffA);
            PG8_WAIT_V(8); PG8_WAIT_L(0); PG8_BAR; PG8_MMA(0, 0, At, B0); PG8_MMA(0, 1, At, B1); PG8_BAR; PG8_SCHED;
            PG8_LDA(At, 0, 1); PG8_STAGE(PG8_SB(0, 0), b2, voffB); PG8_STAGE(PG8_SB(0, 1), b2 + hstep, voffB); PG8_STAGE(PG8_SA(0, 0), a2, voffA);
            PG8_WAIT_V(8); PG8_WAIT_L(0); PG8_BAR; PG8_MMA(1, 0, At, B0); PG8_MMA(1, 1, At, B1); PG8_BAR; PG8_SCHED;
            PG8_LDB(B0, 1, 0); PG8_LDB(B1, 1, 1); PG8_SCHED; PG8_LDA(At, 1, 0); PG8_STAGE(PG8_SA(0, 1), a2 + hstep, voffA);
            PG8_WAIT_V(8); PG8_WAIT_L(0); PG8_BAR; PG8_MMA(0, 0, At, B0); PG8_MMA(0, 1, At, B1); PG8_BAR; PG8_SCHED;
            PG8_LDA(At, 1, 1); PG8_STAGE(PG8_SB(1, 0), b3, voffB); PG8_STAGE(PG8_SB(1, 1), b3 + hstep, voffB); PG8_STAGE(PG8_SA(1, 0), a3, voffA);
            PG8_WAIT_V(8); PG8_WAIT_L(0); PG8_BAR; PG8_MMA(1, 0, At, B0); PG8_MMA(1, 1, At, B1); PG8_BAR; PG8_SCHED;
            } else {
            PG8_LDB(B0, 0, 0); PG8_SCHED; PG8_LDA(At, 0, 0); PG8_STAGE(PG8_SA(1, 1), a1 + hstep, voffA);
            PG8_WAIT_L(8); PG8_BAR; PG8_WAIT_L(0); PG8_MMA(0, 0, At, B0); PG8_BAR; PG8_SCHED;
            PG8_LDB(B1, 0, 1); PG8_STAGE(PG8_SB(0, 0), b2, voffB);
            PG8_BAR; PG8_WAIT_L(0); PG8_MMA(0, 1, At, B1); PG8_BAR;
            PG8_LDA(At, 0, 1); PG8_STAGE(PG8_SA(0, 0), a2, voffA);
            PG8_BAR; PG8_WAIT_L(0); PG8_MMA(1, 0, At, B0); PG8_BAR; PG8_SCHED;
            PG8_STAGE(PG8_SB(0, 1), b2 + hstep, voffB);
            PG8_WAIT_V(6); PG8_BAR; PG8_MMA(1, 1, At, B1); PG8_BAR;
            PG8_LDB(B0, 1, 0); PG8_SCHED; PG8_LDA(At, 1, 0); PG8_STAGE(PG8_SA(0, 1), a2 + hstep, voffA);
            PG8_WAIT_L(8); PG8_BAR; PG8_WAIT_L(0); PG8_MMA(0, 0, At, B0); PG8_BAR; PG8_SCHED;
            PG8_LDB(B1, 1, 1); PG8_STAGE(PG8_SB(1, 0), b3, voffB);
            PG8_BAR; PG8_WAIT_L(0); PG8_MMA(0, 1, At, B1); PG8_BAR;
            PG8_LDA(At, 1, 1); PG8_STAGE(PG8_SA(1, 0), a3, voffA);
            PG8_BAR; PG8_WAIT_L(0); PG8_MMA(1, 0, At, B0); PG8_BAR; PG8_SCHED;
            PG8_STAGE(PG8_SB(1, 1), b3 + hstep, voffB);
            PG8_WAIT_V(6); PG8_BAR; PG8_MMA(1, 1, At, B1); PG8_BAR;
            }
        }
        if constexpr (ALIGN_EPI) { if (wr == 0) PG8_BAR; }
        if constexpr (!Epi::AFTER_DRAIN) { E(acc, cur, wr, wc, fr, fq); S.done(cur); }
        if (!has_next) break;
#pragma unroll
        for (int a = 0; a < 2; ++a)
#pragma unroll
            for (int b = 0; b < 2; ++b)
#pragma unroll
                for (int m = 0; m < 4; ++m)
#pragma unroll
                    for (int n = 0; n < 2; ++n) acc[a][b][m][n] = (f32x4){0.f, 0.f, 0.f, 0.f};
        cur = nxt; cA = nA; cB = nB; ++ui;
        if constexpr (ALIGN_EPI) { if (wr == 1) PG8_BAR; }
    }
    PG8_WAIT_V(0);
    if constexpr (!ALIGN_EPI) { if (wr == 0) PG8_BAR; }
    PG8_BAR;
#undef PG8_SA
#undef PG8_SB
#undef PG8_STAGE
#undef PG8_LDA
#undef PG8_LDB
#undef PG8_MMA
#undef PG8_WAIT_V
#undef PG8_WAIT_L
#undef PG8_BAR
#undef PG8_SCHED
}
}

constexpr int NWAVES = 8, NTHREADS = 512;
constexpr int D = 4096, BATCH = 2, SEQ = 8192, CTXL = 256;
constexpr int ML = BATCH * SEQ;
constexpr int MC = BATCH * CTXL;
constexpr int MT = ML + MC;
constexpr int NMODC = 6 * D;
constexpr int WA = 2048, ABIN = 10240, ABU = 6144, ACONV = 31;
constexpr int HEADS = 8, DQK = 256, DV = 512;
constexpr int QKVO = 12288, CIN = 12320, CINP = 12544;
constexpr int DFF = 11008, DFF2 = 22016;
constexpr int NCH = 66;
constexpr float EPS = 1e-6f;

constexpr size_t MiB = 1u << 20;
constexpr size_t WS_CTL = 0, CTL_ZERO_BYTES = 1 * MiB;
constexpr size_t WS_MOD = 1 * MiB;
constexpr size_t WS_SCP = 2 * MiB;
constexpr size_t WS_SCC = 7 * MiB;
constexpr size_t WS_GATES = 8 * MiB;
constexpr size_t WS_CTXS = 12 * MiB;
constexpr size_t WS_WABIN = 20 * MiB;
constexpr size_t WS_WABOUT = 100 * MiB;
constexpr size_t WS_WMIN = 132 * MiB;
constexpr size_t WS_WMOUT = 230 * MiB;
constexpr size_t WS_WUP0 = 262 * MiB;
constexpr size_t WS_WDN0 = 606 * MiB;
constexpr size_t WS_H = 778 * MiB;
constexpr size_t WS_U = 910 * MiB;
constexpr size_t WS_UC = 1590 * MiB;
constexpr size_t WS_G = 1620 * MiB;
constexpr size_t WS_Y = 1975 * MiB;
constexpr size_t WS_HS = 2239 * MiB;
constexpr size_t WS_XB = 2751 * MiB;
constexpr size_t WS_END = 2883 * MiB;
static_assert(WS_WUP0 + 2 * 172 * MiB == WS_WDN0 && WS_WDN0 + 2 * 86 * MiB <= WS_H, "ws map");
static_assert((size_t)DFF2 * D * 2 <= 172 * MiB && (size_t)D * DFF * 2 <= 86 * MiB && (size_t)CINP * D * 2 <= 98 * MiB, "ws map");
static_assert(WS_H + (size_t)MT * D * 2 <= WS_U && WS_U + (size_t)MT * DFF2 * 2 <= WS_G && WS_G + (size_t)MT * DFF * 2 <= WS_Y && WS_Y + (size_t)MT * D * 4 <= WS_HS && WS_HS + (size_t)2 * ML * D * 4 <= WS_XB && WS_XB + (size_t)MT * D * 2 <= WS_END, "ws map");
static_assert(WS_SCP + (size_t)32 * NCH * 3 * 128 * 4 <= WS_SCC && WS_GATES + (size_t)MT * 32 * 4 <= WS_CTXS && WS_CTXS + (size_t)MC * D * 4 <= WS_WABIN, "ws map");

constexpr int CW_BAR = 4096;
constexpr int LDS_BYTES = 163840;
constexpr int MISC_OFF = LDS_BYTES - 64;

#define LAS __attribute__((address_space(3)))
typedef unsigned short bf16;
typedef unsigned v4u __attribute__((ext_vector_type(4)));
typedef unsigned v2u __attribute__((ext_vector_type(2)));
typedef float f32x4 __attribute__((ext_vector_type(4)));
typedef float f32x2 __attribute__((ext_vector_type(2)));
typedef short bf16x8 __attribute__((ext_vector_type(8)));
typedef short s16x4 __attribute__((ext_vector_type(4)));
#define LDS_WAIT() asm volatile("s_waitcnt lgkmcnt(0)" ::: "memory")

__device__ __forceinline__ unsigned f2bf(float f) { unsigned u = __builtin_bit_cast(unsigned, f); return (u + 0x7fffu + ((u >> 16) & 1u)) >> 16; }
__device__ __forceinline__ unsigned pk2(float lo, float hi) { unsigned r; asm("v_cvt_pk_bf16_f32 %0, %1, %2" : "=v"(r) : "v"(lo), "v"(hi)); return r; }
__device__ __forceinline__ float bflo(unsigned w) { return __builtin_bit_cast(float, w << 16); }
__device__ __forceinline__ float bfhi(unsigned w) { return __builtin_bit_cast(float, w & 0xffff0000u); }
__device__ __forceinline__ float bf1(unsigned short h) { return __builtin_bit_cast(float, ((unsigned)h) << 16); }
__device__ __forceinline__ void cvt8(const v4u r, float (&f)[8]) {
    f[0] = bflo(r.x); f[1] = bfhi(r.x); f[2] = bflo(r.y); f[3] = bfhi(r.y); f[4] = bflo(r.z); f[5] = bfhi(r.z); f[6] = bflo(r.w); f[7] = bfhi(r.w);
}
__device__ __forceinline__ float sigmoidf_(float x) { return __builtin_amdgcn_rcpf(1.0f + __expf(-x)); }
__device__ __forceinline__ float siluf_(float x) { return x * sigmoidf_(x); }
__device__ __forceinline__ float wave_sum(float v) {
#pragma unroll
    for (int o = 1; o < 64; o <<= 1) v += __shfl_xor(v, o);
    return v;
}

#define XB_TMO      128
#define XB_XCNT(j)  (256  + 64 * (j))
#define XB_XSUB(j)  (1280 + 64 * (j))
#define XB_XGEN(j)  (2304 + 64 * (j))
#define XB_TOP      3328
#define XB_TOPGEN   3392
#define XCD_BAR_WORDS 3456
#define XB_SPIN_CAP (1u << 22)

__device__ __forceinline__ unsigned xb_ld(unsigned* p)              { return __hip_atomic_load(p, __ATOMIC_RELAXED, __HIP_MEMORY_SCOPE_AGENT); }
__device__ __forceinline__ unsigned xb_add(unsigned* p, unsigned v) { return __hip_atomic_fetch_add(p, v, __ATOMIC_RELAXED, __HIP_MEMORY_SCOPE_AGENT); }
__device__ __forceinline__ unsigned xb_xcc_id() { return (unsigned)__builtin_amdgcn_s_getreg((3 << 11) | 20) & 0xFu; }
#define XB_SPIN(cond, bar) do { unsigned _sp = 0; while (cond) { __builtin_amdgcn_s_sleep(1); \
    if ((++_sp & 255u) == 0u) { if (xb_ld(&(bar)[XB_TMO])) break; if (_sp > XB_SPIN_CAP) { atomicAdd(&(bar)[XB_TMO], 1u); break; } } } } while (0)

struct XcdBarrier { unsigned* bar; unsigned x; volatile LAS unsigned* st; };

__device__ __forceinline__ XcdBarrier xcd_barrier_post(unsigned* bar, volatile LAS unsigned* st) {
    XcdBarrier b; b.bar = bar; b.x = xb_xcc_id(); b.st = st;
    if (threadIdx.x == 0) (void)xb_add(&bar[XB_XCNT(b.x)], 1u);
    return b;
}
__device__ __forceinline__ void xcd_barrier_complete(unsigned* bar, unsigned x, unsigned& nloc, unsigned& nx) {
    const unsigned G = gridDim.x * gridDim.y * gridDim.z;
    unsigned sum, cnt, mine, sp = 0u;
    for (;;) {
        sum = 0u; cnt = 0u; mine = 0u;
#pragma unroll
        for (unsigned j = 0; j < 16; ++j) { const unsigned c = xb_ld(&bar[XB_XCNT(j)]); sum += c; cnt += (c > 0u) ? 1u : 0u; mine = (j == x) ? c : mine; }
        if (sum == G) break;
        __builtin_amdgcn_s_sleep(1);
        if ((++sp & 255u) == 0u) { if (xb_ld(&bar[XB_TMO])) break; if (sp > XB_SPIN_CAP) { atomicAdd(&bar[XB_TMO], 1u); break; } }
    }
    nloc = mine > 0u ? mine : 1u; nx = cnt > 0u ? cnt : 1u;
}
__device__ __forceinline__ void xcd_barrier(const XcdBarrier& b) {
    asm volatile("s_waitcnt vmcnt(0)" ::: "memory");
    __syncthreads();
    if (threadIdx.x == 0) {
        unsigned* bar = b.bar;
        __builtin_amdgcn_s_waitcnt(0);
        unsigned nloc = b.st[0], nx = b.st[1];
        if (nloc == 0u) { xcd_barrier_complete(bar, b.x, nloc, nx); b.st[0] = nloc; b.st[1] = nx; }
        const unsigned old = xb_add(&bar[XB_XSUB(b.x)], 1u);
        const unsigned gen = old / nloc;
        if (old + 1u == (gen + 1u) * nloc) {
            __builtin_amdgcn_fence(__ATOMIC_RELEASE, "agent");
            asm volatile("s_waitcnt vmcnt(0)" ::: "memory");
            const unsigned og = xb_add(&bar[XB_TOP], 1u);
            const unsigned tg = og / nx;
            if (og + 1u == (tg + 1u) * nx) xb_add(&bar[XB_TOPGEN], 1u);
            else XB_SPIN(xb_ld(&bar[XB_TOPGEN]) == tg, bar);
            __builtin_amdgcn_fence(__ATOMIC_ACQUIRE, "agent");
            xb_add(&bar[XB_XGEN(b.x)], 1u);
            asm volatile("s_waitcnt vmcnt(0)" ::: "memory");
        } else {
            XB_SPIN(xb_ld(&bar[XB_XGEN(b.x)]) == gen, bar);
            __builtin_amdgcn_fence(__ATOMIC_ACQUIRE, "agent");
            asm volatile("s_waitcnt vmcnt(0)" ::: "memory");
        }
    }
    __syncthreads();
}

struct Args { const float* in[21]; float* out; unsigned char* ws; int ph_lo, ph_hi; };
typedef const __attribute__((address_space(4))) Args* CArgs;
__device__ __forceinline__ int opaque_tid(int wave_s) { int t = wave_s * 64 + (int)__builtin_amdgcn_mbcnt_hi(~0u, __builtin_amdgcn_mbcnt_lo(~0u, 0u)); asm volatile("" : "+v"(t)); return t; }
__device__ __forceinline__ CArgs get_args() { CArgs p = (CArgs)__builtin_amdgcn_kernarg_segment_ptr(); asm volatile("" : "+s"(p)); return p; }
enum { I_X = 0, I_C, I_CTX, I_CCTX, I_ADAW, I_ADAB, I_NORMG, I_ABWIN, I_ACONVW, I_ACONVB, I_ALNG, I_ALNB, I_BCONVW, I_ABWOUT, I_MWIN, I_MBG, I_MHNG, I_MWOUT, I_FUP, I_FCONV, I_FDN };

template <int MODE> __device__ __forceinline__ int perm_row(int n0) {
    if (MODE == 1) return n0 < DFF ? 256 * (n0 / 128) + (n0 % 128) : 256 * ((n0 - DFF) / 128) + 128 + ((n0 - DFF) % 128);
    if (MODE == 2) { if (n0 < 4096) { const int ch = n0 & 2047, hi = n0 >> 11; return 256 * (ch / 128) + 128 * hi + (ch % 128); }
                     if (n0 < 6144) return n0;
                     const int j = n0 - 6144, ch = j & 2047, hi = j >> 11; return 6144 + 256 * (ch / 128) + 128 * hi + (ch % 128); }
    return n0;
}
template <int GATE_PERM = 0>
__device__ __forceinline__ void p0_transpose_item(const float* W, int K, int N, bf16* WT, LAS float* scr, int item, int lane) {
    const int nblk = N / 32, kb = item / nblk, nb = item % nblk, k0 = 64 * kb, n0 = 32 * nb;
    const int r0 = perm_row<GATE_PERM>(n0);
#pragma unroll 8
    for (int i = 0; i < 32; ++i) { const int kk = 2 * i + (lane >> 5); scr[kk * 33 + (lane & 31)] = W[(size_t)(k0 + kk) * N + n0 + (lane & 31)]; }
    LDS_WAIT(); asm volatile("" ::: "memory");
    const int c = lane & 7;
#pragma unroll
    for (int j = 0; j < 4; ++j) { const int n = (lane >> 3) + 8 * j; const LAS float* s = scr + (8 * c) * 33 + n;
        v4u o; o.x = pk2(s[0 * 33], s[1 * 33]); o.y = pk2(s[2 * 33], s[3 * 33]); o.z = pk2(s[4 * 33], s[5 * 33]); o.w = pk2(s[6 * 33], s[7 * 33]);
        __builtin_nontemporal_store(o, (v4u*)(WT + (size_t)(r0 + n) * K + k0 + 8 * c)); }
    LDS_WAIT(); asm volatile("" ::: "memory");
}

__device__ __forceinline__ void gemv_units(CArgs a, LAS unsigned char* lds, int layer, int first, int stride, int tid, int lane, int wave) {
    float* MOD = (float*)(a->ws + WS_MOD);
    LAS float* sv = (LAS float*)lds;
    LAS float* red = (LAS float*)(lds + 49152);
    for (int i = tid; i < 3 * D; i += NTHREADS) { const int r = i / D, k = i % D; const float v = (r < 2) ? a->in[I_C][r * D + k] : a->in[I_CCTX][k]; sv[i] = siluf_(v); }
    __syncthreads();
    for (int unit = first; unit < 768; unit += stride) {
        const int n0 = unit * 32;
        const int kg = wave * 8 + (lane >> 3), c4 = (lane & 7) * 4;
        const float* W = a->in[I_ADAW] + (size_t)layer * D * NMODC + (size_t)(kg * 64) * NMODC + n0 + c4;
        f32x4 a0 = {0.f, 0.f, 0.f, 0.f}, a1 = a0, a2 = a0;
        for (int k = 0; k < 64; k += 16) {
            f32x4 w[16];
#pragma unroll
            for (int j = 0; j < 16; ++j) w[j] = __builtin_nontemporal_load((const f32x4*)(W + (size_t)(k + j) * NMODC));
#pragma unroll
            for (int j = 0; j < 16; ++j) { const int kk = kg * 64 + k + j; a0 += w[j] * sv[kk]; a1 += w[j] * sv[D + kk]; a2 += w[j] * sv[2 * D + kk]; }
        }
        *(LAS f32x4*)(red + (kg * 3 + 0) * 32 + c4) = a0; *(LAS f32x4*)(red + (kg * 3 + 1) * 32 + c4) = a1; *(LAS f32x4*)(red + (kg * 3 + 2) * 32 + c4) = a2;
        __syncthreads();
        if (tid < 96) { const int r = tid >> 5, cc = tid & 31; float s = 0.f;
#pragma unroll 8
            for (int g = 0; g < 64; ++g) s += red[(g * 3 + r) * 32 + cc];
            MOD[((size_t)layer * 3 + r) * NMODC + n0 + cc] = s + a->in[I_ADAB][(size_t)layer * NMODC + n0 + cc]; }
        __syncthreads();
    }
}
template <int GATE_PERM>
__device__ __forceinline__ void transpose_item64(const float* W, int K, int N, bf16* WT, LAS float* scr, int item, int lane, int nblk) {
    const int kb = item / nblk, nb = item % nblk, k0 = 64 * kb, n0 = 64 * nb;
    const int r0 = perm_row<GATE_PERM>(n0);
    const int kq = lane >> 4, j4 = (lane & 15) * 4;
    f32x4 v[16];
#pragma unroll
    for (int i = 0; i < 16; ++i) v[i] = __builtin_nontemporal_load((const f32x4*)(W + (size_t)(k0 + 4 * i + kq) * N + n0 + j4));
#pragma unroll
    for (int i = 0; i < 16; ++i) { LAS float* p = scr + (4 * i + kq) * 65 + j4; p[0] = v[i].x; p[1] = v[i].y; p[2] = v[i].z; p[3] = v[i].w; }
    LDS_WAIT(); asm volatile("" ::: "memory");
    const int c = lane & 7;
#pragma unroll
    for (int j = 0; j < 8; ++j) { const int n = (lane >> 3) + 8 * j; const LAS float* p = scr + (8 * c) * 65 + n;
        v4u o; o.x = pk2(p[0 * 65], p[1 * 65]); o.y = pk2(p[2 * 65], p[3 * 65]); o.z = pk2(p[4 * 65], p[5 * 65]); o.w = pk2(p[6 * 65], p[7 * 65]);
        __builtin_nontemporal_store(o, (v4u*)(WT + (size_t)(r0 + n) * K + k0 + 8 * c)); }
    LDS_WAIT(); asm volatile("" ::: "memory");
}
template <int GATE_PERM>
__device__ __forceinline__ void conv_items(const float* W, int K, int N, bf16* WT, LAS unsigned char* lds, int first, int stride, int lane, int wave) {
    LAS float* scr = (LAS float*)(lds + wave * 16640);
    const int nb64 = N / 64, nitems = (K / 64) * nb64;
    for (int it = first; it < nitems; it += stride) transpose_item64<GATE_PERM>(W, K, N, WT, scr, it, lane, nb64);
    if (N % 64) for (int kb = first; kb < K / 64; kb += stride) p0_transpose_item<GATE_PERM>(W, K, N, WT, scr, kb * (N / 32) + (N / 32 - 1), lane);
}
enum { CV_ABIN = 0, CV_ABOUT, CV_MIN, CV_MOUT, CV_UP0, CV_UP1, CV_DN0, CV_DN1 };
template <int WHICH>
__device__ __forceinline__ void conv_matrix(CArgs a, LAS unsigned char* lds, int first, int stride, int lane, int wave) {
    unsigned char* ws = a->ws;
    if (WHICH == CV_ABIN) conv_items<2>(a->in[I_ABWIN], D, ABIN, (bf16*)(ws + WS_WABIN), lds, first, stride, lane, wave);
    if (WHICH == CV_ABOUT) conv_items<0>(a->in[I_ABWOUT], D, D, (bf16*)(ws + WS_WABOUT), lds, first, stride, lane, wave);
    if (WHICH == CV_MIN) { conv_items<0>(a->in[I_MWIN], D, CIN, (bf16*)(ws + WS_WMIN), lds, first, stride, lane, wave);
        v4u* p = (v4u*)((bf16*)(ws + WS_WMIN) + (size_t)CIN * D); const int n16 = (CINP - CIN) * D * 2 / 16;
        for (int i = first * 64 + lane; i < n16; i += stride * 64) p[i] = (v4u){0u, 0u, 0u, 0u}; }
    if (WHICH == CV_MOUT) conv_items<0>(a->in[I_MWOUT], D, D, (bf16*)(ws + WS_WMOUT), lds, first, stride, lane, wave);
    if (WHICH == CV_UP0) conv_items<1>(a->in[I_FUP], D, DFF2, (bf16*)(ws + WS_WUP0), lds, first, stride, lane, wave);
    if (WHICH == CV_UP1) conv_items<1>(a->in[I_FUP] + (size_t)D * DFF2, D, DFF2, (bf16*)(ws + WS_WUP0 + 172 * MiB), lds, first, stride, lane, wave);
    if (WHICH == CV_DN0) conv_items<0>(a->in[I_FDN], DFF, D, (bf16*)(ws + WS_WDN0), lds, first, stride, lane, wave);
    if (WHICH == CV_DN1) conv_items<0>(a->in[I_FDN] + (size_t)DFF * D, DFF, D, (bf16*)(ws + WS_WDN0 + 86 * MiB), lds, first, stride, lane, wave);
}
__device__ __forceinline__ void p0_prologue(CArgs a, LAS unsigned char* lds, int tid, int lane, int wave) {
    gemv_units(a, lds, 0, blockIdx.x, gridDim.x, tid, lane, wave);
    const int gw = blockIdx.x * NWAVES + wave, NGW = gridDim.x * NWAVES;
    conv_matrix<CV_ABIN>(a, lds, gw, NGW, lane, wave);
#if PROBE_E1
    conv_matrix<CV_ABOUT>(a, lds, gw, NGW, lane, wave);
    conv_matrix<CV_UP0>(a, lds, gw, NGW, lane, wave); conv_matrix<CV_DN0>(a, lds, gw, NGW, lane, wave); conv_matrix<CV_MIN>(a, lds, gw, NGW, lane, wave); conv_matrix<CV_MOUT>(a, lds, gw, NGW, lane, wave);
    conv_matrix<CV_UP1>(a, lds, gw, NGW, lane, wave); conv_matrix<CV_DN1>(a, lds, gw, NGW, lane, wave); __syncthreads(); gemv_units(a, lds, 1, blockIdx.x, gridDim.x, tid, lane, wave);
#endif
}
__device__ __forceinline__ int gemm_wgs(int nwg) { const int G = gridDim.x, rounds = (nwg + G - 1) / G; const int g = ((nwg + rounds - 1) / rounds + 7) & ~7; return g < G ? g : G; }

template <bool RES, bool DOH, bool XIN_BF, bool XOUT_BF>
__device__ __forceinline__ void row_phase(LAS unsigned char* lds, int nrows, const void* xin_lat, const void* xin_ctx, void* xout_lat, void* xout_ctx,
                                          const bf16* Y, const float* gpost, const float* modres, int gate_idx,
                                          const float* gpre, const float* modh, int shift_idx, int scale_idx, bf16* H, int tid, int lane, int wave) {
    LAS f32x4* pG = (LAS f32x4*)lds; LAS f32x4* pA = pG + 1024; LAS f32x4* pB = pA + 1024;
    const int G = gridDim.x, rpw = (nrows + G - 1) / G, r0 = (int)blockIdx.x * rpw, r1 = (r0 + rpw < nrows) ? r0 + rpw : nrows;
    for (int vb = r0; vb < r1;) {
        const int mr = vb < ML ? (vb >> 13) : 2;
        const int lim = mr == 0 ? SEQ : (mr == 1 ? ML : nrows), vend = r1 < lim ? r1 : lim;
        __syncthreads();
        for (int i = tid; i < 1024; i += NTHREADS) {
            if (RES) pG[i] = ((const f32x4*)(modres + (size_t)mr * NMODC + gate_idx * D))[i] * ((const f32x4*)gpost)[i];
            if (DOH) { pA[i] = ((const f32x4*)gpre)[i] * (((const f32x4*)(modh + (size_t)mr * NMODC + scale_idx * D))[i] + 1.0f); pB[i] = ((const f32x4*)(modh + (size_t)mr * NMODC + shift_idx * D))[i]; }
        }
        __syncthreads();
        for (int row = vb + wave; row < vend; row += NWAVES) {
            const float* xr = XIN_BF ? nullptr : (row < ML ? (const float*)xin_lat + (size_t)row * D : (const float*)xin_ctx + (size_t)(row - ML) * D);
            const bf16* xrb = XIN_BF ? (const bf16*)xin_lat + (size_t)row * D : nullptr;
            f32x4 v[16];
            if (RES) {
                const bf16* yr = Y + (size_t)row * D; float s = 0.f;
#pragma unroll
                for (int j = 0; j < 16; ++j) { const v2u yw = *(const v2u*)(yr + j * 256 + lane * 4); v[j] = (f32x4){bflo(yw.x), bfhi(yw.x), bflo(yw.y), bfhi(yw.y)}; s += (v[j].x * v[j].x + v[j].y * v[j].y) + (v[j].z * v[j].z + v[j].w * v[j].w); }
                const float rstd = 1.0f / sqrtf(wave_sum(s) * (1.0f / D) + EPS);
                float* xo = XOUT_BF ? nullptr : (row < ML ? (float*)xout_lat + (size_t)row * D : (float*)xout_ctx + (size_t)(row - ML) * D);
                bf16* xob = XOUT_BF ? (bf16*)xout_lat + (size_t)row * D : nullptr;
#pragma unroll
                for (int j = 0; j < 16; ++j) { const int o = j * 256 + lane * 4;
                    f32x4 x;
                    if (XIN_BF) { const v2u xw = *(const v2u*)(xrb + o); x = (f32x4){bflo(xw.x), bfhi(xw.x), bflo(xw.y), bfhi(xw.y)}; } else x = *(const f32x4*)(xr + o);
                    v[j] = x + (v[j] * rstd) * pG[j * 64 + lane];
                    if (XOUT_BF) { v2u w; w.x = pk2(v[j].x, v[j].y); w.y = pk2(v[j].z, v[j].w); *(v2u*)(xob + o) = w; } else *(f32x4*)(xo + o) = v[j];
                    if ((j & 3) == 3) asm volatile("" ::: "memory"); }
            } else {
#pragma unroll
                for (int j = 0; j < 16; ++j) v[j] = *(const f32x4*)(xr + j * 256 + lane * 4);
            }
            if (DOH) {
                float s = 0.f;
#pragma unroll
                for (int j = 0; j < 16; ++j) s += (v[j].x * v[j].x + v[j].y * v[j].y) + (v[j].z * v[j].z + v[j].w * v[j].w);
                const float rstd = 1.0f / sqrtf(wave_sum(s) * (1.0f / D) + EPS);
                bf16* hr = H + (size_t)row * D;
#pragma unroll
                for (int j = 0; j < 16; ++j) { const int o = j * 256 + lane * 4;
                    const f32x4 h = (v[j] * rstd) * pA[j * 64 + lane] + pB[j * 64 + lane];
                    v2u w; w.x = pk2(h.x, h.y); w.y = pk2(h.z, h.w);
                    *(v2u*)(hr + o) = w; }
            }
        }
        vb = vend;
    }
}

__device__ __forceinline__ void mixer_conv_phase(CArgs a, LAS unsigned char* lds, int tid, int lane) {
    const bf16* U = (const bf16*)(a->ws + WS_U);
    bf16* T1 = (bf16*)(a->ws + WS_Y);
    bf16* V = (bf16*)(a->ws + WS_G);
    LAS float* tile = (LAS float*)lds;
    const float* cw = a->in[I_ACONVW]; const float* cb = a->in[I_ACONVB];
    v4u rva[6]; f32x2 w[ACONV]; f32x2 bias = {0.f, 0.f}; int cc_w = -1;
#define MX_ROW(tb_, j_) ((tb_) < 256 ? (((j_) >= 15 && (j_) < 79) ? (tb_) * 64 + ((j_) - 15) : -1) \
        : ((((tb_) - 256) & 3) * 64 + ((j_) - 15) >= 0 && (((tb_) - 256) & 3) * 64 + ((j_) - 15) < CTXL ? ML + (((tb_) - 256) >> 2) * CTXL + (((tb_) - 256) & 3) * 64 + ((j_) - 15) : -1))
#define MX_LOAD(unit_) do { const int tb_ = (unit_) >> 3, cc_ = (unit_) & 7; \
        _Pragma("unroll") for (int q = 0; q < 6; ++q) { const int it = tid + NTHREADS * q; const int j = it >> 5, ch8 = it & 31; const int row = it < 94 * 32 ? MX_ROW(tb_, j) : -1; \
            const size_t o_ = (size_t)(row >= 0 ? row : 0) * ABU + cc_ * 256 + ch8 * 8; rva[q] = *(const v4u*)(U + o_); } } while (0)
    if ((int)blockIdx.x < 264 * 8) MX_LOAD(blockIdx.x);
    for (int unit = blockIdx.x; unit < 264 * 8; unit += gridDim.x) {
        const int tb = unit >> 3, cc = unit & 7;
#pragma unroll
        for (int q = 0; q < 6; ++q) { const int it = tid + NTHREADS * q; const int j = it >> 5, ch8 = it & 31;
            if (it < 94 * 32) { const int row = MX_ROW(tb, j); const float f = row >= 0 ? 1.f : 0.f; const v4u va = rva[q]; f32x4 g0, g1;
                g0.x = f * bflo(va.x); g0.y = f * bfhi(va.x); g0.z = f * bflo(va.y); g0.w = f * bfhi(va.y);
                g1.x = f * bflo(va.z); g1.y = f * bfhi(va.z); g1.z = f * bflo(va.w); g1.w = f * bfhi(va.w);
                *(LAS f32x4*)(tile + j * 256 + ch8 * 8) = g0; *(LAS f32x4*)(tile + j * 256 + ch8 * 8 + 4) = g1; } }
        __syncthreads();
        if (unit + (int)gridDim.x < 264 * 8) MX_LOAD(unit + (int)gridDim.x);
        {
            const int cp = tid & 127, tg = tid >> 7, c = cc * 256 + 2 * cp;
            if (cc != cc_w) { cc_w = cc;
#pragma unroll
                for (int k = 0; k < ACONV; ++k) w[k] = *(const f32x2*)(cw + k * WA + c);
                bias = *(const f32x2*)(cb + c); }
            f32x2 acc[16];
#pragma unroll
            for (int i = 0; i < 16; ++i) acc[i] = (f32x2){0.f, 0.f};
#pragma unroll
            for (int jj = 0; jj < 46; ++jj) {
                const f32x2 g = *(const LAS f32x2*)(tile + (16 * tg + jj) * 256 + 2 * cp);
#pragma unroll
                for (int i = 0; i < 16; ++i) { const int k = jj - i; if (k >= 0 && k < ACONV) acc[i] += w[k] * g; }
            }
            int row0;
            if (tb < 256) row0 = tb * 64 + 16 * tg; else { const int cbk = tb - 256; row0 = ML + (cbk >> 2) * CTXL + (cbk & 3) * 64 + 16 * tg; }
#pragma unroll
            for (int i = 0; i < 16; ++i) { const f32x2 o = acc[i] + bias; *(unsigned*)(T1 + (size_t)(row0 + i) * WA + c) = pk2(o.x, o.y); }
        }
        __syncthreads();
    }
#undef MX_ROW
#undef MX_LOAD
    const float* bw = a->in[I_BCONVW];
    constexpr int NSEG_L = 2 * 64 * 16, NIT_L = NSEG_L * 256, NIT_C = 2 * 32 * 256;
    for (int it = blockIdx.x * NTHREADS + tid; it < NIT_L + NIT_C; it += gridDim.x * NTHREADS) {
        int row0, stride, prow, nrow, c;
        if (it < NIT_L) { const int c8 = it & 255, r = it >> 8, x = r & 63, seg = (r >> 6) & 15, b = r >> 10;
            c = c8 * 8; stride = 64; row0 = b * SEQ + (seg * 8) * 64 + x; prow = seg > 0 ? row0 - 64 : -1; nrow = seg < 15 ? row0 + 8 * 64 : -1; }
        else { const int j = it - NIT_L, c8 = j & 255, r = j >> 8, seg = r & 31, b = r >> 5;
            c = c8 * 8; stride = 1; row0 = ML + b * CTXL + seg * 8; prow = seg > 0 ? row0 - 1 : -1; nrow = seg < 31 ? row0 + 8 : -1; }
        float w[3][8];
#pragma unroll
        for (int k = 0; k < 3; ++k) { const f32x4 w0 = *(const f32x4*)(bw + k * 2048 + c), w1 = *(const f32x4*)(bw + k * 2048 + c + 4);
            w[k][0] = w0.x; w[k][1] = w0.y; w[k][2] = w0.z; w[k][3] = w0.w; w[k][4] = w1.x; w[k][5] = w1.y; w[k][6] = w1.z; w[k][7] = w1.w; }
        const bf16* uz = U + 4096 + c; const bf16* ub = U + 2048 + c;
        v4u rc[10], rb[8];
#pragma unroll
        for (int i = 0; i < 10; ++i) { const int rr = i == 0 ? (prow >= 0 ? prow : row0) : (i == 9 ? (nrow >= 0 ? nrow : row0) : row0 + (i - 1) * stride);
            rc[i] = *(const v4u*)(uz + (size_t)rr * ABU); }
#pragma unroll
        for (int i = 0; i < 8; ++i) rb[i] = *(const v4u*)(ub + (size_t)(row0 + i * stride) * ABU);
        float pp[8], pc[8];
        { float a8[8]; cvt8(rc[0], a8); const float f = prow >= 0 ? 1.f : 0.f;
#pragma unroll
          for (int e = 0; e < 8; ++e) pp[e] = a8[e] * f;
          cvt8(rc[1], pc); }
#pragma unroll
        for (int i = 0; i < 8; ++i) {
            float pn[8], bb[8]; cvt8(rc[i + 2], pn); cvt8(rb[i], bb);
            const float f = (i == 7 && nrow < 0) ? 0.f : 1.f;
#pragma unroll
            for (int e = 0; e < 8; ++e) pn[e] *= f;
            float o[8];
#pragma unroll
            for (int e = 0; e < 8; ++e) o[e] = bb[e] * (w[0][e] * pp[e] + w[1][e] * pc[e] + w[2][e] * pn[e]);
            v4u ov; ov.x = pk2(o[0], o[1]); ov.y = pk2(o[2], o[3]); ov.z = pk2(o[4], o[5]); ov.w = pk2(o[6], o[7]);
            *(v4u*)(V + (size_t)(row0 + i * stride) * D + WA + c) = ov;
#pragma unroll
            for (int e = 0; e < 8; ++e) { pp[e] = pc[e]; pc[e] = pn[e]; }
        }
    }
}
__device__ __forceinline__ void mixer_ln_phase(CArgs a, LAS unsigned char* lds, int tid, int lane, int wave) {
    const bf16* T1 = (const bf16*)(a->ws + WS_Y);
    bf16* V = (bf16*)(a->ws + WS_G);
    LAS f32x4* pg = (LAS f32x4*)lds; LAS f32x4* pb = pg + 512;
    for (int i = tid; i < 512; i += NTHREADS) { pg[i] = ((const f32x4*)a->in[I_ALNG])[i]; pb[i] = ((const f32x4*)a->in[I_ALNB])[i]; }
    __syncthreads();
    const int G = gridDim.x, rpw = (MT + G - 1) / G, r0 = (int)blockIdx.x * rpw, r1 = (r0 + rpw < MT) ? r0 + rpw : MT;
    for (int row = r0 + wave; row < r1; row += NWAVES) {
        f32x4 v[8]; float s = 0.f;
#pragma unroll
        for (int j = 0; j < 8; ++j) { const v2u tw = *(const v2u*)(T1 + (size_t)row * WA + j * 256 + lane * 4); v[j] = (f32x4){bflo(tw.x), bfhi(tw.x), bflo(tw.y), bfhi(tw.y)}; s += (v[j].x + v[j].y) + (v[j].z + v[j].w); }
        const float mu = wave_sum(s) * (1.0f / WA); float q = 0.f;
#pragma unroll
        for (int j = 0; j < 8; ++j) { v[j] = v[j] - mu; q += (v[j].x * v[j].x + v[j].y * v[j].y) + (v[j].z * v[j].z + v[j].w * v[j].w); }
        const float rstd = 1.0f / sqrtf(wave_sum(q) * (1.0f / WA) + EPS);
#pragma unroll
        for (int j = 0; j < 8; ++j) { const int o = j * 256 + lane * 4;
            const f32x4 y = (v[j] * rstd) * pg[j * 64 + lane] + pb[j * 64 + lane];
            v2u w; w.x = pk2(siluf_(y.x), siluf_(y.y)); w.y = pk2(siluf_(y.z), siluf_(y.w));
            *(v2u*)(V + (size_t)row * D + o) = w; }
    }
}

template <int NR>
__device__ __forceinline__ void ffn_gate_slide(const bf16* ug, const bf16* uv, int ldu, bf16* Go, const float* cwg, const float* cwv, int row0, int prow, int nrow) {
    float wg[3][8], wv[3][8];
#pragma unroll
    for (int k = 0; k < 3; ++k) {
        const f32x4 a0 = *(const f32x4*)(cwg + k * DFF2), a1 = *(const f32x4*)(cwg + k * DFF2 + 4), b0 = *(const f32x4*)(cwv + k * DFF2), b1 = *(const f32x4*)(cwv + k * DFF2 + 4);
        wg[k][0] = a0.x; wg[k][1] = a0.y; wg[k][2] = a0.z; wg[k][3] = a0.w; wg[k][4] = a1.x; wg[k][5] = a1.y; wg[k][6] = a1.z; wg[k][7] = a1.w;
        wv[k][0] = b0.x; wv[k][1] = b0.y; wv[k][2] = b0.z; wv[k][3] = b0.w; wv[k][4] = b1.x; wv[k][5] = b1.y; wv[k][6] = b1.z; wv[k][7] = b1.w;
    }
    float pg[8], pv[8], cg[8], cv[8];
    { const float fp = prow >= 0 ? 1.f : 0.f; const int pr = prow >= 0 ? prow : row0;
      const v4u a = *(const v4u*)(ug + (size_t)pr * ldu), b = *(const v4u*)(uv + (size_t)pr * ldu); cvt8(a, pg); cvt8(b, pv);
#pragma unroll
      for (int e = 0; e < 8; ++e) { pg[e] *= fp; pv[e] *= fp; }
      const v4u a2 = *(const v4u*)(ug + (size_t)row0 * ldu), b2 = *(const v4u*)(uv + (size_t)row0 * ldu); cvt8(a2, cg); cvt8(b2, cv); }
    const float fn = nrow >= 0 ? 1.f : 0.f; const int nr = nrow >= 0 ? nrow : row0;
    for (int blk = 0; blk < NR / 4; ++blk) {
        v4u rg[4], rv[4];
#pragma unroll
        for (int i = 0; i < 4; ++i) { const int r = 4 * blk + 1 + i; const int rr = r < NR ? row0 + r : nr;
            rg[i] = *(const v4u*)(ug + (size_t)rr * ldu); rv[i] = *(const v4u*)(uv + (size_t)rr * ldu); }
#pragma unroll
        for (int i = 0; i < 4; ++i) {
            float ng[8], nv[8]; cvt8(rg[i], ng); cvt8(rv[i], nv);
            if (i == 3) { const float f = (4 * blk + 4 < NR) ? 1.f : fn;
#pragma unroll
                for (int e = 0; e < 8; ++e) { ng[e] *= f; nv[e] *= f; } }
            float o[8];
#pragma unroll
            for (int e = 0; e < 8; ++e) { const float g = wg[0][e] * pg[e] + wg[1][e] * cg[e] + wg[2][e] * ng[e], v = wv[0][e] * pv[e] + wv[1][e] * cv[e] + wv[2][e] * nv[e]; o[e] = siluf_(g) * v; }
            v4u w; w.x = pk2(o[0], o[1]); w.y = pk2(o[2], o[3]); w.z = pk2(o[4], o[5]); w.w = pk2(o[6], o[7]);
            *(v4u*)(Go + (size_t)(4 * blk + i) * DFF) = w;
#pragma unroll
            for (int e = 0; e < 8; ++e) { pg[e] = cg[e]; pv[e] = cv[e]; cg[e] = ng[e]; cv[e] = nv[e]; }
        }
    }
}
__device__ __forceinline__ void ffn_gate_ctx_phase(CArgs a, int tid) {
    const bf16* UC = (const bf16*)(a->ws + WS_UC);
    bf16* G = (bf16*)(a->ws + WS_G);
    const float* cw = a->in[I_FCONV];
    constexpr int NC8 = DFF / 8;
    constexpr int NIT = 8 * NC8 * 4, PER = (NIT + 255) / 256;
    for (int it = blockIdx.x * PER + tid; tid < PER && it < NIT; it += gridDim.x * PER) {
        const int q4 = it & 3, rest = it >> 2, c8 = rest % NC8, blk = rest / NC8, ch = c8 * 8;
        const int p0 = (blk & 3) * 64 + q4 * 16, lrow0 = (blk >> 2) * CTXL + p0;
        const bf16* ug = UC + 256 * (ch >> 7) + (ch & 127);
        ffn_gate_slide<16>(ug, ug + 128, DFF2, G + (size_t)(ML + lrow0) * DFF + ch, cw + ch, cw + DFF + ch, lrow0, p0 > 0 ? lrow0 - 1 : -1, p0 + 16 < CTXL ? lrow0 + 16 : -1);
    }
}

__device__ __forceinline__ int chunk_row0(int dir, int b, int c) {
    if (dir == 0) return c < 2 ? ML + b * CTXL + 128 * c : b * SEQ + 128 * (c - 2);
    return c < 2 ? ML + b * CTXL + 128 * (1 - c) : b * SEQ + 128 * (63 - (c - 2));
}
__device__ __forceinline__ float wave_incl_sum(float v, int lane) {
#pragma unroll
    for (int o = 1; o < 64; o <<= 1) { const float t = __shfl_up(v, o); if (lane >= o) v += t; }
    return v;
}
__device__ __forceinline__ float wave_incl_max(float v, int lane) {
#pragma unroll
    for (int o = 1; o < 64; o <<= 1) { const float t = __shfl_up(v, o); if (lane >= o) v = fmaxf(v, t); }
    return v;
}
__device__ __forceinline__ bf16x8 tr_frag(LAS unsigned char* T, int pitch, int k0, int col0, int lane) {
    const int g = lane >> 4, q = (lane & 15) >> 2, p = lane & 3;
    LAS unsigned char* p0 = T + (k0 + 8 * g + q) * pitch + (col0 + 4 * p) * 2;
    const s16x4 lo = __builtin_amdgcn_ds_read_tr16_b64_v4i16((LAS s16x4*)p0);
    const s16x4 hi = __builtin_amdgcn_ds_read_tr16_b64_v4i16((LAS s16x4*)(p0 + 4 * pitch));
    bf16x8 r; r[0] = lo[0]; r[1] = lo[1]; r[2] = lo[2]; r[3] = lo[3]; r[4] = hi[0]; r[5] = hi[1]; r[6] = hi[2]; r[7] = hi[3];
    return r;
}
#ifndef SCAN_REP
#define SCAN_REP 1
#endif
#define MFMA16(y, x, acc) __builtin_amdgcn_mfma_f32_16x16x32_bf16((y), (x), (acc), 0, 0, 0)

constexpr int SK_PITCH = 528;

constexpr size_t WS_QT = WS_G;
constexpr size_t WS_SPP = WS_Y;
constexpr size_t WS_DEN = WS_Y + 64 * MiB;
static_assert((size_t)32 * 64 * 128 * 128 * 2 <= 64 * MiB && WS_DEN + (size_t)32 * 64 * 128 * 4 <= WS_HS, "scan scratch");
__device__ __forceinline__ void chunk_scalars(CArgs a, int dir, int b, int h, int c, LAS float* sAl, LAS float* sPl, int lane) {
    const float* GT = (const float*)(a->ws + WS_GATES);
    float* SCP = (float*)(a->ws + WS_SCP); float* SCG = (float*)(a->ws + WS_SCC);
    const int chain = dir * 16 + b * 8 + h, R0 = chunk_row0(dir, b, c);
    const float bi = a->in[I_MBG][dir * 16 + h], bf = a->in[I_MBG][dir * 16 + 8 + h];
    const int r0 = dir ? 127 - lane : lane, r1 = dir ? 63 - lane : 64 + lane;
    const float i0 = GT[(size_t)(R0 + r0) * 32 + dir * 16 + h] + bi, i1 = GT[(size_t)(R0 + r1) * 32 + dir * 16 + h] + bi;
    const float x0 = GT[(size_t)(R0 + r0) * 32 + dir * 16 + 8 + h] + bf, x1 = GT[(size_t)(R0 + r1) * 32 + dir * 16 + 8 + h] + bf;
    const float f0 = fminf(x0, 0.f) - log1pf(__expf(-fabsf(x0))), f1 = fminf(x1, 0.f) - log1pf(__expf(-fabsf(x1)));
    const float s0 = wave_incl_sum(f0, lane); const float tot0 = __shfl(s0, 63);
    const float s1 = wave_incl_sum(f1, lane) + tot0;
    const float a0 = i0 - s0, a1 = i1 - s1;
    const float p0 = wave_incl_max(a0, lane); const float pm0 = __shfl(p0, 63);
    const float p1 = fmaxf(wave_incl_max(a1, lane), pm0);
    float* o = SCP + ((size_t)chain * NCH + c) * 384;
    o[r0] = a0; o[128 + r0] = p0; o[256 + r0] = s0;
    o[r1] = a1; o[128 + r1] = p1; o[256 + r1] = s1;
    if (sAl) { sAl[r0] = a0; sAl[r1] = a1; }
    if (lane == 63) { SCG[((size_t)chain * NCH + c) * 2] = s1; SCG[((size_t)chain * NCH + c) * 2 + 1] = p1; if (sPl) sPl[0] = p1; }
}
__device__ __forceinline__ void scan_pre_phase(CArgs a, LAS unsigned char* lds, int tid, int lane, int wave) {
    const bf16* QK = (const bf16*)(a->ws + WS_U);
    bf16* SPP = (bf16*)(a->ws + WS_SPP); float* DEN = (float*)(a->ws + WS_DEN); const bf16* QT = (const bf16*)(a->ws + WS_QT);
    LAS unsigned char* Kl = lds; LAS float* sA0 = (LAS float*)(lds + 67584); LAS float* sA1 = sA0 + 128; LAS float* sPt = sA0 + 256;
    const int g = lane >> 4, l15 = lane & 15;
    for (int unit = blockIdx.x; unit < 1024 + 64; unit += gridDim.x) {
        if (unit >= 1024) { if (wave == 0) { const int u = unit - 1024, chain = u >> 1, c = u & 1; chunk_scalars(a, chain >> 4, (chain >> 3) & 1, chain & 7, c, nullptr, nullptr, lane); } continue; }
        const int bh = unit >> 6, j = unit & 63, b = bh >> 3, h = bh & 7;
        const int R0 = b * SEQ + 128 * j, c0 = 2 + j, c1 = 2 + (63 - j);
        const int tl = 16 * wave + l15;
#pragma unroll
        for (int i = 0; i < 8; ++i) { const int idx = tid + NTHREADS * i, r = idx >> 5, ch = idx & 31;
            const v4u v = *(const v4u*)(QK + (size_t)(R0 + r) * QKVO + 2048 + h * DQK + ch * 8);
            *(LAS v4u*)(Kl + r * SK_PITCH + ch * 16) = v; }
        bf16x8 qf[8];
#pragma unroll
        for (int kk = 0; kk < 8; ++kk) qf[kk] = *(const bf16x8*)(QT + ((size_t)((R0 >> 4) + wave) * 64 + 8 * h + kk) * 512 + lane * 8);
        if (wave == 0) chunk_scalars(a, 0, b, h, c0, sA0, sPt, lane);
        if (wave == 1) chunk_scalars(a, 1, b, h, c1, sA1, sPt + 1, lane);
        __syncthreads();
        {
            const float pt0 = sPt[0], pt1 = sPt[1];
            float dp0 = 0.f, dp1 = 0.f;
            int tlv = tl, gv = 4 * g; asm volatile("" : "+v"(tlv), "+v"(gv));
            bf16* sp0 = SPP + (size_t)((0 * 16 + bh) * 64 + (c0 - 2)) * 16384 + (size_t)wave * 2048 + (l15 + 16 * (g >> 1)) * 8 + 4 * (g & 1);
            bf16* sp1 = SPP + (size_t)((1 * 16 + bh) * 64 + (c1 - 2)) * 16384 + (size_t)wave * 2048 + (l15 + 16 * (g >> 1)) * 8 + 4 * (g & 1);
#pragma unroll
            for (int nh = 0; nh < 2; ++nh) {
                f32x4 sacc[4];
#pragma unroll
                for (int n = 0; n < 4; ++n) sacc[n] = (f32x4){0.f, 0.f, 0.f, 0.f};
#pragma unroll
                for (int kk = 0; kk < 8; ++kk)
#pragma unroll
                    for (int n = 0; n < 4; ++n) { const bf16x8 yf = *(const LAS bf16x8*)(Kl + (16 * (4 * nh + n) + l15) * SK_PITCH + (32 * kk + 8 * g) * 2); sacc[n] = MFMA16(yf, qf[kk], sacc[n]); }
#pragma unroll
                for (int n = 0; n < 4; ++n) { float sv0[4], sv1[4]; const int n8 = 4 * nh + n;
#pragma unroll
                    for (int r = 0; r < 4; ++r) { const int sl = 16 * n8 + 4 * g + r; const int sidx = gv + (16 * n8 + r);
                        const float qk = sacc[n][r] * 0.0625f;
                        sv0[r] = (sidx <= tlv) ? qk * __expf(sA0[sl] - pt0) : 0.f; dp0 += sv0[r];
                        sv1[r] = (sidx >= tlv) ? qk * __expf(sA1[sl] - pt1) : 0.f; dp1 += sv1[r]; }
                    v2u w0; w0.x = pk2(sv0[0], sv0[1]); w0.y = pk2(sv0[2], sv0[3]); *(v2u*)(sp0 + (n8 >> 1) * 512 + (n8 & 1) * 256) = w0;
                    v2u w1; w1.x = pk2(sv1[0], sv1[1]); w1.y = pk2(sv1[2], sv1[3]); *(v2u*)(sp1 + (n8 >> 1) * 512 + (n8 & 1) * 256) = w1; }
                asm volatile("" ::: "memory");
            }
            dp0 += __shfl_xor(dp0, 16); dp0 += __shfl_xor(dp0, 32); dp1 += __shfl_xor(dp1, 16); dp1 += __shfl_xor(dp1, 32);
            if (g == 0) { DEN[(size_t)((0 * 16 + bh) * 64 + (c0 - 2)) * 128 + tl] = dp0; DEN[(size_t)((1 * 16 + bh) * 64 + (c1 - 2)) * 128 + tl] = dp1; }
        }
        __syncthreads();
    }
}

constexpr int S2V_PITCH = 160;
constexpr int S2K_PITCH = 544;
__device__ __forceinline__ int s2_sigma(int r) { return (r & ~12) | ((r & 4) << 1) | ((r & 8) >> 1); }
__device__ __forceinline__ bf16x8 tr_frag_sw(LAS unsigned char* T, int pitch, int k0, int col0, int lane) {
    const int g = lane >> 4, q = (lane & 15) >> 2, p = lane & 3;
    LAS unsigned char* p0 = T + (k0 + 16 * (g >> 1) + 4 * (g & 1) + q) * pitch + (col0 + 4 * p) * 2;
    const s16x4 lo = __builtin_amdgcn_ds_read_tr16_b64_v4i16((LAS s16x4*)p0);
    const s16x4 hi = __builtin_amdgcn_ds_read_tr16_b64_v4i16((LAS s16x4*)(p0 + 8 * pitch));
    bf16x8 r; r[0] = lo[0]; r[1] = lo[1]; r[2] = lo[2]; r[3] = lo[3]; r[4] = hi[0]; r[5] = hi[1]; r[6] = hi[2]; r[7] = hi[3];
    return r;
}
constexpr int S2K_OFF = 0, S2V_OFF = 128 * S2K_PITCH, S2S_OFF = S2V_OFF + 128 * S2V_PITCH, S2C_OFF = S2S_OFF + 128 * S2V_PITCH, S2M_OFF = S2C_OFF + 80 * SK_PITCH;
static_assert(S2M_OFF + 4 * 272 <= MISC_OFF, "scan v2 LDS map");
#define SCHED_FENCE() do { } while (0)
#define LDS_BARRIER() do { asm volatile("s_waitcnt lgkmcnt(0)" ::: "memory"); __builtin_amdgcn_s_barrier(); asm volatile("" ::: "memory"); } while (0)
__device__ __forceinline__ void scan_seq_phase(CArgs a, LAS unsigned char* lds, int tid, int lane, int wave) {
    const bf16* QK = (const bf16*)(a->ws + WS_U);
    const float* SCP = (const float*)(a->ws + WS_SCP); const float* SCG = (const float*)(a->ws + WS_SCC);
    const bf16* SPP = (const bf16*)(a->ws + WS_SPP); const float* DEN = (const float*)(a->ws + WS_DEN); const bf16* QT = (const bf16*)(a->ws + WS_QT);
    bf16* HS = (bf16*)(a->ws + WS_HS);
    LAS unsigned char* Kl = lds + S2K_OFF; LAS unsigned char* Vl = lds + S2V_OFF; LAS unsigned char* Vs = lds + S2S_OFF; LAS unsigned char* Cl = lds + S2C_OFF;
    LAS float* mp = (LAS float*)(lds + S2M_OFF); LAS float* ml = mp + 68; LAS float* pt = mp + 136; LAS float* gl = mp + 204;
    for (int unit_ = blockIdx.x; unit_ < 256 * SCAN_REP; unit_ += gridDim.x) { const int u0 = unit_ & 255, unit = ((u0 & 7) << 5) | (u0 >> 3);
        const int chain = unit >> 3, slice = unit & 7, dir = chain >> 4, b = (chain >> 3) & 1, h = chain & 7;
        int tid_u = tid; asm volatile("" : "+v"(tid_u));
        if (tid < NCH) { gl[tid] = SCG[((size_t)chain * NCH + tid) * 2]; pt[tid] = SCG[((size_t)chain * NCH + tid) * 2 + 1]; }
        for (int i = tid_u; i < 80 * SK_PITCH / 4; i += NTHREADS) ((LAS unsigned*)Cl)[i] = 0u;
        for (int i = tid_u; i < 128 * 8; i += NTHREADS) { const int r = i >> 3, w = i & 7; ((LAS unsigned*)(Vs + r * S2V_PITCH + 128))[w] = 0u; }
        __syncthreads();
        if (tid == 0) { float m = 0.f; for (int c = 0; c < NCH; ++c) { const float mx = fmaxf(m, pt[c]); mp[c] = m; ml[c] = mx; m = gl[c] + mx; } }
        __syncthreads();
        f32x4 cacc[5][2];
#pragma unroll
        for (int mt = 0; mt < 5; ++mt)
#pragma unroll
            for (int nt = 0; nt < 2; ++nt) cacc[mt][nt] = (f32x4){0.f, 0.f, 0.f, 0.f};
        v4u kreg[8], vreg[2]; float areg[2];
#define S2_LOAD(cc, T) do { const unsigned koff = (unsigned)((((T) >> 5) * QKVO + ((T) & 31) * 8) * 2), voff = (unsigned)((((T) >> 3) * QKVO + ((T) & 7) * 8) * 2); const int R1_ = chunk_row0(dir, b, (cc)); const char* kb_ = (const char*)(QK + (size_t)R1_ * QKVO + 2048 + h * DQK); const char* vb_ = (const char*)(QK + (size_t)R1_ * QKVO + 4096 + h * DV + slice * 64); \
            const float* ab_ = SCP + ((size_t)chain * NCH + (cc)) * 384; \
            _Pragma("unroll") for (int i = 0; i < 8; ++i) kreg[i] = *(const v4u*)(kb_ + (koff + (unsigned)(i * 16 * QKVO * 2))); \
            _Pragma("unroll") for (int i = 0; i < 2; ++i) { vreg[i] = *(const v4u*)(vb_ + (voff + (unsigned)(i * 64 * QKVO * 2))); areg[i] = ab_[((T) >> 3) + 64 * i]; } } while (0)
#define S2_STORE(cc, T) do { const float mlc_ = ml[(cc)]; \
            _Pragma("unroll") for (int i = 0; i < 8; ++i) { const int idx = (T) + NTHREADS * i, r = idx >> 5, ch = idx & 31; *(LAS v4u*)(Kl + s2_sigma(r) * S2K_PITCH + ch * 16) = kreg[i]; } \
            _Pragma("unroll") for (int i = 0; i < 2; ++i) { const int idx = (T) + NTHREADS * i, r = idx >> 3, ch = idx & 7; const float ws_ = __expf(areg[i] - mlc_) * 0.0625f;     \
                *(LAS v4u*)(Vl + s2_sigma(r) * S2V_PITCH + ch * 16) = vreg[i]; \
                v4u sc_; sc_.x = pk2(bflo(vreg[i].x) * ws_, bfhi(vreg[i].x) * ws_); sc_.y = pk2(bflo(vreg[i].y) * ws_, bfhi(vreg[i].y) * ws_); sc_.z = pk2(bflo(vreg[i].z) * ws_, bfhi(vreg[i].z) * ws_); sc_.w = pk2(bflo(vreg[i].w) * ws_, bfhi(vreg[i].w) * ws_); \
                *(LAS v4u*)(Vs + s2_sigma(r) * S2V_PITCH + ch * 16) = sc_; \
                if (ch == 0) *(LAS unsigned*)(Vs + s2_sigma(r) * S2V_PITCH + 128) = f2bf(ws_); } } while (0)
        S2_LOAD(0, tid_u); S2_STORE(0, tid_u);
        __syncthreads();
#define S2_OUTP false
        for (int c = 0; c < 2; ++c) {
            const int R0 = chunk_row0(dir, b, c);
            const float m_prev = mp[c], m_last = ml[c], ptot = pt[c];
            constexpr bool outp = S2_OUTP; const bool more = (c + 1 < NCH);
            int tid_o = tid; asm volatile("" : "+v"(tid_o));
            const int lane_o = tid_o & 63, g = lane_o >> 4, l15 = lane_o & 15, tl = 16 * wave + l15;
            bf16x8 qf[8], sf[4]; float pv = 0.f, bv = 0.f, dn = 0.f;
            v2u hw[4] = {{0u, 0u}, {0u, 0u}, {0u, 0u}, {0u, 0u}}; v4u hv[2] = {{0u, 0u, 0u, 0u}, {0u, 0u, 0u, 0u}};
            if (outp) {
                const char* qb = (const char*)(QT + ((size_t)((R0 >> 4) + wave) * 64 + 8 * h) * 512); const unsigned qoff = (unsigned)(lane_o * 16);
#pragma unroll
                for (int kk = 0; kk < 8; ++kk) qf[kk] = *(const bf16x8*)(qb + (qoff + (unsigned)(kk * 1024)));
                const float* scp = SCP + ((size_t)chain * NCH + c) * 384;
                pv = scp[128 + tl]; bv = scp[256 + tl]; dn = DEN[(size_t)(chain * 64 + (c - 2)) * 128 + tl];
            }
            SCHED_FENCE();
            const float w_old = __expf(m_prev - m_last);
#pragma unroll
            for (int mt = 0; mt < 5; ++mt)
#pragma unroll
                for (int nt = 0; nt < 2; ++nt) cacc[mt][nt] = cacc[mt][nt] * w_old;
#pragma unroll
            for (int kk = 0; kk < 4; ++kk) {
                bf16x8 yf[2], xf[5];
#pragma unroll
                for (int nt = 0; nt < 2; ++nt) yf[nt] = tr_frag_sw(Kl, S2K_PITCH, 32 * kk, 32 * wave + 16 * nt, lane_o);
#pragma unroll
                for (int mt = 0; mt < 5; ++mt) xf[mt] = tr_frag_sw(Vs, S2V_PITCH, 32 * kk, 16 * mt, lane_o);
                SCHED_FENCE();
#pragma unroll
                for (int mt = 0; mt < 5; ++mt)
#pragma unroll
                    for (int nt = 0; nt < 2; ++nt) cacc[mt][nt] = MFMA16(yf[nt], xf[mt], cacc[mt][nt]);
                SCHED_FENCE();
            }
            if (outp) { const char* sb = (const char*)(SPP + (size_t)(chain * 64 + (c - 2)) * 16384 + (size_t)wave * 2048); const unsigned soff = (unsigned)(lane_o * 16);
#pragma unroll
                for (int kk = 0; kk < 4; ++kk) sf[kk] = *(const bf16x8*)(sb + (soff + (unsigned)(kk * 1024))); }
            if (more) S2_LOAD(c + 1, tid_o);
            SCHED_FENCE();
            if (outp) {
                f32x4 qacc[5];
#pragma unroll
                for (int n = 0; n < 5; ++n) qacc[n] = (f32x4){0.f, 0.f, 0.f, 0.f};
#pragma unroll
                for (int kk = 0; kk < 8; ++kk) {
                    bf16x8 cf[5];
#pragma unroll
                    for (int n = 0; n < 5; ++n) cf[n] = *(const LAS bf16x8*)(Cl + (16 * n + l15) * SK_PITCH + (32 * kk + 8 * g) * 2);
                    SCHED_FENCE();
#pragma unroll
                    for (int n = 0; n < 5; ++n) qacc[n] = MFMA16(cf[n], qf[kk], qacc[n]);
                    SCHED_FENCE();
                }
                f32x4 nacc[4];
#pragma unroll
                for (int n = 0; n < 4; ++n) nacc[n] = (f32x4){0.f, 0.f, 0.f, 0.f};
#pragma unroll
                for (int k2 = 0; k2 < 4; k2 += 2) {
                    bf16x8 vf[2][4];
#pragma unroll
                    for (int u = 0; u < 2; ++u)
#pragma unroll
                        for (int n = 0; n < 4; ++n) vf[u][n] = tr_frag_sw(Vl, S2V_PITCH, 32 * (k2 + u), 16 * n, lane_o);
                    SCHED_FENCE();
#pragma unroll
                    for (int u = 0; u < 2; ++u)
#pragma unroll
                        for (int n = 0; n < 4; ++n) nacc[n] = MFMA16(vf[u][n], sf[k2 + u], nacc[n]);
                    SCHED_FENCE();
                }
                const float mxt = fmaxf(m_prev, pv), rowfac = __expf(ptot - mxt), winter = __expf(m_prev - mxt);
                const float nq = __shfl(qacc[4][0], l15);
                const float den = rowfac * dn + winter * nq;
                const float inv = 1.0f / fmaxf(fabsf(den), __expf(-bv - mxt));
#pragma unroll
                for (int n = 0; n < 4; ++n) { const f32x4 o = (nacc[n] * rowfac + qacc[n] * winter) * inv; hw[n].x = pk2(o.x, o.y); hw[n].y = pk2(o.z, o.w); }
                bf16* hp = HS + ((size_t)dir * ML + R0 + tl) * D + h * DV + slice * 64 + 8 * g;
                const int src0 = l15 + 16 * (2 * (g & 1)), src1 = src0 + 16; const bool hi_n = (g >> 1) != 0;
#pragma unroll
                for (int k = 0; k < 2; ++k) {
                    const unsigned a0x = __shfl(hw[2 * k].x, src0), a0y = __shfl(hw[2 * k].y, src0), a1x = __shfl(hw[2 * k].x, src1), a1y = __shfl(hw[2 * k].y, src1);
                    const unsigned b0x = __shfl(hw[2 * k + 1].x, src0), b0y = __shfl(hw[2 * k + 1].y, src0), b1x = __shfl(hw[2 * k + 1].x, src1), b1y = __shfl(hw[2 * k + 1].y, src1);
                    hv[k].x = hi_n ? b0x : a0x; hv[k].y = hi_n ? b0y : a0y; hv[k].z = hi_n ? b1x : a1x; hv[k].w = hi_n ? b1y : a1y;
                    *(v4u*)(hp + 32 * k) = hv[k]; }
            }
            LDS_BARRIER();
#pragma unroll
            for (int mt = 0; mt < 5; ++mt)
#pragma unroll
                for (int nt = 0; nt < 2; ++nt) { v2u w; w.x = pk2(cacc[mt][nt][0], cacc[mt][nt][1]); w.y = pk2(cacc[mt][nt][2], cacc[mt][nt][3]);
                    *(LAS v2u*)(Cl + (16 * mt + l15) * SK_PITCH + (32 * wave + 16 * nt + 4 * g) * 2) = w; }
            if (more) S2_STORE(c + 1, tid_o);
            asm volatile("" :: "v"(hv[0]), "v"(hv[1]));
            LDS_BARRIER();
                }
#undef S2_OUTP
#define S2_OUTP true
        for (int c = 2; c < NCH; ++c) {
            const int R0 = chunk_row0(dir, b, c);
            const float m_prev = mp[c], m_last = ml[c], ptot = pt[c];
            constexpr bool outp = S2_OUTP; const bool more = (c + 1 < NCH);
            int tid_o = tid; asm volatile("" : "+v"(tid_o));
            const int lane_o = tid_o & 63, g = lane_o >> 4, l15 = lane_o & 15, tl = 16 * wave + l15;
            bf16x8 qf[8], sf[4]; float pv = 0.f, bv = 0.f, dn = 0.f;
            v2u hw[4] = {{0u, 0u}, {0u, 0u}, {0u, 0u}, {0u, 0u}}; v4u hv[2] = {{0u, 0u, 0u, 0u}, {0u, 0u, 0u, 0u}};
            if (outp) {
                const char* qb = (const char*)(QT + ((size_t)((R0 >> 4) + wave) * 64 + 8 * h) * 512); const unsigned qoff = (unsigned)(lane_o * 16);
#pragma unroll
                for (int kk = 0; kk < 8; ++kk) qf[kk] = *(const bf16x8*)(qb + (qoff + (unsigned)(kk * 1024)));
                const float* scp = SCP + ((size_t)chain * NCH + c) * 384;
                pv = scp[128 + tl]; bv = scp[256 + tl]; dn = DEN[(size_t)(chain * 64 + (c - 2)) * 128 + tl];
            }
            SCHED_FENCE();
            const float w_old = __expf(m_prev - m_last);
#pragma unroll
            for (int mt = 0; mt < 5; ++mt)
#pragma unroll
                for (int nt = 0; nt < 2; ++nt) cacc[mt][nt] = cacc[mt][nt] * w_old;
#pragma unroll
            for (int kk = 0; kk < 4; ++kk) {
                bf16x8 yf[2], xf[5];
#pragma unroll
                for (int nt = 0; nt < 2; ++nt) yf[nt] = tr_frag_sw(Kl, S2K_PITCH, 32 * kk, 32 * wave + 16 * nt, lane_o);
#pragma unroll
                for (int mt = 0; mt < 5; ++mt) xf[mt] = tr_frag_sw(Vs, S2V_PITCH, 32 * kk, 16 * mt, lane_o);
                SCHED_FENCE();
#pragma unroll
                for (int mt = 0; mt < 5; ++mt)
#pragma unroll
                    for (int nt = 0; nt < 2; ++nt) cacc[mt][nt] = MFMA16(yf[nt], xf[mt], cacc[mt][nt]);
                SCHED_FENCE();
            }
            if (outp) { const char* sb = (const char*)(SPP + (size_t)(chain * 64 + (c - 2)) * 16384 + (size_t)wave * 2048); const unsigned soff = (unsigned)(lane_o * 16);
#pragma unroll
                for (int kk = 0; kk < 4; ++kk) sf[kk] = *(const bf16x8*)(sb + (soff + (unsigned)(kk * 1024))); }
            if (more) S2_LOAD(c + 1, tid_o);
            SCHED_FENCE();
            if (outp) {
                f32x4 qacc[5];
#pragma unroll
                for (int n = 0; n < 5; ++n) qacc[n] = (f32x4){0.f, 0.f, 0.f, 0.f};
#pragma unroll
                for (int kk = 0; kk < 8; ++kk) {
                    bf16x8 cf[5];
#pragma unroll
                    for (int n = 0; n < 5; ++n) cf[n] = *(const LAS bf16x8*)(Cl + (16 * n + l15) * SK_PITCH + (32 * kk + 8 * g) * 2);
                    SCHED_FENCE();
#pragma unroll
                    for (int n = 0; n < 5; ++n) qacc[n] = MFMA16(cf[n], qf[kk], qacc[n]);
                    SCHED_FENCE();
                }
                f32x4 nacc[4];
#pragma unroll
                for (int n = 0; n < 4; ++n) nacc[n] = (f32x4){0.f, 0.f, 0.f, 0.f};
#pragma unroll
                for (int k2 = 0; k2 < 4; k2 += 2) {
                    bf16x8 vf[2][4];
#pragma unroll
                    for (int u = 0; u < 2; ++u)
#pragma unroll
                        for (int n = 0; n < 4; ++n) vf[u][n] = tr_frag_sw(Vl, S2V_PITCH, 32 * (k2 + u), 16 * n, lane_o);
                    SCHED_FENCE();
#pragma unroll
                    for (int u = 0; u < 2; ++u)
#pragma unroll
                        for (int n = 0; n < 4; ++n) nacc[n] = MFMA16(vf[u][n], sf[k2 + u], nacc[n]);
                    SCHED_FENCE();
                }
                const float mxt = fmaxf(m_prev, pv), rowfac = __expf(ptot - mxt), winter = __expf(m_prev - mxt);
                const float nq = __shfl(qacc[4][0], l15);
                const float den = rowfac * dn + winter * nq;
                const float inv = 1.0f / fmaxf(fabsf(den), __expf(-bv - mxt));
#pragma unroll
                for (int n = 0; n < 4; ++n) { const f32x4 o = (nacc[n] * rowfac + qacc[n] * winter) * inv; hw[n].x = pk2(o.x, o.y); hw[n].y = pk2(o.z, o.w); }
                bf16* hp = HS + ((size_t)dir * ML + R0 + tl) * D + h * DV + slice * 64 + 8 * g;
                const int src0 = l15 + 16 * (2 * (g & 1)), src1 = src0 + 16; const bool hi_n = (g >> 1) != 0;
#pragma unroll
                for (int k = 0; k < 2; ++k) {
                    const unsigned a0x = __shfl(hw[2 * k].x, src0), a0y = __shfl(hw[2 * k].y, src0), a1x = __shfl(hw[2 * k].x, src1), a1y = __shfl(hw[2 * k].y, src1);
                    const unsigned b0x = __shfl(hw[2 * k + 1].x, src0), b0y = __shfl(hw[2 * k + 1].y, src0), b1x = __shfl(hw[2 * k + 1].x, src1), b1y = __shfl(hw[2 * k + 1].y, src1);
                    hv[k].x = hi_n ? b0x : a0x; hv[k].y = hi_n ? b0y : a0y; hv[k].z = hi_n ? b1x : a1x; hv[k].w = hi_n ? b1y : a1y;
                    *(v4u*)(hp + 32 * k) = hv[k]; }
            }
            LDS_BARRIER();
#pragma unroll
            for (int mt = 0; mt < 5; ++mt)
#pragma unroll
                for (int nt = 0; nt < 2; ++nt) { v2u w; w.x = pk2(cacc[mt][nt][0], cacc[mt][nt][1]); w.y = pk2(cacc[mt][nt][2], cacc[mt][nt][3]);
                    *(LAS v2u*)(Cl + (16 * mt + l15) * SK_PITCH + (32 * wave + 16 * nt + 4 * g) * 2) = w; }
            if (more) S2_STORE(c + 1, tid_o);
            asm volatile("" :: "v"(hv[0]), "v"(hv[1]));
            LDS_BARRIER();
                }
#undef S2_OUTP
#undef S2_LOAD
#undef S2_STORE
    }
}

__device__ __forceinline__ void scan_out_phase(CArgs a, LAS unsigned char* lds, int tid, int lane, int wave) {
    const bf16* HS = (const bf16*)(a->ws + WS_HS);
    const bf16* QK = (const bf16*)(a->ws + WS_U);
    bf16* A2 = (bf16*)(a->ws + WS_G);
    LAS f32x4* pg = (LAS f32x4*)lds;
    for (int i = tid; i < 1024; i += NTHREADS) pg[i] = ((const f32x4*)a->in[I_MHNG])[i];
    __syncthreads();
    const int G = gridDim.x, rpw = (ML + G - 1) / G, r0 = (int)blockIdx.x * rpw, r1 = (r0 + rpw < ML) ? r0 + rpw : ML;
    for (int row = r0 + wave; row < r1; row += NWAVES) {
        const bf16* hfp = HS + (size_t)row * D + lane * 8; const bf16* hbp = hfp + (size_t)ML * D; const bf16* op = QK + (size_t)row * QKVO + 8192 + lane * 8; bf16* ap = A2 + (size_t)row * D + lane * 8;
#pragma unroll 1
        for (int hb4 = 0; hb4 < HEADS; hb4 += 4) {
            v4u hf[4], hb[4], ov[4];
#pragma unroll
            for (int i = 0; i < 4; ++i) { hf[i] = *(const v4u*)(hfp + (hb4 + i) * DV); hb[i] = *(const v4u*)(hbp + (hb4 + i) * DV); ov[i] = *(const v4u*)(op + (hb4 + i) * DV); }
#pragma unroll
            for (int i = 0; i < 4; ++i) {
                const f32x4 va = {bflo(hf[i].x) + bflo(hb[i].x), bfhi(hf[i].x) + bfhi(hb[i].x), bflo(hf[i].y) + bflo(hb[i].y), bfhi(hf[i].y) + bfhi(hb[i].y)};
                const f32x4 vb = {bflo(hf[i].z) + bflo(hb[i].z), bfhi(hf[i].z) + bfhi(hb[i].z), bflo(hf[i].w) + bflo(hb[i].w), bfhi(hf[i].w) + bfhi(hb[i].w)};
                const float s = ((va.x * va.x + va.y * va.y) + (va.z * va.z + va.w * va.w)) + ((vb.x * vb.x + vb.y * vb.y) + (vb.z * vb.z + vb.w * vb.w));
                const float rstd = 1.0f / sqrtf(wave_sum(s) * (1.0f / DV) + EPS);
                const f32x4 ga = pg[((hb4 + i) * DV) / 4 + lane * 2], gb = pg[((hb4 + i) * DV) / 4 + lane * 2 + 1];
                const f32x4 ya = (va * rstd) * ga, yb = (vb * rstd) * gb;
                v4u w; w.x = pk2(ya.x * sigmoidf_(bflo(ov[i].x)), ya.y * sigmoidf_(bfhi(ov[i].x))); w.y = pk2(ya.z * sigmoidf_(bflo(ov[i].y)), ya.w * sigmoidf_(bfhi(ov[i].y)));
                w.z = pk2(yb.x * sigmoidf_(bflo(ov[i].z)), yb.y * sigmoidf_(bfhi(ov[i].z))); w.w = pk2(yb.z * sigmoidf_(bflo(ov[i].w)), yb.w * sigmoidf_(bfhi(ov[i].w)));
                *(v4u*)(ap + (hb4 + i) * DV) = w; }
        }
    }
}

constexpr int NPHASES = 21;
__global__ void __launch_bounds__(NTHREADS, 2) fwd_kernel(Args args_unused) {
    extern __shared__ __attribute__((aligned(16))) unsigned char lds_raw[];
    LAS unsigned char* lds = (LAS unsigned char*)lds_raw;
    const int wave_s = __builtin_amdgcn_readfirstlane((int)threadIdx.x >> 6);
    { const int tid = threadIdx.x; volatile LAS unsigned* MISC = (volatile LAS unsigned*)(lds + MISC_OFF);
      if (tid < 16) MISC[tid] = 0u;
      __syncthreads();
      if (!MK_PER_PHASE) (void)xcd_barrier_post((unsigned*)(get_args()->ws + WS_CTL) + CW_BAR, MISC); }
#define PH_IDS for (int tid = opaque_tid(wave_s), lane = tid & 63, wave = __builtin_amdgcn_readfirstlane(tid >> 6), once_ = 1; once_; once_ = 0)
#if MK_PER_PHASE
#define IN(k) (get_args()->ph_lo == (k)) PH_IDS if (true
#define SEAM(k) do { } while (0)
#else
#ifndef PROBE_PHASE
#define PROBE_PHASE -1
#endif
#define IN(k) true) for (int rep_ = 0; rep_ < ((k) == PROBE_PHASE ? 2 : 1); ++rep_) PH_IDS if (true
#define SEAM(k) do { XcdBarrier b_; b_.bar = (unsigned*)(get_args()->ws + WS_CTL) + CW_BAR; b_.x = xb_xcc_id(); b_.st = (volatile LAS unsigned*)(lds + MISC_OFF); xcd_barrier(b_); } while (0)
#endif
#define WSP(off) (get_args()->ws + (off))
#define MODP(layer) ((const float*)WSP(WS_MOD) + (layer) * 3 * NMODC)
#define NGP(i) (get_args()->in[I_NORMG] + (i) * D)

#define GEMM_PHASE(EPI, A_, B_, M_, N_, K_, EINIT, HAS_SIDE, SIDE) { const int nwg_ = ((M_) / 256) * ((N_) / 256), gg_ = (HAS_SIDE) ? gemm_wgs(nwg_) : (int)gridDim.x; \
        if ((int)blockIdx.x < gg_) { pg8::Gemm g{A_, B_, M_, N_, K_}; pg8::StaticOrder S; S.init(M_, N_, gg_, blockIdx.x); EPI E EINIT; pg8::gemm_phase<EPI, pg8::StaticOrder, true, true>(lds, g, S, E, tid); } \
          \
        const int t0_ = (HAS_SIDE) ? gg_ : ((nwg_ % (int)gridDim.x) ? nwg_ % (int)gridDim.x : (int)gridDim.x); \
        if (!PROBE_E1 && (int)blockIdx.x >= t0_) { const int si_ = (int)blockIdx.x - t0_, ns_ = (int)gridDim.x - t0_, sf_ = si_ * NWAVES + wave, sn_ = ns_ * NWAVES; (void)si_; (void)ns_; (void)sf_; (void)sn_; SIDE } }

    if (IN(0)) { p0_prologue(get_args(), lds, tid, lane, wave); __syncthreads(); } SEAM(0);
    if (IN(1)) { CArgs a = get_args(); row_phase<false, true, false, false>(lds, MT, a->in[I_X], a->in[I_CTX], nullptr, nullptr, nullptr, nullptr, nullptr, 0, NGP(0), MODP(0), 0, 1, (bf16*)WSP(WS_H), tid, lane, wave); }
    SEAM(1);
    if (IN(2)) GEMM_PHASE(pg8::EpiAB, (const bf16*)WSP(WS_H), (const bf16*)WSP(WS_WABIN), MT, ABIN, D, ({(bf16*)WSP(WS_U)}), false,
                          conv_matrix<CV_ABOUT>(get_args(), lds, sf_, sn_, lane, wave);)
    SEAM(2);
    if (IN(3)) mixer_conv_phase(get_args(), lds, tid, lane);
    SEAM(3);
    if (IN(4)) mixer_ln_phase(get_args(), lds, tid, lane, wave);
    SEAM(4);
    if (IN(5)) GEMM_PHASE(pg8::EpiBf16, (const bf16*)WSP(WS_G), (const bf16*)WSP(WS_WABOUT), MT, D, D, ({(bf16*)WSP(WS_Y), D}), true,
                          conv_matrix<CV_UP0>(get_args(), lds, sf_, sn_, lane, wave);)
    SEAM(5);
    if (IN(6)) { CArgs a = get_args(); row_phase<true, true, false, true>(lds, MT, a->in[I_X], a->in[I_CTX], WSP(WS_XB), nullptr, (const bf16*)WSP(WS_Y), NGP(1), MODP(0), 2, NGP(2), MODP(0), 3, 4, (bf16*)WSP(WS_H), tid, lane, wave); }
    SEAM(6);
    if (IN(7)) GEMM_PHASE(pg8::EpiGate, (const bf16*)WSP(WS_H), (const bf16*)WSP(WS_WUP0), MT, DFF2, D, ({(bf16*)WSP(WS_G), (bf16*)WSP(WS_UC), get_args()->in[I_FCONV]}), false,
                          conv_matrix<CV_DN0>(get_args(), lds, sf_, sn_, lane, wave);)
    SEAM(7);
    if (IN(8)) ffn_gate_ctx_phase(get_args(), tid);
    SEAM(8);
    if (IN(9)) GEMM_PHASE(pg8::EpiBf16, (const bf16*)WSP(WS_G), (const bf16*)WSP(WS_WDN0), MT, D, DFF, ({(bf16*)WSP(WS_Y), D}), true,
                          gemv_units(get_args(), lds, 1, si_, ns_, tid, lane, wave);
                          conv_matrix<CV_MIN>(get_args(), lds, sf_, sn_, lane, wave); conv_matrix<CV_MOUT>(get_args(), lds, sf_, sn_, lane, wave);
                          conv_matrix<CV_UP1>(get_args(), lds, sf_, sn_, lane, wave);)
    SEAM(9);
    if (IN(10)) { CArgs a = get_args(); row_phase<true, true, true, true>(lds, MT, WSP(WS_XB), nullptr, WSP(WS_XB), nullptr, (const bf16*)WSP(WS_Y), NGP(3), MODP(0), 5, NGP(4), MODP(1), 0, 1, (bf16*)WSP(WS_H), tid, lane, wave); }
    SEAM(10);
    if (IN(11)) GEMM_PHASE(pg8::EpiMIn, (const bf16*)WSP(WS_H), (const bf16*)WSP(WS_WMIN), MT, CINP, D, ({(bf16*)WSP(WS_U), QKVO, (float*)WSP(WS_GATES), (bf16*)WSP(WS_QT)}), false,
                           conv_matrix<CV_DN1>(get_args(), lds, sf_, sn_, lane, wave);)
    SEAM(11);
    if (IN(12)) scan_pre_phase(get_args(), lds, tid, lane, wave);
    SEAM(12);
    if (IN(13)) scan_seq_phase(get_args(), lds, tid, lane, wave);
    SEAM(13);
    if (IN(14)) scan_out_phase(get_args(), lds, tid, lane, wave);
    SEAM(14);
    if (IN(15)) GEMM_PHASE(pg8::EpiBf16, (const bf16*)WSP(WS_G), (const bf16*)WSP(WS_WMOUT), ML, D, D, ({(bf16*)WSP(WS_Y), D}), false, ;)
    SEAM(15);
    if (IN(16)) { CArgs a = get_args(); row_phase<true, true, true, true>(lds, ML, WSP(WS_XB), nullptr, WSP(WS_XB), nullptr, (const bf16*)WSP(WS_Y), NGP(5), MODP(1), 2, NGP(6), MODP(1), 3, 4, (bf16*)WSP(WS_H), tid, lane, wave); }
    SEAM(16);
    if (IN(17)) GEMM_PHASE(pg8::EpiGate, (const bf16*)WSP(WS_H), (const bf16*)WSP(WS_WUP0 + 172 * MiB), ML, DFF2, D, ({(bf16*)WSP(WS_G), (bf16*)WSP(WS_UC), get_args()->in[I_FCONV] + 3 * DFF2}), false, ;)
    SEAM(17);
    if (IN(19)) GEMM_PHASE(pg8::EpiBf16, (const bf16*)WSP(WS_G), (const bf16*)WSP(WS_WDN0 + 86 * MiB), ML, D, DFF, ({(bf16*)WSP(WS_Y), D}), false, ;)
    SEAM(19);
    if (IN(20)) { CArgs a = get_args(); row_phase<true, false, true, false>(lds, ML, WSP(WS_XB), nullptr, a->out, nullptr, (const bf16*)WSP(WS_Y), NGP(7), MODP(1), 5, nullptr, nullptr, 0, 0, nullptr, tid, lane, wave); }
#undef IN
#undef SEAM
}

extern "C" void kernel_launch(void* const* d_in, const int* in_sizes, int n_in, void* d_out, int out_size, void* d_ws, size_t ws_size, hipStream_t stream) {
    static int grid = 0;
    if (grid == 0) {
        if (n_in != 21 || out_size != ML * D || ws_size < WS_END) { fprintf(stderr, "kernel_launch: unexpected problem (n_in %d, out %d, ws %zu < %zu); nothing launched\n", n_in, out_size, ws_size, (size_t)WS_END); grid = -1; return; }
        int dev = 0, cus = 0, per_cu = 0;
        if (hipGetDevice(&dev) != hipSuccess || hipDeviceGetAttribute(&cus, hipDeviceAttributeMultiprocessorCount, dev) != hipSuccess) { grid = -1; return; }
        if (hipFuncSetAttribute((const void*)fwd_kernel, hipFuncAttributeMaxDynamicSharedMemorySize, LDS_BYTES) != hipSuccess) { fprintf(stderr, "kernel_launch: hipFuncSetAttribute failed\n"); grid = -1; return; }
        if (hipOccupancyMaxActiveBlocksPerMultiprocessor(&per_cu, (const void*)fwd_kernel, NTHREADS, LDS_BYTES) != hipSuccess || per_cu < 1)
            fprintf(stderr, "kernel_launch: occupancy query reports %d workgroups per CU\n", per_cu);
        (void)hipGetLastError();
        grid = cus;
    }
    if (grid < 0) return;
    if (hipMemsetAsync((char*)d_ws + WS_CTL, 0, CTL_ZERO_BYTES, stream) != hipSuccess) return;
    Args a{};
    for (int i = 0; i < 21; ++i) a.in[i] = (const float*)d_in[i];
    a.out = (float*)d_out; a.ws = (unsigned char*)d_ws;
#if MK_PER_PHASE
    for (int p = 0; p < NPHASES; ++p) { a.ph_lo = p; a.ph_hi = p + 1; hipLaunchKernelGGL(fwd_kernel, dim3(grid), dim3(NTHREADS), LDS_BYTES, stream, a); }
#else
    a.ph_lo = 0; a.ph_hi = NPHASES;
    hipLaunchKernelGGL(fwd_kernel, dim3(grid), dim3(NTHREADS), LDS_BYTES, stream, a);
#endif
}
```

```cpp
#include <hip/hip_runtime.h>
#include <cstdio>
#include <cstdint>

#ifndef PROBE_E1
#define PROBE_E1 0
#endif
#ifndef MK_PER_PHASE
#define MK_PER_PHASE 0
#endif

namespace pg8 {
#define PG8_LAS __attribute__((address_space(3)))
typedef unsigned short bf16_t;
typedef short bf16x8 __attribute__((ext_vector_type(8)));
typedef float f32x4 __attribute__((ext_vector_type(4)));
typedef unsigned u32x4 __attribute__((ext_vector_type(4)));
constexpr int BM = 256, BK = 64, HALF = 128, HTB = HALF * BK * 2, STAGE_BYTES = 8 * HTB, NXCD = 8, WGM = 4;

__host__ __device__ __forceinline__ int lds_byte(int r, int c) { const int st = (r >> 4) * 2 + (c >> 5), rr = r & 15, cc = c & 31, ob = rr * 64 + cc * 2; return st * 1024 + (ob ^ (((ob >> 9) & 1) << 5)); }
__host__ __device__ __forceinline__ void stage_rc(int b, int& R, int& C) { const int st = b / 1024, sb = b % 1024, swz = sb ^ (((sb >> 9) & 1) << 5); R = (st >> 1) * 16 + swz / 64; C = (st & 1) * 32 + (swz % 64) / 2; }
__host__ __device__ __forceinline__ int perm32(int rho) { const int n = rho >> 4, i = rho & 15; return 8 * (i >> 2) + 4 * n + (i & 3); }

struct Unit { int pm, pn; };
struct Gemm { const bf16_t* A; const bf16_t* Bt; int M, N, K; };

struct StaticOrder {
    int nM, nN, nwg, G, c;
    __host__ __device__ void init(int M, int N, int G_, int c_) { nM = M / BM; nN = N / BM; nwg = nM * nN; G = G_; c = c_; }
    __host__ __device__ bool next(int i, Unit& u) const {
        const long L = (long)i * G + c; if (L >= nwg) return false;
        int wgid = (int)L; { const int q = nwg / NXCD, r = nwg % NXCD, xcd = wgid % NXCD, off = wgid / NXCD; wgid = (xcd < r ? xcd * (q + 1) : r * (q + 1) + (xcd - r) * q) + off; }
        const int nig = WGM * nN, gid = wgid / nig, fm = gid * WGM, gsz = (nM - fm) < WGM ? (nM - fm) : WGM;
        u.pm = fm + ((wgid % nig) % gsz); u.pn = (wgid % nig) / gsz; return true;
    }
    __device__ __forceinline__ void a_ready(const Unit&) const {}
    __device__ __forceinline__ void done(const Unit&) const {}
};

__device__ __forceinline__ unsigned cvt_pk_bf16(float lo, float hi) { unsigned r; asm volatile("v_cvt_pk_bf16_f32 %0, %1, %2" : "=v"(r) : "v"(lo), "v"(hi)); return r; }

struct EpiBf16 {
    static constexpr bool PERM = true, AFTER_DRAIN = false, PERM_A = false;
    bf16_t* O; int ldc;
    __device__ __forceinline__ void operator()(const f32x4 (&acc)[2][2][4][2], const Unit& u, int wr, int wc, int fr, int fq) const {
        const int row0 = u.pm * BM + wr * 64 + fr, col0 = u.pn * BM + wc * 32 + 8 * fq;
#pragma unroll
        for (int ai = 0; ai < 2; ++ai)
#pragma unroll
            for (int m = 0; m < 4; ++m) { bf16_t* rowp = O + (size_t)(row0 + ai * HALF + m * 16) * ldc + col0;
#pragma unroll
                for (int bj = 0; bj < 2; ++bj) { const f32x4 v0 = acc[ai][bj][m][0], v1 = acc[ai][bj][m][1];
                    u32x4 w; w.x = cvt_pk_bf16(v0[0], v0[1]); w.y = cvt_pk_bf16(v0[2], v0[3]); w.z = cvt_pk_bf16(v1[0], v1[1]); w.w = cvt_pk_bf16(v1[2], v1[3]);
                    *(u32x4*)(rowp + bj * HALF) = w; } }
    }
};
struct EpiAB {
    static constexpr bool PERM = true, AFTER_DRAIN = false, PERM_A = false;
    bf16_t* O;
    __device__ __forceinline__ void operator()(const f32x4 (&acc)[2][2][4][2], const Unit& u, int wr, int wc, int fr, int fq) const {
        const int row0 = u.pm * BM + wr * 64 + fr;
        if (u.pn >= 16 && u.pn < 24) {
            const int col0 = 2048 + (u.pn - 16) * BM + wc * 32 + 8 * fq;
#pragma unroll
            for (int ai = 0; ai < 2; ++ai)
#pragma unroll
                for (int m = 0; m < 4; ++m) { bf16_t* rowp = O + (size_t)(row0 + ai * HALF + m * 16) * 6144 + col0;
#pragma unroll
                    for (int bj = 0; bj < 2; ++bj) { const f32x4 v0 = acc[ai][bj][m][0], v1 = acc[ai][bj][m][1];
                        u32x4 w; w.x = cvt_pk_bf16(v0[0], v0[1]); w.y = cvt_pk_bf16(v0[2], v0[3]); w.z = cvt_pk_bf16(v1[0], v1[1]); w.w = cvt_pk_bf16(v1[2], v1[3]);
                        *(u32x4*)(rowp + bj * HALF) = w; } }
            return;
        }
        const bool glu = u.pn < 16;
        const int col0 = (glu ? u.pn * 128 : 4096 + (u.pn - 24) * 128) + wc * 32 + 8 * fq;
#pragma unroll
        for (int ai = 0; ai < 2; ++ai)
#pragma unroll
            for (int m = 0; m < 4; ++m) { float o[8];
#pragma unroll
                for (int n = 0; n < 2; ++n)
#pragma unroll
                    for (int j = 0; j < 4; ++j) { const float x = acc[ai][0][m][n][j], y = acc[ai][1][m][n][j];
                        o[4 * n + j] = glu ? x * __builtin_amdgcn_rcpf(1.0f + __expf(-y)) : x * y; }
                u32x4 w; w.x = cvt_pk_bf16(o[0], o[1]); w.y = cvt_pk_bf16(o[2], o[3]); w.z = cvt_pk_bf16(o[4], o[5]); w.w = cvt_pk_bf16(o[6], o[7]);
                *(u32x4*)(O + (size_t)(row0 + ai * HALF + m * 16) * 6144 + col0) = w; }
    }
};
struct EpiMIn {
    static constexpr bool PERM = true, AFTER_DRAIN = false, PERM_A = false;
    bf16_t* O; int ldc; float* gates; bf16_t* QT;
    __device__ __forceinline__ void operator()(const f32x4 (&acc)[2][2][4][2], const Unit& u, int wr, int wc, int fr, int fq) const {
        const int row0 = u.pm * BM + wr * 64 + fr;
        if (u.pn < 8) {
#pragma unroll
            for (int ai = 0; ai < 2; ++ai)
#pragma unroll
                for (int m = 0; m < 4; ++m) { const int rb = (u.pm * BM + wr * 64 + ai * HALF + m * 16) >> 4;
#pragma unroll
                    for (int bj = 0; bj < 2; ++bj) { const f32x4 v0 = acc[ai][bj][m][0], v1 = acc[ai][bj][m][1];
                        u32x4 w; w.x = cvt_pk_bf16(v0[0], v0[1]); w.y = cvt_pk_bf16(v0[2], v0[3]); w.z = cvt_pk_bf16(v1[0], v1[1]); w.w = cvt_pk_bf16(v1[2], v1[3]);
                        *(u32x4*)(QT + ((size_t)rb * 64 + (u.pn * 8 + bj * 4 + wc)) * 512 + (fr + 16 * fq) * 8) = w; } }
        } else if (u.pn < 48) {
            const int col0 = u.pn * BM + wc * 32 + 8 * fq;
#pragma unroll
            for (int ai = 0; ai < 2; ++ai)
#pragma unroll
                for (int m = 0; m < 4; ++m) { bf16_t* rowp = O + (size_t)(row0 + ai * HALF + m * 16) * ldc + col0;
#pragma unroll
                    for (int bj = 0; bj < 2; ++bj) { const f32x4 v0 = acc[ai][bj][m][0], v1 = acc[ai][bj][m][1];
                        u32x4 w; w.x = cvt_pk_bf16(v0[0], v0[1]); w.y = cvt_pk_bf16(v0[2], v0[3]); w.z = cvt_pk_bf16(v1[0], v1[1]); w.w = cvt_pk_bf16(v1[2], v1[3]);
                        *(u32x4*)(rowp + bj * HALF) = w; } }
        } else if (wc == 0) {
#pragma unroll
            for (int ai = 0; ai < 2; ++ai)
#pragma unroll
                for (int m = 0; m < 4; ++m) { float* rowp = gates + (size_t)(row0 + ai * HALF + m * 16) * 32 + 8 * fq;
#pragma unroll
                    for (int n = 0; n < 2; ++n) *(f32x4*)(rowp + 4 * n) = acc[ai][0][m][n]; }
        }
    }
};

__device__ __forceinline__ float dpp_ror1(float v) { return __builtin_bit_cast(float, __builtin_amdgcn_update_dpp(0, __builtin_bit_cast(int, v), 0x121, 0xf, 0xf, false)); }
__device__ __forceinline__ float dpp_rol1(float v) { return __builtin_bit_cast(float, __builtin_amdgcn_update_dpp(0, __builtin_bit_cast(int, v), 0x12F, 0xf, 0xf, false)); }
template <bool NOLOAD = false, bool NOSTORE = false> struct EpiGateT {
    static constexpr bool PERM = true, AFTER_DRAIN = false, PERM_A = true;
    bf16_t* G; bf16_t* UC; const float* cw;
    __device__ __forceinline__ static float shr1(float v) { return __builtin_bit_cast(float, __builtin_amdgcn_update_dpp(0, __builtin_bit_cast(int, v), 0x111, 0xf, 0xf, true)); }
    __device__ __forceinline__ static float shl1(float v) { return __builtin_bit_cast(float, __builtin_amdgcn_update_dpp(0, __builtin_bit_cast(int, v), 0x101, 0xf, 0xf, true)); }
    __device__ __forceinline__ void operator()(const f32x4 (&acc)[2][2][4][2], const Unit& u, int wr, int wc, int fr, int fq) const {
        const int row0 = u.pm * BM + wr * 64 + 4 * fr;
        if (u.pm >= 64) {
            const int col0 = u.pn * BM + wc * 32 + 8 * fq;
#pragma unroll
            for (int ai = 0; ai < 2; ++ai)
#pragma unroll
                for (int m = 0; m < 4; ++m) { bf16_t* rowp = UC + (size_t)(row0 - 64 * BM + ai * HALF + m) * 22016 + col0;
#pragma unroll
                    for (int bj = 0; bj < 2; ++bj) { const f32x4 v0 = acc[ai][bj][m][0], v1 = acc[ai][bj][m][1];
                        u32x4 w; w.x = cvt_pk_bf16(v0[0], v0[1]); w.y = cvt_pk_bf16(v0[2], v0[3]); w.z = cvt_pk_bf16(v1[0], v1[1]); w.w = cvt_pk_bf16(v1[2], v1[3]);
                        *(u32x4*)(rowp + bj * HALF) = w; } }
            return;
        }
        const int ch = u.pn * 128 + wc * 32 + 8 * fq;
        typedef unsigned u32x2 __attribute__((ext_vector_type(2)));
        u32x2 pw[2][4];
#pragma unroll
        for (int n = 0; n < 2; ++n) {
            f32x4 wg[3], wv[3];
#pragma unroll
            for (int k = 0; k < 3; ++k) { if (NOLOAD) { wg[k] = (f32x4){0.3f, 0.4f, 0.5f, 0.6f}; wv[k] = (f32x4){0.6f, 0.5f, 0.4f, 0.3f}; } else { wg[k] = *(const f32x4*)(cw + k * 22016 + ch + 4 * n); wv[k] = *(const f32x4*)(cw + k * 22016 + 11008 + ch + 4 * n); } }
#pragma unroll
            for (int ai = 0; ai < 2; ++ai) {
                float o[4][4];
#pragma unroll
                for (int j = 0; j < 4; ++j) {
                    const float gp = shr1(acc[ai][0][3][n][j]), gn = shl1(acc[ai][0][0][n][j]), vp = shr1(acc[ai][1][3][n][j]), vn = shl1(acc[ai][1][0][n][j]);
#pragma unroll
                    for (int m = 0; m < 4; ++m) {
                        const float gL = m > 0 ? acc[ai][0][m - 1][n][j] : gp, gR = m < 3 ? acc[ai][0][m + 1][n][j] : gn;
                        const float vL = m > 0 ? acc[ai][1][m - 1][n][j] : vp, vR = m < 3 ? acc[ai][1][m + 1][n][j] : vn;
                        const float g = wg[0][j] * gL + wg[1][j] * acc[ai][0][m][n][j] + wg[2][j] * gR;
                        const float v = wv[0][j] * vL + wv[1][j] * acc[ai][1][m][n][j] + wv[2][j] * vR;
                        o[m][j] = g * __builtin_amdgcn_rcpf(1.0f + __expf(-g)) * v; }
                }
#pragma unroll
                for (int m = 0; m < 4; ++m) { u32x2 w; w.x = cvt_pk_bf16(o[m][0], o[m][1]); w.y = cvt_pk_bf16(o[m][2], o[m][3]);
                    if (n == 0) pw[ai][m] = w;
                    else { u32x4 w4; w4.x = pw[ai][m].x; w4.y = pw[ai][m].y; w4.z = w.x; w4.w = w.y;
                        if (NOSTORE) asm volatile("" :: "v"(w4)); else *(u32x4*)(G + (size_t)(row0 + ai * HALF + m) * 11008 + ch) = w4; } }
                __builtin_amdgcn_sched_barrier(0);
            }
        }
    }
};
typedef EpiGateT<false, false> EpiGate;

template <class Epi, class Sched, bool ALIGN_EPI = false, bool SP2 = false>
__device__ __forceinline__ void gemm_phase(PG8_LAS unsigned char* lds, const Gemm g, const Sched& S, const Epi& E, const int tid) {
    const int wid = __builtin_amdgcn_readfirstlane(tid >> 6), lane = tid & 63, wr = wid >> 2, wc = wid & 3, fr = lane & 15, fq = lane >> 4;
    const int K = g.K, nt = K / BK;
    unsigned voffA[2], voffB[2];
#pragma unroll
    for (int i = 0; i < 2; ++i) { int R, C; stage_rc(tid * 16 + i * 8192, R, C); const int Rb = Epi::PERM ? ((R & ~31) + perm32(R & 31)) : R;
        const int Ra = Epi::PERM_A ? ((R & ~63) + 4 * (R & 15) + ((R >> 4) & 3)) : R;
        voffA[i] = (unsigned)(Ra * K + C) * 2u; voffB[i] = (unsigned)(Rb * K + C) * 2u; }
    const size_t kstep = (size_t)(BK * 2);
    const size_t hstep = (size_t)HALF * K * 2;
    const size_t tstep = 2 * hstep;
    const unsigned ldsw = (unsigned)wid * 1024u;
    const int aoff = lds_byte(wr * 64 + fr, fq * 8), boff = lds_byte(wc * 32 + fr, fq * 8);
#define PG8_SA(b, h) (((b) * 2 + (h)) * HTB)
#define PG8_SB(b, h) ((4 + (b) * 2 + (h)) * HTB)
#define PG8_STAGE(bufoff, gbase, voff) do { _Pragma("unroll") for (int _i = 0; _i < 2; ++_i) \
        __builtin_amdgcn_global_load_lds((const unsigned*)((const char*)(gbase) + (voff)[_i]), (PG8_LAS unsigned*)(lds + (bufoff) + ldsw + _i * 8192), 16, 0, 0); } while (0)
#define PG8_LDA(dst, b, h) do { _Pragma("unroll") for (int m = 0; m < 4; ++m) _Pragma("unroll") for (int k = 0; k < 2; ++k) dst[m][k] = *(const PG8_LAS bf16x8*)(lds + PG8_SA(b, h) + aoff + m * 2048 + k * 1024); } while (0)
#define PG8_LDB(dst, b, h) do { _Pragma("unroll") for (int n = 0; n < 2; ++n) _Pragma("unroll") for (int k = 0; k < 2; ++k) dst[n][k] = *(const PG8_LAS bf16x8*)(lds + PG8_SB(b, h) + boff + n * 2048 + k * 1024); } while (0)
#define PG8_MMA(ai, bj, At, Bt) do { __builtin_amdgcn_s_setprio(1); _Pragma("unroll") for (int m = 0; m < 4; ++m) _Pragma("unroll") for (int n = 0; n < 2; ++n) _Pragma("unroll") for (int k = 0; k < 2; ++k) \
        acc[ai][bj][m][n] = __builtin_amdgcn_mfma_f32_16x16x32_bf16(Bt[n][k], At[m][k], acc[ai][bj][m][n], 0, 0, 0); __builtin_amdgcn_s_setprio(0); } while (0)
#define PG8_WAIT_V(n) asm volatile("s_waitcnt vmcnt(" #n ")" ::: "memory")
#define PG8_WAIT_L(n) asm volatile("s_waitcnt lgkmcnt(" #n ")" ::: "memory")
#define PG8_BAR __builtin_amdgcn_s_barrier()
#define PG8_SCHED __builtin_amdgcn_sched_barrier(0)
    Unit cur, nxt; int ui = 0;
    if (!S.next(0, cur)) return;
    f32x4 acc[2][2][4][2];
#pragma unroll
    for (int a = 0; a < 2; ++a)
#pragma unroll
        for (int b = 0; b < 2; ++b)
#pragma unroll
            for (int m = 0; m < 4; ++m)
#pragma unroll
                for (int n = 0; n < 2; ++n) acc[a][b][m][n] = (f32x4){0.f, 0.f, 0.f, 0.f};
    bf16x8 At[4][2], B0[2][2], B1[2][2];
    const char* cA = (const char*)g.A + (size_t)cur.pm * tstep; const char* cB = (const char*)g.Bt + (size_t)cur.pn * tstep;
    S.a_ready(cur);
    if constexpr (SP2) {
        PG8_STAGE(PG8_SB(0, 0), cB, voffB); PG8_STAGE(PG8_SB(0, 1), cB + hstep, voffB); PG8_STAGE(PG8_SA(0, 0), cA, voffA); PG8_STAGE(PG8_SA(0, 1), cA + hstep, voffA);
        if (wr == 1) PG8_BAR;
        PG8_WAIT_V(2); PG8_BAR;
        PG8_STAGE(PG8_SB(1, 0), cB + kstep, voffB); PG8_STAGE(PG8_SA(1, 0), cA + kstep, voffA); PG8_STAGE(PG8_SB(1, 1), cB + hstep + kstep, voffB);
        PG8_WAIT_V(6); PG8_BAR;
    } else {
        PG8_STAGE(PG8_SB(0, 0), cB, voffB); PG8_STAGE(PG8_SA(0, 0), cA, voffA); PG8_STAGE(PG8_SB(0, 1), cB + hstep, voffB); PG8_STAGE(PG8_SA(0, 1), cA + hstep, voffA);
        if (wr == 1) PG8_BAR;
        PG8_WAIT_V(4); PG8_BAR;
        PG8_STAGE(PG8_SB(1, 0), cB + kstep, voffB); PG8_STAGE(PG8_SA(1, 0), cA + kstep, voffA); PG8_STAGE(PG8_SB(1, 1), cB + hstep + kstep, voffB);
        PG8_WAIT_V(6); PG8_BAR;
    }
    for (;;) {
        const bool has_next = S.next(ui + 1, nxt);
        const char* nA = has_next ? (const char*)g.A + (size_t)nxt.pm * tstep : cA; const char* nB = has_next ? (const char*)g.Bt + (size_t)nxt.pn * tstep : cB;
        for (int t = 0; t < nt; t += 2) {
            const bool last = (t == nt - 2);
            const char* a1 = cA + (size_t)(t + 1) * kstep;
            const char* a2 = last ? nA : cA + (size_t)(t + 2) * kstep; const char* b2 = last ? nB : cB + (size_t)(t + 2) * kstep;
            const char* a3 = a2 + kstep; const char* b3 = b2 + kstep;
            if (last && has_next) S.a_ready(nxt);
            if constexpr (SP2) {
            PG8_LDB(B0, 0, 0); PG8_LDB(B1, 0, 1); PG8_SCHED; PG8_LDA(At, 0, 0); PG8_STAGE(PG8_SA(1, 1), a1 + hstep, voffA);
            PG8_WAIT_V(8); PG8_WAIT_L(0); PG8_BAR; PG8_MMA(0, 0, At, B0); PG8_MMA(0, 1, At, B1); PG8_BAR; PG8_SCHED;
            PG8_LDA(At, 0, 1); PG8_STAGE(PG8_SB(0, 0), b2, voffB); PG8_STAGE(PG8_SB(0, 1), b2 + hstep, voffB); PG8_STAGE(PG8_SA(0, 0), a2, voffA);
            PG8_WAIT_V(8); PG8_WAIT_L(0); PG8_BAR; PG8_MMA(1, 0, At, B0); PG8_MMA(1, 1, At, B1); PG8_BAR; PG8_SCHED;
            PG8_LDB(B0, 1, 0); PG8_LDB(B1, 1, 1); PG8_SCHED; PG8_LDA(At, 1, 0); PG8_STAGE(PG8_SA(0, 1), a2 + hstep, voffA);
            PG8_WAIT_V(8); PG8_WAIT_L(0); PG8_BAR; PG8_MMA(0, 0, At, B0); PG8_MMA(0, 1, At, B1); PG8_BAR; PG8_SCHED;
            PG8_LDA(At, 1, 1); PG8_STAGE(PG8_SB(1, 0), b3, voffB); PG8_STAGE(PG8_SB(1, 1), b3 + hstep, voffB); PG8_STAGE(PG8_SA(1, 0), a3, voffA);
            PG8_WAIT_V(8); PG8_WAIT_L(0); PG8_BAR; PG8_MMA(1, 0, At, B0); PG8_MMA(1, 1, At, B1); PG8_BAR; PG8_SCHED;
            } else {
            PG8_LDB(B0, 0, 0); PG8_SCHED; PG8_LDA(At, 0, 0); PG8_STAGE(PG8_SA(1, 1), a1 + hstep, voffA);
            PG8_WAIT_L(8); PG8_BAR; PG8_WAIT_L(0); PG8_MMA(0, 0, At, B0); PG8_BAR; PG8_SCHED;
            PG8_LDB(B1, 0, 1); PG8_STAGE(PG8_SB(0, 0), b2, voffB);
            PG8_BAR; PG8_WAIT_L(0); PG8_MMA(0, 1, At, B1); PG8_BAR;
            PG8_LDA(At, 0, 1); PG8_STAGE(PG8_SA(0, 0), a2, voffA);
            PG8_BAR; PG8_WAIT_L(0); PG8_MMA(1, 0, At, B0); PG8_BAR; PG8_SCHED;
            PG8_STAGE(PG8_SB(0, 1), b2 + hstep, voffB);
            PG8_WAIT_V(6); PG8_BAR; PG8_MMA(1, 1, At, B1); PG8_BAR;
            PG8_LDB(B0, 1, 0); PG8_SCHED; PG8_LDA(At, 1, 0); PG8_STAGE(PG8_SA(0, 1), a2 + hstep, voffA);
            PG8_WAIT_L(8); PG8_BAR; PG8_WAIT_L(0); PG8_MMA(0, 0, At, B0); PG8_BAR; PG8_SCHED;
            PG8_LDB(B1, 1, 1); PG8_STAGE(PG8_SB(1, 0), b3, voffB);
            PG8_BAR; PG8_WAIT_L(0); PG8_MMA(0, 1, At, B1); PG8_BAR;
            PG8_LDA(At, 1, 1); PG8_STAGE(PG8_SA(1, 0), a3, voffA);
            PG8_BAR; PG8_WAIT_L(0); PG8_MMA(1, 0, At, B0); PG8_BAR; PG8_SCHED;
            PG8_STAGE(PG8_SB(1, 1), b3 + hstep, voffB);
            PG8_WAIT_V(6); PG8_BAR; PG8_MMA(1, 1, At, B1); PG8_BAR;
            }
        }
        if constexpr (ALIGN_EPI) { if (wr == 0) PG8_BAR; }
        if constexpr (!Epi::AFTER_DRAIN) { E(acc, cur, wr, wc, fr, fq); S.done(cur); }
        if (!has_next) break;
#pragma unroll
        for (int a = 0; a < 2; ++a)
#pragma unroll
            for (int b = 0; b < 2; ++b)
#pragma unroll
                for (int m = 0; m < 4; ++m)
#pragma unroll
                    for (int n = 0; n < 2; ++n) acc[a][b][m][n] = (f32x4){0.f, 0.f, 0.f, 0.f};
        cur = nxt; cA = nA; cB = nB; ++ui;
        if constexpr (ALIGN_EPI) { if (wr == 1) PG8_BAR; }
    }
    PG8_WAIT_V(0);
    if constexpr (!ALIGN_EPI) { if (wr == 0) PG8_BAR; }
    PG8_BAR;
#undef PG8_SA
#undef PG8_SB
#undef PG8_STAGE
#undef PG8_LDA
#undef PG8_LDB
#undef PG8_MMA
#undef PG8_WAIT_V
#undef PG8_WAIT_L
#undef PG8_BAR
#undef PG8_SCHED
}
}

constexpr int NWAVES = 8, NTHREADS = 512;
constexpr int D = 4096, BATCH = 2, SEQ = 8192, CTXL = 256;
constexpr int ML = BATCH * SEQ;
constexpr int MC = BATCH * CTXL;
constexpr int MT = ML + MC;
constexpr int NMODC = 6 * D;
constexpr int WA = 2048, ABIN = 10240, ABU = 6144, ACONV = 31;
constexpr int HEADS = 8, DQK = 256, DV = 512;
constexpr int QKVO = 12288, CIN = 12320, CINP = 12544;
constexpr int DFF = 11008, DFF2 = 22016;
constexpr int NCH = 66;
constexpr float EPS = 1e-6f;

constexpr size_t MiB = 1u << 20;
constexpr size_t WS_CTL = 0, CTL_ZERO_BYTES = 1 * MiB;
constexpr size_t WS_MOD = 1 * MiB;
constexpr size_t WS_SCP = 2 * MiB;
constexpr size_t WS_SCC = 7 * MiB;
constexpr size_t WS_GATES = 8 * MiB;
constexpr size_t WS_CTXS = 12 * MiB;
constexpr size_t WS_WABIN = 20 * MiB;
constexpr size_t WS_WABOUT = 100 * MiB;
constexpr size_t WS_WMIN = 132 * MiB;
constexpr size_t WS_WMOUT = 230 * MiB;
constexpr size_t WS_WUP0 = 262 * MiB;
constexpr size_t WS_WDN0 = 606 * MiB;
constexpr size_t WS_H = 778 * MiB;
constexpr size_t WS_U = 910 * MiB;
constexpr size_t WS_UC = 1590 * MiB;
constexpr size_t WS_G = 1620 * MiB;
constexpr size_t WS_Y = 1975 * MiB;
constexpr size_t WS_HS = 2239 * MiB;
constexpr size_t WS_XB = 2751 * MiB;
constexpr size_t WS_END = 2883 * MiB;
static_assert(WS_WUP0 + 2 * 172 * MiB == WS_WDN0 && WS_WDN0 + 2 * 86 * MiB <= WS_H, "ws map");
static_assert((size_t)DFF2 * D * 2 <= 172 * MiB && (size_t)D * DFF * 2 <= 86 * MiB && (size_t)CINP * D * 2 <= 98 * MiB, "ws map");
static_assert(WS_H + (size_t)MT * D * 2 <= WS_U && WS_U + (size_t)MT * DFF2 * 2 <= WS_G && WS_G + (size_t)MT * DFF * 2 <= WS_Y && WS_Y + (size_t)MT * D * 4 <= WS_HS && WS_HS + (size_t)2 * ML * D * 4 <= WS_XB && WS_XB + (size_t)MT * D * 2 <= WS_END, "ws map");
static_assert(WS_SCP + (size_t)32 * NCH * 3 * 128 * 4 <= WS_SCC && WS_GATES + (size_t)MT * 32 * 4 <= WS_CTXS && WS_CTXS + (size_t)MC * D * 4 <= WS_WABIN, "ws map");

constexpr int CW_BAR = 4096;
constexpr int LDS_BYTES = 163840;
constexpr int MISC_OFF = LDS_BYTES - 64;

#define LAS __attribute__((address_space(3)))
typedef unsigned short bf16;
typedef unsigned v4u __attribute__((ext_vector_type(4)));
typedef unsigned v2u __attribute__((ext_vector_type(2)));
typedef float f32x4 __attribute__((ext_vector_type(4)));
typedef float f32x2 __attribute__((ext_vector_type(2)));
typedef short bf16x8 __attribute__((ext_vector_type(8)));
typedef short s16x4 __attribute__((ext_vector_type(4)));
#define LDS_WAIT() asm volatile("s_waitcnt lgkmcnt(0)" ::: "memory")

__device__ __forceinline__ unsigned f2bf(float f) { unsigned u = __builtin_bit_cast(unsigned, f); return (u + 0x7fffu + ((u >> 16) & 1u)) >> 16; }
__device__ __forceinline__ unsigned pk2(float lo, float hi) { unsigned r; asm("v_cvt_pk_bf16_f32 %0, %1, %2" : "=v"(r) : "v"(lo), "v"(hi)); return r; }
__device__ __forceinline__ float bflo(unsigned w) { return __builtin_bit_cast(float, w << 16); }
__device__ __forceinline__ float bfhi(unsigned w) { return __builtin_bit_cast(float, w & 0xffff0000u); }
__device__ __forceinline__ float bf1(unsigned short h) { return __builtin_bit_cast(float, ((unsigned)h) << 16); }
__device__ __forceinline__ void cvt8(const v4u r, float (&f)[8]) {
    f[0] = bflo(r.x); f[1] = bfhi(r.x); f[2] = bflo(r.y); f[3] = bfhi(r.y); f[4] = bflo(r.z); f[5] = bfhi(r.z); f[6] = bflo(r.w); f[7] = bfhi(r.w);
}
__device__ __forceinline__ float sigmoidf_(float x) { return __builtin_amdgcn_rcpf(1.0f + __expf(-x)); }
__device__ __forceinline__ float siluf_(float x) { return x * sigmoidf_(x); }
__device__ __forceinline__ float wave_sum(float v) {
#pragma unroll
    for (int o = 1; o < 64; o <<= 1) v += __shfl_xor(v, o);
    return v;
}

#define XB_TMO      128
#define XB_XCNT(j)  (256  + 64 * (j))
#define XB_XSUB(j)  (1280 + 64 * (j))
#define XB_XGEN(j)  (2304 + 64 * (j))
#define XB_TOP      3328
#define XB_TOPGEN   3392
#define XCD_BAR_WORDS 3456
#define XB_SPIN_CAP (1u << 22)

__device__ __forceinline__ unsigned xb_ld(unsigned* p)              { return __hip_atomic_load(p, __ATOMIC_RELAXED, __HIP_MEMORY_SCOPE_AGENT); }
__device__ __forceinline__ unsigned xb_add(unsigned* p, unsigned v) { return __hip_atomic_fetch_add(p, v, __ATOMIC_RELAXED, __HIP_MEMORY_SCOPE_AGENT); }
__device__ __forceinline__ unsigned xb_xcc_id() { return (unsigned)__builtin_amdgcn_s_getreg((3 << 11) | 20) & 0xFu; }
#define XB_SPIN(cond, bar) do { unsigned _sp = 0; while (cond) { __builtin_amdgcn_s_sleep(1); \
    if ((++_sp & 255u) == 0u) { if (xb_ld(&(bar)[XB_TMO])) break; if (_sp > XB_SPIN_CAP) { atomicAdd(&(bar)[XB_TMO], 1u); break; } } } } while (0)

struct XcdBarrier { unsigned* bar; unsigned x; volatile LAS unsigned* st; };

__device__ __forceinline__ XcdBarrier xcd_barrier_post(unsigned* bar, volatile LAS unsigned* st) {
    XcdBarrier b; b.bar = bar; b.x = xb_xcc_id(); b.st = st;
    if (threadIdx.x == 0) (void)xb_add(&bar[XB_XCNT(b.x)], 1u);
    return b;
}
__device__ __forceinline__ void xcd_barrier_complete(unsigned* bar, unsigned x, unsigned& nloc, unsigned& nx) {
    const unsigned G = gridDim.x * gridDim.y * gridDim.z;
    unsigned sum, cnt, mine, sp = 0u;
    for (;;) {
        sum = 0u; cnt = 0u; mine = 0u;
#pragma unroll
        for (unsigned j = 0; j < 16; ++j) { const unsigned c = xb_ld(&bar[XB_XCNT(j)]); sum += c; cnt += (c > 0u) ? 1u : 0u; mine = (j == x) ? c : mine; }
        if (sum == G) break;
        __builtin_amdgcn_s_sleep(1);
        if ((++sp & 255u) == 0u) { if (xb_ld(&bar[XB_TMO])) break; if (sp > XB_SPIN_CAP) { atomicAdd(&bar[XB_TMO], 1u); break; } }
    }
    nloc = mine > 0u ? mine : 1u; nx = cnt > 0u ? cnt : 1u;
}
__device__ __forceinline__ void xcd_barrier(const XcdBarrier& b) {
    asm volatile("s_waitcnt vmcnt(0)" ::: "memory");
    __syncthreads();
    if (threadIdx.x == 0) {
        unsigned* bar = b.bar;
        __builtin_amdgcn_s_waitcnt(0);
        unsigned nloc = b.st[0], nx = b.st[1];
        if (nloc == 0u) { xcd_barrier_complete(bar, b.x, nloc, nx); b.st[0] = nloc; b.st[1] = nx; }
        const unsigned old = xb_add(&bar[XB_XSUB(b.x)], 1u);
        const unsigned gen = old / nloc;
        if (old + 1u == (gen + 1u) * nloc) {
            __builtin_amdgcn_fence(__ATOMIC_RELEASE, "agent");
            asm volatile("s_waitcnt vmcnt(0)" ::: "memory");
            const unsigned og = xb_add(&bar[XB_TOP], 1u);
            const unsigned tg = og / nx;
            if (og + 1u == (tg + 1u) * nx) xb_add(&bar[XB_TOPGEN], 1u);
            else XB_SPIN(xb_ld(&bar[XB_TOPGEN]) == tg, bar);
            __builtin_amdgcn_fence(__ATOMIC_ACQUIRE, "agent");
            xb_add(&bar[XB_XGEN(b.x)], 1u);
            asm volatile("s_waitcnt vmcnt(0)" ::: "memory");
        } else {
            XB_SPIN(xb_ld(&bar[XB_XGEN(b.x)]) == gen, bar);
            __builtin_amdgcn_fence(__ATOMIC_ACQUIRE, "agent");
            asm volatile("s_waitcnt vmcnt(0)" ::: "memory");
        }
    }
    __syncthreads();
}

struct Args { const float* in[21]; float* out; unsigned char* ws; int ph_lo, ph_hi; };
typedef const __attribute__((address_space(4))) Args* CArgs;
__device__ __forceinline__ int opaque_tid(int wave_s) { int t = wave_s * 64 + (int)__builtin_amdgcn_mbcnt_hi(~0u, __builtin_amdgcn_mbcnt_lo(~0u, 0u)); asm volatile("" : "+v"(t)); return t; }
__device__ __forceinline__ CArgs get_args() { CArgs p = (CArgs)__builtin_amdgcn_kernarg_segment_ptr(); asm volatile("" : "+s"(p)); return p; }
enum { I_X = 0, I_C, I_CTX, I_CCTX, I_ADAW, I_ADAB, I_NORMG, I_ABWIN, I_ACONVW, I_ACONVB, I_ALNG, I_ALNB, I_BCONVW, I_ABWOUT, I_MWIN, I_MBG, I_MHNG, I_MWOUT, I_FUP, I_FCONV, I_FDN };

template <int MODE> __device__ __forceinline__ int perm_row(int n0) {
    if (MODE == 1) return n0 < DFF ? 256 * (n0 / 128) + (n0 % 128) : 256 * ((n0 - DFF) / 128) + 128 + ((n0 - DFF) % 128);
    if (MODE == 2) { if (n0 < 4096) { const int ch = n0 & 2047, hi = n0 >> 11; return 256 * (ch / 128) + 128 * hi + (ch % 128); }
                     if (n0 < 6144) return n0;
                     const int j = n0 - 6144, ch = j & 2047, hi = j >> 11; return 6144 + 256 * (ch / 128) + 128 * hi + (ch % 128); }
    return n0;
}
template <int GATE_PERM = 0>
__device__ __forceinline__ void p0_transpose_item(const float* W, int K, int N, bf16* WT, LAS float* scr, int item, int lane) {
    const int nblk = N / 32, kb = item / nblk, nb = item % nblk, k0 = 64 * kb, n0 = 32 * nb;
    const int r0 = perm_row<GATE_PERM>(n0);
#pragma unroll 8
    for (int i = 0; i < 32; ++i) { const int kk = 2 * i + (lane >> 5); scr[kk * 33 + (lane & 31)] = W[(size_t)(k0 + kk) * N + n0 + (lane & 31)]; }
    LDS_WAIT(); asm volatile("" ::: "memory");
    const int c = lane & 7;
#pragma unroll
    for (int j = 0; j < 4; ++j) { const int n = (lane >> 3) + 8 * j; const LAS float* s = scr + (8 * c) * 33 + n;
        v4u o; o.x = pk2(s[0 * 33], s[1 * 33]); o.y = pk2(s[2 * 33], s[3 * 33]); o.z = pk2(s[4 * 33], s[5 * 33]); o.w = pk2(s[6 * 33], s[7 * 33]);
        __builtin_nontemporal_store(o, (v4u*)(WT + (size_t)(r0 + n) * K + k0 + 8 * c)); }
    LDS_WAIT(); asm volatile("" ::: "memory");
}

__device__ __forceinline__ void gemv_units(CArgs a, LAS unsigned char* lds, int layer, int first, int stride, int tid, int lane, int wave) {
    float* MOD = (float*)(a->ws + WS_MOD);
    LAS float* sv = (LAS float*)lds;
    LAS float* red = (LAS float*)(lds + 49152);
    for (int i = tid; i < 3 * D; i += NTHREADS) { const int r = i / D, k = i % D; const float v = (r < 2) ? a->in[I_C][r * D + k] : a->in[I_CCTX][k]; sv[i] = siluf_(v); }
    __syncthreads();
    for (int unit = first; unit < 768; unit += stride) {
        const int n0 = unit * 32;
        const int kg = wave * 8 + (lane >> 3), c4 = (lane & 7) * 4;
        const float* W = a->in[I_ADAW] + (size_t)layer * D * NMODC + (size_t)(kg * 64) * NMODC + n0 + c4;
        f32x4 a0 = {0.f, 0.f, 0.f, 0.f}, a1 = a0, a2 = a0;
        for (int k = 0; k < 64; k += 16) {
            f32x4 w[16];
#pragma unroll
            for (int j = 0; j < 16; ++j) w[j] = __builtin_nontemporal_load((const f32x4*)(W + (size_t)(k + j) * NMODC));
#pragma unroll
            for (int j = 0; j < 16; ++j) { const int kk = kg * 64 + k + j; a0 += w[j] * sv[kk]; a1 += w[j] * sv[D + kk]; a2 += w[j] * sv[2 * D + kk]; }
        }
        *(LAS f32x4*)(red + (kg * 3 + 0) * 32 + c4) = a0; *(LAS f32x4*)(red + (kg * 3 + 1) * 32 + c4) = a1; *(LAS f32x4*)(red + (kg * 3 + 2) * 32 + c4) = a2;
        __syncthreads();
        if (tid < 96) { const int r = tid >> 5, cc = tid & 31; float s = 0.f;
#pragma unroll 8
            for (int g = 0; g < 64; ++g) s += red[(g * 3 + r) * 32 + cc];
            MOD[((size_t)layer * 3 + r) * NMODC + n0 + cc] = s + a->in[I_ADAB][(size_t)layer * NMODC + n0 + cc]; }
        __syncthreads();
    }
}
template <int GATE_PERM>
__device__ __forceinline__ void transpose_item64(const float* W, int K, int N, bf16* WT, LAS float* scr, int item, int lane, int nblk) {
    const int kb = item / nblk, nb = item % nblk, k0 = 64 * kb, n0 = 64 * nb;
    const int r0 = perm_row<GATE_PERM>(n0);
    const int kq = lane >> 4, j4 = (lane & 15) * 4;
    f32x4 v[16];
#pragma unroll
    for (int i = 0; i < 16; ++i) v[i] = __builtin_nontemporal_load((const f32x4*)(W + (size_t)(k0 + 4 * i + kq) * N + n0 + j4));
#pragma unroll
    for (int i = 0; i < 16; ++i) { LAS float* p = scr + (4 * i + kq) * 65 + j4; p[0] = v[i].x; p[1] = v[i].y; p[2] = v[i].z; p[3] = v[i].w; }
    LDS_WAIT(); asm volatile("" ::: "memory");
    const int c = lane & 7;
#pragma unroll
    for (int j = 0; j < 8; ++j) { const int n = (lane >> 3) + 8 * j; const LAS float* p = scr + (8 * c) * 65 + n;
        v4u o; o.x = pk2(p[0 * 65], p[1 * 65]); o.y = pk2(p[2 * 65], p[3 * 65]); o.z = pk2(p[4 * 65], p[5 * 65]); o.w = pk2(p[6 * 65], p[7 * 65]);
        __builtin_nontemporal_store(o, (v4u*)(WT + (size_t)(r0 + n) * K + k0 + 8 * c)); }
    LDS_WAIT(); asm volatile("" ::: "memory");
}
template <int GATE_PERM>
__device__ __forceinline__ void conv_items(const float* W, int K, int N, bf16* WT, LAS unsigned char* lds, int first, int stride, int lane, int wave) {
    LAS float* scr = (LAS float*)(lds + wave * 16640);
    const int nb64 = N / 64, nitems = (K / 64) * nb64;
    for (int it = first; it < nitems; it += stride) transpose_item64<GATE_PERM>(W, K, N, WT, scr, it, lane, nb64);
    if (N % 64) for (int kb = first; kb < K / 64; kb += stride) p0_transpose_item<GATE_PERM>(W, K, N, WT, scr, kb * (N / 32) + (N / 32 - 1), lane);
}
enum { CV_ABIN = 0, CV_ABOUT, CV_MIN, CV_MOUT, CV_UP0, CV_UP1, CV_DN0, CV_DN1 };
template <int WHICH>
__device__ __forceinline__ void conv_matrix(CArgs a, LAS unsigned char* lds, int first, int stride, int lane, int wave) {
    unsigned char* ws = a->ws;
    if (WHICH == CV_ABIN) conv_items<2>(a->in[I_ABWIN], D, ABIN, (bf16*)(ws + WS_WABIN), lds, first, stride, lane, wave);
    if (WHICH == CV_ABOUT) conv_items<0>(a->in[I_ABWOUT], D, D, (bf16*)(ws + WS_WABOUT), lds, first, stride, lane, wave);
    if (WHICH == CV_MIN) { conv_items<0>(a->in[I_MWIN], D, CIN, (bf16*)(ws + WS_WMIN), lds, first, stride, lane, wave);
        v4u* p = (v4u*)((bf16*)(ws + WS_WMIN) + (size_t)CIN * D); const int n16 = (CINP - CIN) * D * 2 / 16;
        for (int i = first * 64 + lane; i < n16; i += stride * 64) p[i] = (v4u){0u, 0u, 0u, 0u}; }
    if (WHICH == CV_MOUT) conv_items<0>(a->in[I_MWOUT], D, D, (bf16*)(ws + WS_WMOUT), lds, first, stride, lane, wave);
    if (WHICH == CV_UP0) conv_items<1>(a->in[I_FUP], D, DFF2, (bf16*)(ws + WS_WUP0), lds, first, stride, lane, wave);
    if (WHICH == CV_UP1) conv_items<1>(a->in[I_FUP] + (size_t)D * DFF2, D, DFF2, (bf16*)(ws + WS_WUP0 + 172 * MiB), lds, first, stride, lane, wave);
    if (WHICH == CV_DN0) conv_items<0>(a->in[I_FDN], DFF, D, (bf16*)(ws + WS_WDN0), lds, first, stride, lane, wave);
    if (WHICH == CV_DN1) conv_items<0>(a->in[I_FDN] + (size_t)DFF * D, DFF, D, (bf16*)(ws + WS_WDN0 + 86 * MiB), lds, first, stride, lane, wave);
}
__device__ __forceinline__ void p0_prologue(CArgs a, LAS unsigned char* lds, int tid, int lane, int wave) {
    gemv_units(a, lds, 0, blockIdx.x, gridDim.x, tid, lane, wave);
    const int gw = blockIdx.x * NWAVES + wave, NGW = gridDim.x * NWAVES;
    conv_matrix<CV_ABIN>(a, lds, gw, NGW, lane, wave);
#if PROBE_E1
    conv_matrix<CV_ABOUT>(a, lds, gw, NGW, lane, wave);
    conv_matrix<CV_UP0>(a, lds, gw, NGW, lane, wave); conv_matrix<CV_DN0>(a, lds, gw, NGW, lane, wave); conv_matrix<CV_MIN>(a, lds, gw, NGW, lane, wave); conv_matrix<CV_MOUT>(a, lds, gw, NGW, lane, wave);
    conv_matrix<CV_UP1>(a, lds, gw, NGW, lane, wave); conv_matrix<CV_DN1>(a, lds, gw, NGW, lane, wave); __syncthreads(); gemv_units(a, lds, 1, blockIdx.x, gridDim.x, tid, lane, wave);
#endif
}
__device__ __forceinline__ int gemm_wgs(int nwg) { const int G = gridDim.x, rounds = (nwg + G - 1) / G; const int g = ((nwg + rounds - 1) / rounds + 7) & ~7; return g < G ? g : G; }

template <bool RES, bool DOH, bool XIN_BF, bool XOUT_BF>
__device__ __forceinline__ void row_phase(LAS unsigned char* lds, int nrows, const void* xin_lat, const void* xin_ctx, void* xout_lat, void* xout_ctx,
                                          const bf16* Y, const float* gpost, const float* modres, int gate_idx,
                                          const float* gpre, const float* modh, int shift_idx, int scale_idx, bf16* H, int tid, int lane, int wave) {
    LAS f32x4* pG = (LAS f32x4*)lds; LAS f32x4* pA = pG + 1024; LAS f32x4* pB = pA + 1024;
    const int G = gridDim.x, rpw = (nrows + G - 1) / G, r0 = (int)blockIdx.x * rpw, r1 = (r0 + rpw < nrows) ? r0 + rpw : nrows;
    for (int vb = r0; vb < r1;) {
        const int mr = vb < ML ? (vb >> 13) : 2;
        const int lim = mr == 0 ? SEQ : (mr == 1 ? ML : nrows), vend = r1 < lim ? r1 : lim;
        __syncthreads();
        for (int i = tid; i < 1024; i += NTHREADS) {
            if (RES) pG[i] = ((const f32x4*)(modres + (size_t)mr * NMODC + gate_idx * D))[i] * ((const f32x4*)gpost)[i];
            if (DOH) { pA[i] = ((const f32x4*)gpre)[i] * (((const f32x4*)(modh + (size_t)mr * NMODC + scale_idx * D))[i] + 1.0f); pB[i] = ((const f32x4*)(modh + (size_t)mr * NMODC + shift_idx * D))[i]; }
        }
        __syncthreads();
        for (int row = vb + wave; row < vend; row += NWAVES) {
            const float* xr = XIN_BF ? nullptr : (row < ML ? (const float*)xin_lat + (size_t)row * D : (const float*)xin_ctx + (size_t)(row - ML) * D);
            const bf16* xrb = XIN_BF ? (const bf16*)xin_lat + (size_t)row * D : nullptr;
            f32x4 v[16];
            if (RES) {
                const bf16* yr = Y + (size_t)row * D; float s = 0.f;
#pragma unroll
                for (int j = 0; j < 16; ++j) { const v2u yw = *(const v2u*)(yr + j * 256 + lane * 4); v[j] = (f32x4){bflo(yw.x), bfhi(yw.x), bflo(yw.y), bfhi(yw.y)}; s += (v[j].x * v[j].x + v[j].y * v[j].y) + (v[j].z * v[j].z + v[j].w * v[j].w); }
                const float rstd = 1.0f / sqrtf(wave_sum(s) * (1.0f / D) + EPS);
                float* xo = XOUT_BF ? nullptr : (row < ML ? (float*)xout_lat + (size_t)row * D : (float*)xout_ctx + (size_t)(row - ML) * D);
                bf16* xob = XOUT_BF ? (bf16*)xout_lat + (size_t)row * D : nullptr;
#pragma unroll
                for (int j = 0; j < 16; ++j) { const int o = j * 256 + lane * 4;
                    f32x4 x;
                    if (XIN_BF) { const v2u xw = *(const v2u*)(xrb + o); x = (f32x4){bflo(xw.x), bfhi(xw.x), bflo(xw.y), bfhi(xw.y)}; } else x = *(const f32x4*)(xr + o);
                    v[j] = x + (v[j] * rstd) * pG[j * 64 + lane];
                    if (XOUT_BF) { v2u w; w.x = pk2(v[j].x, v[j].y); w.y = pk2(v[j].z, v[j].w); *(v2u*)(xob + o) = w; } else *(f32x4*)(xo + o) = v[j];
                    if ((j & 3) == 3) asm volatile("" ::: "memory"); }
            } else {
#pragma unroll
                for (int j = 0; j < 16; ++j) v[j] = *(const f32x4*)(xr + j * 256 + lane * 4);
            }
            if (DOH) {
                float s = 0.f;
#pragma unroll
                for (int j = 0; j < 16; ++j) s += (v[j].x * v[j].x + v[j].y * v[j].y) + (v[j].z * v[j].z + v[j].w * v[j].w);
                const float rstd = 1.0f / sqrtf(wave_sum(s) * (1.0f / D) + EPS);
                bf16* hr = H + (size_t)row * D;
#pragma unroll
                for (int j = 0; j < 16; ++j) { const int o = j * 256 + lane * 4;
                    const f32x4 h = (v[j] * rstd) * pA[j * 64 + lane] + pB[j * 64 + lane];
                    v2u w; w.x = pk2(h.x, h.y); w.y = pk2(h.z, h.w);
                    *(v2u*)(hr + o) = w; }
            }
        }
        vb = vend;
    }
}

__device__ __forceinline__ void mixer_conv_phase(CArgs a, LAS unsigned char* lds, int tid, int lane) {
    const bf16* U = (const bf16*)(a->ws + WS_U);
    bf16* T1 = (bf16*)(a->ws + WS_Y);
    bf16* V = (bf16*)(a->ws + WS_G);
    LAS float* tile = (LAS float*)lds;
    const float* cw = a->in[I_ACONVW]; const float* cb = a->in[I_ACONVB];
    v4u rva[6]; f32x2 w[ACONV]; f32x2 bias = {0.f, 0.f}; int cc_w = -1;
#define MX_ROW(tb_, j_) ((tb_) < 256 ? (((j_) >= 15 && (j_) < 79) ? (tb_) * 64 + ((j_) - 15) : -1) \
        : ((((tb_) - 256) & 3) * 64 + ((j_) - 15) >= 0 && (((tb_) - 256) & 3) * 64 + ((j_) - 15) < CTXL ? ML + (((tb_) - 256) >> 2) * CTXL + (((tb_) - 256) & 3) * 64 + ((j_) - 15) : -1))
#define MX_LOAD(unit_) do { const int tb_ = (unit_) >> 3, cc_ = (unit_) & 7; \
        _Pragma("unroll") for (int q = 0; q < 6; ++q) { const int it = tid + NTHREADS * q; const int j = it >> 5, ch8 = it & 31; const int row = it < 94 * 32 ? MX_ROW(tb_, j) : -1; \
            const size_t o_ = (size_t)(row >= 0 ? row : 0) * ABU + cc_ * 256 + ch8 * 8; rva[q] = *(const v4u*)(U + o_); } } while (0)
    if ((int)blockIdx.x < 264 * 8) MX_LOAD(blockIdx.x);
    for (int unit = blockIdx.x; unit < 264 * 8; unit += gridDim.x) {
        const int tb = unit >> 3, cc = unit & 7;
#pragma unroll
        for (int q = 0; q < 6; ++q) { const int it = tid + NTHREADS * q; const int j = it >> 5, ch8 = it & 31;
            if (it < 94 * 32) { const int row = MX_ROW(tb, j); const float f = row >= 0 ? 1.f : 0.f; const v4u va = rva[q]; f32x4 g0, g1;
                g0.x = f * bflo(va.x); g0.y = f * bfhi(va.x); g0.z = f * bflo(va.y); g0.w = f * bfhi(va.y);
                g1.x = f * bflo(va.z); g1.y = f * bfhi(va.z); g1.z = f * bflo(va.w); g1.w = f * bfhi(va.w);
                *(LAS f32x4*)(tile + j * 256 + ch8 * 8) = g0; *(LAS f32x4*)(tile + j * 256 + ch8 * 8 + 4) = g1; } }
        __syncthreads();
        if (unit + (int)gridDim.x < 264 * 8) MX_LOAD(unit + (int)gridDim.x);
        {
            const int cp = tid & 127, tg = tid >> 7, c = cc * 256 + 2 * cp;
            if (cc != cc_w) { cc_w = cc;
#pragma unroll
                for (int k = 0; k < ACONV; ++k) w[k] = *(const f32x2*)(cw + k * WA + c);
                bias = *(const f32x2*)(cb + c); }
            f32x2 acc[16];
#pragma unroll
            for (int i = 0; i < 16; ++i) acc[i] = (f32x2){0.f, 0.f};
#pragma unroll
            for (int jj = 0; jj < 46; ++jj) {
                const f32x2 g = *(const LAS f32x2*)(tile + (16 * tg + jj) * 256 + 2 * cp);
#pragma unroll
                for (int i = 0; i < 16; ++i) { const int k = jj - i; if (k >= 0 && k < ACONV) acc[i] += w[k] * g; }
            }
            LAS unsigned* otile = (LAS unsigned*)(lds + 98304);
#pragma unroll
            for (int i = 0; i < 16; ++i) { const f32x2 o = acc[i] + bias; otile[(16 * tg + i) * 128 + cp] = pk2(o.x, o.y); }
            __syncthreads();
            int rbase;
            if (tb < 256) rbase = tb * 64; else { const int cbk = tb - 256; rbase = ML + (cbk >> 2) * CTXL + (cbk & 3) * 64; }
#pragma unroll
            for (int k = 0; k < 4; ++k) { const int q = tid + NTHREADS * k, r = q >> 5, c16 = q & 31;
                *(v4u*)(T1 + (size_t)(rbase + r) * WA + cc * 256 + c16 * 8) = *(const LAS v4u*)(otile + r * 128 + c16 * 4); }
        }
        __syncthreads();
    }
#undef MX_ROW
#undef MX_LOAD
    const float* bw = a->in[I_BCONVW];
    constexpr int NSEG_L = 2 * 64 * 16, NIT_L = NSEG_L * 256, NIT_C = 2 * 32 * 256;
    for (int it = blockIdx.x * NTHREADS + tid; it < NIT_L + NIT_C; it += gridDim.x * NTHREADS) {
        int row0, stride, prow, nrow, c;
        if (it < NIT_L) { const int c8 = it & 255, r = it >> 8, x = r & 63, seg = (r >> 6) & 15, b = r >> 10;
            c = c8 * 8; stride = 64; row0 = b * SEQ + (seg * 8) * 64 + x; prow = seg > 0 ? row0 - 64 : -1; nrow = seg < 15 ? row0 + 8 * 64 : -1; }
        else { const int j = it - NIT_L, c8 = j & 255, r = j >> 8, seg = r & 31, b = r >> 5;
            c = c8 * 8; stride = 1; row0 = ML + b * CTXL + seg * 8; prow = seg > 0 ? row0 - 1 : -1; nrow = seg < 31 ? row0 + 8 : -1; }
        float w[3][8];
#pragma unroll
        for (int k = 0; k < 3; ++k) { const f32x4 w0 = *(const f32x4*)(bw + k * 2048 + c), w1 = *(const f32x4*)(bw + k * 2048 + c + 4);
            w[k][0] = w0.x; w[k][1] = w0.y; w[k][2] = w0.z; w[k][3] = w0.w; w[k][4] = w1.x; w[k][5] = w1.y; w[k][6] = w1.z; w[k][7] = w1.w; }
        const bf16* uz = U + 4096 + c; const bf16* ub = U + 2048 + c;
        v4u rc[10], rb[8];
#pragma unroll
        for (int i = 0; i < 10; ++i) { const int rr = i == 0 ? (prow >= 0 ? prow : row0) : (i == 9 ? (nrow >= 0 ? nrow : row0) : row0 + (i - 1) * stride);
            rc[i] = *(const v4u*)(uz + (size_t)rr * ABU); }
#pragma unroll
        for (int i = 0; i < 8; ++i) rb[i] = *(const v4u*)(ub + (size_t)(row0 + i * stride) * ABU);
        float pp[8], pc[8];
        { float a8[8]; cvt8(rc[0], a8); const float f = prow >= 0 ? 1.f : 0.f;
#pragma unroll
          for (int e = 0; e < 8; ++e) pp[e] = a8[e] * f;
          cvt8(rc[1], pc); }
#pragma unroll
        for (int i = 0; i < 8; ++i) {
            float pn[8], bb[8]; cvt8(rc[i + 2], pn); cvt8(rb[i], bb);
            const float f = (i == 7 && nrow < 0) ? 0.f : 1.f;
#pragma unroll
            for (int e = 0; e < 8; ++e) pn[e] *= f;
            float o[8];
#pragma unroll
            for (int e = 0; e < 8; ++e) o[e] = bb[e] * (w[0][e] * pp[e] + w[1][e] * pc[e] + w[2][e] * pn[e]);
            v4u ov; ov.x = pk2(o[0], o[1]); ov.y = pk2(o[2], o[3]); ov.z = pk2(o[4], o[5]); ov.w = pk2(o[6], o[7]);
            *(v4u*)(V + (size_t)(row0 + i * stride) * D + WA + c) = ov;
#pragma unroll
            for (int e = 0; e < 8; ++e) { pp[e] = pc[e]; pc[e] = pn[e]; }
        }
    }
}
__device__ __forceinline__ void mixer_ln_phase(CArgs a, LAS unsigned char* lds, int tid, int lane, int wave) {
    const bf16* T1 = (const bf16*)(a->ws + WS_Y);
    bf16* V = (bf16*)(a->ws + WS_G);
    LAS f32x4* pg = (LAS f32x4*)lds; LAS f32x4* pb = pg + 512;
    for (int i = tid; i < 512; i += NTHREADS) { pg[i] = ((const f32x4*)a->in[I_ALNG])[i]; pb[i] = ((const f32x4*)a->in[I_ALNB])[i]; }
    __syncthreads();
    const int G = gridDim.x, rpw = (MT + G - 1) / G, r0 = (int)blockIdx.x * rpw, r1 = (r0 + rpw < MT) ? r0 + rpw : MT;
    for (int row = r0 + wave; row < r1; row += NWAVES) {
        f32x4 v[8]; float s = 0.f;
#pragma unroll
        for (int j = 0; j < 8; ++j) { const v2u tw = *(const v2u*)(T1 + (size_t)row * WA + j * 256 + lane * 4); v[j] = (f32x4){bflo(tw.x), bfhi(tw.x), bflo(tw.y), bfhi(tw.y)}; s += (v[j].x + v[j].y) + (v[j].z + v[j].w); }
        const float mu = wave_sum(s) * (1.0f / WA); float q = 0.f;
#pragma unroll
        for (int j = 0; j < 8; ++j) { v[j] = v[j] - mu; q += (v[j].x * v[j].x + v[j].y * v[j].y) + (v[j].z * v[j].z + v[j].w * v[j].w); }
        const float rstd = 1.0f / sqrtf(wave_sum(q) * (1.0f / WA) + EPS);
#pragma unroll
        for (int j = 0; j < 8; ++j) { const int o = j * 256 + lane * 4;
            const f32x4 y = (v[j] * rstd) * pg[j * 64 + lane] + pb[j * 64 + lane];
            v2u w; w.x = pk2(siluf_(y.x), siluf_(y.y)); w.y = pk2(siluf_(y.z), siluf_(y.w));
            *(v2u*)(V + (size_t)row * D + o) = w; }
    }
}

template <int NR>
__device__ __forceinline__ void ffn_gate_slide(const bf16* ug, const bf16* uv, int ldu, bf16* Go, const float* cwg, const float* cwv, int row0, int prow, int nrow) {
    float wg[3][8], wv[3][8];
#pragma unroll
    for (int k = 0; k < 3; ++k) {
        const f32x4 a0 = *(const f32x4*)(cwg + k * DFF2), a1 = *(const f32x4*)(cwg + k * DFF2 + 4), b0 = *(const f32x4*)(cwv + k * DFF2), b1 = *(const f32x4*)(cwv + k * DFF2 + 4);
        wg[k][0] = a0.x; wg[k][1] = a0.y; wg[k][2] = a0.z; wg[k][3] = a0.w; wg[k][4] = a1.x; wg[k][5] = a1.y; wg[k][6] = a1.z; wg[k][7] = a1.w;
        wv[k][0] = b0.x; wv[k][1] = b0.y; wv[k][2] = b0.z; wv[k][3] = b0.w; wv[k][4] = b1.x; wv[k][5] = b1.y; wv[k][6] = b1.z; wv[k][7] = b1.w;
    }
    float pg[8], pv[8], cg[8], cv[8];
    { const float fp = prow >= 0 ? 1.f : 0.f; const int pr = prow >= 0 ? prow : row0;
      const v4u a = *(const v4u*)(ug + (size_t)pr * ldu), b = *(const v4u*)(uv + (size_t)pr * ldu); cvt8(a, pg); cvt8(b, pv);
#pragma unroll
      for (int e = 0; e < 8; ++e) { pg[e] *= fp; pv[e] *= fp; }
      const v4u a2 = *(const v4u*)(ug + (size_t)row0 * ldu), b2 = *(const v4u*)(uv + (size_t)row0 * ldu); cvt8(a2, cg); cvt8(b2, cv); }
    const float fn = nrow >= 0 ? 1.f : 0.f; const int nr = nrow >= 0 ? nrow : row0;
    for (int blk = 0; blk < NR / 4; ++blk) {
        v4u rg[4], rv[4];
#pragma unroll
        for (int i = 0; i < 4; ++i) { const int r = 4 * blk + 1 + i; const int rr = r < NR ? row0 + r : nr;
            rg[i] = *(const v4u*)(ug + (size_t)rr * ldu); rv[i] = *(const v4u*)(uv + (size_t)rr * ldu); }
#pragma unroll
        for (int i = 0; i < 4; ++i) {
            float ng[8], nv[8]; cvt8(rg[i], ng); cvt8(rv[i], nv);
            if (i == 3) { const float f = (4 * blk + 4 < NR) ? 1.f : fn;
#pragma unroll
                for (int e = 0; e < 8; ++e) { ng[e] *= f; nv[e] *= f; } }
            float o[8];
#pragma unroll
            for (int e = 0; e < 8; ++e) { const float g = wg[0][e] * pg[e] + wg[1][e] * cg[e] + wg[2][e] * ng[e], v = wv[0][e] * pv[e] + wv[1][e] * cv[e] + wv[2][e] * nv[e]; o[e] = siluf_(g) * v; }
            v4u w; w.x = pk2(o[0], o[1]); w.y = pk2(o[2], o[3]); w.z = pk2(o[4], o[5]); w.w = pk2(o[6], o[7]);
            *(v4u*)(Go + (size_t)(4 * blk + i) * DFF) = w;
#pragma unroll
            for (int e = 0; e < 8; ++e) { pg[e] = cg[e]; pv[e] = cv[e]; cg[e] = ng[e]; cv[e] = nv[e]; }
        }
    }
}
__device__ __forceinline__ void ffn_gate_ctx_phase(CArgs a, int tid) {
    const bf16* UC = (const bf16*)(a->ws + WS_UC);
    bf16* G = (bf16*)(a->ws + WS_G);
    const float* cw = a->in[I_FCONV];
    constexpr int NC8 = DFF / 8;
    constexpr int NIT = 8 * NC8 * 4, PER = (NIT + 255) / 256;
    for (int it = blockIdx.x * PER + tid; tid < PER && it < NIT; it += gridDim.x * PER) {
        const int q4 = it & 3, rest = it >> 2, c8 = rest % NC8, blk = rest / NC8, ch = c8 * 8;
        const int p0 = (blk & 3) * 64 + q4 * 16, lrow0 = (blk >> 2) * CTXL + p0;
        const bf16* ug = UC + 256 * (ch >> 7) + (ch & 127);
        ffn_gate_slide<16>(ug, ug + 128, DFF2, G + (size_t)(ML + lrow0) * DFF + ch, cw + ch, cw + DFF + ch, lrow0, p0 > 0 ? lrow0 - 1 : -1, p0 + 16 < CTXL ? lrow0 + 16 : -1);
    }
}

__device__ __forceinline__ int chunk_row0(int dir, int b, int c) {
    if (dir == 0) return c < 2 ? ML + b * CTXL + 128 * c : b * SEQ + 128 * (c - 2);
    return c < 2 ? ML + b * CTXL + 128 * (1 - c) : b * SEQ + 128 * (63 - (c - 2));
}
__device__ __forceinline__ float wave_incl_sum(float v, int lane) {
#pragma unroll
    for (int o = 1; o < 64; o <<= 1) { const float t = __shfl_up(v, o); if (lane >= o) v += t; }
    return v;
}
__device__ __forceinline__ float wave_incl_max(float v, int lane) {
#pragma unroll
    for (int o = 1; o < 64; o <<= 1) { const float t = __shfl_up(v, o); if (lane >= o) v = fmaxf(v, t); }
    return v;
}
__device__ __forceinline__ bf16x8 tr_frag(LAS unsigned char* T, int pitch, int k0, int col0, int lane) {
    const int g = lane >> 4, q = (lane & 15) >> 2, p = lane & 3;
    LAS unsigned char* p0 = T + (k0 + 8 * g + q) * pitch + (col0 + 4 * p) * 2;
    const s16x4 lo = __builtin_amdgcn_ds_read_tr16_b64_v4i16((LAS s16x4*)p0);
    const s16x4 hi = __builtin_amdgcn_ds_read_tr16_b64_v4i16((LAS s16x4*)(p0 + 4 * pitch));
    bf16x8 r; r[0] = lo[0]; r[1] = lo[1]; r[2] = lo[2]; r[3] = lo[3]; r[4] = hi[0]; r[5] = hi[1]; r[6] = hi[2]; r[7] = hi[3];
    return r;
}
#ifndef SCAN_REP
#define SCAN_REP 1
#endif
#define MFMA16(y, x, acc) __builtin_amdgcn_mfma_f32_16x16x32_bf16((y), (x), (acc), 0, 0, 0)

constexpr int SK_PITCH = 528;

constexpr size_t WS_QT = WS_G;
constexpr size_t WS_SPP = WS_Y;
constexpr size_t WS_DEN = WS_Y + 64 * MiB;
static_assert((size_t)32 * 64 * 128 * 128 * 2 <= 64 * MiB && WS_DEN + (size_t)32 * 64 * 128 * 4 <= WS_HS, "scan scratch");
__device__ __forceinline__ void chunk_scalars(CArgs a, int dir, int b, int h, int c, LAS float* sAl, LAS float* sPl, int lane) {
    const float* GT = (const float*)(a->ws + WS_GATES);
    float* SCP = (float*)(a->ws + WS_SCP); float* SCG = (float*)(a->ws + WS_SCC);
    const int chain = dir * 16 + b * 8 + h, R0 = chunk_row0(dir, b, c);
    const float bi = a->in[I_MBG][dir * 16 + h], bf = a->in[I_MBG][dir * 16 + 8 + h];
    const int r0 = dir ? 127 - lane : lane, r1 = dir ? 63 - lane : 64 + lane;
    const float i0 = GT[(size_t)(R0 + r0) * 32 + dir * 16 + h] + bi, i1 = GT[(size_t)(R0 + r1) * 32 + dir * 16 + h] + bi;
    const float x0 = GT[(size_t)(R0 + r0) * 32 + dir * 16 + 8 + h] + bf, x1 = GT[(size_t)(R0 + r1) * 32 + dir * 16 + 8 + h] + bf;
    const float f0 = fminf(x0, 0.f) - log1pf(__expf(-fabsf(x0))), f1 = fminf(x1, 0.f) - log1pf(__expf(-fabsf(x1)));
    const float s0 = wave_incl_sum(f0, lane); const float tot0 = __shfl(s0, 63);
    const float s1 = wave_incl_sum(f1, lane) + tot0;
    const float a0 = i0 - s0, a1 = i1 - s1;
    const float p0 = wave_incl_max(a0, lane); const float pm0 = __shfl(p0, 63);
    const float p1 = fmaxf(wave_incl_max(a1, lane), pm0);
    float* o = SCP + ((size_t)chain * NCH + c) * 384;
    o[r0] = a0; o[128 + r0] = p0; o[256 + r0] = s0;
    o[r1] = a1; o[128 + r1] = p1; o[256 + r1] = s1;
    if (sAl) { sAl[r0] = a0; sAl[r1] = a1; }
    if (lane == 63) { SCG[((size_t)chain * NCH + c) * 2] = s1; SCG[((size_t)chain * NCH + c) * 2 + 1] = p1; if (sPl) sPl[0] = p1; }
}
__device__ __forceinline__ void scan_pre_phase(CArgs a, LAS unsigned char* lds, int tid, int lane, int wave) {
    const bf16* QK = (const bf16*)(a->ws + WS_U);
    bf16* SPP = (bf16*)(a->ws + WS_SPP); float* DEN = (float*)(a->ws + WS_DEN); const bf16* QT = (const bf16*)(a->ws + WS_QT);
    LAS unsigned char* Kl = lds; LAS float* sA0 = (LAS float*)(lds + 67584); LAS float* sA1 = sA0 + 128; LAS float* sPt = sA0 + 256;
    const int g = lane >> 4, l15 = lane & 15;
    for (int unit = blockIdx.x; unit < 1024 + 64; unit += gridDim.x) {
        if (unit >= 1024) { if (wave == 0) { const int u = unit - 1024, chain = u >> 1, c = u & 1; chunk_scalars(a, chain >> 4, (chain >> 3) & 1, chain & 7, c, nullptr, nullptr, lane); } continue; }
        const int bh = unit >> 6, j = unit & 63, b = bh >> 3, h = bh & 7;
        const int R0 = b * SEQ + 128 * j, c0 = 2 + j, c1 = 2 + (63 - j);
        const int tl = 16 * wave + l15;
#pragma unroll
        for (int i = 0; i < 8; ++i) { const int idx = tid + NTHREADS * i, r = idx >> 5, ch = idx & 31;
            const v4u v = *(const v4u*)(QK + (size_t)(R0 + r) * QKVO + 2048 + h * DQK + ch * 8);
            *(LAS v4u*)(Kl + r * SK_PITCH + ch * 16) = v; }
        bf16x8 qf[8];
#pragma unroll
        for (int kk = 0; kk < 8; ++kk) qf[kk] = *(const bf16x8*)(QT + ((size_t)((R0 >> 4) + wave) * 64 + 8 * h + kk) * 512 + lane * 8);
        if (wave == 0) chunk_scalars(a, 0, b, h, c0, sA0, sPt, lane);
        if (wave == 1) chunk_scalars(a, 1, b, h, c1, sA1, sPt + 1, lane);
        __syncthreads();
        {
            const float pt0 = sPt[0], pt1 = sPt[1];
            float dp0 = 0.f, dp1 = 0.f;
            int tlv = tl, gv = 4 * g; asm volatile("" : "+v"(tlv), "+v"(gv));
            bf16* sp0 = SPP + (size_t)((0 * 16 + bh) * 64 + (c0 - 2)) * 16384 + (size_t)wave * 2048 + (l15 + 16 * (g >> 1)) * 8 + 4 * (g & 1);
            bf16* sp1 = SPP + (size_t)((1 * 16 + bh) * 64 + (c1 - 2)) * 16384 + (size_t)wave * 2048 + (l15 + 16 * (g >> 1)) * 8 + 4 * (g & 1);
#pragma unroll
            for (int nh = 0; nh < 2; ++nh) {
                f32x4 sacc[4];
#pragma unroll
                for (int n = 0; n < 4; ++n) sacc[n] = (f32x4){0.f, 0.f, 0.f, 0.f};
#pragma unroll
                for (int kk = 0; kk < 8; ++kk)
#pragma unroll
                    for (int n = 0; n < 4; ++n) { const bf16x8 yf = *(const LAS bf16x8*)(Kl + (16 * (4 * nh + n) + l15) * SK_PITCH + (32 * kk + 8 * g) * 2); sacc[n] = MFMA16(yf, qf[kk], sacc[n]); }
#pragma unroll
                for (int n = 0; n < 4; ++n) { float sv0[4], sv1[4]; const int n8 = 4 * nh + n;
#pragma unroll
                    for (int r = 0; r < 4; ++r) { const int sl = 16 * n8 + 4 * g + r; const int sidx = gv + (16 * n8 + r);
                        const float qk = sacc[n][r] * 0.0625f;
                        sv0[r] = (sidx <= tlv) ? qk * __expf(sA0[sl] - pt0) : 0.f; dp0 += sv0[r];
                        sv1[r] = (sidx >= tlv) ? qk * __expf(sA1[sl] - pt1) : 0.f; dp1 += sv1[r]; }
                    v2u w0; w0.x = pk2(sv0[0], sv0[1]); w0.y = pk2(sv0[2], sv0[3]); *(v2u*)(sp0 + (n8 >> 1) * 512 + (n8 & 1) * 256) = w0;
                    v2u w1; w1.x = pk2(sv1[0], sv1[1]); w1.y = pk2(sv1[2], sv1[3]); *(v2u*)(sp1 + (n8 >> 1) * 512 + (n8 & 1) * 256) = w1; }
                asm volatile("" ::: "memory");
            }
            dp0 += __shfl_xor(dp0, 16); dp0 += __shfl_xor(dp0, 32); dp1 += __shfl_xor(dp1, 16); dp1 += __shfl_xor(dp1, 32);
            if (g == 0) { DEN[(size_t)((0 * 16 + bh) * 64 + (c0 - 2)) * 128 + tl] = dp0; DEN[(size_t)((1 * 16 + bh) * 64 + (c1 - 2)) * 128 + tl] = dp1; }
        }
        __syncthreads();
    }
}

constexpr int S2V_PITCH = 160;
constexpr int S2K_PITCH = 544;
__device__ __forceinline__ int s2_sigma(int r) { return (r & ~12) | ((r & 4) << 1) | ((r & 8) >> 1); }
__device__ __forceinline__ bf16x8 tr_frag_sw(LAS unsigned char* T, int pitch, int k0, int col0, int lane) {
    const int g = lane >> 4, q = (lane & 15) >> 2, p = lane & 3;
    LAS unsigned char* p0 = T + (k0 + 16 * (g >> 1) + 4 * (g & 1) + q) * pitch + (col0 + 4 * p) * 2;
    const s16x4 lo = __builtin_amdgcn_ds_read_tr16_b64_v4i16((LAS s16x4*)p0);
    const s16x4 hi = __builtin_amdgcn_ds_read_tr16_b64_v4i16((LAS s16x4*)(p0 + 8 * pitch));
    bf16x8 r; r[0] = lo[0]; r[1] = lo[1]; r[2] = lo[2]; r[3] = lo[3]; r[4] = hi[0]; r[5] = hi[1]; r[6] = hi[2]; r[7] = hi[3];
    return r;
}
constexpr int S2K_OFF = 0, S2V_OFF = 128 * S2K_PITCH, S2S_OFF = S2V_OFF + 128 * S2V_PITCH, S2C_OFF = S2S_OFF + 128 * S2V_PITCH, S2M_OFF = S2C_OFF + 80 * SK_PITCH;
static_assert(S2M_OFF + 4 * 272 <= MISC_OFF, "scan v2 LDS map");
#define SCHED_FENCE() do { } while (0)
#define LDS_BARRIER() do { asm volatile("s_waitcnt lgkmcnt(0)" ::: "memory"); __builtin_amdgcn_s_barrier(); asm volatile("" ::: "memory"); } while (0)
__device__ __forceinline__ void scan_seq_phase(CArgs a, LAS unsigned char* lds, int tid, int lane, int wave) {
    const bf16* QK = (const bf16*)(a->ws + WS_U);
    const float* SCP = (const float*)(a->ws + WS_SCP); const float* SCG = (const float*)(a->ws + WS_SCC);
    const bf16* SPP = (const bf16*)(a->ws + WS_SPP); const float* DEN = (const float*)(a->ws + WS_DEN); const bf16* QT = (const bf16*)(a->ws + WS_QT);
    bf16* HS = (bf16*)(a->ws + WS_HS);
    LAS unsigned char* Kl = lds + S2K_OFF; LAS unsigned char* Vl = lds + S2V_OFF; LAS unsigned char* Vs = lds + S2S_OFF; LAS unsigned char* Cl = lds + S2C_OFF;
    LAS float* mp = (LAS float*)(lds + S2M_OFF); LAS float* ml = mp + 68; LAS float* pt = mp + 136; LAS float* gl = mp + 204;
    for (int unit_ = blockIdx.x; unit_ < 256 * SCAN_REP; unit_ += gridDim.x) { const int u0 = unit_ & 255, unit = ((u0 & 7) << 5) | (u0 >> 3);
        const int chain = unit >> 3, slice = unit & 7, dir = chain >> 4, b = (chain >> 3) & 1, h = chain & 7;
        int tid_u = tid; asm volatile("" : "+v"(tid_u));
        if (tid < NCH) { gl[tid] = SCG[((size_t)chain * NCH + tid) * 2]; pt[tid] = SCG[((size_t)chain * NCH + tid) * 2 + 1]; }
        for (int i = tid_u; i < 80 * SK_PITCH / 4; i += NTHREADS) ((LAS unsigned*)Cl)[i] = 0u;
        for (int i = tid_u; i < 128 * 8; i += NTHREADS) { const int r = i >> 3, w = i & 7; ((LAS unsigned*)(Vs + r * S2V_PITCH + 128))[w] = 0u; }
        __syncthreads();
        if (tid == 0) { float m = 0.f; for (int c = 0; c < NCH; ++c) { const float mx = fmaxf(m, pt[c]); mp[c] = m; ml[c] = mx; m = gl[c] + mx; } }
        __syncthreads();
        f32x4 cacc[5][2];
#pragma unroll
        for (int mt = 0; mt < 5; ++mt)
#pragma unroll
            for (int nt = 0; nt < 2; ++nt) cacc[mt][nt] = (f32x4){0.f, 0.f, 0.f, 0.f};
        v4u kreg[8], vreg[2]; float areg[2];
#define S2_LOAD(cc, T) do { const unsigned koff = (unsigned)((((T) >> 5) * QKVO + ((T) & 31) * 8) * 2), voff = (unsigned)((((T) >> 3) * QKVO + ((T) & 7) * 8) * 2); const int R1_ = chunk_row0(dir, b, (cc)); const char* kb_ = (const char*)(QK + (size_t)R1_ * QKVO + 2048 + h * DQK); const char* vb_ = (const char*)(QK + (size_t)R1_ * QKVO + 4096 + h * DV + slice * 64); \
            const float* ab_ = SCP + ((size_t)chain * NCH + (cc)) * 384; \
            _Pragma("unroll") for (int i = 0; i < 8; ++i) kreg[i] = *(const v4u*)(kb_ + (koff + (unsigned)(i * 16 * QKVO * 2))); \
            _Pragma("unroll") for (int i = 0; i < 2; ++i) { vreg[i] = *(const v4u*)(vb_ + (voff + (unsigned)(i * 64 * QKVO * 2))); areg[i] = ab_[((T) >> 3) + 64 * i]; } } while (0)
#define S2_STORE(cc, T) do { const float mlc_ = ml[(cc)]; \
            _Pragma("unroll") for (int i = 0; i < 8; ++i) { const int idx = (T) + NTHREADS * i, r = idx >> 5, ch = idx & 31; *(LAS v4u*)(Kl + s2_sigma(r) * S2K_PITCH + ch * 16) = kreg[i]; } \
            _Pragma("unroll") for (int i = 0; i < 2; ++i) { const int idx = (T) + NTHREADS * i, r = idx >> 3, ch = idx & 7; const float ws_ = __expf(areg[i] - mlc_) * 0.0625f;     \
                *(LAS v4u*)(Vl + s2_sigma(r) * S2V_PITCH + ch * 16) = vreg[i]; \
                v4u sc_; sc_.x = pk2(bflo(vreg[i].x) * ws_, bfhi(vreg[i].x) * ws_); sc_.y = pk2(bflo(vreg[i].y) * ws_, bfhi(vreg[i].y) * ws_); sc_.z = pk2(bflo(vreg[i].z) * ws_, bfhi(vreg[i].z) * ws_); sc_.w = pk2(bflo(vreg[i].w) * ws_, bfhi(vreg[i].w) * ws_); \
                *(LAS v4u*)(Vs + s2_sigma(r) * S2V_PITCH + ch * 16) = sc_; \
                if (ch == 0) *(LAS unsigned*)(Vs + s2_sigma(r) * S2V_PITCH + 128) = f2bf(ws_); } } while (0)
        S2_LOAD(0, tid_u); S2_STORE(0, tid_u);
        __syncthreads();
#define S2_OUTP false
        for (int c = 0; c < 2; ++c) {
            const int R0 = chunk_row0(dir, b, c);
            const float m_prev = mp[c], m_last = ml[c], ptot = pt[c];
            constexpr bool outp = S2_OUTP; const bool more = (c + 1 < NCH);
            int tid_o = tid; asm volatile("" : "+v"(tid_o));
            const int lane_o = tid_o & 63, g = lane_o >> 4, l15 = lane_o & 15, tl = 16 * wave + l15;
            bf16x8 qf[8], sf[4]; float pv = 0.f, bv = 0.f, dn = 0.f;
            v2u hw[4] = {{0u, 0u}, {0u, 0u}, {0u, 0u}, {0u, 0u}}; v4u hv[2] = {{0u, 0u, 0u, 0u}, {0u, 0u, 0u, 0u}};
            if (outp) {
                const char* qb = (const char*)(QT + ((size_t)((R0 >> 4) + wave) * 64 + 8 * h) * 512); const unsigned qoff = (unsigned)(lane_o * 16);
#pragma unroll
                for (int kk = 0; kk < 8; ++kk) qf[kk] = *(const bf16x8*)(qb + (qoff + (unsigned)(kk * 1024)));
                const float* scp = SCP + ((size_t)chain * NCH + c) * 384;
                pv = scp[128 + tl]; bv = scp[256 + tl]; dn = DEN[(size_t)(chain * 64 + (c - 2)) * 128 + tl];
            }
            SCHED_FENCE();
            const float w_old = __expf(m_prev - m_last);
#pragma unroll
            for (int mt = 0; mt < 5; ++mt)
#pragma unroll
                for (int nt = 0; nt < 2; ++nt) cacc[mt][nt] = cacc[mt][nt] * w_old;
#pragma unroll
            for (int kk = 0; kk < 4; ++kk) {
                bf16x8 yf[2], xf[5];
#pragma unroll
                for (int nt = 0; nt < 2; ++nt) yf[nt] = tr_frag_sw(Kl, S2K_PITCH, 32 * kk, 32 * wave + 16 * nt, lane_o);
#pragma unroll
                for (int mt = 0; mt < 5; ++mt) xf[mt] = tr_frag_sw(Vs, S2V_PITCH, 32 * kk, 16 * mt, lane_o);
                SCHED_FENCE();
#pragma unroll
                for (int mt = 0; mt < 5; ++mt)
#pragma unroll
                    for (int nt = 0; nt < 2; ++nt) cacc[mt][nt] = MFMA16(yf[nt], xf[mt], cacc[mt][nt]);
                SCHED_FENCE();
            }
            if (outp) { const char* sb = (const char*)(SPP + (size_t)(chain * 64 + (c - 2)) * 16384 + (size_t)wave * 2048); const unsigned soff = (unsigned)(lane_o * 16);
#pragma unroll
                for (int kk = 0; kk < 4; ++kk) sf[kk] = *(const bf16x8*)(sb + (soff + (unsigned)(kk * 1024))); }
            if (more) S2_LOAD(c + 1, tid_o);
            SCHED_FENCE();
            if (outp) {
                f32x4 qacc[5];
#pragma unroll
                for (int n = 0; n < 5; ++n) qacc[n] = (f32x4){0.f, 0.f, 0.f, 0.f};
#pragma unroll
                for (int kk = 0; kk < 8; ++kk) {
                    bf16x8 cf[5];
#pragma unroll
                    for (int n = 0; n < 5; ++n) cf[n] = *(const LAS bf16x8*)(Cl + (16 * n + l15) * SK_PITCH + (32 * kk + 8 * g) * 2);
                    SCHED_FENCE();
#pragma unroll
                    for (int n = 0; n < 5; ++n) qacc[n] = MFMA16(cf[n], qf[kk], qacc[n]);
                    SCHED_FENCE();
                }
                f32x4 nacc[4];
#pragma unroll
                for (int n = 0; n < 4; ++n) nacc[n] = (f32x4){0.f, 0.f, 0.f, 0.f};
#pragma unroll
                for (int k2 = 0; k2 < 4; k2 += 2) {
                    bf16x8 vf[2][4];
#pragma unroll
                    for (int u = 0; u < 2; ++u)
#pragma unroll
                        for (int n = 0; n < 4; ++n) vf[u][n] = tr_frag_sw(Vl, S2V_PITCH, 32 * (k2 + u), 16 * n, lane_o);
                    SCHED_FENCE();
#pragma unroll
                    for (int u = 0; u < 2; ++u)
#pragma unroll
                        for (int n = 0; n < 4; ++n) nacc[n] = MFMA16(vf[u][n], sf[k2 + u], nacc[n]);
                    SCHED_FENCE();
                }
                const float mxt = fmaxf(m_prev, pv), rowfac = __expf(ptot - mxt), winter = __expf(m_prev - mxt);
                const float nq = __shfl(qacc[4][0], l15);
                const float den = rowfac * dn + winter * nq;
                const float inv = 1.0f / fmaxf(fabsf(den), __expf(-bv - mxt));
#pragma unroll
                for (int n = 0; n < 4; ++n) { const f32x4 o = (nacc[n] * rowfac + qacc[n] * winter) * inv; hw[n].x = pk2(o.x, o.y); hw[n].y = pk2(o.z, o.w); }
                bf16* hp = HS + ((size_t)dir * ML + R0 + tl) * D + h * DV + slice * 64 + 8 * g;
                const int src0 = l15 + 16 * (2 * (g & 1)), src1 = src0 + 16; const bool hi_n = (g >> 1) != 0;
#pragma unroll
                for (int k = 0; k < 2; ++k) {
                    const unsigned a0x = __shfl(hw[2 * k].x, src0), a0y = __shfl(hw[2 * k].y, src0), a1x = __shfl(hw[2 * k].x, src1), a1y = __shfl(hw[2 * k].y, src1);
                    const unsigned b0x = __shfl(hw[2 * k + 1].x, src0), b0y = __shfl(hw[2 * k + 1].y, src0), b1x = __shfl(hw[2 * k + 1].x, src1), b1y = __shfl(hw[2 * k + 1].y, src1);
                    hv[k].x = hi_n ? b0x : a0x; hv[k].y = hi_n ? b0y : a0y; hv[k].z = hi_n ? b1x : a1x; hv[k].w = hi_n ? b1y : a1y;
                    *(v4u*)(hp + 32 * k) = hv[k]; }
            }
            LDS_BARRIER();
#pragma unroll
            for (int mt = 0; mt < 5; ++mt)
#pragma unroll
                for (int nt = 0; nt < 2; ++nt) { v2u w; w.x = pk2(cacc[mt][nt][0], cacc[mt][nt][1]); w.y = pk2(cacc[mt][nt][2], cacc[mt][nt][3]);
                    *(LAS v2u*)(Cl + (16 * mt + l15) * SK_PITCH + (32 * wave + 16 * nt + 4 * g) * 2) = w; }
            if (more) S2_STORE(c + 1, tid_o);
            asm volatile("" :: "v"(hv[0]), "v"(hv[1]));
            LDS_BARRIER();
                }
#undef S2_OUTP
#define S2_OUTP true
        for (int c = 2; c < NCH; ++c) {
            const int R0 = chunk_row0(dir, b, c);
            const float m_prev = mp[c], m_last = ml[c], ptot = pt[c];
            constexpr bool outp = S2_OUTP; const bool more = (c + 1 < NCH);
            int tid_o = tid; asm volatile("" : "+v"(tid_o));
            const int lane_o = tid_o & 63, g = lane_o >> 4, l15 = lane_o & 15, tl = 16 * wave + l15;
            bf16x8 qf[8], sf[4]; float pv = 0.f, bv = 0.f, dn = 0.f;
            v2u hw[4] = {{0u, 0u}, {0u, 0u}, {0u, 0u}, {0u, 0u}}; v4u hv[2] = {{0u, 0u, 0u, 0u}, {0u, 0u, 0u, 0u}};
            if (outp) {
                const char* qb = (const char*)(QT + ((size_t)((R0 >> 4) + wave) * 64 + 8 * h) * 512); const unsigned qoff = (unsigned)(lane_o * 16);
#pragma unroll
                for (int kk = 0; kk < 8; ++kk) qf[kk] = *(const bf16x8*)(qb + (qoff + (unsigned)(kk * 1024)));
                const float* scp = SCP + ((size_t)chain * NCH + c) * 384;
                pv = scp[128 + tl]; bv = scp[256 + tl]; dn = DEN[(size_t)(chain * 64 + (c - 2)) * 128 + tl];
            }
            SCHED_FENCE();
            const float w_old = __expf(m_prev - m_last);
#pragma unroll
            for (int mt = 0; mt < 5; ++mt)
#pragma unroll
                for (int nt = 0; nt < 2; ++nt) cacc[mt][nt] = cacc[mt][nt] * w_old;
#pragma unroll
            for (int kk = 0; kk < 4; ++kk) {
                bf16x8 yf[2], xf[5];
#pragma unroll
                for (int nt = 0; nt < 2; ++nt) yf[nt] = tr_frag_sw(Kl, S2K_PITCH, 32 * kk, 32 * wave + 16 * nt, lane_o);
#pragma unroll
                for (int mt = 0; mt < 5; ++mt) xf[mt] = tr_frag_sw(Vs, S2V_PITCH, 32 * kk, 16 * mt, lane_o);
                SCHED_FENCE();
#pragma unroll
                for (int mt = 0; mt < 5; ++mt)
#pragma unroll
                    for (int nt = 0; nt < 2; ++nt) cacc[mt][nt] = MFMA16(yf[nt], xf[mt], cacc[mt][nt]);
                SCHED_FENCE();
            }
            if (outp) { const char* sb = (const char*)(SPP + (size_t)(chain * 64 + (c - 2)) * 16384 + (size_t)wave * 2048); const unsigned soff = (unsigned)(lane_o * 16);
#pragma unroll
                for (int kk = 0; kk < 4; ++kk) sf[kk] = *(const bf16x8*)(sb + (soff + (unsigned)(kk * 1024))); }
            if (more) S2_LOAD(c + 1, tid_o);
            SCHED_FENCE();
            if (outp) {
                f32x4 qacc[5];
#pragma unroll
                for (int n = 0; n < 5; ++n) qacc[n] = (f32x4){0.f, 0.f, 0.f, 0.f};
#pragma unroll
                for (int kk = 0; kk < 8; ++kk) {
                    bf16x8 cf[5];
#pragma unroll
                    for (int n = 0; n < 5; ++n) cf[n] = *(const LAS bf16x8*)(Cl + (16 * n + l15) * SK_PITCH + (32 * kk + 8 * g) * 2);
                    SCHED_FENCE();
#pragma unroll
                    for (int n = 0; n < 5; ++n) qacc[n] = MFMA16(cf[n], qf[kk], qacc[n]);
                    SCHED_FENCE();
                }
                f32x4 nacc[4];
#pragma unroll
                for (int n = 0; n < 4; ++n) nacc[n] = (f32x4){0.f, 0.f, 0.f, 0.f};
#pragma unroll
                for (int k2 = 0; k2 < 4; k2 += 2) {
                    bf16x8 vf[2][4];
#pragma unroll
                    for (int u = 0; u < 2; ++u)
#pragma unroll
                        for (int n = 0; n < 4; ++n) vf[u][n] = tr_frag_sw(Vl, S2V_PITCH, 32 * (k2 + u), 16 * n, lane_o);
                    SCHED_FENCE();
#pragma unroll
                    for (int u = 0; u < 2; ++u)
#pragma unroll
                        for (int n = 0; n < 4; ++n) nacc[n] = MFMA16(vf[u][n], sf[k2 + u], nacc[n]);
                    SCHED_FENCE();
                }
                const float mxt = fmaxf(m_prev, pv), rowfac = __expf(ptot - mxt), winter = __expf(m_prev - mxt);
                const float nq = __shfl(qacc[4][0], l15);
                const float den = rowfac * dn + winter * nq;
                const float inv = 1.0f / fmaxf(fabsf(den), __expf(-bv - mxt));
#pragma unroll
                for (int n = 0; n < 4; ++n) { const f32x4 o = (nacc[n] * rowfac + qacc[n] * winter) * inv; hw[n].x = pk2(o.x, o.y); hw[n].y = pk2(o.z, o.w); }
                bf16* hp = HS + ((size_t)dir * ML + R0 + tl) * D + h * DV + slice * 64 + 8 * g;
                const int src0 = l15 + 16 * (2 * (g & 1)), src1 = src0 + 16; const bool hi_n = (g >> 1) != 0;
#pragma unroll
                for (int k = 0; k < 2; ++k) {
                    const unsigned a0x = __shfl(hw[2 * k].x, src0), a0y = __shfl(hw[2 * k].y, src0), a1x = __shfl(hw[2 * k].x, src1), a1y = __shfl(hw[2 * k].y, src1);
                    const unsigned b0x = __shfl(hw[2 * k + 1].x, src0), b0y = __shfl(hw[2 * k + 1].y, src0), b1x = __shfl(hw[2 * k + 1].x, src1), b1y = __shfl(hw[2 * k + 1].y, src1);
                    hv[k].x = hi_n ? b0x : a0x; hv[k].y = hi_n ? b0y : a0y; hv[k].z = hi_n ? b1x : a1x; hv[k].w = hi_n ? b1y : a1y;
                    *(v4u*)(hp + 32 * k) = hv[k]; }
            }
            LDS_BARRIER();
#pragma unroll
            for (int mt = 0; mt < 5; ++mt)
#pragma unroll
                for (int nt = 0; nt < 2; ++nt) { v2u w; w.x = pk2(cacc[mt][nt][0], cacc[mt][nt][1]); w.y = pk2(cacc[mt][nt][2], cacc[mt][nt][3]);
                    *(LAS v2u*)(Cl + (16 * mt + l15) * SK_PITCH + (32 * wave + 16 * nt + 4 * g) * 2) = w; }
            if (more) S2_STORE(c + 1, tid_o);
            asm volatile("" :: "v"(hv[0]), "v"(hv[1]));
            LDS_BARRIER();
                }
#undef S2_OUTP
#undef S2_LOAD
#undef S2_STORE
    }
}

__device__ __forceinline__ void scan_out_phase(CArgs a, LAS unsigned char* lds, int tid, int lane, int wave) {
    const bf16* HS = (const bf16*)(a->ws + WS_HS);
    const bf16* QK = (const bf16*)(a->ws + WS_U);
    bf16* A2 = (bf16*)(a->ws + WS_G);
    LAS f32x4* pg = (LAS f32x4*)lds;
    for (int i = tid; i < 1024; i += NTHREADS) pg[i] = ((const f32x4*)a->in[I_MHNG])[i];
    __syncthreads();
    const int G = gridDim.x, rpw = (ML + G - 1) / G, r0 = (int)blockIdx.x * rpw, r1 = (r0 + rpw < ML) ? r0 + rpw : ML;
    for (int row = r0 + wave; row < r1; row += NWAVES) {
        const bf16* hfp = HS + (size_t)row * D + lane * 8; const bf16* hbp = hfp + (size_t)ML * D; const bf16* op = QK + (size_t)row * QKVO + 8192 + lane * 8; bf16* ap = A2 + (size_t)row * D + lane * 8;
#pragma unroll 1
        for (int hb4 = 0; hb4 < HEADS; hb4 += 4) {
            v4u hf[4], hb[4], ov[4];
#pragma unroll
            for (int i = 0; i < 4; ++i) { hf[i] = *(const v4u*)(hfp + (hb4 + i) * DV); hb[i] = *(const v4u*)(hbp + (hb4 + i) * DV); ov[i] = *(const v4u*)(op + (hb4 + i) * DV); }
#pragma unroll
            for (int i = 0; i < 4; ++i) {
                const f32x4 va = {bflo(hf[i].x) + bflo(hb[i].x), bfhi(hf[i].x) + bfhi(hb[i].x), bflo(hf[i].y) + bflo(hb[i].y), bfhi(hf[i].y) + bfhi(hb[i].y)};
                const f32x4 vb = {bflo(hf[i].z) + bflo(hb[i].z), bfhi(hf[i].z) + bfhi(hb[i].z), bflo(hf[i].w) + bflo(hb[i].w), bfhi(hf[i].w) + bfhi(hb[i].w)};
                const float s = ((va.x * va.x + va.y * va.y) + (va.z * va.z + va.w * va.w)) + ((vb.x * vb.x + vb.y * vb.y) + (vb.z * vb.z + vb.w * vb.w));
                const float rstd = 1.0f / sqrtf(wave_sum(s) * (1.0f / DV) + EPS);
                const f32x4 ga = pg[((hb4 + i) * DV) / 4 + lane * 2], gb = pg[((hb4 + i) * DV) / 4 + lane * 2 + 1];
                const f32x4 ya = (va * rstd) * ga, yb = (vb * rstd) * gb;
                v4u w; w.x = pk2(ya.x * sigmoidf_(bflo(ov[i].x)), ya.y * sigmoidf_(bfhi(ov[i].x))); w.y = pk2(ya.z * sigmoidf_(bflo(ov[i].y)), ya.w * sigmoidf_(bfhi(ov[i].y)));
                w.z = pk2(yb.x * sigmoidf_(bflo(ov[i].z)), yb.y * sigmoidf_(bfhi(ov[i].z))); w.w = pk2(yb.z * sigmoidf_(bflo(ov[i].w)), yb.w * sigmoidf_(bfhi(ov[i].w)));
                *(v4u*)(ap + (hb4 + i) * DV) = w; }
        }
    }
}

constexpr int NPHASES = 21;
__global__ void __launch_bounds__(NTHREADS, 2) fwd_kernel(Args args_unused) {
    extern __shared__ __attribute__((aligned(16))) unsigned char lds_raw[];
    LAS unsigned char* lds = (LAS unsigned char*)lds_raw;
    const int wave_s = __builtin_amdgcn_readfirstlane((int)threadIdx.x >> 6);
    { const int tid = threadIdx.x; volatile LAS unsigned* MISC = (volatile LAS unsigned*)(lds + MISC_OFF);
      if (tid < 16) MISC[tid] = 0u;
      __syncthreads();
      if (!MK_PER_PHASE) (void)xcd_barrier_post((unsigned*)(get_args()->ws + WS_CTL) + CW_BAR, MISC); }
#define PH_IDS for (int tid = opaque_tid(wave_s), lane = tid & 63, wave = __builtin_amdgcn_readfirstlane(tid >> 6), once_ = 1; once_; once_ = 0)
#if MK_PER_PHASE
#define IN(k) (get_args()->ph_lo == (k)) PH_IDS if (true
#define SEAM(k) do { } while (0)
#else
#ifndef PROBE_PHASE
#define PROBE_PHASE -1
#endif
#define IN(k) true) for (int rep_ = 0; rep_ < ((k) == PROBE_PHASE ? 2 : 1); ++rep_) PH_IDS if (true
#define SEAM(k) do { XcdBarrier b_; b_.bar = (unsigned*)(get_args()->ws + WS_CTL) + CW_BAR; b_.x = xb_xcc_id(); b_.st = (volatile LAS unsigned*)(lds + MISC_OFF); xcd_barrier(b_); } while (0)
#endif
#define WSP(off) (get_args()->ws + (off))
#define MODP(layer) ((const float*)WSP(WS_MOD) + (layer) * 3 * NMODC)
#define NGP(i) (get_args()->in[I_NORMG] + (i) * D)

#define GEMM_PHASE(EPI, A_, B_, M_, N_, K_, EINIT, HAS_SIDE, SIDE) { const int nwg_ = ((M_) / 256) * ((N_) / 256), gg_ = (HAS_SIDE) ? gemm_wgs(nwg_) : (int)gridDim.x; \
        if ((int)blockIdx.x < gg_) { pg8::Gemm g{A_, B_, M_, N_, K_}; pg8::StaticOrder S; S.init(M_, N_, gg_, blockIdx.x); EPI E EINIT; pg8::gemm_phase<EPI, pg8::StaticOrder, true, true>(lds, g, S, E, tid); } \
          \
        const int t0_ = (HAS_SIDE) ? gg_ : ((nwg_ % (int)gridDim.x) ? nwg_ % (int)gridDim.x : (int)gridDim.x); \
        if (!PROBE_E1 && (int)blockIdx.x >= t0_) { const int si_ = (int)blockIdx.x - t0_, ns_ = (int)gridDim.x - t0_, sf_ = si_ * NWAVES + wave, sn_ = ns_ * NWAVES; (void)si_; (void)ns_; (void)sf_; (void)sn_; SIDE } }

    if (IN(0)) { p0_prologue(get_args(), lds, tid, lane, wave); __syncthreads(); } SEAM(0);
    if (IN(1)) { CArgs a = get_args(); row_phase<false, true, false, false>(lds, MT, a->in[I_X], a->in[I_CTX], nullptr, nullptr, nullptr, nullptr, nullptr, 0, NGP(0), MODP(0), 0, 1, (bf16*)WSP(WS_H), tid, lane, wave); }
    SEAM(1);
    if (IN(2)) GEMM_PHASE(pg8::EpiAB, (const bf16*)WSP(WS_H), (const bf16*)WSP(WS_WABIN), MT, ABIN, D, ({(bf16*)WSP(WS_U)}), false,
                          conv_matrix<CV_ABOUT>(get_args(), lds, sf_, sn_, lane, wave);)
    SEAM(2);
    if (IN(3)) mixer_conv_phase(get_args(), lds, tid, lane);
    SEAM(3);
    if (IN(4)) mixer_ln_phase(get_args(), lds, tid, lane, wave);
    SEAM(4);
    if (IN(5)) GEMM_PHASE(pg8::EpiBf16, (const bf16*)WSP(WS_G), (const bf16*)WSP(WS_WABOUT), MT, D, D, ({(bf16*)WSP(WS_Y), D}), true,
                          conv_matrix<CV_UP0>(get_args(), lds, sf_, sn_, lane, wave);)
    SEAM(5);
    if (IN(6)) { CArgs a = get_args(); row_phase<true, true, false, true>(lds, MT, a->in[I_X], a->in[I_CTX], WSP(WS_XB), nullptr, (const bf16*)WSP(WS_Y), NGP(1), MODP(0), 2, NGP(2), MODP(0), 3, 4, (bf16*)WSP(WS_H), tid, lane, wave); }
    SEAM(6);
    if (IN(7)) GEMM_PHASE(pg8::EpiGate, (const bf16*)WSP(WS_H), (const bf16*)WSP(WS_WUP0), MT, DFF2, D, ({(bf16*)WSP(WS_G), (bf16*)WSP(WS_UC), get_args()->in[I_FCONV]}), false,
                          conv_matrix<CV_DN0>(get_args(), lds, sf_, sn_, lane, wave);)
    SEAM(7);
    if (IN(8)) ffn_gate_ctx_phase(get_args(), tid);
    SEAM(8);
    if (IN(9)) GEMM_PHASE(pg8::EpiBf16, (const bf16*)WSP(WS_G), (const bf16*)WSP(WS_WDN0), MT, D, DFF, ({(bf16*)WSP(WS_Y), D}), true,
                          gemv_units(get_args(), lds, 1, si_, ns_, tid, lane, wave);
                          conv_matrix<CV_MIN>(get_args(), lds, sf_, sn_, lane, wave); conv_matrix<CV_MOUT>(get_args(), lds, sf_, sn_, lane, wave);
                          conv_matrix<CV_UP1>(get_args(), lds, sf_, sn_, lane, wave);)
    SEAM(9);
    if (IN(10)) { CArgs a = get_args(); row_phase<true, true, true, true>(lds, MT, WSP(WS_XB), nullptr, WSP(WS_XB), nullptr, (const bf16*)WSP(WS_Y), NGP(3), MODP(0), 5, NGP(4), MODP(1), 0, 1, (bf16*)WSP(WS_H), tid, lane, wave); }
    SEAM(10);
    if (IN(11)) GEMM_PHASE(pg8::EpiMIn, (const bf16*)WSP(WS_H), (const bf16*)WSP(WS_WMIN), MT, CINP, D, ({(bf16*)WSP(WS_U), QKVO, (float*)WSP(WS_GATES), (bf16*)WSP(WS_QT)}), false,
                           conv_matrix<CV_DN1>(get_args(), lds, sf_, sn_, lane, wave);)
    SEAM(11);
    if (IN(12)) scan_pre_phase(get_args(), lds, tid, lane, wave);
    SEAM(12);
    if (IN(13)) scan_seq_phase(get_args(), lds, tid, lane, wave);
    SEAM(13);
    if (IN(14)) scan_out_phase(get_args(), lds, tid, lane, wave);
    SEAM(14);
    if (IN(15)) GEMM_PHASE(pg8::EpiBf16, (const bf16*)WSP(WS_G), (const bf16*)WSP(WS_WMOUT), ML, D, D, ({(bf16*)WSP(WS_Y), D}), false, ;)
    SEAM(15);
    if (IN(16)) { CArgs a = get_args(); row_phase<true, true, true, true>(lds, ML, WSP(WS_XB), nullptr, WSP(WS_XB), nullptr, (const bf16*)WSP(WS_Y), NGP(5), MODP(1), 2, NGP(6), MODP(1), 3, 4, (bf16*)WSP(WS_H), tid, lane, wave); }
    SEAM(16);
    if (IN(17)) GEMM_PHASE(pg8::EpiGate, (const bf16*)WSP(WS_H), (const bf16*)WSP(WS_WUP0 + 172 * MiB), ML, DFF2, D, ({(bf16*)WSP(WS_G), (bf16*)WSP(WS_UC), get_args()->in[I_FCONV] + 3 * DFF2}), false, ;)
    SEAM(17);
    if (IN(19)) GEMM_PHASE(pg8::EpiBf16, (const bf16*)WSP(WS_G), (const bf16*)WSP(WS_WDN0 + 86 * MiB), ML, D, DFF, ({(bf16*)WSP(WS_Y), D}), false, ;)
    SEAM(19);
    if (IN(20)) { CArgs a = get_args(); row_phase<true, false, true, false>(lds, ML, WSP(WS_XB), nullptr, a->out, nullptr, (const bf16*)WSP(WS_Y), NGP(7), MODP(1), 5, nullptr, nullptr, 0, 0, nullptr, tid, lane, wave); }
#undef IN
#undef SEAM
}

extern "C" void kernel_launch(void* const* d_in, const int* in_sizes, int n_in, void* d_out, int out_size, void* d_ws, size_t ws_size, hipStream_t stream) {
    static int grid = 0;
    if (grid == 0) {
        if (n_in != 21 || out_size != ML * D || ws_size < WS_END) { fprintf(stderr, "kernel_launch: unexpected problem (n_in %d, out %d, ws %zu < %zu); nothing launched\n", n_in, out_size, ws_size, (size_t)WS_END); grid = -1; return; }
        int dev = 0, cus = 0, per_cu = 0;
        if (hipGetDevice(&dev) != hipSuccess || hipDeviceGetAttribute(&cus, hipDeviceAttributeMultiprocessorCount, dev) != hipSuccess) { grid = -1; return; }
        if (hipFuncSetAttribute((const void*)fwd_kernel, hipFuncAttributeMaxDynamicSharedMemorySize, LDS_BYTES) != hipSuccess) { fprintf(stderr, "kernel_launch: hipFuncSetAttribute failed\n"); grid = -1; return; }
        if (hipOccupancyMaxActiveBlocksPerMultiprocessor(&per_cu, (const void*)fwd_kernel, NTHREADS, LDS_BYTES) != hipSuccess || per_cu < 1)
            fprintf(stderr, "kernel_launch: occupancy query reports %d workgroups per CU\n", per_cu);
        (void)hipGetLastError();
        grid = cus;
    }
    if (grid < 0) return;
    if (hipMemsetAsync((char*)d_ws + WS_CTL, 0, CTL_ZERO_BYTES, stream) != hipSuccess) return;
    Args a{};
    for (int i = 0; i < 21; ++i) a.in[i] = (const float*)d_in[i];
    a.out = (float*)d_out; a.ws = (unsigned char*)d_ws;
#if MK_PER_PHASE
    for (int p = 0; p < NPHASES; ++p) { a.ph_lo = p; a.ph_hi = p + 1; hipLaunchKernelGGL(fwd_kernel, dim3(grid), dim3(NTHREADS), LDS_BYTES, stream, a); }
#else
    a.ph_lo = 0; a.ph_hi = NPHASES;
    hipLaunchKernelGGL(fwd_kernel, dim3(grid), dim3(NTHREADS), LDS_BYTES, stream, a);
#endif
}
```

```cpp
#include <hip/hip_runtime.h>
#include <cstdio>
#include <cstdint>

#ifndef PROBE_E1
#define PROBE_E1 0
#endif
#ifndef MK_PER_PHASE
#define MK_PER_PHASE 0
#endif

namespace pg8 {
#define PG8_LAS __attribute__((address_space(3)))
typedef unsigned short bf16_t;
typedef short bf16x8 __attribute__((ext_vector_type(8)));
typedef float f32x4 __attribute__((ext_vector_type(4)));
typedef unsigned u32x4 __attribute__((ext_vector_type(4)));
constexpr int BM = 256, BK = 64, HALF = 128, HTB = HALF * BK * 2, STAGE_BYTES = 8 * HTB, NXCD = 8, WGM = 4;

__host__ __device__ __forceinline__ int lds_byte(int r, int c) { const int st = (r >> 4) * 2 + (c >> 5), rr = r & 15, cc = c & 31, ob = rr * 64 + cc * 2; return st * 1024 + (ob ^ (((ob >> 9) & 1) << 5)); }
__host__ __device__ __forceinline__ void stage_rc(int b, int& R, int& C) { const int st = b / 1024, sb = b % 1024, swz = sb ^ (((sb >> 9) & 1) << 5); R = (st >> 1) * 16 + swz / 64; C = (st & 1) * 32 + (swz % 64) / 2; }
__host__ __device__ __forceinline__ int perm32(int rho) { const int n = rho >> 4, i = rho & 15; return 8 * (i >> 2) + 4 * n + (i & 3); }

struct Unit { int pm, pn; };
struct Gemm { const bf16_t* A; const bf16_t* Bt; int M, N, K; };

struct StaticOrder {
    int nM, nN, nwg, G, c;
    __host__ __device__ void init(int M, int N, int G_, int c_) { nM = M / BM; nN = N / BM; nwg = nM * nN; G = G_; c = c_; }
    __host__ __device__ bool next(int i, Unit& u) const {
        const long L = (long)i * G + c; if (L >= nwg) return false;
        int wgid = (int)L; { const int q = nwg / NXCD, r = nwg % NXCD, xcd = wgid % NXCD, off = wgid / NXCD; wgid = (xcd < r ? xcd * (q + 1) : r * (q + 1) + (xcd - r) * q) + off; }
        const int nig = WGM * nN, gid = wgid / nig, fm = gid * WGM, gsz = (nM - fm) < WGM ? (nM - fm) : WGM;
        u.pm = fm + ((wgid % nig) % gsz); u.pn = (wgid % nig) / gsz; return true;
    }
    __device__ __forceinline__ void a_ready(const Unit&) const {}
    __device__ __forceinline__ void done(const Unit&) const {}
};

__device__ __forceinline__ unsigned cvt_pk_bf16(float lo, float hi) { unsigned r; asm volatile("v_cvt_pk_bf16_f32 %0, %1, %2" : "=v"(r) : "v"(lo), "v"(hi)); return r; }

struct EpiBf16 {
    static constexpr bool PERM = true, AFTER_DRAIN = false, PERM_A = false;
    bf16_t* O; int ldc;
    __device__ __forceinline__ void operator()(const f32x4 (&acc)[2][2][4][2], const Unit& u, int wr, int wc, int fr, int fq) const {
        const int row0 = u.pm * BM + wr * 64 + fr, col0 = u.pn * BM + wc * 32 + 8 * fq;
#pragma unroll
        for (int ai = 0; ai < 2; ++ai)
#pragma unroll
            for (int m = 0; m < 4; ++m) { bf16_t* rowp = O + (size_t)(row0 + ai * HALF + m * 16) * ldc + col0;
#pragma unroll
                for (int bj = 0; bj < 2; ++bj) { const f32x4 v0 = acc[ai][bj][m][0], v1 = acc[ai][bj][m][1];
                    u32x4 w; w.x = cvt_pk_bf16(v0[0], v0[1]); w.y = cvt_pk_bf16(v0[2], v0[3]); w.z = cvt_pk_bf16(v1[0], v1[1]); w.w = cvt_pk_bf16(v1[2], v1[3]);
                    *(u32x4*)(rowp + bj * HALF) = w; } }
    }
};
struct EpiAB {
    static constexpr bool PERM = true, AFTER_DRAIN = false, PERM_A = false;
    bf16_t* O;
    __device__ __forceinline__ void operator()(const f32x4 (&acc)[2][2][4][2], const Unit& u, int wr, int wc, int fr, int fq) const {
        const int row0 = u.pm * BM + wr * 64 + fr;
        if (u.pn >= 16 && u.pn < 24) {
            const int col0 = 2048 + (u.pn - 16) * BM + wc * 32 + 8 * fq;
#pragma unroll
            for (int ai = 0; ai < 2; ++ai)
#pragma unroll
                for (int m = 0; m < 4; ++m) { bf16_t* rowp = O + (size_t)(row0 + ai * HALF + m * 16) * 6144 + col0;
#pragma unroll
                    for (int bj = 0; bj < 2; ++bj) { const f32x4 v0 = acc[ai][bj][m][0], v1 = acc[ai][bj][m][1];
                        u32x4 w; w.x = cvt_pk_bf16(v0[0], v0[1]); w.y = cvt_pk_bf16(v0[2], v0[3]); w.z = cvt_pk_bf16(v1[0], v1[1]); w.w = cvt_pk_bf16(v1[2], v1[3]);
                        *(u32x4*)(rowp + bj * HALF) = w; } }
            return;
        }
        const bool glu = u.pn < 16;
        const int col0 = (glu ? u.pn * 128 : 4096 + (u.pn - 24) * 128) + wc * 32 + 8 * fq;
#pragma unroll
        for (int ai = 0; ai < 2; ++ai)
#pragma unroll
            for (int m = 0; m < 4; ++m) { float o[8];
#pragma unroll
                for (int n = 0; n < 2; ++n)
#pragma unroll
                    for (int j = 0; j < 4; ++j) { const float x = acc[ai][0][m][n][j], y = acc[ai][1][m][n][j];
                        o[4 * n + j] = glu ? x * __builtin_amdgcn_rcpf(1.0f + __expf(-y)) : x * y; }
                u32x4 w; w.x = cvt_pk_bf16(o[0], o[1]); w.y = cvt_pk_bf16(o[2], o[3]); w.z = cvt_pk_bf16(o[4], o[5]); w.w = cvt_pk_bf16(o[6], o[7]);
                *(u32x4*)(O + (size_t)(row0 + ai * HALF + m * 16) * 6144 + col0) = w; }
    }
};
struct EpiMIn {
    static constexpr bool PERM = true, AFTER_DRAIN = false, PERM_A = false;
    bf16_t* O; int ldc; float* gates; bf16_t* QT;
    __device__ __forceinline__ void operator()(const f32x4 (&acc)[2][2][4][2], const Unit& u, int wr, int wc, int fr, int fq) const {
        const int row0 = u.pm * BM + wr * 64 + fr;
        if (u.pn < 8) {
#pragma unroll
            for (int ai = 0; ai < 2; ++ai)
#pragma unroll
                for (int m = 0; m < 4; ++m) { const int rb = (u.pm * BM + wr * 64 + ai * HALF + m * 16) >> 4;
#pragma unroll
                    for (int bj = 0; bj < 2; ++bj) { const f32x4 v0 = acc[ai][bj][m][0], v1 = acc[ai][bj][m][1];
                        u32x4 w; w.x = cvt_pk_bf16(v0[0], v0[1]); w.y = cvt_pk_bf16(v0[2], v0[3]); w.z = cvt_pk_bf16(v1[0], v1[1]); w.w = cvt_pk_bf16(v1[2], v1[3]);
                        *(u32x4*)(QT + ((size_t)rb * 64 + (u.pn * 8 + bj * 4 + wc)) * 512 + (fr + 16 * fq) * 8) = w; } }
        } else if (u.pn < 48) {
            const int col0 = u.pn * BM + wc * 32 + 8 * fq;
#pragma unroll
            for (int ai = 0; ai < 2; ++ai)
#pragma unroll
                for (int m = 0; m < 4; ++m) { bf16_t* rowp = O + (size_t)(row0 + ai * HALF + m * 16) * ldc + col0;
#pragma unroll
                    for (int bj = 0; bj < 2; ++bj) { const f32x4 v0 = acc[ai][bj][m][0], v1 = acc[ai][bj][m][1];
                        u32x4 w; w.x = cvt_pk_bf16(v0[0], v0[1]); w.y = cvt_pk_bf16(v0[2], v0[3]); w.z = cvt_pk_bf16(v1[0], v1[1]); w.w = cvt_pk_bf16(v1[2], v1[3]);
                        *(u32x4*)(rowp + bj * HALF) = w; } }
        } else if (wc == 0) {
#pragma unroll
            for (int ai = 0; ai < 2; ++ai)
#pragma unroll
                for (int m = 0; m < 4; ++m) { float* rowp = gates + (size_t)(row0 + ai * HALF + m * 16) * 32 + 8 * fq;
#pragma unroll
                    for (int n = 0; n < 2; ++n) *(f32x4*)(rowp + 4 * n) = acc[ai][0][m][n]; }
        }
    }
};

__device__ __forceinline__ float dpp_ror1(float v) { return __builtin_bit_cast(float, __builtin_amdgcn_update_dpp(0, __builtin_bit_cast(int, v), 0x121, 0xf, 0xf, false)); }
__device__ __forceinline__ float dpp_rol1(float v) { return __builtin_bit_cast(float, __builtin_amdgcn_update_dpp(0, __builtin_bit_cast(int, v), 0x12F, 0xf, 0xf, false)); }
template <bool NOLOAD = false, bool NOSTORE = false> struct EpiGateT {
    static constexpr bool PERM = true, AFTER_DRAIN = false, PERM_A = true;
    bf16_t* G; bf16_t* UC; const float* cw;
    __device__ __forceinline__ static float shr1(float v) { return __builtin_bit_cast(float, __builtin_amdgcn_update_dpp(0, __builtin_bit_cast(int, v), 0x111, 0xf, 0xf, true)); }
    __device__ __forceinline__ static float shl1(float v) { return __builtin_bit_cast(float, __builtin_amdgcn_update_dpp(0, __builtin_bit_cast(int, v), 0x101, 0xf, 0xf, true)); }
    __device__ __forceinline__ void operator()(const f32x4 (&acc)[2][2][4][2], const Unit& u, int wr, int wc, int fr, int fq) const {
        const int row0 = u.pm * BM + wr * 64 + 4 * fr;
        if (u.pm >= 64) {
            const int col0 = u.pn * BM + wc * 32 + 8 * fq;
#pragma unroll
            for (int ai = 0; ai < 2; ++ai)
#pragma unroll
                for (int m = 0; m < 4; ++m) { bf16_t* rowp = UC + (size_t)(row0 - 64 * BM + ai * HALF + m) * 22016 + col0;
#pragma unroll
                    for (int bj = 0; bj < 2; ++bj) { const f32x4 v0 = acc[ai][bj][m][0], v1 = acc[ai][bj][m][1];
                        u32x4 w; w.x = cvt_pk_bf16(v0[0], v0[1]); w.y = cvt_pk_bf16(v0[2], v0[3]); w.z = cvt_pk_bf16(v1[0], v1[1]); w.w = cvt_pk_bf16(v1[2], v1[3]);
                        *(u32x4*)(rowp + bj * HALF) = w; } }
            return;
        }
        const int ch = u.pn * 128 + wc * 32 + 8 * fq;
        typedef unsigned u32x2 __attribute__((ext_vector_type(2)));
        u32x2 pw[2][4];
#pragma unroll
        for (int n = 0; n < 2; ++n) {
            f32x4 wg[3], wv[3];
#pragma unroll
            for (int k = 0; k < 3; ++k) { if (NOLOAD) { wg[k] = (f32x4){0.3f, 0.4f, 0.5f, 0.6f}; wv[k] = (f32x4){0.6f, 0.5f, 0.4f, 0.3f}; } else { wg[k] = *(const f32x4*)(cw + k * 22016 + ch + 4 * n); wv[k] = *(const f32x4*)(cw + k * 22016 + 11008 + ch + 4 * n); } }
#pragma unroll
            for (int ai = 0; ai < 2; ++ai) {
                float o[4][4];
                typedef float f32x2_ __attribute__((ext_vector_type(2)));
#pragma unroll
                for (int jp = 0; jp < 4; jp += 2) {
                    float gg[4][2], vv[4][2];
#pragma unroll
                    for (int jj = 0; jj < 2; ++jj) { const int j = jp + jj;
                        const float gp = shr1(acc[ai][0][3][n][j]), gn = shl1(acc[ai][0][0][n][j]), vp = shr1(acc[ai][1][3][n][j]), vn = shl1(acc[ai][1][0][n][j]);
#pragma unroll
                        for (int m = 0; m < 4; ++m) {
                            const float gL = m > 0 ? acc[ai][0][m - 1][n][j] : gp, gR = m < 3 ? acc[ai][0][m + 1][n][j] : gn;
                            const float vL = m > 0 ? acc[ai][1][m - 1][n][j] : vp, vR = m < 3 ? acc[ai][1][m + 1][n][j] : vn;
                            gg[m][jj] = wg[0][j] * gL + wg[1][j] * acc[ai][0][m][n][j] + wg[2][j] * gR;
                            vv[m][jj] = wv[0][j] * vL + wv[1][j] * acc[ai][1][m][n][j] + wv[2][j] * vR; } }
#pragma unroll
                    for (int m = 0; m < 4; ++m) { const f32x2_ G = {gg[m][0], gg[m][1]}, V = {vv[m][0], vv[m][1]};
                        const f32x2_ t = G * -1.44269504088896341f;
                        const f32x2_ d = (f32x2_){__builtin_amdgcn_exp2f(t.x), __builtin_amdgcn_exp2f(t.y)} + 1.0f;
                        const f32x2_ r = {__builtin_amdgcn_rcpf(d.x), __builtin_amdgcn_rcpf(d.y)};
                        const f32x2_ oo = (G * r) * V;
                        o[m][jp] = oo.x; o[m][jp + 1] = oo.y; }
                }
#pragma unroll
                for (int m = 0; m < 4; ++m) { u32x2 w; w.x = cvt_pk_bf16(o[m][0], o[m][1]); w.y = cvt_pk_bf16(o[m][2], o[m][3]);
                    if (n == 0) pw[ai][m] = w;
                    else { u32x4 w4; w4.x = pw[ai][m].x; w4.y = pw[ai][m].y; w4.z = w.x; w4.w = w.y;
                        if (NOSTORE) asm volatile("" :: "v"(w4)); else *(u32x4*)(G + (size_t)(row0 + ai * HALF + m) * 11008 + ch) = w4; } }
                __builtin_amdgcn_sched_barrier(0);
            }
        }
    }
};
typedef EpiGateT<false, false> EpiGate;

template <class Epi, class Sched, bool ALIGN_EPI = false, bool SP2 = false>
__device__ __forceinline__ void gemm_phase(PG8_LAS unsigned char* lds, const Gemm g, const Sched& S, const Epi& E, const int tid) {
    const int wid = __builtin_amdgcn_readfirstlane(tid >> 6), lane = tid & 63, wr = wid >> 2, wc = wid & 3, fr = lane & 15, fq = lane >> 4;
    const int K = g.K, nt = K / BK;
    unsigned voffA[2], voffB[2];
#pragma unroll
    for (int i = 0; i < 2; ++i) { int R, C; stage_rc(tid * 16 + i * 8192, R, C); const int Rb = Epi::PERM ? ((R & ~31) + perm32(R & 31)) : R;
        const int Ra = Epi::PERM_A ? ((R & ~63) + 4 * (R & 15) + ((R >> 4) & 3)) : R;
        voffA[i] = (unsigned)(Ra * K + C) * 2u; voffB[i] = (unsigned)(Rb * K + C) * 2u; }
    const size_t kstep = (size_t)(BK * 2);
    const size_t hstep = (size_t)HALF * K * 2;
    const size_t tstep = 2 * hstep;
    const unsigned ldsw = (unsigned)wid * 1024u;
    const int aoff = lds_byte(wr * 64 + fr, fq * 8), boff = lds_byte(wc * 32 + fr, fq * 8);
#define PG8_SA(b, h) (((b) * 2 + (h)) * HTB)
#define PG8_SB(b, h) ((4 + (b) * 2 + (h)) * HTB)
#define PG8_STAGE(bufoff, gbase, voff) do { _Pragma("unroll") for (int _i = 0; _i < 2; ++_i) \
        __builtin_amdgcn_global_load_lds((const unsigned*)((const char*)(gbase) + (voff)[_i]), (PG8_LAS unsigned*)(lds + (bufoff) + ldsw + _i * 8192), 16, 0, 0); } while (0)
#define PG8_LDA(dst, b, h) do { _Pragma("unroll") for (int m = 0; m < 4; ++m) _Pragma("unroll") for (int k = 0; k < 2; ++k) dst[m][k] = *(const PG8_LAS bf16x8*)(lds + PG8_SA(b, h) + aoff + m * 2048 + k * 1024); } while (0)
#define PG8_LDB(dst, b, h) do { _Pragma("unroll") for (int n = 0; n < 2; ++n) _Pragma("unroll") for (int k = 0; k < 2; ++k) dst[n][k] = *(const PG8_LAS bf16x8*)(lds + PG8_SB(b, h) + boff + n * 2048 + k * 1024); } while (0)
#define PG8_MMA(ai, bj, At, Bt) do { __builtin_amdgcn_s_setprio(1); _Pragma("unroll") for (int m = 0; m < 4; ++m) _Pragma("unroll") for (int n = 0; n < 2; ++n) _Pragma("unroll") for (int k = 0; k < 2; ++k) \
        acc[ai][bj][m][n] = __builtin_amdgcn_mfma_f32_16x16x32_bf16(Bt[n][k], At[m][k], acc[ai][bj][m][n], 0, 0, 0); __builtin_amdgcn_s_setprio(0); } while (0)
#define PG8_WAIT_V(n) asm volatile("s_waitcnt vmcnt(" #n ")" ::: "memory")
#define PG8_WAIT_L(n) asm volatile("s_waitcnt lgkmcnt(" #n ")" ::: "memory")
#define PG8_BAR __builtin_amdgcn_s_barrier()
#define PG8_SCHED __builtin_amdgcn_sched_barrier(0)
    Unit cur, nxt; int ui = 0;
    if (!S.next(0, cur)) return;
    f32x4 acc[2][2][4][2];
#pragma unroll
    for (int a = 0; a < 2; ++a)
#pragma unroll
        for (int b = 0; b < 2; ++b)
#pragma unroll
            for (int m = 0; m < 4; ++m)
#pragma unroll
                for (int n = 0; n < 2; ++n) acc[a][b][m][n] = (f32x4){0.f, 0.f, 0.f, 0.f};
    bf16x8 At[4][2], B0[2][2], B1[2][2];
    const char* cA = (const char*)g.A + (size_t)cur.pm * tstep; const char* cB = (const char*)g.Bt + (size_t)cur.pn * tstep;
    S.a_ready(cur);
    if constexpr (SP2) {
        PG8_STAGE(PG8_SB(0, 0), cB, voffB); PG8_STAGE(PG8_SB(0, 1), cB + hstep, voffB); PG8_STAGE(PG8_SA(0, 0), cA, voffA); PG8_STAGE(PG8_SA(0, 1), cA + hstep, voffA);
        if (wr == 1) PG8_BAR;
        PG8_WAIT_V(2); PG8_BAR;
        PG8_STAGE(PG8_SB(1, 0), cB + kstep, voffB); PG8_STAGE(PG8_SA(1, 0), cA + kstep, voffA); PG8_STAGE(PG8_SB(1, 1), cB + hstep + kstep, voffB);
        PG8_WAIT_V(6); PG8_BAR;
    } else {
        PG8_STAGE(PG8_SB(0, 0), cB, voffB); PG8_STAGE(PG8_SA(0, 0), cA, voffA); PG8_STAGE(PG8_SB(0, 1), cB + hstep, voffB); PG8_STAGE(PG8_SA(0, 1), cA + hstep, voffA);
        if (wr == 1) PG8_BAR;
        PG8_WAIT_V(4); PG8_BAR;
        PG8_STAGE(PG8_SB(1, 0), cB + kstep, voffB); PG8_STAGE(PG8_SA(1, 0), cA + kstep, voffA); PG8_STAGE(PG8_SB(1, 1), cB + hstep + kstep, voffB);
        PG8_WAIT_V(6); PG8_BAR;
    }
    for (;;) {
        const bool has_next = S.next(ui + 1, nxt);
        const char* nA = has_next ? (const char*)g.A + (size_t)nxt.pm * tstep : cA; const char* nB = has_next ? (const char*)g.Bt + (size_t)nxt.pn * tstep : cB;
        for (int t = 0; t < nt; t += 2) {
            const bool last = (t == nt - 2);
            const char* a1 = cA + (size_t)(t + 1) * kstep;
            const char* a2 = last ? nA : cA + (size_t)(t + 2) * kstep; const char* b2 = last ? nB : cB + (size_t)(t + 2) * kstep;
            const char* a3 = a2 + kstep; const char* b3 = b2 + kstep;
            if (last && has_next) S.a_ready(nxt);
            if constexpr (SP2) {
            PG8_LDB(B0, 0, 0); PG8_LDB(B1, 0, 1); PG8_SCHED; PG8_LDA(At, 0, 0); PG8_STAGE(PG8_SA(1, 1), a1 + hstep, voffA);
            PG8_WAIT_V(8); PG8_WAIT_L(0); PG8_BAR; PG8_MMA(0, 0, At, B0); PG8_MMA(0, 1, At, B1); PG8_BAR; PG8_SCHED;
            PG8_LDA(At, 0, 1); PG8_STAGE(PG8_SB(0, 0), b2, voffB); PG8_STAGE(PG8_SB(0, 1), b2 + hstep, voffB); PG8_STAGE(PG8_SA(0, 0), a2, voffA);
            PG8_WAIT_V(8); PG8_WAIT_L(0); PG8_BAR; PG8_MMA(1, 0, At, B0); PG8_MMA(1, 1, At, B1); PG8_BAR; PG8_SCHED;
            PG8_LDB(B0, 1, 0); PG8_LDB(B1, 1, 1); PG8_SCHED; PG8_LDA(At, 1, 0); PG8_STAGE(PG8_SA(0, 1), a2 + hstep, voffA);
            PG8_WAIT_V(8); PG8_WAIT_L(0); PG8_BAR; PG8_MMA(0, 0, At, B0); PG8_MMA(0, 1, At, B1); PG8_BAR; PG8_SCHED;
            PG8_LDA(At, 1, 1); PG8_STAGE(PG8_SB(1, 0), b3, voffB); PG8_STAGE(PG8_SB(1, 1), b3 + hstep, voffB); PG8_STAGE(PG8_SA(1, 0), a3, voffA);
            PG8_WAIT_V(8); PG8_WAIT_L(0); PG8_BAR; PG8_MMA(1, 0, At, B0); PG8_MMA(1, 1, At, B1); PG8_BAR; PG8_SCHED;
            } else {
            PG8_LDB(B0, 0, 0); PG8_SCHED; PG8_LDA(At, 0, 0); PG8_STAGE(PG8_SA(1, 1), a1 + hstep, voffA);
            PG8_WAIT_L(8); PG8_BAR; PG8_WAIT_L(0); PG8_MMA(0, 0, At, B0); PG8_BAR; PG8_SCHED;
            PG8_LDB(B1, 0, 1); PG8_STAGE(PG8_SB(0, 0), b2, voffB);
            PG8_BAR; PG8_WAIT_L(0); PG8_MMA(0, 1, At, B1); PG8_BAR;
            PG8_LDA(At, 0, 1); PG8_STAGE(PG8_SA(0, 0), a2, voffA);
            PG8_BAR; PG8_WAIT_L(0); PG8_MMA(1, 0, At, B0); PG8_BAR; PG8_SCHED;
            PG8_STAGE(PG8_SB(0, 1), b2 + hstep, voffB);
            PG8_WAIT_V(6); PG8_BAR; PG8_MMA(1, 1, At, B1); PG8_BAR;
            PG8_LDB(B0, 1, 0); PG8_SCHED; PG8_LDA(At, 1, 0); PG8_STAGE(PG8_SA(0, 1), a2 + hstep, voffA);
            PG8_WAIT_L(8); PG8_BAR; PG8_WAIT_L(0); PG8_MMA(0, 0, At, B0); PG8_BAR; PG8_SCHED;
            PG8_LDB(B1, 1, 1); PG8_STAGE(PG8_SB(1, 0), b3, voffB);
            PG8_BAR; PG8_WAIT_L(0); PG8_MMA(0, 1, At, B1); PG8_BAR;
            PG8_LDA(At, 1, 1); PG8_STAGE(PG8_SA(1, 0), a3, voffA);
            PG8_BAR; PG8_WAIT_L(0); PG8_MMA(1, 0, At, B0); PG8_BAR; PG8_SCHED;
            PG8_STAGE(PG8_SB(1, 1), b3 + hstep, voffB);
            PG8_WAIT_V(6); PG8_BAR; PG8_MMA(1, 1, At, B1); PG8_BAR;
            }
        }
        if constexpr (ALIGN_EPI) { if (wr == 0) PG8_BAR; }
        if constexpr (!Epi::AFTER_DRAIN) { E(acc, cur, wr, wc, fr, fq); S.done(cur); }
        if (!has_next) break;
#pragma unroll
        for (int a = 0; a < 2; ++a)
#pragma unroll
            for (int b = 0; b < 2; ++b)
#pragma unroll
                for (int m = 0; m < 4; ++m)
#pragma unroll
                    for (int n = 0; n < 2; ++n) acc[a][b][m][n] = (f32x4){0.f, 0.f, 0.f, 0.f};
        cur = nxt; cA = nA; cB = nB; ++ui;
        if constexpr (ALIGN_EPI) { if (wr == 1) PG8_BAR; }
    }
    PG8_WAIT_V(0);
    if constexpr (!ALIGN_EPI) { if (wr == 0) PG8_BAR; }
    PG8_BAR;
#undef PG8_SA
#undef PG8_SB
#undef PG8_STAGE
#undef PG8_LDA
#undef PG8_LDB
#undef PG8_MMA
#undef PG8_WAIT_V
#undef PG8_WAIT_L
#undef PG8_BAR
#undef PG8_SCHED
}
}

constexpr int NWAVES = 8, NTHREADS = 512;
constexpr int D = 4096, BATCH = 2, SEQ = 8192, CTXL = 256;
constexpr int ML = BATCH * SEQ;
constexpr int MC = BATCH * CTXL;
constexpr int MT = ML + MC;
constexpr int NMODC = 6 * D;
constexpr int WA = 2048, ABIN = 10240, ABU = 6144, ACONV = 31;
constexpr int HEADS = 8, DQK = 256, DV = 512;
constexpr int QKVO = 12288, CIN = 12320, CINP = 12544;
constexpr int DFF = 11008, DFF2 = 22016;
constexpr int NCH = 66;
constexpr float EPS = 1e-6f;

constexpr size_t MiB = 1u << 20;
constexpr size_t WS_CTL = 0, CTL_ZERO_BYTES = 1 * MiB;
constexpr size_t WS_MOD = 1 * MiB;
constexpr size_t WS_SCP = 2 * MiB;
constexpr size_t WS_SCC = 7 * MiB;
constexpr size_t WS_GATES = 8 * MiB;
constexpr size_t WS_CTXS = 12 * MiB;
constexpr size_t WS_WABIN = 20 * MiB;
constexpr size_t WS_WABOUT = 100 * MiB;
constexpr size_t WS_WMIN = 132 * MiB;
constexpr size_t WS_WMOUT = 230 * MiB;
constexpr size_t WS_WUP0 = 262 * MiB;
constexpr size_t WS_WDN0 = 606 * MiB;
constexpr size_t WS_H = 778 * MiB;
constexpr size_t WS_U = 910 * MiB;
constexpr size_t WS_UC = 1590 * MiB;
constexpr size_t WS_G = 1620 * MiB;
constexpr size_t WS_Y = 1975 * MiB;
constexpr size_t WS_HS = 2239 * MiB;
constexpr size_t WS_XB = 2751 * MiB;
constexpr size_t WS_END = 2883 * MiB;
static_assert(WS_WUP0 + 2 * 172 * MiB == WS_WDN0 && WS_WDN0 + 2 * 86 * MiB <= WS_H, "ws map");
static_assert((size_t)DFF2 * D * 2 <= 172 * MiB && (size_t)D * DFF * 2 <= 86 * MiB && (size_t)CINP * D * 2 <= 98 * MiB, "ws map");
static_assert(WS_H + (size_t)MT * D * 2 <= WS_U && WS_U + (size_t)MT * DFF2 * 2 <= WS_G && WS_G + (size_t)MT * DFF * 2 <= WS_Y && WS_Y + (size_t)MT * D * 4 <= WS_HS && WS_HS + (size_t)2 * ML * D * 4 <= WS_XB && WS_XB + (size_t)MT * D * 2 <= WS_END, "ws map");
static_assert(WS_SCP + (size_t)32 * NCH * 3 * 128 * 4 <= WS_SCC && WS_GATES + (size_t)MT * 32 * 4 <= WS_CTXS && WS_CTXS + (size_t)MC * D * 4 <= WS_WABIN, "ws map");

constexpr int CW_BAR = 4096;
constexpr int LDS_BYTES = 163840;
constexpr int MISC_OFF = LDS_BYTES - 64;

#define LAS __attribute__((address_space(3)))
typedef unsigned short bf16;
typedef unsigned v4u __attribute__((ext_vector_type(4)));
typedef unsigned v2u __attribute__((ext_vector_type(2)));
typedef float f32x4 __attribute__((ext_vector_type(4)));
typedef float f32x2 __attribute__((ext_vector_type(2)));
typedef short bf16x8 __attribute__((ext_vector_type(8)));
typedef short s16x4 __attribute__((ext_vector_type(4)));
#define LDS_WAIT() asm volatile("s_waitcnt lgkmcnt(0)" ::: "memory")

__device__ __forceinline__ unsigned f2bf(float f) { unsigned u = __builtin_bit_cast(unsigned, f); return (u + 0x7fffu + ((u >> 16) & 1u)) >> 16; }
__device__ __forceinline__ unsigned pk2(float lo, float hi) { unsigned r; asm("v_cvt_pk_bf16_f32 %0, %1, %2" : "=v"(r) : "v"(lo), "v"(hi)); return r; }
__device__ __forceinline__ float bflo(unsigned w) { return __builtin_bit_cast(float, w << 16); }
__device__ __forceinline__ float bfhi(unsigned w) { return __builtin_bit_cast(float, w & 0xffff0000u); }
__device__ __forceinline__ float bf1(unsigned short h) { return __builtin_bit_cast(float, ((unsigned)h) << 16); }
__device__ __forceinline__ void cvt8(const v4u r, float (&f)[8]) {
    f[0] = bflo(r.x); f[1] = bfhi(r.x); f[2] = bflo(r.y); f[3] = bfhi(r.y); f[4] = bflo(r.z); f[5] = bfhi(r.z); f[6] = bflo(r.w); f[7] = bfhi(r.w);
}
__device__ __forceinline__ float sigmoidf_(float x) { return __builtin_amdgcn_rcpf(1.0f + __expf(-x)); }
__device__ __forceinline__ float siluf_(float x) { return x * sigmoidf_(x); }
__device__ __forceinline__ float wave_sum(float v) {
#pragma unroll
    for (int o = 1; o < 64; o <<= 1) v += __shfl_xor(v, o);
    return v;
}

#define XB_TMO      128
#define XB_XCNT(j)  (256  + 64 * (j))
#define XB_XSUB(j)  (1280 + 64 * (j))
#define XB_XGEN(j)  (2304 + 64 * (j))
#define XB_TOP      3328
#define XB_TOPGEN   3392
#define XCD_BAR_WORDS 3456
#define XB_SPIN_CAP (1u << 22)

__device__ __forceinline__ unsigned xb_ld(unsigned* p)              { return __hip_atomic_load(p, __ATOMIC_RELAXED, __HIP_MEMORY_SCOPE_AGENT); }
__device__ __forceinline__ unsigned xb_add(unsigned* p, unsigned v) { return __hip_atomic_fetch_add(p, v, __ATOMIC_RELAXED, __HIP_MEMORY_SCOPE_AGENT); }
__device__ __forceinline__ unsigned xb_xcc_id() { return (unsigned)__builtin_amdgcn_s_getreg((3 << 11) | 20) & 0xFu; }
#define XB_SPIN(cond, bar) do { unsigned _sp = 0; while (cond) { __builtin_amdgcn_s_sleep(1); \
    if ((++_sp & 255u) == 0u) { if (xb_ld(&(bar)[XB_TMO])) break; if (_sp > XB_SPIN_CAP) { atomicAdd(&(bar)[XB_TMO], 1u); break; } } } } while (0)

struct XcdBarrier { unsigned* bar; unsigned x; volatile LAS unsigned* st; };

__device__ __forceinline__ XcdBarrier xcd_barrier_post(unsigned* bar, volatile LAS unsigned* st) {
    XcdBarrier b; b.bar = bar; b.x = xb_xcc_id(); b.st = st;
    if (threadIdx.x == 0) (void)xb_add(&bar[XB_XCNT(b.x)], 1u);
    return b;
}
__device__ __forceinline__ void xcd_barrier_complete(unsigned* bar, unsigned x, unsigned& nloc, unsigned& nx) {
    const unsigned G = gridDim.x * gridDim.y * gridDim.z;
    unsigned sum, cnt, mine, sp = 0u;
    for (;;) {
        sum = 0u; cnt = 0u; mine = 0u;
#pragma unroll
        for (unsigned j = 0; j < 16; ++j) { const unsigned c = xb_ld(&bar[XB_XCNT(j)]); sum += c; cnt += (c > 0u) ? 1u : 0u; mine = (j == x) ? c : mine; }
        if (sum == G) break;
        __builtin_amdgcn_s_sleep(1);
        if ((++sp & 255u) == 0u) { if (xb_ld(&bar[XB_TMO])) break; if (sp > XB_SPIN_CAP) { atomicAdd(&bar[XB_TMO], 1u); break; } }
    }
    nloc = mine > 0u ? mine : 1u; nx = cnt > 0u ? cnt : 1u;
}
__device__ __forceinline__ void xcd_barrier(const XcdBarrier& b) {
    asm volatile("s_waitcnt vmcnt(0)" ::: "memory");
    __syncthreads();
    if (threadIdx.x == 0) {
        unsigned* bar = b.bar;
        __builtin_amdgcn_s_waitcnt(0);
        unsigned nloc = b.st[0], nx = b.st[1];
        if (nloc == 0u) { xcd_barrier_complete(bar, b.x, nloc, nx); b.st[0] = nloc; b.st[1] = nx; }
        const unsigned old = xb_add(&bar[XB_XSUB(b.x)], 1u);
        const unsigned gen = old / nloc;
        if (old + 1u == (gen + 1u) * nloc) {
            __builtin_amdgcn_fence(__ATOMIC_RELEASE, "agent");
            asm volatile("s_waitcnt vmcnt(0)" ::: "memory");
            const unsigned og = xb_add(&bar[XB_TOP], 1u);
            const unsigned tg = og / nx;
            if (og + 1u == (tg + 1u) * nx) xb_add(&bar[XB_TOPGEN], 1u);
            else XB_SPIN(xb_ld(&bar[XB_TOPGEN]) == tg, bar);
            __builtin_amdgcn_fence(__ATOMIC_ACQUIRE, "agent");
            xb_add(&bar[XB_XGEN(b.x)], 1u);
            asm volatile("s_waitcnt vmcnt(0)" ::: "memory");
        } else {
            XB_SPIN(xb_ld(&bar[XB_XGEN(b.x)]) == gen, bar);
            __builtin_amdgcn_fence(__ATOMIC_ACQUIRE, "agent");
            asm volatile("s_waitcnt vmcnt(0)" ::: "memory");
        }
    }
    __syncthreads();
}

struct Args { const float* in[21]; float* out; unsigned char* ws; int ph_lo, ph_hi; };
typedef const __attribute__((address_space(4))) Args* CArgs;
__device__ __forceinline__ int opaque_tid(int wave_s) { int t = wave_s * 64 + (int)__builtin_amdgcn_mbcnt_hi(~0u, __builtin_amdgcn_mbcnt_lo(~0u, 0u)); asm volatile("" : "+v"(t)); return t; }
__device__ __forceinline__ CArgs get_args() { CArgs p = (CArgs)__builtin_amdgcn_kernarg_segment_ptr(); asm volatile("" : "+s"(p)); return p; }
enum { I_X = 0, I_C, I_CTX, I_CCTX, I_ADAW, I_ADAB, I_NORMG, I_ABWIN, I_ACONVW, I_ACONVB, I_ALNG, I_ALNB, I_BCONVW, I_ABWOUT, I_MWIN, I_MBG, I_MHNG, I_MWOUT, I_FUP, I_FCONV, I_FDN };

template <int MODE> __device__ __forceinline__ int perm_row(int n0) {
    if (MODE == 1) return n0 < DFF ? 256 * (n0 / 128) + (n0 % 128) : 256 * ((n0 - DFF) / 128) + 128 + ((n0 - DFF) % 128);
    if (MODE == 2) { if (n0 < 4096) { const int ch = n0 & 2047, hi = n0 >> 11; return 256 * (ch / 128) + 128 * hi + (ch % 128); }
                     if (n0 < 6144) return n0;
                     const int j = n0 - 6144, ch = j & 2047, hi = j >> 11; return 6144 + 256 * (ch / 128) + 128 * hi + (ch % 128); }
    return n0;
}
template <int GATE_PERM = 0>
__device__ __forceinline__ void p0_transpose_item(const float* W, int K, int N, bf16* WT, LAS float* scr, int item, int lane) {
    const int nblk = N / 32, kb = item / nblk, nb = item % nblk, k0 = 64 * kb, n0 = 32 * nb;
    const int r0 = perm_row<GATE_PERM>(n0);
#pragma unroll 8
    for (int i = 0; i < 32; ++i) { const int kk = 2 * i + (lane >> 5); scr[kk * 33 + (lane & 31)] = W[(size_t)(k0 + kk) * N + n0 + (lane & 31)]; }
    LDS_WAIT(); asm volatile("" ::: "memory");
    const int c = lane & 7;
#pragma unroll
    for (int j = 0; j < 4; ++j) { const int n = (lane >> 3) + 8 * j; const LAS float* s = scr + (8 * c) * 33 + n;
        v4u o; o.x = pk2(s[0 * 33], s[1 * 33]); o.y = pk2(s[2 * 33], s[3 * 33]); o.z = pk2(s[4 * 33], s[5 * 33]); o.w = pk2(s[6 * 33], s[7 * 33]);
        __builtin_nontemporal_store(o, (v4u*)(WT + (size_t)(r0 + n) * K + k0 + 8 * c)); }
    LDS_WAIT(); asm volatile("" ::: "memory");
}

__device__ __forceinline__ void gemv_units(CArgs a, LAS unsigned char* lds, int layer, int first, int stride, int tid, int lane, int wave) {
    float* MOD = (float*)(a->ws + WS_MOD);
    LAS float* sv = (LAS float*)lds;
    LAS float* red = (LAS float*)(lds + 49152);
    for (int i = tid; i < 3 * D; i += NTHREADS) { const int r = i / D, k = i % D; const float v = (r < 2) ? a->in[I_C][r * D + k] : a->in[I_CCTX][k]; sv[i] = siluf_(v); }
    __syncthreads();
    for (int unit = first; unit < 768; unit += stride) {
        const int n0 = unit * 32;
        const int kg = wave * 8 + (lane >> 3), c4 = (lane & 7) * 4;
        const float* W = a->in[I_ADAW] + (size_t)layer * D * NMODC + (size_t)(kg * 64) * NMODC + n0 + c4;
        f32x4 a0 = {0.f, 0.f, 0.f, 0.f}, a1 = a0, a2 = a0;
        for (int k = 0; k < 64; k += 16) {
            f32x4 w[16];
#pragma unroll
            for (int j = 0; j < 16; ++j) w[j] = __builtin_nontemporal_load((const f32x4*)(W + (size_t)(k + j) * NMODC));
#pragma unroll
            for (int j = 0; j < 16; ++j) { const int kk = kg * 64 + k + j; a0 += w[j] * sv[kk]; a1 += w[j] * sv[D + kk]; a2 += w[j] * sv[2 * D + kk]; }
        }
        *(LAS f32x4*)(red + (kg * 3 + 0) * 32 + c4) = a0; *(LAS f32x4*)(red + (kg * 3 + 1) * 32 + c4) = a1; *(LAS f32x4*)(red + (kg * 3 + 2) * 32 + c4) = a2;
        __syncthreads();
        if (tid < 96) { const int r = tid >> 5, cc = tid & 31; float s = 0.f;
#pragma unroll 8
            for (int g = 0; g < 64; ++g) s += red[(g * 3 + r) * 32 + cc];
            MOD[((size_t)layer * 3 + r) * NMODC + n0 + cc] = s + a->in[I_ADAB][(size_t)layer * NMODC + n0 + cc]; }
        __syncthreads();
    }
}
template <int GATE_PERM>
__device__ __forceinline__ void transpose_item64(const float* W, int K, int N, bf16* WT, LAS float* scr, int item, int lane, int nblk) {
    const int kb = item / nblk, nb = item % nblk, k0 = 64 * kb, n0 = 64 * nb;
    const int r0 = perm_row<GATE_PERM>(n0);
    const int kq = lane >> 4, j4 = (lane & 15) * 4;
    f32x4 v[16];
#pragma unroll
    for (int i = 0; i < 16; ++i) v[i] = __builtin_nontemporal_load((const f32x4*)(W + (size_t)(k0 + 4 * i + kq) * N + n0 + j4));
#pragma unroll
    for (int i = 0; i < 16; ++i) { LAS float* p = scr + (4 * i + kq) * 65 + j4; p[0] = v[i].x; p[1] = v[i].y; p[2] = v[i].z; p[3] = v[i].w; }
    LDS_WAIT(); asm volatile("" ::: "memory");
    const int c = lane & 7;
#pragma unroll
    for (int j = 0; j < 8; ++j) { const int n = (lane >> 3) + 8 * j; const LAS float* p = scr + (8 * c) * 65 + n;
        v4u o; o.x = pk2(p[0 * 65], p[1 * 65]); o.y = pk2(p[2 * 65], p[3 * 65]); o.z = pk2(p[4 * 65], p[5 * 65]); o.w = pk2(p[6 * 65], p[7 * 65]);
        __builtin_nontemporal_store(o, (v4u*)(WT + (size_t)(r0 + n) * K + k0 + 8 * c)); }
    LDS_WAIT(); asm volatile("" ::: "memory");
}
template <int GATE_PERM>
__device__ __forceinline__ void conv_items(const float* W, int K, int N, bf16* WT, LAS unsigned char* lds, int first, int stride, int lane, int wave) {
    LAS float* scr = (LAS float*)(lds + wave * 16640);
    const int nb64 = N / 64, nitems = (K / 64) * nb64;
    for (int it = first; it < nitems; it += stride) transpose_item64<GATE_PERM>(W, K, N, WT, scr, it, lane, nb64);
    if (N % 64) for (int kb = first; kb < K / 64; kb += stride) p0_transpose_item<GATE_PERM>(W, K, N, WT, scr, kb * (N / 32) + (N / 32 - 1), lane);
}
enum { CV_ABIN = 0, CV_ABOUT, CV_MIN, CV_MOUT, CV_UP0, CV_UP1, CV_DN0, CV_DN1 };
template <int WHICH>
__device__ __forceinline__ void conv_matrix(CArgs a, LAS unsigned char* lds, int first, int stride, int lane, int wave) {
    unsigned char* ws = a->ws;
    if (WHICH == CV_ABIN) conv_items<2>(a->in[I_ABWIN], D, ABIN, (bf16*)(ws + WS_WABIN), lds, first, stride, lane, wave);
    if (WHICH == CV_ABOUT) conv_items<0>(a->in[I_ABWOUT], D, D, (bf16*)(ws + WS_WABOUT), lds, first, stride, lane, wave);
    if (WHICH == CV_MIN) { conv_items<0>(a->in[I_MWIN], D, CIN, (bf16*)(ws + WS_WMIN), lds, first, stride, lane, wave);
        v4u* p = (v4u*)((bf16*)(ws + WS_WMIN) + (size_t)CIN * D); const int n16 = (CINP - CIN) * D * 2 / 16;
        for (int i = first * 64 + lane; i < n16; i += stride * 64) p[i] = (v4u){0u, 0u, 0u, 0u}; }
    if (WHICH == CV_MOUT) conv_items<0>(a->in[I_MWOUT], D, D, (bf16*)(ws + WS_WMOUT), lds, first, stride, lane, wave);
    if (WHICH == CV_UP0) conv_items<1>(a->in[I_FUP], D, DFF2, (bf16*)(ws + WS_WUP0), lds, first, stride, lane, wave);
    if (WHICH == CV_UP1) conv_items<1>(a->in[I_FUP] + (size_t)D * DFF2, D, DFF2, (bf16*)(ws + WS_WUP0 + 172 * MiB), lds, first, stride, lane, wave);
    if (WHICH == CV_DN0) conv_items<0>(a->in[I_FDN], DFF, D, (bf16*)(ws + WS_WDN0), lds, first, stride, lane, wave);
    if (WHICH == CV_DN1) conv_items<0>(a->in[I_FDN] + (size_t)DFF * D, DFF, D, (bf16*)(ws + WS_WDN0 + 86 * MiB), lds, first, stride, lane, wave);
}
__device__ __forceinline__ void p0_prologue(CArgs a, LAS unsigned char* lds, int tid, int lane, int wave) {
    gemv_units(a, lds, 0, blockIdx.x, gridDim.x, tid, lane, wave);
    const int gw = blockIdx.x * NWAVES + wave, NGW = gridDim.x * NWAVES;
    conv_matrix<CV_ABIN>(a, lds, gw, NGW, lane, wave);
#if PROBE_E1
    conv_matrix<CV_ABOUT>(a, lds, gw, NGW, lane, wave);
    conv_matrix<CV_UP0>(a, lds, gw, NGW, lane, wave); conv_matrix<CV_DN0>(a, lds, gw, NGW, lane, wave); conv_matrix<CV_MIN>(a, lds, gw, NGW, lane, wave); conv_matrix<CV_MOUT>(a, lds, gw, NGW, lane, wave);
    conv_matrix<CV_UP1>(a, lds, gw, NGW, lane, wave); conv_matrix<CV_DN1>(a, lds, gw, NGW, lane, wave); __syncthreads(); gemv_units(a, lds, 1, blockIdx.x, gridDim.x, tid, lane, wave);
#endif
}
__device__ __forceinline__ int gemm_wgs(int nwg) { const int G = gridDim.x, rounds = (nwg + G - 1) / G; const int g = ((nwg + rounds - 1) / rounds + 7) & ~7; return g < G ? g : G; }

template <bool RES, bool DOH, bool XIN_BF, bool XOUT_BF>
__device__ __forceinline__ void row_phase(LAS unsigned char* lds, int nrows, const void* xin_lat, const void* xin_ctx, void* xout_lat, void* xout_ctx,
                                          const bf16* Y, const float* gpost, const float* modres, int gate_idx,
                                          const float* gpre, const float* modh, int shift_idx, int scale_idx, bf16* H, int tid, int lane, int wave) {
    LAS f32x4* pG = (LAS f32x4*)lds; LAS f32x4* pA = pG + 1024; LAS f32x4* pB = pA + 1024;
    const int G = gridDim.x, rpw = (nrows + G - 1) / G, r0 = (int)blockIdx.x * rpw, r1 = (r0 + rpw < nrows) ? r0 + rpw : nrows;
    for (int vb = r0; vb < r1;) {
        const int mr = vb < ML ? (vb >> 13) : 2;
        const int lim = mr == 0 ? SEQ : (mr == 1 ? ML : nrows), vend = r1 < lim ? r1 : lim;
        __syncthreads();
        for (int i = tid; i < 1024; i += NTHREADS) {
            if (RES) pG[i] = ((const f32x4*)(modres + (size_t)mr * NMODC + gate_idx * D))[i] * ((const f32x4*)gpost)[i];
            if (DOH) { pA[i] = ((const f32x4*)gpre)[i] * (((const f32x4*)(modh + (size_t)mr * NMODC + scale_idx * D))[i] + 1.0f); pB[i] = ((const f32x4*)(modh + (size_t)mr * NMODC + shift_idx * D))[i]; }
        }
        __syncthreads();
        for (int row = vb + wave; row < vend; row += NWAVES) {
            const float* xr = XIN_BF ? nullptr : (row < ML ? (const float*)xin_lat + (size_t)row * D : (const float*)xin_ctx + (size_t)(row - ML) * D);
            const bf16* xrb = XIN_BF ? (const bf16*)xin_lat + (size_t)row * D : nullptr;
            f32x4 v[16];
            if (RES) {
                const bf16* yr = Y + (size_t)row * D; float s = 0.f;
#pragma unroll
                for (int j = 0; j < 16; ++j) { const v2u yw = *(const v2u*)(yr + j * 256 + lane * 4); v[j] = (f32x4){bflo(yw.x), bfhi(yw.x), bflo(yw.y), bfhi(yw.y)}; s += (v[j].x * v[j].x + v[j].y * v[j].y) + (v[j].z * v[j].z + v[j].w * v[j].w); }
                const float rstd = 1.0f / sqrtf(wave_sum(s) * (1.0f / D) + EPS);
                float* xo = XOUT_BF ? nullptr : (row < ML ? (float*)xout_lat + (size_t)row * D : (float*)xout_ctx + (size_t)(row - ML) * D);
                bf16* xob = XOUT_BF ? (bf16*)xout_lat + (size_t)row * D : nullptr;
#pragma unroll
                for (int j = 0; j < 16; ++j) { const int o = j * 256 + lane * 4;
                    f32x4 x;
                    if (XIN_BF) { const v2u xw = *(const v2u*)(xrb + o); x = (f32x4){bflo(xw.x), bfhi(xw.x), bflo(xw.y), bfhi(xw.y)}; } else x = *(const f32x4*)(xr + o);
                    v[j] = x + (v[j] * rstd) * pG[j * 64 + lane];
                    if (XOUT_BF) { v2u w; w.x = pk2(v[j].x, v[j].y); w.y = pk2(v[j].z, v[j].w); *(v2u*)(xob + o) = w; } else *(f32x4*)(xo + o) = v[j];
                    if ((j & 3) == 3) asm volatile("" ::: "memory"); }
            } else {
#pragma unroll
                for (int j = 0; j < 16; ++j) v[j] = *(const f32x4*)(xr + j * 256 + lane * 4);
            }
            if (DOH) {
                float s = 0.f;
#pragma unroll
                for (int j = 0; j < 16; ++j) s += (v[j].x * v[j].x + v[j].y * v[j].y) + (v[j].z * v[j].z + v[j].w * v[j].w);
                const float rstd = 1.0f / sqrtf(wave_sum(s) * (1.0f / D) + EPS);
                bf16* hr = H + (size_t)row * D;
#pragma unroll
                for (int j = 0; j < 16; ++j) { const int o = j * 256 + lane * 4;
                    const f32x4 h = (v[j] * rstd) * pA[j * 64 + lane] + pB[j * 64 + lane];
                    v2u w; w.x = pk2(h.x, h.y); w.y = pk2(h.z, h.w);
                    *(v2u*)(hr + o) = w; }
            }
        }
        vb = vend;
    }
}

__device__ __forceinline__ void mixer_conv_phase(CArgs a, LAS unsigned char* lds, int tid, int lane) {
    const bf16* U = (const bf16*)(a->ws + WS_U);
    bf16* T1 = (bf16*)(a->ws + WS_Y);
    bf16* V = (bf16*)(a->ws + WS_G);
    LAS float* tile = (LAS float*)lds;
    const float* cw = a->in[I_ACONVW]; const float* cb = a->in[I_ACONVB];
    v4u rva[6]; f32x2 w[ACONV]; f32x2 bias = {0.f, 0.f}; int cc_w = -1;
#define MX_ROW(tb_, j_) ((tb_) < 256 ? (((j_) >= 15 && (j_) < 79) ? (tb_) * 64 + ((j_) - 15) : -1) \
        : ((((tb_) - 256) & 3) * 64 + ((j_) - 15) >= 0 && (((tb_) - 256) & 3) * 64 + ((j_) - 15) < CTXL ? ML + (((tb_) - 256) >> 2) * CTXL + (((tb_) - 256) & 3) * 64 + ((j_) - 15) : -1))
#define MX_LOAD(unit_) do { const int tb_ = (unit_) >> 3, cc_ = (unit_) & 7; \
        _Pragma("unroll") for (int q = 0; q < 6; ++q) { const int it = tid + NTHREADS * q; const int j = it >> 5, ch8 = it & 31; const int row = it < 94 * 32 ? MX_ROW(tb_, j) : -1; \
            const size_t o_ = (size_t)(row >= 0 ? row : 0) * ABU + cc_ * 256 + ch8 * 8; rva[q] = *(const v4u*)(U + o_); } } while (0)
    if ((int)blockIdx.x < 264 * 8) MX_LOAD(blockIdx.x);
    for (int unit = blockIdx.x; unit < 264 * 8; unit += gridDim.x) {
        const int tb = unit >> 3, cc = unit & 7;
#pragma unroll
        for (int q = 0; q < 6; ++q) { const int it = tid + NTHREADS * q; const int j = it >> 5, ch8 = it & 31;
            if (it < 94 * 32) { const int row = MX_ROW(tb, j); const float f = row >= 0 ? 1.f : 0.f; const v4u va = rva[q]; f32x4 g0, g1;
                g0.x = f * bflo(va.x); g0.y = f * bfhi(va.x); g0.z = f * bflo(va.y); g0.w = f * bfhi(va.y);
                g1.x = f * bflo(va.z); g1.y = f * bfhi(va.z); g1.z = f * bflo(va.w); g1.w = f * bfhi(va.w);
                *(LAS f32x4*)(tile + j * 256 + ch8 * 8) = g0; *(LAS f32x4*)(tile + j * 256 + ch8 * 8 + 4) = g1; } }
        __syncthreads();
        if (unit + (int)gridDim.x < 264 * 8) MX_LOAD(unit + (int)gridDim.x);
        {
            const int cp = tid & 127, tg = tid >> 7, c = cc * 256 + 2 * cp;
            if (cc != cc_w) { cc_w = cc;
#pragma unroll
                for (int k = 0; k < ACONV; ++k) w[k] = *(const f32x2*)(cw + k * WA + c);
                bias = *(const f32x2*)(cb + c); }
            f32x2 acc[16];
#pragma unroll
            for (int i = 0; i < 16; ++i) acc[i] = (f32x2){0.f, 0.f};
#pragma unroll
            for (int jj = 0; jj < 46; ++jj) {
                const f32x2 g = *(const LAS f32x2*)(tile + (16 * tg + jj) * 256 + 2 * cp);
#pragma unroll
                for (int i = 0; i < 16; ++i) { const int k = jj - i; if (k >= 0 && k < ACONV) acc[i] += w[k] * g; }
            }
            LAS unsigned* otile = (LAS unsigned*)(lds + 98304);
#pragma unroll
            for (int i = 0; i < 16; ++i) { const f32x2 o = acc[i] + bias; otile[(16 * tg + i) * 128 + cp] = pk2(o.x, o.y); }
            __syncthreads();
            int rbase;
            if (tb < 256) rbase = tb * 64; else { const int cbk = tb - 256; rbase = ML + (cbk >> 2) * CTXL + (cbk & 3) * 64; }
#pragma unroll
            for (int k = 0; k < 4; ++k) { const int q = tid + NTHREADS * k, r = q >> 5, c16 = q & 31;
                *(v4u*)(T1 + (size_t)(rbase + r) * WA + cc * 256 + c16 * 8) = *(const LAS v4u*)(otile + r * 128 + c16 * 4); }
        }
        __syncthreads();
    }
#undef MX_ROW
#undef MX_LOAD
    const float* bw = a->in[I_BCONVW];
    constexpr int NSEG_L = 2 * 64 * 16, NIT_L = NSEG_L * 256, NIT_C = 2 * 32 * 256;
    for (int it = blockIdx.x * NTHREADS + tid; it < NIT_L + NIT_C; it += gridDim.x * NTHREADS) {
        int row0, stride, prow, nrow, c;
        if (it < NIT_L) { const int c8 = it & 255, r = it >> 8, x = r & 63, seg = (r >> 6) & 15, b = r >> 10;
            c = c8 * 8; stride = 64; row0 = b * SEQ + (seg * 8) * 64 + x; prow = seg > 0 ? row0 - 64 : -1; nrow = seg < 15 ? row0 + 8 * 64 : -1; }
        else { const int j = it - NIT_L, c8 = j & 255, r = j >> 8, seg = r & 31, b = r >> 5;
            c = c8 * 8; stride = 1; row0 = ML + b * CTXL + seg * 8; prow = seg > 0 ? row0 - 1 : -1; nrow = seg < 31 ? row0 + 8 : -1; }
        float w[3][8];
#pragma unroll
        for (int k = 0; k < 3; ++k) { const f32x4 w0 = *(const f32x4*)(bw + k * 2048 + c), w1 = *(const f32x4*)(bw + k * 2048 + c + 4);
            w[k][0] = w0.x; w[k][1] = w0.y; w[k][2] = w0.z; w[k][3] = w0.w; w[k][4] = w1.x; w[k][5] = w1.y; w[k][6] = w1.z; w[k][7] = w1.w; }
        const bf16* uz = U + 4096 + c; const bf16* ub = U + 2048 + c;
        v4u rc[10], rb[8];
#pragma unroll
        for (int i = 0; i < 10; ++i) { const int rr = i == 0 ? (prow >= 0 ? prow : row0) : (i == 9 ? (nrow >= 0 ? nrow : row0) : row0 + (i - 1) * stride);
            rc[i] = *(const v4u*)(uz + (size_t)rr * ABU); }
#pragma unroll
        for (int i = 0; i < 8; ++i) rb[i] = *(const v4u*)(ub + (size_t)(row0 + i * stride) * ABU);
        float pp[8], pc[8];
        { float a8[8]; cvt8(rc[0], a8); const float f = prow >= 0 ? 1.f : 0.f;
#pragma unroll
          for (int e = 0; e < 8; ++e) pp[e] = a8[e] * f;
          cvt8(rc[1], pc); }
#pragma unroll
        for (int i = 0; i < 8; ++i) {
            float pn[8], bb[8]; cvt8(rc[i + 2], pn); cvt8(rb[i], bb);
            const float f = (i == 7 && nrow < 0) ? 0.f : 1.f;
#pragma unroll
            for (int e = 0; e < 8; ++e) pn[e] *= f;
            float o[8];
#pragma unroll
            for (int e = 0; e < 8; ++e) o[e] = bb[e] * (w[0][e] * pp[e] + w[1][e] * pc[e] + w[2][e] * pn[e]);
            v4u ov; ov.x = pk2(o[0], o[1]); ov.y = pk2(o[2], o[3]); ov.z = pk2(o[4], o[5]); ov.w = pk2(o[6], o[7]);
            *(v4u*)(V + (size_t)(row0 + i * stride) * D + WA + c) = ov;
#pragma unroll
            for (int e = 0; e < 8; ++e) { pp[e] = pc[e]; pc[e] = pn[e]; }
        }
    }
}
__device__ __forceinline__ void mixer_ln_phase(CArgs a, LAS unsigned char* lds, int tid, int lane, int wave) {
    const bf16* T1 = (const bf16*)(a->ws + WS_Y);
    bf16* V = (bf16*)(a->ws + WS_G);
    LAS f32x4* pg = (LAS f32x4*)lds; LAS f32x4* pb = pg + 512;
    for (int i = tid; i < 512; i += NTHREADS) { pg[i] = ((const f32x4*)a->in[I_ALNG])[i]; pb[i] = ((const f32x4*)a->in[I_ALNB])[i]; }
    __syncthreads();
    const int G = gridDim.x, rpw = (MT + G - 1) / G, r0 = (int)blockIdx.x * rpw, r1 = (r0 + rpw < MT) ? r0 + rpw : MT;
    for (int row = r0 + wave; row < r1; row += NWAVES) {
        f32x4 v[8]; float s = 0.f;
#pragma unroll
        for (int j = 0; j < 8; ++j) { const v2u tw = *(const v2u*)(T1 + (size_t)row * WA + j * 256 + lane * 4); v[j] = (f32x4){bflo(tw.x), bfhi(tw.x), bflo(tw.y), bfhi(tw.y)}; s += (v[j].x + v[j].y) + (v[j].z + v[j].w); }
        const float mu = wave_sum(s) * (1.0f / WA); float q = 0.f;
#pragma unroll
        for (int j = 0; j < 8; ++j) { v[j] = v[j] - mu; q += (v[j].x * v[j].x + v[j].y * v[j].y) + (v[j].z * v[j].z + v[j].w * v[j].w); }
        const float rstd = 1.0f / sqrtf(wave_sum(q) * (1.0f / WA) + EPS);
#pragma unroll
        for (int j = 0; j < 8; ++j) { const int o = j * 256 + lane * 4;
            const f32x4 y = (v[j] * rstd) * pg[j * 64 + lane] + pb[j * 64 + lane];
            v2u w; w.x = pk2(siluf_(y.x), siluf_(y.y)); w.y = pk2(siluf_(y.z), siluf_(y.w));
            *(v2u*)(V + (size_t)row * D + o) = w; }
    }
}

template <int NR>
__device__ __forceinline__ void ffn_gate_slide(const bf16* ug, const bf16* uv, int ldu, bf16* Go, const float* cwg, const float* cwv, int row0, int prow, int nrow) {
    float wg[3][8], wv[3][8];
#pragma unroll
    for (int k = 0; k < 3; ++k) {
        const f32x4 a0 = *(const f32x4*)(cwg + k * DFF2), a1 = *(const f32x4*)(cwg + k * DFF2 + 4), b0 = *(const f32x4*)(cwv + k * DFF2), b1 = *(const f32x4*)(cwv + k * DFF2 + 4);
        wg[k][0] = a0.x; wg[k][1] = a0.y; wg[k][2] = a0.z; wg[k][3] = a0.w; wg[k][4] = a1.x; wg[k][5] = a1.y; wg[k][6] = a1.z; wg[k][7] = a1.w;
        wv[k][0] = b0.x; wv[k][1] = b0.y; wv[k][2] = b0.z; wv[k][3] = b0.w; wv[k][4] = b1.x; wv[k][5] = b1.y; wv[k][6] = b1.z; wv[k][7] = b1.w;
    }
    float pg[8], pv[8], cg[8], cv[8];
    { const float fp = prow >= 0 ? 1.f : 0.f; const int pr = prow >= 0 ? prow : row0;
      const v4u a = *(const v4u*)(ug + (size_t)pr * ldu), b = *(const v4u*)(uv + (size_t)pr * ldu); cvt8(a, pg); cvt8(b, pv);
#pragma unroll
      for (int e = 0; e < 8; ++e) { pg[e] *= fp; pv[e] *= fp; }
      const v4u a2 = *(const v4u*)(ug + (size_t)row0 * ldu), b2 = *(const v4u*)(uv + (size_t)row0 * ldu); cvt8(a2, cg); cvt8(b2, cv); }
    const float fn = nrow >= 0 ? 1.f : 0.f; const int nr = nrow >= 0 ? nrow : row0;
    for (int blk = 0; blk < NR / 4; ++blk) {
        v4u rg[4], rv[4];
#pragma unroll
        for (int i = 0; i < 4; ++i) { const int r = 4 * blk + 1 + i; const int rr = r < NR ? row0 + r : nr;
            rg[i] = *(const v4u*)(ug + (size_t)rr * ldu); rv[i] = *(const v4u*)(uv + (size_t)rr * ldu); }
#pragma unroll
        for (int i = 0; i < 4; ++i) {
            float ng[8], nv[8]; cvt8(rg[i], ng); cvt8(rv[i], nv);
            if (i == 3) { const float f = (4 * blk + 4 < NR) ? 1.f : fn;
#pragma unroll
                for (int e = 0; e < 8; ++e) { ng[e] *= f; nv[e] *= f; } }
            float o[8];
#pragma unroll
            for (int e = 0; e < 8; ++e) { const float g = wg[0][e] * pg[e] + wg[1][e] * cg[e] + wg[2][e] * ng[e], v = wv[0][e] * pv[e] + wv[1][e] * cv[e] + wv[2][e] * nv[e]; o[e] = siluf_(g) * v; }
            v4u w; w.x = pk2(o[0], o[1]); w.y = pk2(o[2], o[3]); w.z = pk2(o[4], o[5]); w.w = pk2(o[6], o[7]);
            *(v4u*)(Go + (size_t)(4 * blk + i) * DFF) = w;
#pragma unroll
            for (int e = 0; e < 8; ++e) { pg[e] = cg[e]; pv[e] = cv[e]; cg[e] = ng[e]; cv[e] = nv[e]; }
        }
    }
}
__device__ __forceinline__ void ffn_gate_ctx_phase(CArgs a, int tid) {
    const bf16* UC = (const bf16*)(a->ws + WS_UC);
    bf16* G = (bf16*)(a->ws + WS_G);
    const float* cw = a->in[I_FCONV];
    constexpr int NC8 = DFF / 8;
    constexpr int NIT = 8 * NC8 * 4, PER = (NIT + 255) / 256;
    for (int it = blockIdx.x * PER + tid; tid < PER && it < NIT; it += gridDim.x * PER) {
        const int q4 = it & 3, rest = it >> 2, c8 = rest % NC8, blk = rest / NC8, ch = c8 * 8;
        const int p0 = (blk & 3) * 64 + q4 * 16, lrow0 = (blk >> 2) * CTXL + p0;
        const bf16* ug = UC + 256 * (ch >> 7) + (ch & 127);
        ffn_gate_slide<16>(ug, ug + 128, DFF2, G + (size_t)(ML + lrow0) * DFF + ch, cw + ch, cw + DFF + ch, lrow0, p0 > 0 ? lrow0 - 1 : -1, p0 + 16 < CTXL ? lrow0 + 16 : -1);
    }
}

__device__ __forceinline__ int chunk_row0(int dir, int b, int c) {
    if (dir == 0) return c < 2 ? ML + b * CTXL + 128 * c : b * SEQ + 128 * (c - 2);
    return c < 2 ? ML + b * CTXL + 128 * (1 - c) : b * SEQ + 128 * (63 - (c - 2));
}
__device__ __forceinline__ float wave_incl_sum(float v, int lane) {
#pragma unroll
    for (int o = 1; o < 64; o <<= 1) { const float t = __shfl_up(v, o); if (lane >= o) v += t; }
    return v;
}
__device__ __forceinline__ float wave_incl_max(float v, int lane) {
#pragma unroll
    for (int o = 1; o < 64; o <<= 1) { const float t = __shfl_up(v, o); if (lane >= o) v = fmaxf(v, t); }
    return v;
}
__device__ __forceinline__ bf16x8 tr_frag(LAS unsigned char* T, int pitch, int k0, int col0, int lane) {
    const int g = lane >> 4, q = (lane & 15) >> 2, p = lane & 3;
    LAS unsigned char* p0 = T + (k0 + 8 * g + q) * pitch + (col0 + 4 * p) * 2;
    const s16x4 lo = __builtin_amdgcn_ds_read_tr16_b64_v4i16((LAS s16x4*)p0);
    const s16x4 hi = __builtin_amdgcn_ds_read_tr16_b64_v4i16((LAS s16x4*)(p0 + 4 * pitch));
    bf16x8 r; r[0] = lo[0]; r[1] = lo[1]; r[2] = lo[2]; r[3] = lo[3]; r[4] = hi[0]; r[5] = hi[1]; r[6] = hi[2]; r[7] = hi[3];
    return r;
}
#ifndef SCAN_REP
#define SCAN_REP 1
#endif
#define MFMA16(y, x, acc) __builtin_amdgcn_mfma_f32_16x16x32_bf16((y), (x), (acc), 0, 0, 0)

constexpr int SK_PITCH = 528;

constexpr size_t WS_QT = WS_G;
constexpr size_t WS_SPP = WS_Y;
constexpr size_t WS_DEN = WS_Y + 64 * MiB;
static_assert((size_t)32 * 64 * 128 * 128 * 2 <= 64 * MiB && WS_DEN + (size_t)32 * 64 * 128 * 4 <= WS_HS, "scan scratch");
__device__ __forceinline__ void chunk_scalars(CArgs a, int dir, int b, int h, int c, LAS float* sAl, LAS float* sPl, int lane) {
    const float* GT = (const float*)(a->ws + WS_GATES);
    float* SCP = (float*)(a->ws + WS_SCP); float* SCG = (float*)(a->ws + WS_SCC);
    const int chain = dir * 16 + b * 8 + h, R0 = chunk_row0(dir, b, c);
    const float bi = a->in[I_MBG][dir * 16 + h], bf = a->in[I_MBG][dir * 16 + 8 + h];
    const int r0 = dir ? 127 - lane : lane, r1 = dir ? 63 - lane : 64 + lane;
    const float i0 = GT[(size_t)(R0 + r0) * 32 + dir * 16 + h] + bi, i1 = GT[(size_t)(R0 + r1) * 32 + dir * 16 + h] + bi;
    const float x0 = GT[(size_t)(R0 + r0) * 32 + dir * 16 + 8 + h] + bf, x1 = GT[(size_t)(R0 + r1) * 32 + dir * 16 + 8 + h] + bf;
    const float f0 = fminf(x0, 0.f) - log1pf(__expf(-fabsf(x0))), f1 = fminf(x1, 0.f) - log1pf(__expf(-fabsf(x1)));
    const float s0 = wave_incl_sum(f0, lane); const float tot0 = __shfl(s0, 63);
    const float s1 = wave_incl_sum(f1, lane) + tot0;
    const float a0 = i0 - s0, a1 = i1 - s1;
    const float p0 = wave_incl_max(a0, lane); const float pm0 = __shfl(p0, 63);
    const float p1 = fmaxf(wave_incl_max(a1, lane), pm0);
    float* o = SCP + ((size_t)chain * NCH + c) * 384;
    o[r0] = a0; o[128 + r0] = p0; o[256 + r0] = s0;
    o[r1] = a1; o[128 + r1] = p1; o[256 + r1] = s1;
    if (sAl) { sAl[r0] = a0; sAl[r1] = a1; }
    if (lane == 63) { SCG[((size_t)chain * NCH + c) * 2] = s1; SCG[((size_t)chain * NCH + c) * 2 + 1] = p1; if (sPl) sPl[0] = p1; }
}
__device__ __forceinline__ void scan_pre_phase(CArgs a, LAS unsigned char* lds, int tid, int lane, int wave) {
    const bf16* QK = (const bf16*)(a->ws + WS_U);
    bf16* SPP = (bf16*)(a->ws + WS_SPP); float* DEN = (float*)(a->ws + WS_DEN); const bf16* QT = (const bf16*)(a->ws + WS_QT);
    LAS unsigned char* Kl = lds; LAS float* sA0 = (LAS float*)(lds + 67584); LAS float* sA1 = sA0 + 128; LAS float* sPt = sA0 + 256;
    const int g = lane >> 4, l15 = lane & 15;
    for (int unit = blockIdx.x; unit < 1024 + 64; unit += gridDim.x) {
        if (unit >= 1024) { if (wave == 0) { const int u = unit - 1024, chain = u >> 1, c = u & 1; chunk_scalars(a, chain >> 4, (chain >> 3) & 1, chain & 7, c, nullptr, nullptr, lane); } continue; }
        const int bh = unit >> 6, j = unit & 63, b = bh >> 3, h = bh & 7;
        const int R0 = b * SEQ + 128 * j, c0 = 2 + j, c1 = 2 + (63 - j);
        const int tl = 16 * wave + l15;
#pragma unroll
        for (int i = 0; i < 8; ++i) { const int idx = tid + NTHREADS * i, r = idx >> 5, ch = idx & 31;
            const v4u v = *(const v4u*)(QK + (size_t)(R0 + r) * QKVO + 2048 + h * DQK + ch * 8);
            *(LAS v4u*)(Kl + r * SK_PITCH + ch * 16) = v; }
        bf16x8 qf[8];
#pragma unroll
        for (int kk = 0; kk < 8; ++kk) qf[kk] = *(const bf16x8*)(QT + ((size_t)((R0 >> 4) + wave) * 64 + 8 * h + kk) * 512 + lane * 8);
        if (wave == 0) chunk_scalars(a, 0, b, h, c0, sA0, sPt, lane);
        if (wave == 1) chunk_scalars(a, 1, b, h, c1, sA1, sPt + 1, lane);
        __syncthreads();
        {
            const float pt0 = sPt[0], pt1 = sPt[1];
            float dp0 = 0.f, dp1 = 0.f;
            int tlv = tl, gv = 4 * g; asm volatile("" : "+v"(tlv), "+v"(gv));
            bf16* sp0 = SPP + (size_t)((0 * 16 + bh) * 64 + (c0 - 2)) * 16384 + (size_t)wave * 2048 + (l15 + 16 * (g >> 1)) * 8 + 4 * (g & 1);
            bf16* sp1 = SPP + (size_t)((1 * 16 + bh) * 64 + (c1 - 2)) * 16384 + (size_t)wave * 2048 + (l15 + 16 * (g >> 1)) * 8 + 4 * (g & 1);
#pragma unroll
            for (int nh = 0; nh < 2; ++nh) {
                f32x4 sacc[4];
#pragma unroll
                for (int n = 0; n < 4; ++n) sacc[n] = (f32x4){0.f, 0.f, 0.f, 0.f};
#pragma unroll
                for (int kk = 0; kk < 8; ++kk)
#pragma unroll
                    for (int n = 0; n < 4; ++n) { const bf16x8 yf = *(const LAS bf16x8*)(Kl + (16 * (4 * nh + n) + l15) * SK_PITCH + (32 * kk + 8 * g) * 2); sacc[n] = MFMA16(yf, qf[kk], sacc[n]); }
#pragma unroll
                for (int n = 0; n < 4; ++n) { float sv0[4], sv1[4]; const int n8 = 4 * nh + n;
#pragma unroll
                    for (int r = 0; r < 4; ++r) { const int sl = 16 * n8 + 4 * g + r; const int sidx = gv + (16 * n8 + r);
                        const float qk = sacc[n][r] * 0.0625f;
                        sv0[r] = (sidx <= tlv) ? qk * __expf(sA0[sl] - pt0) : 0.f; dp0 += sv0[r];
                        sv1[r] = (sidx >= tlv) ? qk * __expf(sA1[sl] - pt1) : 0.f; dp1 += sv1[r]; }
                    v2u w0; w0.x = pk2(sv0[0], sv0[1]); w0.y = pk2(sv0[2], sv0[3]); *(v2u*)(sp0 + (n8 >> 1) * 512 + (n8 & 1) * 256) = w0;
                    v2u w1; w1.x = pk2(sv1[0], sv1[1]); w1.y = pk2(sv1[2], sv1[3]); *(v2u*)(sp1 + (n8 >> 1) * 512 + (n8 & 1) * 256) = w1; }
                asm volatile("" ::: "memory");
            }
            dp0 += __shfl_xor(dp0, 16); dp0 += __shfl_xor(dp0, 32); dp1 += __shfl_xor(dp1, 16); dp1 += __shfl_xor(dp1, 32);
            if (g == 0) { DEN[(size_t)((0 * 16 + bh) * 64 + (c0 - 2)) * 128 + tl] = dp0; DEN[(size_t)((1 * 16 + bh) * 64 + (c1 - 2)) * 128 + tl] = dp1; }
        }
        __syncthreads();
    }
}

constexpr int S2V_PITCH = 160;
constexpr int S2K_PITCH = 544;
__device__ __forceinline__ int s2_sigma(int r) { return (r & ~12) | ((r & 4) << 1) | ((r & 8) >> 1); }
__device__ __forceinline__ bf16x8 tr_frag_sw(LAS unsigned char* T, int pitch, int k0, int col0, int lane) {
    const int g = lane >> 4, q = (lane & 15) >> 2, p = lane & 3;
    LAS unsigned char* p0 = T + (k0 + 16 * (g >> 1) + 4 * (g & 1) + q) * pitch + (col0 + 4 * p) * 2;
    const s16x4 lo = __builtin_amdgcn_ds_read_tr16_b64_v4i16((LAS s16x4*)p0);
    const s16x4 hi = __builtin_amdgcn_ds_read_tr16_b64_v4i16((LAS s16x4*)(p0 + 8 * pitch));
    bf16x8 r; r[0] = lo[0]; r[1] = lo[1]; r[2] = lo[2]; r[3] = lo[3]; r[4] = hi[0]; r[5] = hi[1]; r[6] = hi[2]; r[7] = hi[3];
    return r;
}
constexpr int S2K_OFF = 0, S2V_OFF = 128 * S2K_PITCH, S2S_OFF = S2V_OFF + 128 * S2V_PITCH, S2C_OFF = S2S_OFF + 128 * S2V_PITCH, S2M_OFF = S2C_OFF + 80 * SK_PITCH;
static_assert(S2M_OFF + 4 * 272 <= MISC_OFF, "scan v2 LDS map");
#define SCHED_FENCE() do { } while (0)
#define LDS_BARRIER() do { asm volatile("s_waitcnt lgkmcnt(0)" ::: "memory"); __builtin_amdgcn_s_barrier(); asm volatile("" ::: "memory"); } while (0)
__device__ __forceinline__ void scan_seq_phase(CArgs a, LAS unsigned char* lds, int tid, int lane, int wave) {
    const bf16* QK = (const bf16*)(a->ws + WS_U);
    const float* SCP = (const float*)(a->ws + WS_SCP); const float* SCG = (const float*)(a->ws + WS_SCC);
    const bf16* SPP = (const bf16*)(a->ws + WS_SPP); const float* DEN = (const float*)(a->ws + WS_DEN); const bf16* QT = (const bf16*)(a->ws + WS_QT);
    bf16* HS = (bf16*)(a->ws + WS_HS);
    LAS unsigned char* Kl = lds + S2K_OFF; LAS unsigned char* Vl = lds + S2V_OFF; LAS unsigned char* Vs = lds + S2S_OFF; LAS unsigned char* Cl = lds + S2C_OFF;
    LAS float* mp = (LAS float*)(lds + S2M_OFF); LAS float* ml = mp + 68; LAS float* pt = mp + 136; LAS float* gl = mp + 204;
    for (int unit_ = blockIdx.x; unit_ < 256 * SCAN_REP; unit_ += gridDim.x) { const int u0 = unit_ & 255, unit = ((u0 & 7) << 5) | (u0 >> 3);
        const int chain = unit >> 3, slice = unit & 7, dir = chain >> 4, b = (chain >> 3) & 1, h = chain & 7;
        int tid_u = tid; asm volatile("" : "+v"(tid_u));
        if (tid < NCH) { gl[tid] = SCG[((size_t)chain * NCH + tid) * 2]; pt[tid] = SCG[((size_t)chain * NCH + tid) * 2 + 1]; }
        for (int i = tid_u; i < 80 * SK_PITCH / 4; i += NTHREADS) ((LAS unsigned*)Cl)[i] = 0u;
        for (int i = tid_u; i < 128 * 8; i += NTHREADS) { const int r = i >> 3, w = i & 7; ((LAS unsigned*)(Vs + r * S2V_PITCH + 128))[w] = 0u; }
        __syncthreads();
        if (tid == 0) { float m = 0.f; for (int c = 0; c < NCH; ++c) { const float mx = fmaxf(m, pt[c]); mp[c] = m; ml[c] = mx; m = gl[c] + mx; } }
        __syncthreads();
        f32x4 cacc[5][2];
#pragma unroll
        for (int mt = 0; mt < 5; ++mt)
#pragma unroll
            for (int nt = 0; nt < 2; ++nt) cacc[mt][nt] = (f32x4){0.f, 0.f, 0.f, 0.f};
        v4u kreg[8], vreg[2]; float areg[2];
#define S2_LOAD(cc, T) do { const unsigned koff = (unsigned)((((T) >> 5) * QKVO + ((T) & 31) * 8) * 2), voff = (unsigned)((((T) >> 3) * QKVO + ((T) & 7) * 8) * 2); const int R1_ = chunk_row0(dir, b, (cc)); const char* kb_ = (const char*)(QK + (size_t)R1_ * QKVO + 2048 + h * DQK); const char* vb_ = (const char*)(QK + (size_t)R1_ * QKVO + 4096 + h * DV + slice * 64); \
            const float* ab_ = SCP + ((size_t)chain * NCH + (cc)) * 384; \
            _Pragma("unroll") for (int i = 0; i < 8; ++i) kreg[i] = *(const v4u*)(kb_ + (koff + (unsigned)(i * 16 * QKVO * 2))); \
            _Pragma("unroll") for (int i = 0; i < 2; ++i) { vreg[i] = *(const v4u*)(vb_ + (voff + (unsigned)(i * 64 * QKVO * 2))); areg[i] = ab_[((T) >> 3) + 64 * i]; } } while (0)
#define S2_STORE(cc, T) do { const float mlc_ = ml[(cc)]; \
            _Pragma("unroll") for (int i = 0; i < 8; ++i) { const int idx = (T) + NTHREADS * i, r = idx >> 5, ch = idx & 31; *(LAS v4u*)(Kl + s2_sigma(r) * S2K_PITCH + ch * 16) = kreg[i]; } \
            _Pragma("unroll") for (int i = 0; i < 2; ++i) { const int idx = (T) + NTHREADS * i, r = idx >> 3, ch = idx & 7; const float ws_ = __expf(areg[i] - mlc_) * 0.0625f;     \
                *(LAS v4u*)(Vl + s2_sigma(r) * S2V_PITCH + ch * 16) = vreg[i]; \
                v4u sc_; sc_.x = pk2(bflo(vreg[i].x) * ws_, bfhi(vreg[i].x) * ws_); sc_.y = pk2(bflo(vreg[i].y) * ws_, bfhi(vreg[i].y) * ws_); sc_.z = pk2(bflo(vreg[i].z) * ws_, bfhi(vreg[i].z) * ws_); sc_.w = pk2(bflo(vreg[i].w) * ws_, bfhi(vreg[i].w) * ws_); \
                *(LAS v4u*)(Vs + s2_sigma(r) * S2V_PITCH + ch * 16) = sc_; \
                if (ch == 0) *(LAS unsigned*)(Vs + s2_sigma(r) * S2V_PITCH + 128) = f2bf(ws_); } } while (0)
        S2_LOAD(0, tid_u); S2_STORE(0, tid_u);
        __syncthreads();
#define S2_OUTP false
        for (int c = 0; c < 2; ++c) {
            const int R0 = chunk_row0(dir, b, c);
            const float m_prev = mp[c], m_last = ml[c], ptot = pt[c];
            constexpr bool outp = S2_OUTP; const bool more = (c + 1 < NCH);
            int tid_o = tid; asm volatile("" : "+v"(tid_o));
            const int lane_o = tid_o & 63, g = lane_o >> 4, l15 = lane_o & 15, tl = 16 * wave + l15;
            bf16x8 qf[8], sf[4]; float pv = 0.f, bv = 0.f, dn = 0.f;
            v2u hw[4] = {{0u, 0u}, {0u, 0u}, {0u, 0u}, {0u, 0u}}; v4u hv[2] = {{0u, 0u, 0u, 0u}, {0u, 0u, 0u, 0u}};
            if (outp) {
                const char* qb = (const char*)(QT + ((size_t)((R0 >> 4) + wave) * 64 + 8 * h) * 512); const unsigned qoff = (unsigned)(lane_o * 16);
#pragma unroll
                for (int kk = 0; kk < 8; ++kk) qf[kk] = *(const bf16x8*)(qb + (qoff + (unsigned)(kk * 1024)));
                const float* scp = SCP + ((size_t)chain * NCH + c) * 384;
                pv = scp[128 + tl]; bv = scp[256 + tl]; dn = DEN[(size_t)(chain * 64 + (c - 2)) * 128 + tl];
            }
            SCHED_FENCE();
            const float w_old = __expf(m_prev - m_last);
#pragma unroll
            for (int mt = 0; mt < 5; ++mt)
#pragma unroll
                for (int nt = 0; nt < 2; ++nt) cacc[mt][nt] = cacc[mt][nt] * w_old;
#pragma unroll
            for (int kk = 0; kk < 4; ++kk) {
                bf16x8 yf[2], xf[5];
#pragma unroll
                for (int nt = 0; nt < 2; ++nt) yf[nt] = tr_frag_sw(Kl, S2K_PITCH, 32 * kk, 32 * wave + 16 * nt, lane_o);
#pragma unroll
                for (int mt = 0; mt < 5; ++mt) xf[mt] = tr_frag_sw(Vs, S2V_PITCH, 32 * kk, 16 * mt, lane_o);
                SCHED_FENCE();
#pragma unroll
                for (int mt = 0; mt < 5; ++mt)
#pragma unroll
                    for (int nt = 0; nt < 2; ++nt) cacc[mt][nt] = MFMA16(yf[nt], xf[mt], cacc[mt][nt]);
                SCHED_FENCE();
            }
            if (outp) { const char* sb = (const char*)(SPP + (size_t)(chain * 64 + (c - 2)) * 16384 + (size_t)wave * 2048); const unsigned soff = (unsigned)(lane_o * 16);
#pragma unroll
                for (int kk = 0; kk < 4; ++kk) sf[kk] = *(const bf16x8*)(sb + (soff + (unsigned)(kk * 1024))); }
            if (more) S2_LOAD(c + 1, tid_o);
            SCHED_FENCE();
            if (outp) {
                f32x4 qacc[5];
#pragma unroll
                for (int n = 0; n < 5; ++n) qacc[n] = (f32x4){0.f, 0.f, 0.f, 0.f};
#pragma unroll
                for (int kk = 0; kk < 8; ++kk) {
                    bf16x8 cf[5];
#pragma unroll
                    for (int n = 0; n < 5; ++n) cf[n] = *(const LAS bf16x8*)(Cl + (16 * n + l15) * SK_PITCH + (32 * kk + 8 * g) * 2);
                    SCHED_FENCE();
#pragma unroll
                    for (int n = 0; n < 5; ++n) qacc[n] = MFMA16(cf[n], qf[kk], qacc[n]);
                    SCHED_FENCE();
                }
                f32x4 nacc[4];
#pragma unroll
                for (int n = 0; n < 4; ++n) nacc[n] = (f32x4){0.f, 0.f, 0.f, 0.f};
#pragma unroll
                for (int k2 = 0; k2 < 4; k2 += 2) {
                    bf16x8 vf[2][4];
#pragma unroll
                    for (int u = 0; u < 2; ++u)
#pragma unroll
                        for (int n = 0; n < 4; ++n) vf[u][n] = tr_frag_sw(Vl, S2V_PITCH, 32 * (k2 + u), 16 * n, lane_o);
                    SCHED_FENCE();
#pragma unroll
                    for (int u = 0; u < 2; ++u)
#pragma unroll
                        for (int n = 0; n < 4; ++n) nacc[n] = MFMA16(vf[u][n], sf[k2 + u], nacc[n]);
                    SCHED_FENCE();
                }
                const float mxt = fmaxf(m_prev, pv), rowfac = __expf(ptot - mxt), winter = __expf(m_prev - mxt);
                const float nq = __shfl(qacc[4][0], l15);
                const float den = rowfac * dn + winter * nq;
                const float inv = 1.0f / fmaxf(fabsf(den), __expf(-bv - mxt));
#pragma unroll
                for (int n = 0; n < 4; ++n) { const f32x4 o = (nacc[n] * rowfac + qacc[n] * winter) * inv; hw[n].x = pk2(o.x, o.y); hw[n].y = pk2(o.z, o.w); }
                bf16* hp = HS + ((size_t)dir * ML + R0 + tl) * D + h * DV + slice * 64 + 8 * g;
                const int src0 = l15 + 16 * (2 * (g & 1)), src1 = src0 + 16; const bool hi_n = (g >> 1) != 0;
#pragma unroll
                for (int k = 0; k < 2; ++k) {
                    const unsigned a0x = __shfl(hw[2 * k].x, src0), a0y = __shfl(hw[2 * k].y, src0), a1x = __shfl(hw[2 * k].x, src1), a1y = __shfl(hw[2 * k].y, src1);
                    const unsigned b0x = __shfl(hw[2 * k + 1].x, src0), b0y = __shfl(hw[2 * k + 1].y, src0), b1x = __shfl(hw[2 * k + 1].x, src1), b1y = __shfl(hw[2 * k + 1].y, src1);
                    hv[k].x = hi_n ? b0x : a0x; hv[k].y = hi_n ? b0y : a0y; hv[k].z = hi_n ? b1x : a1x; hv[k].w = hi_n ? b1y : a1y;
                    *(v4u*)(hp + 32 * k) = hv[k]; }
            }
            LDS_BARRIER();
#pragma unroll
            for (int mt = 0; mt < 5; ++mt)
#pragma unroll
                for (int nt = 0; nt < 2; ++nt) { v2u w; w.x = pk2(cacc[mt][nt][0], cacc[mt][nt][1]); w.y = pk2(cacc[mt][nt][2], cacc[mt][nt][3]);
                    *(LAS v2u*)(Cl + (16 * mt + l15) * SK_PITCH + (32 * wave + 16 * nt + 4 * g) * 2) = w; }
            if (more) S2_STORE(c + 1, tid_o);
            asm volatile("" :: "v"(hv[0]), "v"(hv[1]));
            LDS_BARRIER();
                }
#undef S2_OUTP
#define S2_OUTP true
        for (int c = 2; c < NCH; ++c) {
            const int R0 = chunk_row0(dir, b, c);
            const float m_prev = mp[c], m_last = ml[c], ptot = pt[c];
            constexpr bool outp = S2_OUTP; const bool more = (c + 1 < NCH);
            int tid_o = tid; asm volatile("" : "+v"(tid_o));
            const int lane_o = tid_o & 63, g = lane_o >> 4, l15 = lane_o & 15, tl = 16 * wave + l15;
            bf16x8 qf[8], sf[4]; float pv = 0.f, bv = 0.f, dn = 0.f;
            v2u hw[4] = {{0u, 0u}, {0u, 0u}, {0u, 0u}, {0u, 0u}}; v4u hv[2] = {{0u, 0u, 0u, 0u}, {0u, 0u, 0u, 0u}};
            if (outp) {
                const char* qb = (const char*)(QT + ((size_t)((R0 >> 4) + wave) * 64 + 8 * h) * 512); const unsigned qoff = (unsigned)(lane_o * 16);
#pragma unroll
                for (int kk = 0; kk < 8; ++kk) qf[kk] = *(const bf16x8*)(qb + (qoff + (unsigned)(kk * 1024)));
                const float* scp = SCP + ((size_t)chain * NCH + c) * 384;
                pv = scp[128 + tl]; bv = scp[256 + tl]; dn = DEN[(size_t)(chain * 64 + (c - 2)) * 128 + tl];
            }
            SCHED_FENCE();
            const float w_old = __expf(m_prev - m_last);
#pragma unroll
            for (int mt = 0; mt < 5; ++mt)
#pragma unroll
                for (int nt = 0; nt < 2; ++nt) cacc[mt][nt] = cacc[mt][nt] * w_old;
#pragma unroll
            for (int kk = 0; kk < 4; ++kk) {
                bf16x8 yf[2], xf[5];
#pragma unroll
                for (int nt = 0; nt < 2; ++nt) yf[nt] = tr_frag_sw(Kl, S2K_PITCH, 32 * kk, 32 * wave + 16 * nt, lane_o);
#pragma unroll
                for (int mt = 0; mt < 5; ++mt) xf[mt] = tr_frag_sw(Vs, S2V_PITCH, 32 * kk, 16 * mt, lane_o);
                SCHED_FENCE();
#pragma unroll
                for (int mt = 0; mt < 5; ++mt)
#pragma unroll
                    for (int nt = 0; nt < 2; ++nt) cacc[mt][nt] = MFMA16(yf[nt], xf[mt], cacc[mt][nt]);
                SCHED_FENCE();
            }
            if (outp) { const char* sb = (const char*)(SPP + (size_t)(chain * 64 + (c - 2)) * 16384 + (size_t)wave * 2048); const unsigned soff = (unsigned)(lane_o * 16);
#pragma unroll
                for (int kk = 0; kk < 4; ++kk) sf[kk] = *(const bf16x8*)(sb + (soff + (unsigned)(kk * 1024))); }
            if (more) S2_LOAD(c + 1, tid_o);
            SCHED_FENCE();
            if (outp) {
                f32x4 qacc[5];
#pragma unroll
                for (int n = 0; n < 5; ++n) qacc[n] = (f32x4){0.f, 0.f, 0.f, 0.f};
#pragma unroll
                for (int kk = 0; kk < 8; ++kk) {
                    bf16x8 cf[5];
#pragma unroll
                    for (int n = 0; n < 5; ++n) cf[n] = *(const LAS bf16x8*)(Cl + (16 * n + l15) * SK_PITCH + (32 * kk + 8 * g) * 2);
                    SCHED_FENCE();
#pragma unroll
                    for (int n = 0; n < 5; ++n) qacc[n] = MFMA16(cf[n], qf[kk], qacc[n]);
                    SCHED_FENCE();
                }
                f32x4 nacc[4];
#pragma unroll
                for (int n = 0; n < 4; ++n) nacc[n] = (f32x4){0.f, 0.f, 0.f, 0.f};
#pragma unroll
                for (int k2 = 0; k2 < 4; k2 += 2) {
                    bf16x8 vf[2][4];
#pragma unroll
                    for (int u = 0; u < 2; ++u)
#pragma unroll
                        for (int n = 0; n < 4; ++n) vf[u][n] = tr_frag_sw(Vl, S2V_PITCH, 32 * (k2 + u), 16 * n, lane_o);
                    SCHED_FENCE();
#pragma unroll
                    for (int u = 0; u < 2; ++u)
#pragma unroll
                        for (int n = 0; n < 4; ++n) nacc[n] = MFMA16(vf[u][n], sf[k2 + u], nacc[n]);
                    SCHED_FENCE();
                }
                const float mxt = fmaxf(m_prev, pv), rowfac = __expf(ptot - mxt), winter = __expf(m_prev - mxt);
                const float nq = __shfl(qacc[4][0], l15);
                const float den = rowfac * dn + winter * nq;
                const float inv = 1.0f / fmaxf(fabsf(den), __expf(-bv - mxt));
#pragma unroll
                for (int n = 0; n < 4; ++n) { const f32x4 o = (nacc[n] * rowfac + qacc[n] * winter) * inv; hw[n].x = pk2(o.x, o.y); hw[n].y = pk2(o.z, o.w); }
                bf16* hp = HS + ((size_t)dir * ML + R0 + tl) * D + h * DV + slice * 64 + 8 * g;
                const int src0 = l15 + 16 * (2 * (g & 1)), src1 = src0 + 16; const bool hi_n = (g >> 1) != 0;
#pragma unroll
                for (int k = 0; k < 2; ++k) {
                    const unsigned a0x = __shfl(hw[2 * k].x, src0), a0y = __shfl(hw[2 * k].y, src0), a1x = __shfl(hw[2 * k].x, src1), a1y = __shfl(hw[2 * k].y, src1);
                    const unsigned b0x = __shfl(hw[2 * k + 1].x, src0), b0y = __shfl(hw[2 * k + 1].y, src0), b1x = __shfl(hw[2 * k + 1].x, src1), b1y = __shfl(hw[2 * k + 1].y, src1);
                    hv[k].x = hi_n ? b0x : a0x; hv[k].y = hi_n ? b0y : a0y; hv[k].z = hi_n ? b1x : a1x; hv[k].w = hi_n ? b1y : a1y;
                    *(v4u*)(hp + 32 * k) = hv[k]; }
            }
            LDS_BARRIER();
#pragma unroll
            for (int mt = 0; mt < 5; ++mt)
#pragma unroll
                for (int nt = 0; nt < 2; ++nt) { v2u w; w.x = pk2(cacc[mt][nt][0], cacc[mt][nt][1]); w.y = pk2(cacc[mt][nt][2], cacc[mt][nt][3]);
                    *(LAS v2u*)(Cl + (16 * mt + l15) * SK_PITCH + (32 * wave + 16 * nt + 4 * g) * 2) = w; }
            if (more) S2_STORE(c + 1, tid_o);
            asm volatile("" :: "v"(hv[0]), "v"(hv[1]));
            LDS_BARRIER();
                }
#undef S2_OUTP
#undef S2_LOAD
#undef S2_STORE
    }
}

__device__ __forceinline__ void scan_out_phase(CArgs a, LAS unsigned char* lds, int tid, int lane, int wave) {
    const bf16* HS = (const bf16*)(a->ws + WS_HS);
    const bf16* QK = (const bf16*)(a->ws + WS_U);
    bf16* A2 = (bf16*)(a->ws + WS_G);
    LAS f32x4* pg = (LAS f32x4*)lds;
    for (int i = tid; i < 1024; i += NTHREADS) pg[i] = ((const f32x4*)a->in[I_MHNG])[i];
    __syncthreads();
    const int G = gridDim.x, rpw = (ML + G - 1) / G, r0 = (int)blockIdx.x * rpw, r1 = (r0 + rpw < ML) ? r0 + rpw : ML;
    for (int row = r0 + wave; row < r1; row += NWAVES) {
        const bf16* hfp = HS + (size_t)row * D + lane * 8; const bf16* hbp = hfp + (size_t)ML * D; const bf16* op = QK + (size_t)row * QKVO + 8192 + lane * 8; bf16* ap = A2 + (size_t)row * D + lane * 8;
#pragma unroll 1
        for (int hb4 = 0; hb4 < HEADS; hb4 += 4) {
            v4u hf[4], hb[4], ov[4];
#pragma unroll
            for (int i = 0; i < 4; ++i) { hf[i] = *(const v4u*)(hfp + (hb4 + i) * DV); hb[i] = *(const v4u*)(hbp + (hb4 + i) * DV); ov[i] = *(const v4u*)(op + (hb4 + i) * DV); }
#pragma unroll
            for (int i = 0; i < 4; ++i) {
                const f32x4 va = {bflo(hf[i].x) + bflo(hb[i].x), bfhi(hf[i].x) + bfhi(hb[i].x), bflo(hf[i].y) + bflo(hb[i].y), bfhi(hf[i].y) + bfhi(hb[i].y)};
                const f32x4 vb = {bflo(hf[i].z) + bflo(hb[i].z), bfhi(hf[i].z) + bfhi(hb[i].z), bflo(hf[i].w) + bflo(hb[i].w), bfhi(hf[i].w) + bfhi(hb[i].w)};
                const float s = ((va.x * va.x + va.y * va.y) + (va.z * va.z + va.w * va.w)) + ((vb.x * vb.x + vb.y * vb.y) + (vb.z * vb.z + vb.w * vb.w));
                const float rstd = 1.0f / sqrtf(wave_sum(s) * (1.0f / DV) + EPS);
                const f32x4 ga = pg[((hb4 + i) * DV) / 4 + lane * 2], gb = pg[((hb4 + i) * DV) / 4 + lane * 2 + 1];
                const f32x4 ya = (va * rstd) * ga, yb = (vb * rstd) * gb;
                v4u w; w.x = pk2(ya.x * sigmoidf_(bflo(ov[i].x)), ya.y * sigmoidf_(bfhi(ov[i].x))); w.y = pk2(ya.z * sigmoidf_(bflo(ov[i].y)), ya.w * sigmoidf_(bfhi(ov[i].y)));
                w.z = pk2(yb.x * sigmoidf_(bflo(ov[i].z)), yb.y * sigmoidf_(bfhi(ov[i].z))); w.w = pk2(yb.z * sigmoidf_(bflo(ov[i].w)), yb.w * sigmoidf_(bfhi(ov[i].w)));
                *(v4u*)(ap + (hb4 + i) * DV) = w; }
        }
    }
}

constexpr int NPHASES = 21;
__global__ void __launch_bounds__(NTHREADS, 2) fwd_kernel(Args args_unused) {
    extern __shared__ __attribute__((aligned(16))) unsigned char lds_raw[];
    LAS unsigned char* lds = (LAS unsigned char*)lds_raw;
    const int wave_s = __builtin_amdgcn_readfirstlane((int)threadIdx.x >> 6);
    { const int tid = threadIdx.x; volatile LAS unsigned* MISC = (volatile LAS unsigned*)(lds + MISC_OFF);
      if (tid < 16) MISC[tid] = 0u;
      __syncthreads();
      if (!MK_PER_PHASE) (void)xcd_barrier_post((unsigned*)(get_args()->ws + WS_CTL) + CW_BAR, MISC); }
#define PH_IDS for (int tid = opaque_tid(wave_s), lane = tid & 63, wave = __builtin_amdgcn_readfirstlane(tid >> 6), once_ = 1; once_; once_ = 0)
#if MK_PER_PHASE
#define IN(k) (get_args()->ph_lo == (k)) PH_IDS if (true
#define SEAM(k) do { } while (0)
#else
#ifndef PROBE_PHASE
#define PROBE_PHASE -1
#endif
#define IN(k) true) for (int rep_ = 0; rep_ < ((k) == PROBE_PHASE ? 2 : 1); ++rep_) PH_IDS if (true
#define SEAM(k) do { XcdBarrier b_; b_.bar = (unsigned*)(get_args()->ws + WS_CTL) + CW_BAR; b_.x = xb_xcc_id(); b_.st = (volatile LAS unsigned*)(lds + MISC_OFF); xcd_barrier(b_); } while (0)
#endif
#define WSP(off) (get_args()->ws + (off))
#define MODP(layer) ((const float*)WSP(WS_MOD) + (layer) * 3 * NMODC)
#define NGP(i) (get_args()->in[I_NORMG] + (i) * D)

#define GEMM_PHASE(EPI, A_, B_, M_, N_, K_, EINIT, HAS_SIDE, SIDE) { const int nwg_ = ((M_) / 256) * ((N_) / 256), gg_ = (HAS_SIDE) ? gemm_wgs(nwg_) : (int)gridDim.x; \
        if ((int)blockIdx.x < gg_) { pg8::Gemm g{A_, B_, M_, N_, K_}; pg8::StaticOrder S; S.init(M_, N_, gg_, blockIdx.x); EPI E EINIT; pg8::gemm_phase<EPI, pg8::StaticOrder, true, true>(lds, g, S, E, tid); } \
          \
        const int t0_ = (HAS_SIDE) ? gg_ : ((nwg_ % (int)gridDim.x) ? nwg_ % (int)gridDim.x : (int)gridDim.x); \
        if (!PROBE_E1 && (int)blockIdx.x >= t0_) { const int si_ = (int)blockIdx.x - t0_, ns_ = (int)gridDim.x - t0_, sf_ = si_ * NWAVES + wave, sn_ = ns_ * NWAVES; (void)si_; (void)ns_; (void)sf_; (void)sn_; SIDE } }

    if (IN(0)) { p0_prologue(get_args(), lds, tid, lane, wave); __syncthreads(); } SEAM(0);
    if (IN(1)) { CArgs a = get_args(); row_phase<false, true, false, false>(lds, MT, a->in[I_X], a->in[I_CTX], nullptr, nullptr, nullptr, nullptr, nullptr, 0, NGP(0), MODP(0), 0, 1, (bf16*)WSP(WS_H), tid, lane, wave); }
    SEAM(1);
    if (IN(2)) GEMM_PHASE(pg8::EpiAB, (const bf16*)WSP(WS_H), (const bf16*)WSP(WS_WABIN), MT, ABIN, D, ({(bf16*)WSP(WS_U)}), false,
                          conv_matrix<CV_ABOUT>(get_args(), lds, sf_, sn_, lane, wave);)
    SEAM(2);
    if (IN(3)) mixer_conv_phase(get_args(), lds, tid, lane);
    SEAM(3);
    if (IN(4)) mixer_ln_phase(get_args(), lds, tid, lane, wave);
    SEAM(4);
    if (IN(5)) GEMM_PHASE(pg8::EpiBf16, (const bf16*)WSP(WS_G), (const bf16*)WSP(WS_WABOUT), MT, D, D, ({(bf16*)WSP(WS_Y), D}), true,
                          conv_matrix<CV_UP0>(get_args(), lds, sf_, sn_, lane, wave);)
    SEAM(5);
    if (IN(6)) { CArgs a = get_args(); row_phase<true, true, false, true>(lds, MT, a->in[I_X], a->in[I_CTX], WSP(WS_XB), nullptr, (const bf16*)WSP(WS_Y), NGP(1), MODP(0), 2, NGP(2), MODP(0), 3, 4, (bf16*)WSP(WS_H), tid, lane, wave); }
    SEAM(6);
    if (IN(7)) GEMM_PHASE(pg8::EpiGate, (const bf16*)WSP(WS_H), (const bf16*)WSP(WS_WUP0), MT, DFF2, D, ({(bf16*)WSP(WS_G), (bf16*)WSP(WS_UC), get_args()->in[I_FCONV]}), false,
                          conv_matrix<CV_DN0>(get_args(), lds, sf_, sn_, lane, wave);)
    SEAM(7);
    if (IN(8)) ffn_gate_ctx_phase(get_args(), tid);
    SEAM(8);
    if (IN(9)) GEMM_PHASE(pg8::EpiBf16, (const bf16*)WSP(WS_G), (const bf16*)WSP(WS_WDN0), MT, D, DFF, ({(bf16*)WSP(WS_Y), D}), true,
                          gemv_units(get_args(), lds, 1, si_, ns_, tid, lane, wave);
                          conv_matrix<CV_MIN>(get_args(), lds, sf_, sn_, lane, wave); conv_matrix<CV_MOUT>(get_args(), lds, sf_, sn_, lane, wave);
                          conv_matrix<CV_UP1>(get_args(), lds, sf_, sn_, lane, wave);)
    SEAM(9);
    if (IN(10)) { CArgs a = get_args(); row_phase<true, true, true, true>(lds, MT, WSP(WS_XB), nullptr, WSP(WS_XB), nullptr, (const bf16*)WSP(WS_Y), NGP(3), MODP(0), 5, NGP(4), MODP(1), 0, 1, (bf16*)WSP(WS_H), tid, lane, wave); }
    SEAM(10);
    if (IN(11)) GEMM_PHASE(pg8::EpiMIn, (const bf16*)WSP(WS_H), (const bf16*)WSP(WS_WMIN), MT, CINP, D, ({(bf16*)WSP(WS_U), QKVO, (float*)WSP(WS_GATES), (bf16*)WSP(WS_QT)}), false,
                           conv_matrix<CV_DN1>(get_args(), lds, sf_, sn_, lane, wave);)
    SEAM(11);
    if (IN(12)) scan_pre_phase(get_args(), lds, tid, lane, wave);
    SEAM(12);
    if (IN(13)) scan_seq_phase(get_args(), lds, tid, lane, wave);
    SEAM(13);
    if (IN(14)) scan_out_phase(get_args(), lds, tid, lane, wave);
    SEAM(14);
    if (IN(15)) GEMM_PHASE(pg8::EpiBf16, (const bf16*)WSP(WS_G), (const bf16*)WSP(WS_WMOUT), ML, D, D, ({(bf16*)WSP(WS_Y), D}), false, ;)
    SEAM(15);
    if (IN(16)) { CArgs a = get_args(); row_phase<true, true, true, true>(lds, ML, WSP(WS_XB), nullptr, WSP(WS_XB), nullptr, (const bf16*)WSP(WS_Y), NGP(5), MODP(1), 2, NGP(6), MODP(1), 3, 4, (bf16*)WSP(WS_H), tid, lane, wave); }
    SEAM(16);
    if (IN(17)) GEMM_PHASE(pg8::EpiGate, (const bf16*)WSP(WS_H), (const bf16*)WSP(WS_WUP0 + 172 * MiB), ML, DFF2, D, ({(bf16*)WSP(WS_G), (bf16*)WSP(WS_UC), get_args()->in[I_FCONV] + 3 * DFF2}), false, ;)
    SEAM(17);
    if (IN(19)) GEMM_PHASE(pg8::EpiBf16, (const bf16*)WSP(WS_G), (const bf16*)WSP(WS_WDN0 + 86 * MiB), ML, D, DFF, ({(bf16*)WSP(WS_Y), D}), false, ;)
    SEAM(19);
    if (IN(20)) { CArgs a = get_args(); row_phase<true, false, true, false>(lds, ML, WSP(WS_XB), nullptr, a->out, nullptr, (const bf16*)WSP(WS_Y), NGP(7), MODP(1), 5, nullptr, nullptr, 0, 0, nullptr, tid, lane, wave); }
#undef IN
#undef SEAM
}

extern "C" void kernel_launch(void* const* d_in, const int* in_sizes, int n_in, void* d_out, int out_size, void* d_ws, size_t ws_size, hipStream_t stream) {
    static int grid = 0;
    if (grid == 0) {
        if (n_in != 21 || out_size != ML * D || ws_size < WS_END) { fprintf(stderr, "kernel_launch: unexpected problem (n_in %d, out %d, ws %zu < %zu); nothing launched\n", n_in, out_size, ws_size, (size_t)WS_END); grid = -1; return; }
        int dev = 0, cus = 0, per_cu = 0;
        if (hipGetDevice(&dev) != hipSuccess || hipDeviceGetAttribute(&cus, hipDeviceAttributeMultiprocessorCount, dev) != hipSuccess) { grid = -1; return; }
        if (hipFuncSetAttribute((const void*)fwd_kernel, hipFuncAttributeMaxDynamicSharedMemorySize, LDS_BYTES) != hipSuccess) { fprintf(stderr, "kernel_launch: hipFuncSetAttribute failed\n"); grid = -1; return; }
        if (hipOccupancyMaxActiveBlocksPerMultiprocessor(&per_cu, (const void*)fwd_kernel, NTHREADS, LDS_BYTES) != hipSuccess || per_cu < 1)
            fprintf(stderr, "kernel_launch: occupancy query reports %d workgroups per CU\n", per_cu);
        (void)hipGetLastError();
        grid = cus;
    }
    if (grid < 0) return;
    if (hipMemsetAsync((char*)d_ws + WS_CTL, 0, CTL_ZERO_BYTES, stream) != hipSuccess) return;
    Args a{};
    for (int i = 0; i < 21; ++i) a.in[i] = (const float*)d_in[i];
    a.out = (float*)d_out; a.ws = (unsigned char*)d_ws;
#if MK_PER_PHASE
    for (int p = 0; p < NPHASES; ++p) { a.ph_lo = p; a.ph_hi = p + 1; hipLaunchKernelGGL(fwd_kernel, dim3(grid), dim3(NTHREADS), LDS_BYTES, stream, a); }
#else
    a.ph_lo = 0; a.ph_hi = NPHASES;
    hipLaunchKernelGGL(fwd_kernel, dim3(grid), dim3(NTHREADS), LDS_BYTES, stream, a);
#endif
}
```

```cpp
#include <hip/hip_runtime.h>
#include <cstdio>
#include <cstdint>

#ifndef PROBE_E1
#define PROBE_E1 0
#endif
#ifndef MK_PER_PHASE
#define MK_PER_PHASE 0
#endif

namespace pg8 {
#define PG8_LAS __attribute__((address_space(3)))
typedef unsigned short bf16_t;
typedef short bf16x8 __attribute__((ext_vector_type(8)));
typedef float f32x4 __attribute__((ext_vector_type(4)));
typedef unsigned u32x4 __attribute__((ext_vector_type(4)));
constexpr int BM = 256, BK = 64, HALF = 128, HTB = HALF * BK * 2, STAGE_BYTES = 8 * HTB, NXCD = 8, WGM = 4;

__host__ __device__ __forceinline__ int lds_byte(int r, int c) { const int st = (r >> 4) * 2 + (c >> 5), rr = r & 15, cc = c & 31, ob = rr * 64 + cc * 2; return st * 1024 + (ob ^ (((ob >> 9) & 1) << 5)); }
__host__ __device__ __forceinline__ void stage_rc(int b, int& R, int& C) { const int st = b / 1024, sb = b % 1024, swz = sb ^ (((sb >> 9) & 1) << 5); R = (st >> 1) * 16 + swz / 64; C = (st & 1) * 32 + (swz % 64) / 2; }
__host__ __device__ __forceinline__ int perm32(int rho) { const int n = rho >> 4, i = rho & 15; return 8 * (i >> 2) + 4 * n + (i & 3); }

struct Unit { int pm, pn; };
struct Gemm { const bf16_t* A; const bf16_t* Bt; int M, N, K; };

struct StaticOrder {
    int nM, nN, nwg, G, c;
    __host__ __device__ void init(int M, int N, int G_, int c_) { nM = M / BM; nN = N / BM; nwg = nM * nN; G = G_; c = c_; }
    __host__ __device__ bool next(int i, Unit& u) const {
        const long L = (long)i * G + c; if (L >= nwg) return false;
        int wgid = (int)L; { const int q = nwg / NXCD, r = nwg % NXCD, xcd = wgid % NXCD, off = wgid / NXCD; wgid = (xcd < r ? xcd * (q + 1) : r * (q + 1) + (xcd - r) * q) + off; }
        const int nig = WGM * nN, gid = wgid / nig, fm = gid * WGM, gsz = (nM - fm) < WGM ? (nM - fm) : WGM;
        u.pm = fm + ((wgid % nig) % gsz); u.pn = (wgid % nig) / gsz; return true;
    }
    __device__ __forceinline__ void a_ready(const Unit&) const {}
    __device__ __forceinline__ void done(const Unit&) const {}
};

__device__ __forceinline__ unsigned cvt_pk_bf16(float lo, float hi) { unsigned r; asm volatile("v_cvt_pk_bf16_f32 %0, %1, %2" : "=v"(r) : "v"(lo), "v"(hi)); return r; }

struct EpiBf16 {
    static constexpr bool PERM = true, AFTER_DRAIN = false, PERM_A = false;
    bf16_t* O; int ldc;
    __device__ __forceinline__ void operator()(const f32x4 (&acc)[2][2][4][2], const Unit& u, int wr, int wc, int fr, int fq) const {
        const int row0 = u.pm * BM + wr * 64 + fr, col0 = u.pn * BM + wc * 32 + 8 * fq;
#pragma unroll
        for (int ai = 0; ai < 2; ++ai)
#pragma unroll
            for (int m = 0; m < 4; ++m) { bf16_t* rowp = O + (size_t)(row0 + ai * HALF + m * 16) * ldc + col0;
#pragma unroll
                for (int bj = 0; bj < 2; ++bj) { const f32x4 v0 = acc[ai][bj][m][0], v1 = acc[ai][bj][m][1];
                    u32x4 w; w.x = cvt_pk_bf16(v0[0], v0[1]); w.y = cvt_pk_bf16(v0[2], v0[3]); w.z = cvt_pk_bf16(v1[0], v1[1]); w.w = cvt_pk_bf16(v1[2], v1[3]);
                    *(u32x4*)(rowp + bj * HALF) = w; } }
    }
};
struct EpiAB {
    static constexpr bool PERM = true, AFTER_DRAIN = false, PERM_A = false;
    bf16_t* O;
    __device__ __forceinline__ void operator()(const f32x4 (&acc)[2][2][4][2], const Unit& u, int wr, int wc, int fr, int fq) const {
        const int row0 = u.pm * BM + wr * 64 + fr;
        if (u.pn >= 16 && u.pn < 24) {
            const int col0 = 2048 + (u.pn - 16) * BM + wc * 32 + 8 * fq;
#pragma unroll
            for (int ai = 0; ai < 2; ++ai)
#pragma unroll
                for (int m = 0; m < 4; ++m) { bf16_t* rowp = O + (size_t)(row0 + ai * HALF + m * 16) * 6144 + col0;
#pragma unroll
                    for (int bj = 0; bj < 2; ++bj) { const f32x4 v0 = acc[ai][bj][m][0], v1 = acc[ai][bj][m][1];
                        u32x4 w; w.x = cvt_pk_bf16(v0[0], v0[1]); w.y = cvt_pk_bf16(v0[2], v0[3]); w.z = cvt_pk_bf16(v1[0], v1[1]); w.w = cvt_pk_bf16(v1[2], v1[3]);
                        *(u32x4*)(rowp + bj * HALF) = w; } }
            return;
        }
        const bool glu = u.pn < 16;
        const int col0 = (glu ? u.pn * 128 : 4096 + (u.pn - 24) * 128) + wc * 32 + 8 * fq;
#pragma unroll
        for (int ai = 0; ai < 2; ++ai)
#pragma unroll
            for (int m = 0; m < 4; ++m) { float o[8];
#pragma unroll
                for (int n = 0; n < 2; ++n)
#pragma unroll
                    for (int j = 0; j < 4; ++j) { const float x = acc[ai][0][m][n][j], y = acc[ai][1][m][n][j];
                        o[4 * n + j] = glu ? x * __builtin_amdgcn_rcpf(1.0f + __expf(-y)) : x * y; }
                u32x4 w; w.x = cvt_pk_bf16(o[0], o[1]); w.y = cvt_pk_bf16(o[2], o[3]); w.z = cvt_pk_bf16(o[4], o[5]); w.w = cvt_pk_bf16(o[6], o[7]);
                *(u32x4*)(O + (size_t)(row0 + ai * HALF + m * 16) * 6144 + col0) = w; }
    }
};
struct EpiMIn {
    static constexpr bool PERM = true, AFTER_DRAIN = false, PERM_A = false;
    bf16_t* O; int ldc; float* gates; bf16_t* QT;
    __device__ __forceinline__ void operator()(const f32x4 (&acc)[2][2][4][2], const Unit& u, int wr, int wc, int fr, int fq) const {
        const int row0 = u.pm * BM + wr * 64 + fr;
        if (u.pn < 8) {
#pragma unroll
            for (int ai = 0; ai < 2; ++ai)
#pragma unroll
                for (int m = 0; m < 4; ++m) { const int rb = (u.pm * BM + wr * 64 + ai * HALF + m * 16) >> 4;
#pragma unroll
                    for (int bj = 0; bj < 2; ++bj) { const f32x4 v0 = acc[ai][bj][m][0], v1 = acc[ai][bj][m][1];
                        u32x4 w; w.x = cvt_pk_bf16(v0[0], v0[1]); w.y = cvt_pk_bf16(v0[2], v0[3]); w.z = cvt_pk_bf16(v1[0], v1[1]); w.w = cvt_pk_bf16(v1[2], v1[3]);
                        *(u32x4*)(QT + ((size_t)rb * 64 + (u.pn * 8 + bj * 4 + wc)) * 512 + (fr + 16 * fq) * 8) = w; } }
        } else if (u.pn < 48) {
            const int col0 = u.pn * BM + wc * 32 + 8 * fq;
#pragma unroll
            for (int ai = 0; ai < 2; ++ai)
#pragma unroll
                for (int m = 0; m < 4; ++m) { bf16_t* rowp = O + (size_t)(row0 + ai * HALF + m * 16) * ldc + col0;
#pragma unroll
                    for (int bj = 0; bj < 2; ++bj) { const f32x4 v0 = acc[ai][bj][m][0], v1 = acc[ai][bj][m][1];
                        u32x4 w; w.x = cvt_pk_bf16(v0[0], v0[1]); w.y = cvt_pk_bf16(v0[2], v0[3]); w.z = cvt_pk_bf16(v1[0], v1[1]); w.w = cvt_pk_bf16(v1[2], v1[3]);
                        *(u32x4*)(rowp + bj * HALF) = w; } }
        } else if (wc == 0) {
#pragma unroll
            for (int ai = 0; ai < 2; ++ai)
#pragma unroll
                for (int m = 0; m < 4; ++m) { float* rowp = gates + (size_t)(row0 + ai * HALF + m * 16) * 32 + 8 * fq;
#pragma unroll
                    for (int n = 0; n < 2; ++n) *(f32x4*)(rowp + 4 * n) = acc[ai][0][m][n]; }
        }
    }
};

__device__ __forceinline__ float dpp_ror1(float v) { return __builtin_bit_cast(float, __builtin_amdgcn_update_dpp(0, __builtin_bit_cast(int, v), 0x121, 0xf, 0xf, false)); }
__device__ __forceinline__ float dpp_rol1(float v) { return __builtin_bit_cast(float, __builtin_amdgcn_update_dpp(0, __builtin_bit_cast(int, v), 0x12F, 0xf, 0xf, false)); }
template <bool NOLOAD = false, bool NOSTORE = false> struct EpiGateT {
    static constexpr bool PERM = true, AFTER_DRAIN = false, PERM_A = true;
    bf16_t* G; bf16_t* UC; const float* cw;
    __device__ __forceinline__ static float shr1(float v) { return __builtin_bit_cast(float, __builtin_amdgcn_update_dpp(0, __builtin_bit_cast(int, v), 0x111, 0xf, 0xf, true)); }
    __device__ __forceinline__ static float shl1(float v) { return __builtin_bit_cast(float, __builtin_amdgcn_update_dpp(0, __builtin_bit_cast(int, v), 0x101, 0xf, 0xf, true)); }
    __device__ __forceinline__ void operator()(const f32x4 (&acc)[2][2][4][2], const Unit& u, int wr, int wc, int fr, int fq) const {
        const int row0 = u.pm * BM + wr * 64 + 4 * fr;
        if (u.pm >= 64) {
            const int col0 = u.pn * BM + wc * 32 + 8 * fq;
#pragma unroll
            for (int ai = 0; ai < 2; ++ai)
#pragma unroll
                for (int m = 0; m < 4; ++m) { bf16_t* rowp = UC + (size_t)(row0 - 64 * BM + ai * HALF + m) * 22016 + col0;
#pragma unroll
                    for (int bj = 0; bj < 2; ++bj) { const f32x4 v0 = acc[ai][bj][m][0], v1 = acc[ai][bj][m][1];
                        u32x4 w; w.x = cvt_pk_bf16(v0[0], v0[1]); w.y = cvt_pk_bf16(v0[2], v0[3]); w.z = cvt_pk_bf16(v1[0], v1[1]); w.w = cvt_pk_bf16(v1[2], v1[3]);
                        *(u32x4*)(rowp + bj * HALF) = w; } }
            return;
        }
        const int ch = u.pn * 128 + wc * 32 + 8 * fq;
        typedef unsigned u32x2 __attribute__((ext_vector_type(2)));
        u32x2 pw[2][4];
#pragma unroll
        for (int n = 0; n < 2; ++n) {
            f32x4 wg[3], wv[3];
#pragma unroll
            for (int k = 0; k < 3; ++k) { if (NOLOAD) { wg[k] = (f32x4){0.3f, 0.4f, 0.5f, 0.6f}; wv[k] = (f32x4){0.6f, 0.5f, 0.4f, 0.3f}; } else { wg[k] = *(const f32x4*)(cw + k * 22016 + ch + 4 * n); wv[k] = *(const f32x4*)(cw + k * 22016 + 11008 + ch + 4 * n); } }
#pragma unroll
            for (int ai = 0; ai < 2; ++ai) {
                float o[4][4];
                typedef float f32x2_ __attribute__((ext_vector_type(2)));
#pragma unroll
                for (int jp = 0; jp < 4; jp += 2) {
                    float gg[4][2], vv[4][2];
#pragma unroll
                    for (int jj = 0; jj < 2; ++jj) { const int j = jp + jj;
                        const float gp = shr1(acc[ai][0][3][n][j]), gn = shl1(acc[ai][0][0][n][j]), vp = shr1(acc[ai][1][3][n][j]), vn = shl1(acc[ai][1][0][n][j]);
#pragma unroll
                        for (int m = 0; m < 4; ++m) {
                            const float gL = m > 0 ? acc[ai][0][m - 1][n][j] : gp, gR = m < 3 ? acc[ai][0][m + 1][n][j] : gn;
                            const float vL = m > 0 ? acc[ai][1][m - 1][n][j] : vp, vR = m < 3 ? acc[ai][1][m + 1][n][j] : vn;
                            gg[m][jj] = wg[0][j] * gL + wg[1][j] * acc[ai][0][m][n][j] + wg[2][j] * gR;
                            vv[m][jj] = wv[0][j] * vL + wv[1][j] * acc[ai][1][m][n][j] + wv[2][j] * vR; } }
#pragma unroll
                    for (int m = 0; m < 4; ++m) { const f32x2_ G = {gg[m][0], gg[m][1]}, V = {vv[m][0], vv[m][1]};
                        const f32x2_ t = G * -1.44269504088896341f;
                        const f32x2_ d = (f32x2_){__builtin_amdgcn_exp2f(t.x), __builtin_amdgcn_exp2f(t.y)} + 1.0f;
                        const f32x2_ r = {__builtin_amdgcn_rcpf(d.x), __builtin_amdgcn_rcpf(d.y)};
                        const f32x2_ oo = (G * r) * V;
                        o[m][jp] = oo.x; o[m][jp + 1] = oo.y; }
                }
#pragma unroll
                for (int m = 0; m < 4; ++m) { u32x2 w; w.x = cvt_pk_bf16(o[m][0], o[m][1]); w.y = cvt_pk_bf16(o[m][2], o[m][3]);
                    if (n == 0) pw[ai][m] = w;
                    else { u32x4 w4; w4.x = pw[ai][m].x; w4.y = pw[ai][m].y; w4.z = w.x; w4.w = w.y;
                        if (NOSTORE) asm volatile("" :: "v"(w4)); else *(u32x4*)(G + (size_t)(row0 + ai * HALF + m) * 11008 + ch) = w4; } }
                __builtin_amdgcn_sched_barrier(0);
            }
        }
    }
};
typedef EpiGateT<false, false> EpiGate;

__device__ __forceinline__ f32x4 zero4() { typedef float f32x2z __attribute__((ext_vector_type(2))); f32x2z lo, hi;
    asm volatile("v_pk_mov_b32 %0, 0, 0\n\tv_pk_mov_b32 %1, 0, 0" : "=v"(lo), "=v"(hi)); return __builtin_shufflevector(lo, hi, 0, 1, 2, 3); }
template <class Epi, class Sched, bool ALIGN_EPI = false, bool SP2 = false>
__device__ __forceinline__ void gemm_phase(PG8_LAS unsigned char* lds, const Gemm g, const Sched& S, const Epi& E, const int tid) {
    const int wid = __builtin_amdgcn_readfirstlane(tid >> 6), lane = tid & 63, wr = wid >> 2, wc = wid & 3, fr = lane & 15, fq = lane >> 4;
    const int K = g.K, nt = K / BK;
    unsigned voffA[2], voffB[2];
#pragma unroll
    for (int i = 0; i < 2; ++i) { int R, C; stage_rc(tid * 16 + i * 8192, R, C); const int Rb = Epi::PERM ? ((R & ~31) + perm32(R & 31)) : R;
        const int Ra = Epi::PERM_A ? ((R & ~63) + 4 * (R & 15) + ((R >> 4) & 3)) : R;
        voffA[i] = (unsigned)(Ra * K + C) * 2u; voffB[i] = (unsigned)(Rb * K + C) * 2u; }
    const size_t kstep = (size_t)(BK * 2);
    const size_t hstep = (size_t)HALF * K * 2;
    const size_t tstep = 2 * hstep;
    const unsigned ldsw = (unsigned)wid * 1024u;
    const int aoff = lds_byte(wr * 64 + fr, fq * 8), boff = lds_byte(wc * 32 + fr, fq * 8);
#define PG8_SA(b, h) (((b) * 2 + (h)) * HTB)
#define PG8_SB(b, h) ((4 + (b) * 2 + (h)) * HTB)
#define PG8_STAGE(bufoff, gbase, voff) do { _Pragma("unroll") for (int _i = 0; _i < 2; ++_i) \
        __builtin_amdgcn_global_load_lds((const unsigned*)((const char*)(gbase) + (voff)[_i]), (PG8_LAS unsigned*)(lds + (bufoff) + ldsw + _i * 8192), 16, 0, 0); } while (0)
#define PG8_LDA(dst, b, h) do { _Pragma("unroll") for (int m = 0; m < 4; ++m) _Pragma("unroll") for (int k = 0; k < 2; ++k) dst[m][k] = *(const PG8_LAS bf16x8*)(lds + PG8_SA(b, h) + aoff + m * 2048 + k * 1024); } while (0)
#define PG8_LDB(dst, b, h) do { _Pragma("unroll") for (int n = 0; n < 2; ++n) _Pragma("unroll") for (int k = 0; k < 2; ++k) dst[n][k] = *(const PG8_LAS bf16x8*)(lds + PG8_SB(b, h) + boff + n * 2048 + k * 1024); } while (0)
#define PG8_MMA(ai, bj, At, Bt) do { __builtin_amdgcn_s_setprio(1); _Pragma("unroll") for (int m = 0; m < 4; ++m) _Pragma("unroll") for (int n = 0; n < 2; ++n) _Pragma("unroll") for (int k = 0; k < 2; ++k) \
        acc[ai][bj][m][n] = __builtin_amdgcn_mfma_f32_16x16x32_bf16(Bt[n][k], At[m][k], acc[ai][bj][m][n], 0, 0, 0); __builtin_amdgcn_s_setprio(0); } while (0)
#define PG8_WAIT_V(n) asm volatile("s_waitcnt vmcnt(" #n ")" ::: "memory")
#define PG8_WAIT_L(n) asm volatile("s_waitcnt lgkmcnt(" #n ")" ::: "memory")
#define PG8_BAR __builtin_amdgcn_s_barrier()
#define PG8_SCHED __builtin_amdgcn_sched_barrier(0)
    Unit cur, nxt; int ui = 0;
    if (!S.next(0, cur)) return;
    f32x4 acc[2][2][4][2];
#pragma unroll
    for (int a = 0; a < 2; ++a)
#pragma unroll
        for (int b = 0; b < 2; ++b)
#pragma unroll
            for (int m = 0; m < 4; ++m)
#pragma unroll
                for (int n = 0; n < 2; ++n) acc[a][b][m][n] = zero4();
    bf16x8 At[4][2], B0[2][2], B1[2][2];
    const char* cA = (const char*)g.A + (size_t)cur.pm * tstep; const char* cB = (const char*)g.Bt + (size_t)cur.pn * tstep;
    S.a_ready(cur);
    if constexpr (SP2) {
        PG8_STAGE(PG8_SB(0, 0), cB, voffB); PG8_STAGE(PG8_SB(0, 1), cB + hstep, voffB); PG8_STAGE(PG8_SA(0, 0), cA, voffA); PG8_STAGE(PG8_SA(0, 1), cA + hstep, voffA);
        if (wr == 1) PG8_BAR;
        PG8_WAIT_V(2); PG8_BAR;
        PG8_STAGE(PG8_SB(1, 0), cB + kstep, voffB); PG8_STAGE(PG8_SA(1, 0), cA + kstep, voffA); PG8_STAGE(PG8_SB(1, 1), cB + hstep + kstep, voffB);
        PG8_WAIT_V(6); PG8_BAR;
    } else {
        PG8_STAGE(PG8_SB(0, 0), cB, voffB); PG8_STAGE(PG8_SA(0, 0), cA, voffA); PG8_STAGE(PG8_SB(0, 1), cB + hstep, voffB); PG8_STAGE(PG8_SA(0, 1), cA + hstep, voffA);
        if (wr == 1) PG8_BAR;
        PG8_WAIT_V(4); PG8_BAR;
        PG8_STAGE(PG8_SB(1, 0), cB + kstep, voffB); PG8_STAGE(PG8_SA(1, 0), cA + kstep, voffA); PG8_STAGE(PG8_SB(1, 1), cB + hstep + kstep, voffB);
        PG8_WAIT_V(6); PG8_BAR;
    }
    for (;;) {
        const bool has_next = S.next(ui + 1, nxt);
        const char* nA = has_next ? (const char*)g.A + (size_t)nxt.pm * tstep : cA; const char* nB = has_next ? (const char*)g.Bt + (size_t)nxt.pn * tstep : cB;
        for (int t = 0; t < nt; t += 2) {
            const bool last = (t == nt - 2);
            const char* a1 = cA + (size_t)(t + 1) * kstep;
            const char* a2 = last ? nA : cA + (size_t)(t + 2) * kstep; const char* b2 = last ? nB : cB + (size_t)(t + 2) * kstep;
            const char* a3 = a2 + kstep; const char* b3 = b2 + kstep;
            if (last && has_next) S.a_ready(nxt);
            if constexpr (SP2) {
            PG8_LDB(B0, 0, 0); PG8_LDB(B1, 0, 1); PG8_SCHED; PG8_LDA(At, 0, 0); PG8_STAGE(PG8_SA(1, 1), a1 + hstep, voffA);
            PG8_WAIT_V(8); PG8_WAIT_L(0); PG8_BAR; PG8_MMA(0, 0, At, B0); PG8_MMA(0, 1, At, B1); PG8_BAR; PG8_SCHED;
            PG8_LDA(At, 0, 1); PG8_STAGE(PG8_SB(0, 0), b2, voffB); PG8_STAGE(PG8_SB(0, 1), b2 + hstep, voffB); PG8_STAGE(PG8_SA(0, 0), a2, voffA);
            PG8_WAIT_V(8); PG8_WAIT_L(0); PG8_BAR; PG8_MMA(1, 0, At, B0); PG8_MMA(1, 1, At, B1); PG8_BAR; PG8_SCHED;
            PG8_LDB(B0, 1, 0); PG8_LDB(B1, 1, 1); PG8_SCHED; PG8_LDA(At, 1, 0); PG8_STAGE(PG8_SA(0, 1), a2 + hstep, voffA);
            PG8_WAIT_V(8); PG8_WAIT_L(0); PG8_BAR; PG8_MMA(0, 0, At, B0); PG8_MMA(0, 1, At, B1); PG8_BAR; PG8_SCHED;
            PG8_LDA(At, 1, 1); PG8_STAGE(PG8_SB(1, 0), b3, voffB); PG8_STAGE(PG8_SB(1, 1), b3 + hstep, voffB); PG8_STAGE(PG8_SA(1, 0), a3, voffA);
            PG8_WAIT_V(8); PG8_WAIT_L(0); PG8_BAR; PG8_MMA(1, 0, At, B0); PG8_MMA(1, 1, At, B1); PG8_BAR; PG8_SCHED;
            } else {
            PG8_LDB(B0, 0, 0); PG8_SCHED; PG8_LDA(At, 0, 0); PG8_STAGE(PG8_SA(1, 1), a1 + hstep, voffA);
            PG8_WAIT_L(8); PG8_BAR; PG8_WAIT_L(0); PG8_MMA(0, 0, At, B0); PG8_BAR; PG8_SCHED;
            PG8_LDB(B1, 0, 1); PG8_STAGE(PG8_SB(0, 0), b2, voffB);
            PG8_BAR; PG8_WAIT_L(0); PG8_MMA(0, 1, At, B1); PG8_BAR;
            PG8_LDA(At, 0, 1); PG8_STAGE(PG8_SA(0, 0), a2, voffA);
            PG8_BAR; PG8_WAIT_L(0); PG8_MMA(1, 0, At, B0); PG8_BAR; PG8_SCHED;
            PG8_STAGE(PG8_SB(0, 1), b2 + hstep, voffB);
            PG8_WAIT_V(6); PG8_BAR; PG8_MMA(1, 1, At, B1); PG8_BAR;
            PG8_LDB(B0, 1, 0); PG8_SCHED; PG8_LDA(At, 1, 0); PG8_STAGE(PG8_SA(0, 1), a2 + hstep, voffA);
            PG8_WAIT_L(8); PG8_BAR; PG8_WAIT_L(0); PG8_MMA(0, 0, At, B0); PG8_BAR; PG8_SCHED;
            PG8_LDB(B1, 1, 1); PG8_STAGE(PG8_SB(1, 0), b3, voffB);
            PG8_BAR; PG8_WAIT_L(0); PG8_MMA(0, 1, At, B1); PG8_BAR;
            PG8_LDA(At, 1, 1); PG8_STAGE(PG8_SA(1, 0), a3, voffA);
            PG8_BAR; PG8_WAIT_L(0); PG8_MMA(1, 0, At, B0); PG8_BAR; PG8_SCHED;
            PG8_STAGE(PG8_SB(1, 1), b3 + hstep, voffB);
            PG8_WAIT_V(6); PG8_BAR; PG8_MMA(1, 1, At, B1); PG8_BAR;
            }
        }
        if constexpr (ALIGN_EPI) { if (wr == 0) PG8_BAR; }
        if constexpr (!Epi::AFTER_DRAIN) { E(acc, cur, wr, wc, fr, fq); S.done(cur); }
        if (!has_next) break;
#pragma unroll
        for (int a = 0; a < 2; ++a)
#pragma unroll
            for (int b = 0; b < 2; ++b)
#pragma unroll
                for (int m = 0; m < 4; ++m)
#pragma unroll
                    for (int n = 0; n < 2; ++n) acc[a][b][m][n] = zero4();
        cur = nxt; cA = nA; cB = nB; ++ui;
        if constexpr (ALIGN_EPI) { if (wr == 1) PG8_BAR; }
    }
    PG8_WAIT_V(0);
    if constexpr (!ALIGN_EPI) { if (wr == 0) PG8_BAR; }
    PG8_BAR;
#undef PG8_SA
#undef PG8_SB
#undef PG8_STAGE
#undef PG8_LDA
#undef PG8_LDB
#undef PG8_MMA
#undef PG8_WAIT_V
#undef PG8_WAIT_L
#undef PG8_BAR
#undef PG8_SCHED
}
}

constexpr int NWAVES = 8, NTHREADS = 512;
constexpr int D = 4096, BATCH = 2, SEQ = 8192, CTXL = 256;
constexpr int ML = BATCH * SEQ;
constexpr int MC = BATCH * CTXL;
constexpr int MT = ML + MC;
constexpr int NMODC = 6 * D;
constexpr int WA = 2048, ABIN = 10240, ABU = 6144, ACONV = 31;
constexpr int HEADS = 8, DQK = 256, DV = 512;
constexpr int QKVO = 12288, CIN = 12320, CINP = 12544;
constexpr int DFF = 11008, DFF2 = 22016;
constexpr int NCH = 66;
constexpr float EPS = 1e-6f;

constexpr size_t MiB = 1u << 20;
constexpr size_t WS_CTL = 0, CTL_ZERO_BYTES = 1 * MiB;
constexpr size_t WS_MOD = 1 * MiB;
constexpr size_t WS_SCP = 2 * MiB;
constexpr size_t WS_SCC = 7 * MiB;
constexpr size_t WS_GATES = 8 * MiB;
constexpr size_t WS_CTXS = 12 * MiB;
constexpr size_t WS_WABIN = 20 * MiB;
constexpr size_t WS_WABOUT = 100 * MiB;
constexpr size_t WS_WMIN = 132 * MiB;
constexpr size_t WS_WMOUT = 230 * MiB;
constexpr size_t WS_WUP0 = 262 * MiB;
constexpr size_t WS_WDN0 = 606 * MiB;
constexpr size_t WS_H = 778 * MiB;
constexpr size_t WS_U = 910 * MiB;
constexpr size_t WS_UC = 1590 * MiB;
constexpr size_t WS_G = 1620 * MiB;
constexpr size_t WS_Y = 1975 * MiB;
constexpr size_t WS_HS = 2239 * MiB;
constexpr size_t WS_XB = 2751 * MiB;
constexpr size_t WS_END = 2883 * MiB;
static_assert(WS_WUP0 + 2 * 172 * MiB == WS_WDN0 && WS_WDN0 + 2 * 86 * MiB <= WS_H, "ws map");
static_assert((size_t)DFF2 * D * 2 <= 172 * MiB && (size_t)D * DFF * 2 <= 86 * MiB && (size_t)CINP * D * 2 <= 98 * MiB, "ws map");
static_assert(WS_H + (size_t)MT * D * 2 <= WS_U && WS_U + (size_t)MT * DFF2 * 2 <= WS_G && WS_G + (size_t)MT * DFF * 2 <= WS_Y && WS_Y + (size_t)MT * D * 4 <= WS_HS && WS_HS + (size_t)2 * ML * D * 4 <= WS_XB && WS_XB + (size_t)MT * D * 2 <= WS_END, "ws map");
static_assert(WS_SCP + (size_t)32 * NCH * 3 * 128 * 4 <= WS_SCC && WS_GATES + (size_t)MT * 32 * 4 <= WS_CTXS && WS_CTXS + (size_t)MC * D * 4 <= WS_WABIN, "ws map");

constexpr int CW_BAR = 4096;
constexpr int LDS_BYTES = 163840;
constexpr int MISC_OFF = LDS_BYTES - 64;

#define LAS __attribute__((address_space(3)))
typedef unsigned short bf16;
typedef unsigned v4u __attribute__((ext_vector_type(4)));
typedef unsigned v2u __attribute__((ext_vector_type(2)));
typedef float f32x4 __attribute__((ext_vector_type(4)));
typedef float f32x2 __attribute__((ext_vector_type(2)));
typedef short bf16x8 __attribute__((ext_vector_type(8)));
typedef short s16x4 __attribute__((ext_vector_type(4)));
#define LDS_WAIT() asm volatile("s_waitcnt lgkmcnt(0)" ::: "memory")

__device__ __forceinline__ unsigned f2bf(float f) { unsigned u = __builtin_bit_cast(unsigned, f); return (u + 0x7fffu + ((u >> 16) & 1u)) >> 16; }
__device__ __forceinline__ unsigned pk2(float lo, float hi) { unsigned r; asm("v_cvt_pk_bf16_f32 %0, %1, %2" : "=v"(r) : "v"(lo), "v"(hi)); return r; }
__device__ __forceinline__ float bflo(unsigned w) { return __builtin_bit_cast(float, w << 16); }
__device__ __forceinline__ float bfhi(unsigned w) { return __builtin_bit_cast(float, w & 0xffff0000u); }
__device__ __forceinline__ float bf1(unsigned short h) { return __builtin_bit_cast(float, ((unsigned)h) << 16); }
__device__ __forceinline__ void cvt8(const v4u r, float (&f)[8]) {
    f[0] = bflo(r.x); f[1] = bfhi(r.x); f[2] = bflo(r.y); f[3] = bfhi(r.y); f[4] = bflo(r.z); f[5] = bfhi(r.z); f[6] = bflo(r.w); f[7] = bfhi(r.w);
}
__device__ __forceinline__ float sigmoidf_(float x) { return __builtin_amdgcn_rcpf(1.0f + __expf(-x)); }
__device__ __forceinline__ float siluf_(float x) { return x * sigmoidf_(x); }
__device__ __forceinline__ float wave_sum(float v) {
#pragma unroll
    for (int o = 1; o < 64; o <<= 1) v += __shfl_xor(v, o);
    return v;
}

#define XB_TMO      128
#define XB_XCNT(j)  (256  + 64 * (j))
#define XB_XSUB(j)  (1280 + 64 * (j))
#define XB_XGEN(j)  (2304 + 64 * (j))
#define XB_TOP      3328
#define XB_TOPGEN   3392
#define XCD_BAR_WORDS 3456
#define XB_SPIN_CAP (1u << 22)

__device__ __forceinline__ unsigned xb_ld(unsigned* p)              { return __hip_atomic_load(p, __ATOMIC_RELAXED, __HIP_MEMORY_SCOPE_AGENT); }
__device__ __forceinline__ unsigned xb_add(unsigned* p, unsigned v) { return __hip_atomic_fetch_add(p, v, __ATOMIC_RELAXED, __HIP_MEMORY_SCOPE_AGENT); }
__device__ __forceinline__ unsigned xb_xcc_id() { return (unsigned)__builtin_amdgcn_s_getreg((3 << 11) | 20) & 0xFu; }
#define XB_SPIN(cond, bar) do { unsigned _sp = 0; while (cond) { __builtin_amdgcn_s_sleep(1); \
    if ((++_sp & 255u) == 0u) { if (xb_ld(&(bar)[XB_TMO])) break; if (_sp > XB_SPIN_CAP) { atomicAdd(&(bar)[XB_TMO], 1u); break; } } } } while (0)

struct XcdBarrier { unsigned* bar; unsigned x; volatile LAS unsigned* st; };

__device__ __forceinline__ XcdBarrier xcd_barrier_post(unsigned* bar, volatile LAS unsigned* st) {
    XcdBarrier b; b.bar = bar; b.x = xb_xcc_id(); b.st = st;
    if (threadIdx.x == 0) (void)xb_add(&bar[XB_XCNT(b.x)], 1u);
    return b;
}
__device__ __forceinline__ void xcd_barrier_complete(unsigned* bar, unsigned x, unsigned& nloc, unsigned& nx) {
    const unsigned G = gridDim.x * gridDim.y * gridDim.z;
    unsigned sum, cnt, mine, sp = 0u;
    for (;;) {
        sum = 0u; cnt = 0u; mine = 0u;
#pragma unroll
        for (unsigned j = 0; j < 16; ++j) { const unsigned c = xb_ld(&bar[XB_XCNT(j)]); sum += c; cnt += (c > 0u) ? 1u : 0u; mine = (j == x) ? c : mine; }
        if (sum == G) break;
        __builtin_amdgcn_s_sleep(1);
        if ((++sp & 255u) == 0u) { if (xb_ld(&bar[XB_TMO])) break; if (sp > XB_SPIN_CAP) { atomicAdd(&bar[XB_TMO], 1u); break; } }
    }
    nloc = mine > 0u ? mine : 1u; nx = cnt > 0u ? cnt : 1u;
}
__device__ __forceinline__ void xcd_barrier(const XcdBarrier& b) {
    asm volatile("s_waitcnt vmcnt(0)" ::: "memory");
    __syncthreads();
    if (threadIdx.x == 0) {
        unsigned* bar = b.bar;
        __builtin_amdgcn_s_waitcnt(0);
        unsigned nloc = b.st[0], nx = b.st[1];
        if (nloc == 0u) { xcd_barrier_complete(bar, b.x, nloc, nx); b.st[0] = nloc; b.st[1] = nx; }
        const unsigned old = xb_add(&bar[XB_XSUB(b.x)], 1u);
        const unsigned gen = old / nloc;
        if (old + 1u == (gen + 1u) * nloc) {
            __builtin_amdgcn_fence(__ATOMIC_RELEASE, "agent");
            asm volatile("s_waitcnt vmcnt(0)" ::: "memory");
            const unsigned og = xb_add(&bar[XB_TOP], 1u);
            const unsigned tg = og / nx;
            if (og + 1u == (tg + 1u) * nx) xb_add(&bar[XB_TOPGEN], 1u);
            else XB_SPIN(xb_ld(&bar[XB_TOPGEN]) == tg, bar);
            __builtin_amdgcn_fence(__ATOMIC_ACQUIRE, "agent");
            xb_add(&bar[XB_XGEN(b.x)], 1u);
            asm volatile("s_waitcnt vmcnt(0)" ::: "memory");
        } else {
            XB_SPIN(xb_ld(&bar[XB_XGEN(b.x)]) == gen, bar);
            __builtin_amdgcn_fence(__ATOMIC_ACQUIRE, "agent");
            asm volatile("s_waitcnt vmcnt(0)" ::: "memory");
        }
    }
    __syncthreads();
}

struct Args { const float* in[21]; float* out; unsigned char* ws; int ph_lo, ph_hi; };
typedef const __attribute__((address_space(4))) Args* CArgs;
__device__ __forceinline__ int opaque_tid(int wave_s) { int t = wave_s * 64 + (int)__builtin_amdgcn_mbcnt_hi(~0u, __builtin_amdgcn_mbcnt_lo(~0u, 0u)); asm volatile("" : "+v"(t)); return t; }
__device__ __forceinline__ CArgs get_args() { CArgs p = (CArgs)__builtin_amdgcn_kernarg_segment_ptr(); asm volatile("" : "+s"(p)); return p; }
enum { I_X = 0, I_C, I_CTX, I_CCTX, I_ADAW, I_ADAB, I_NORMG, I_ABWIN, I_ACONVW, I_ACONVB, I_ALNG, I_ALNB, I_BCONVW, I_ABWOUT, I_MWIN, I_MBG, I_MHNG, I_MWOUT, I_FUP, I_FCONV, I_FDN };

template <int MODE> __device__ __forceinline__ int perm_row(int n0) {
    if (MODE == 1) return n0 < DFF ? 256 * (n0 / 128) + (n0 % 128) : 256 * ((n0 - DFF) / 128) + 128 + ((n0 - DFF) % 128);
    if (MODE == 2) { if (n0 < 4096) { const int ch = n0 & 2047, hi = n0 >> 11; return 256 * (ch / 128) + 128 * hi + (ch % 128); }
                     if (n0 < 6144) return n0;
                     const int j = n0 - 6144, ch = j & 2047, hi = j >> 11; return 6144 + 256 * (ch / 128) + 128 * hi + (ch % 128); }
    return n0;
}
template <int GATE_PERM = 0>
__device__ __forceinline__ void p0_transpose_item(const float* W, int K, int N, bf16* WT, LAS float* scr, int item, int lane) {
    const int nblk = N / 32, kb = item / nblk, nb = item % nblk, k0 = 64 * kb, n0 = 32 * nb;
    const int r0 = perm_row<GATE_PERM>(n0);
#pragma unroll 8
    for (int i = 0; i < 32; ++i) { const int kk = 2 * i + (lane >> 5); scr[kk * 33 + (lane & 31)] = W[(size_t)(k0 + kk) * N + n0 + (lane & 31)]; }
    LDS_WAIT(); asm volatile("" ::: "memory");
    const int c = lane & 7;
#pragma unroll
    for (int j = 0; j < 4; ++j) { const int n = (lane >> 3) + 8 * j; const LAS float* s = scr + (8 * c) * 33 + n;
        v4u o; o.x = pk2(s[0 * 33], s[1 * 33]); o.y = pk2(s[2 * 33], s[3 * 33]); o.z = pk2(s[4 * 33], s[5 * 33]); o.w = pk2(s[6 * 33], s[7 * 33]);
        __builtin_nontemporal_store(o, (v4u*)(WT + (size_t)(r0 + n) * K + k0 + 8 * c)); }
    LDS_WAIT(); asm volatile("" ::: "memory");
}

__device__ __forceinline__ void gemv_units(CArgs a, LAS unsigned char* lds, int layer, int first, int stride, int tid, int lane, int wave) {
    float* MOD = (float*)(a->ws + WS_MOD);
    LAS float* sv = (LAS float*)lds;
    LAS float* red = (LAS float*)(lds + 49152);
    for (int i = tid; i < 3 * D; i += NTHREADS) { const int r = i / D, k = i % D; const float v = (r < 2) ? a->in[I_C][r * D + k] : a->in[I_CCTX][k]; sv[i] = siluf_(v); }
    __syncthreads();
    for (int unit = first; unit < 768; unit += stride) {
        const int n0 = unit * 32;
        const int kg = wave * 8 + (lane >> 3), c4 = (lane & 7) * 4;
        const float* W = a->in[I_ADAW] + (size_t)layer * D * NMODC + (size_t)(kg * 64) * NMODC + n0 + c4;
        f32x4 a0 = {0.f, 0.f, 0.f, 0.f}, a1 = a0, a2 = a0;
        for (int k = 0; k < 64; k += 16) {
            f32x4 w[16];
#pragma unroll
            for (int j = 0; j < 16; ++j) w[j] = __builtin_nontemporal_load((const f32x4*)(W + (size_t)(k + j) * NMODC));
#pragma unroll
            for (int j = 0; j < 16; ++j) { const int kk = kg * 64 + k + j; a0 += w[j] * sv[kk]; a1 += w[j] * sv[D + kk]; a2 += w[j] * sv[2 * D + kk]; }
        }
        *(LAS f32x4*)(red + (kg * 3 + 0) * 32 + c4) = a0; *(LAS f32x4*)(red + (kg * 3 + 1) * 32 + c4) = a1; *(LAS f32x4*)(red + (kg * 3 + 2) * 32 + c4) = a2;
        __syncthreads();
        if (tid < 96) { const int r = tid >> 5, cc = tid & 31; float s = 0.f;
#pragma unroll 8
            for (int g = 0; g < 64; ++g) s += red[(g * 3 + r) * 32 + cc];
            MOD[((size_t)layer * 3 + r) * NMODC + n0 + cc] = s + a->in[I_ADAB][(size_t)layer * NMODC + n0 + cc]; }
        __syncthreads();
    }
}
template <int GATE_PERM>
__device__ __forceinline__ void transpose_item64(const float* W, int K, int N, bf16* WT, LAS float* scr, int item, int lane, int nblk) {
    const int kb = item / nblk, nb = item % nblk, k0 = 64 * kb, n0 = 64 * nb;
    const int r0 = perm_row<GATE_PERM>(n0);
    const int kq = lane >> 4, j4 = (lane & 15) * 4;
    f32x4 v[16];
#pragma unroll
    for (int i = 0; i < 16; ++i) v[i] = __builtin_nontemporal_load((const f32x4*)(W + (size_t)(k0 + 4 * i + kq) * N + n0 + j4));
#pragma unroll
    for (int i = 0; i < 16; ++i) { LAS float* p = scr + (4 * i + kq) * 65 + j4; p[0] = v[i].x; p[1] = v[i].y; p[2] = v[i].z; p[3] = v[i].w; }
    LDS_WAIT(); asm volatile("" ::: "memory");
    const int c = lane & 7;
#pragma unroll
    for (int j = 0; j < 8; ++j) { const int n = (lane >> 3) + 8 * j; const LAS float* p = scr + (8 * c) * 65 + n;
        v4u o; o.x = pk2(p[0 * 65], p[1 * 65]); o.y = pk2(p[2 * 65], p[3 * 65]); o.z = pk2(p[4 * 65], p[5 * 65]); o.w = pk2(p[6 * 65], p[7 * 65]);
        __builtin_nontemporal_store(o, (v4u*)(WT + (size_t)(r0 + n) * K + k0 + 8 * c)); }
    LDS_WAIT(); asm volatile("" ::: "memory");
}
template <int GATE_PERM>
__device__ __forceinline__ void conv_items(const float* W, int K, int N, bf16* WT, LAS unsigned char* lds, int first, int stride, int lane, int wave) {
    LAS float* scr = (LAS float*)(lds + wave * 16640);
    const int nb64 = N / 64, nitems = (K / 64) * nb64;
    for (int it = first; it < nitems; it += stride) transpose_item64<GATE_PERM>(W, K, N, WT, scr, it, lane, nb64);
    if (N % 64) for (int kb = first; kb < K / 64; kb += stride) p0_transpose_item<GATE_PERM>(W, K, N, WT, scr, kb * (N / 32) + (N / 32 - 1), lane);
}
enum { CV_ABIN = 0, CV_ABOUT, CV_MIN, CV_MOUT, CV_UP0, CV_UP1, CV_DN0, CV_DN1 };
template <int WHICH>
__device__ __forceinline__ void conv_matrix(CArgs a, LAS unsigned char* lds, int first, int stride, int lane, int wave) {
    unsigned char* ws = a->ws;
    if (WHICH == CV_ABIN) conv_items<2>(a->in[I_ABWIN], D, ABIN, (bf16*)(ws + WS_WABIN), lds, first, stride, lane, wave);
    if (WHICH == CV_ABOUT) conv_items<0>(a->in[I_ABWOUT], D, D, (bf16*)(ws + WS_WABOUT), lds, first, stride, lane, wave);
    if (WHICH == CV_MIN) { conv_items<0>(a->in[I_MWIN], D, CIN, (bf16*)(ws + WS_WMIN), lds, first, stride, lane, wave);
        v4u* p = (v4u*)((bf16*)(ws + WS_WMIN) + (size_t)CIN * D); const int n16 = (CINP - CIN) * D * 2 / 16;
        for (int i = first * 64 + lane; i < n16; i += stride * 64) p[i] = (v4u){0u, 0u, 0u, 0u}; }
    if (WHICH == CV_MOUT) conv_items<0>(a->in[I_MWOUT], D, D, (bf16*)(ws + WS_WMOUT), lds, first, stride, lane, wave);
    if (WHICH == CV_UP0) conv_items<1>(a->in[I_FUP], D, DFF2, (bf16*)(ws + WS_WUP0), lds, first, stride, lane, wave);
    if (WHICH == CV_UP1) conv_items<1>(a->in[I_FUP] + (size_t)D * DFF2, D, DFF2, (bf16*)(ws + WS_WUP0 + 172 * MiB), lds, first, stride, lane, wave);
    if (WHICH == CV_DN0) conv_items<0>(a->in[I_FDN], DFF, D, (bf16*)(ws + WS_WDN0), lds, first, stride, lane, wave);
    if (WHICH == CV_DN1) conv_items<0>(a->in[I_FDN] + (size_t)DFF * D, DFF, D, (bf16*)(ws + WS_WDN0 + 86 * MiB), lds, first, stride, lane, wave);
}
__device__ __forceinline__ void p0_prologue(CArgs a, LAS unsigned char* lds, int tid, int lane, int wave) {
    gemv_units(a, lds, 0, blockIdx.x, gridDim.x, tid, lane, wave);
    const int gw = blockIdx.x * NWAVES + wave, NGW = gridDim.x * NWAVES;
    conv_matrix<CV_ABIN>(a, lds, gw, NGW, lane, wave);
#if PROBE_E1
    conv_matrix<CV_ABOUT>(a, lds, gw, NGW, lane, wave);
    conv_matrix<CV_UP0>(a, lds, gw, NGW, lane, wave); conv_matrix<CV_DN0>(a, lds, gw, NGW, lane, wave); conv_matrix<CV_MIN>(a, lds, gw, NGW, lane, wave); conv_matrix<CV_MOUT>(a, lds, gw, NGW, lane, wave);
    conv_matrix<CV_UP1>(a, lds, gw, NGW, lane, wave); conv_matrix<CV_DN1>(a, lds, gw, NGW, lane, wave); __syncthreads(); gemv_units(a, lds, 1, blockIdx.x, gridDim.x, tid, lane, wave);
#endif
}
__device__ __forceinline__ int gemm_wgs(int nwg) { const int G = gridDim.x, rounds = (nwg + G - 1) / G; const int g = ((nwg + rounds - 1) / rounds + 7) & ~7; return g < G ? g : G; }

template <bool RES, bool DOH, bool XIN_BF, bool XOUT_BF>
__device__ __forceinline__ void row_phase(LAS unsigned char* lds, int nrows, const void* xin_lat, const void* xin_ctx, void* xout_lat, void* xout_ctx,
                                          const bf16* Y, const float* gpost, const float* modres, int gate_idx,
                                          const float* gpre, const float* modh, int shift_idx, int scale_idx, bf16* H, int tid, int lane, int wave) {
    LAS f32x4* pG = (LAS f32x4*)lds; LAS f32x4* pA = pG + 1024; LAS f32x4* pB = pA + 1024;
    const int G = gridDim.x, rpw = (nrows + G - 1) / G, r0 = (int)blockIdx.x * rpw, r1 = (r0 + rpw < nrows) ? r0 + rpw : nrows;
    for (int vb = r0; vb < r1;) {
        const int mr = vb < ML ? (vb >> 13) : 2;
        const int lim = mr == 0 ? SEQ : (mr == 1 ? ML : nrows), vend = r1 < lim ? r1 : lim;
        __syncthreads();
        for (int i = tid; i < 1024; i += NTHREADS) {
            if (RES) pG[i] = ((const f32x4*)(modres + (size_t)mr * NMODC + gate_idx * D))[i] * ((const f32x4*)gpost)[i];
            if (DOH) { pA[i] = ((const f32x4*)gpre)[i] * (((const f32x4*)(modh + (size_t)mr * NMODC + scale_idx * D))[i] + 1.0f); pB[i] = ((const f32x4*)(modh + (size_t)mr * NMODC + shift_idx * D))[i]; }
        }
        __syncthreads();
        for (int row = vb + wave; row < vend; row += NWAVES) {
            const float* xr = XIN_BF ? nullptr : (row < ML ? (const float*)xin_lat + (size_t)row * D : (const float*)xin_ctx + (size_t)(row - ML) * D);
            const bf16* xrb = XIN_BF ? (const bf16*)xin_lat + (size_t)row * D : nullptr;
            f32x4 v[16];
            if (RES) {
                const bf16* yr = Y + (size_t)row * D; float s = 0.f;
#pragma unroll
                for (int j = 0; j < 16; ++j) { const v2u yw = *(const v2u*)(yr + j * 256 + lane * 4); v[j] = (f32x4){bflo(yw.x), bfhi(yw.x), bflo(yw.y), bfhi(yw.y)}; s += (v[j].x * v[j].x + v[j].y * v[j].y) + (v[j].z * v[j].z + v[j].w * v[j].w); }
                const float rstd = 1.0f / sqrtf(wave_sum(s) * (1.0f / D) + EPS);
                float* xo = XOUT_BF ? nullptr : (row < ML ? (float*)xout_lat + (size_t)row * D : (float*)xout_ctx + (size_t)(row - ML) * D);
                bf16* xob = XOUT_BF ? (bf16*)xout_lat + (size_t)row * D : nullptr;
#pragma unroll
                for (int j = 0; j < 16; ++j) { const int o = j * 256 + lane * 4;
                    f32x4 x;
                    if (XIN_BF) { const v2u xw = *(const v2u*)(xrb + o); x = (f32x4){bflo(xw.x), bfhi(xw.x), bflo(xw.y), bfhi(xw.y)}; } else x = *(const f32x4*)(xr + o);
                    v[j] = x + (v[j] * rstd) * pG[j * 64 + lane];
                    if (XOUT_BF) { v2u w; w.x = pk2(v[j].x, v[j].y); w.y = pk2(v[j].z, v[j].w); *(v2u*)(xob + o) = w; } else *(f32x4*)(xo + o) = v[j];
                    if ((j & 3) == 3) asm volatile("" ::: "memory"); }
            } else {
#pragma unroll
                for (int j = 0; j < 16; ++j) v[j] = *(const f32x4*)(xr + j * 256 + lane * 4);
            }
            if (DOH) {
                float s = 0.f;
#pragma unroll
                for (int j = 0; j < 16; ++j) s += (v[j].x * v[j].x + v[j].y * v[j].y) + (v[j].z * v[j].z + v[j].w * v[j].w);
                const float rstd = 1.0f / sqrtf(wave_sum(s) * (1.0f / D) + EPS);
                bf16* hr = H + (size_t)row * D;
#pragma unroll
                for (int j = 0; j < 16; ++j) { const int o = j * 256 + lane * 4;
                    const f32x4 h = (v[j] * rstd) * pA[j * 64 + lane] + pB[j * 64 + lane];
                    v2u w; w.x = pk2(h.x, h.y); w.y = pk2(h.z, h.w);
                    *(v2u*)(hr + o) = w; }
            }
        }
        vb = vend;
    }
}

__device__ __forceinline__ void mixer_conv_phase(CArgs a, LAS unsigned char* lds, int tid, int lane) {
    const bf16* U = (const bf16*)(a->ws + WS_U);
    bf16* T1 = (bf16*)(a->ws + WS_Y);
    bf16* V = (bf16*)(a->ws + WS_G);
    LAS float* tile = (LAS float*)lds;
    const float* cw = a->in[I_ACONVW]; const float* cb = a->in[I_ACONVB];
    v4u rva[6]; f32x2 w[ACONV]; f32x2 bias = {0.f, 0.f}; int cc_w = -1;
#define MX_ROW(tb_, j_) ((tb_) < 256 ? (((j_) >= 15 && (j_) < 79) ? (tb_) * 64 + ((j_) - 15) : -1) \
        : ((((tb_) - 256) & 3) * 64 + ((j_) - 15) >= 0 && (((tb_) - 256) & 3) * 64 + ((j_) - 15) < CTXL ? ML + (((tb_) - 256) >> 2) * CTXL + (((tb_) - 256) & 3) * 64 + ((j_) - 15) : -1))
#define MX_LOAD(unit_) do { const int tb_ = (unit_) >> 3, cc_ = (unit_) & 7; \
        _Pragma("unroll") for (int q = 0; q < 6; ++q) { const int it = tid + NTHREADS * q; const int j = it >> 5, ch8 = it & 31; const int row = it < 94 * 32 ? MX_ROW(tb_, j) : -1; \
            const size_t o_ = (size_t)(row >= 0 ? row : 0) * ABU + cc_ * 256 + ch8 * 8; rva[q] = *(const v4u*)(U + o_); } } while (0)
    if ((int)blockIdx.x < 264 * 8) MX_LOAD(blockIdx.x);
    for (int unit = blockIdx.x; unit < 264 * 8; unit += gridDim.x) {
        const int tb = unit >> 3, cc = unit & 7;
#pragma unroll
        for (int q = 0; q < 6; ++q) { const int it = tid + NTHREADS * q; const int j = it >> 5, ch8 = it & 31;
            if (it < 94 * 32) { const int row = MX_ROW(tb, j); const float f = row >= 0 ? 1.f : 0.f; const v4u va = rva[q]; f32x4 g0, g1;
                g0.x = f * bflo(va.x); g0.y = f * bfhi(va.x); g0.z = f * bflo(va.y); g0.w = f * bfhi(va.y);
                g1.x = f * bflo(va.z); g1.y = f * bfhi(va.z); g1.z = f * bflo(va.w); g1.w = f * bfhi(va.w);
                *(LAS f32x4*)(tile + j * 256 + ch8 * 8) = g0; *(LAS f32x4*)(tile + j * 256 + ch8 * 8 + 4) = g1; } }
        __syncthreads();
        if (unit + (int)gridDim.x < 264 * 8) MX_LOAD(unit + (int)gridDim.x);
        {
            const int cp = tid & 127, tg = tid >> 7, c = cc * 256 + 2 * cp;
            if (cc != cc_w) { cc_w = cc;
#pragma unroll
                for (int k = 0; k < ACONV; ++k) w[k] = *(const f32x2*)(cw + k * WA + c);
                bias = *(const f32x2*)(cb + c); }
            f32x2 acc[16];
#pragma unroll
            for (int i = 0; i < 16; ++i) acc[i] = (f32x2){0.f, 0.f};
#pragma unroll
            for (int jj = 0; jj < 46; ++jj) {
                const f32x2 g = *(const LAS f32x2*)(tile + (16 * tg + jj) * 256 + 2 * cp);
#pragma unroll
                for (int i = 0; i < 16; ++i) { const int k = jj - i; if (k >= 0 && k < ACONV) acc[i] += w[k] * g; }
            }
            LAS unsigned* otile = (LAS unsigned*)(lds + 98304);
#pragma unroll
            for (int i = 0; i < 16; ++i) { const f32x2 o = acc[i] + bias; otile[(16 * tg + i) * 128 + cp] = pk2(o.x, o.y); }
            __syncthreads();
            int rbase;
            if (tb < 256) rbase = tb * 64; else { const int cbk = tb - 256; rbase = ML + (cbk >> 2) * CTXL + (cbk & 3) * 64; }
#pragma unroll
            for (int k = 0; k < 4; ++k) { const int q = tid + NTHREADS * k, r = q >> 5, c16 = q & 31;
                *(v4u*)(T1 + (size_t)(rbase + r) * WA + cc * 256 + c16 * 8) = *(const LAS v4u*)(otile + r * 128 + c16 * 4); }
        }
        __syncthreads();
    }
#undef MX_ROW
#undef MX_LOAD
    const float* bw = a->in[I_BCONVW];
    constexpr int NSEG_L = 2 * 64 * 16, NIT_L = NSEG_L * 256, NIT_C = 2 * 32 * 256;
    for (int it = blockIdx.x * NTHREADS + tid; it < NIT_L + NIT_C; it += gridDim.x * NTHREADS) {
        int row0, stride, prow, nrow, c;
        if (it < NIT_L) { const int c8 = it & 255, r = it >> 8, x = r & 63, seg = (r >> 6) & 15, b = r >> 10;
            c = c8 * 8; stride = 64; row0 = b * SEQ + (seg * 8) * 64 + x; prow = seg > 0 ? row0 - 64 : -1; nrow = seg < 15 ? row0 + 8 * 64 : -1; }
        else { const int j = it - NIT_L, c8 = j & 255, r = j >> 8, seg = r & 31, b = r >> 5;
            c = c8 * 8; stride = 1; row0 = ML + b * CTXL + seg * 8; prow = seg > 0 ? row0 - 1 : -1; nrow = seg < 31 ? row0 + 8 : -1; }
        float w[3][8];
#pragma unroll
        for (int k = 0; k < 3; ++k) { const f32x4 w0 = *(const f32x4*)(bw + k * 2048 + c), w1 = *(const f32x4*)(bw + k * 2048 + c + 4);
            w[k][0] = w0.x; w[k][1] = w0.y; w[k][2] = w0.z; w[k][3] = w0.w; w[k][4] = w1.x; w[k][5] = w1.y; w[k][6] = w1.z; w[k][7] = w1.w; }
        const bf16* uz = U + 4096 + c; const bf16* ub = U + 2048 + c;
        v4u rc[10], rb[8];
#pragma unroll
        for (int i = 0; i < 10; ++i) { const int rr = i == 0 ? (prow >= 0 ? prow : row0) : (i == 9 ? (nrow >= 0 ? nrow : row0) : row0 + (i - 1) * stride);
            rc[i] = *(const v4u*)(uz + (size_t)rr * ABU); }
#pragma unroll
        for (int i = 0; i < 8; ++i) rb[i] = *(const v4u*)(ub + (size_t)(row0 + i * stride) * ABU);
        float pp[8], pc[8];
        { float a8[8]; cvt8(rc[0], a8); const float f = prow >= 0 ? 1.f : 0.f;
#pragma unroll
          for (int e = 0; e < 8; ++e) pp[e] = a8[e] * f;
          cvt8(rc[1], pc); }
#pragma unroll
        for (int i = 0; i < 8; ++i) {
            float pn[8], bb[8]; cvt8(rc[i + 2], pn); cvt8(rb[i], bb);
            const float f = (i == 7 && nrow < 0) ? 0.f : 1.f;
#pragma unroll
            for (int e = 0; e < 8; ++e) pn[e] *= f;
            float o[8];
#pragma unroll
            for (int e = 0; e < 8; ++e) o[e] = bb[e] * (w[0][e] * pp[e] + w[1][e] * pc[e] + w[2][e] * pn[e]);
            v4u ov; ov.x = pk2(o[0], o[1]); ov.y = pk2(o[2], o[3]); ov.z = pk2(o[4], o[5]); ov.w = pk2(o[6], o[7]);
            *(v4u*)(V + (size_t)(row0 + i * stride) * D + WA + c) = ov;
#pragma unroll
            for (int e = 0; e < 8; ++e) { pp[e] = pc[e]; pc[e] = pn[e]; }
        }
    }
}
__device__ __forceinline__ void mixer_ln_phase(CArgs a, LAS unsigned char* lds, int tid, int lane, int wave) {
    const bf16* T1 = (const bf16*)(a->ws + WS_Y);
    bf16* V = (bf16*)(a->ws + WS_G);
    LAS f32x4* pg = (LAS f32x4*)lds; LAS f32x4* pb = pg + 512;
    for (int i = tid; i < 512; i += NTHREADS) { pg[i] = ((const f32x4*)a->in[I_ALNG])[i]; pb[i] = ((const f32x4*)a->in[I_ALNB])[i]; }
    __syncthreads();
    const int G = gridDim.x, rpw = (MT + G - 1) / G, r0 = (int)blockIdx.x * rpw, r1 = (r0 + rpw < MT) ? r0 + rpw : MT;
    for (int row = r0 + wave; row < r1; row += NWAVES) {
        f32x4 v[8]; float s = 0.f;
#pragma unroll
        for (int j = 0; j < 8; ++j) { const v2u tw = *(const v2u*)(T1 + (size_t)row * WA + j * 256 + lane * 4); v[j] = (f32x4){bflo(tw.x), bfhi(tw.x), bflo(tw.y), bfhi(tw.y)}; s += (v[j].x + v[j].y) + (v[j].z + v[j].w); }
        const float mu = wave_sum(s) * (1.0f / WA); float q = 0.f;
#pragma unroll
        for (int j = 0; j < 8; ++j) { v[j] = v[j] - mu; q += (v[j].x * v[j].x + v[j].y * v[j].y) + (v[j].z * v[j].z + v[j].w * v[j].w); }
        const float rstd = 1.0f / sqrtf(wave_sum(q) * (1.0f / WA) + EPS);
#pragma unroll
        for (int j = 0; j < 8; ++j) { const int o = j * 256 + lane * 4;
            const f32x4 y = (v[j] * rstd) * pg[j * 64 + lane] + pb[j * 64 + lane];
            v2u w; w.x = pk2(siluf_(y.x), siluf_(y.y)); w.y = pk2(siluf_(y.z), siluf_(y.w));
            *(v2u*)(V + (size_t)row * D + o) = w; }
    }
}

template <int NR>
__device__ __forceinline__ void ffn_gate_slide(const bf16* ug, const bf16* uv, int ldu, bf16* Go, const float* cwg, const float* cwv, int row0, int prow, int nrow) {
    float wg[3][8], wv[3][8];
#pragma unroll
    for (int k = 0; k < 3; ++k) {
        const f32x4 a0 = *(const f32x4*)(cwg + k * DFF2), a1 = *(const f32x4*)(cwg + k * DFF2 + 4), b0 = *(const f32x4*)(cwv + k * DFF2), b1 = *(const f32x4*)(cwv + k * DFF2 + 4);
        wg[k][0] = a0.x; wg[k][1] = a0.y; wg[k][2] = a0.z; wg[k][3] = a0.w; wg[k][4] = a1.x; wg[k][5] = a1.y; wg[k][6] = a1.z; wg[k][7] = a1.w;
        wv[k][0] = b0.x; wv[k][1] = b0.y; wv[k][2] = b0.z; wv[k][3] = b0.w; wv[k][4] = b1.x; wv[k][5] = b1.y; wv[k][6] = b1.z; wv[k][7] = b1.w;
    }
    float pg[8], pv[8], cg[8], cv[8];
    { const float fp = prow >= 0 ? 1.f : 0.f; const int pr = prow >= 0 ? prow : row0;
      const v4u a = *(const v4u*)(ug + (size_t)pr * ldu), b = *(const v4u*)(uv + (size_t)pr * ldu); cvt8(a, pg); cvt8(b, pv);
#pragma unroll
      for (int e = 0; e < 8; ++e) { pg[e] *= fp; pv[e] *= fp; }
      const v4u a2 = *(const v4u*)(ug + (size_t)row0 * ldu), b2 = *(const v4u*)(uv + (size_t)row0 * ldu); cvt8(a2, cg); cvt8(b2, cv); }
    const float fn = nrow >= 0 ? 1.f : 0.f; const int nr = nrow >= 0 ? nrow : row0;
    for (int blk = 0; blk < NR / 4; ++blk) {
        v4u rg[4], rv[4];
#pragma unroll
        for (int i = 0; i < 4; ++i) { const int r = 4 * blk + 1 + i; const int rr = r < NR ? row0 + r : nr;
            rg[i] = *(const v4u*)(ug + (size_t)rr * ldu); rv[i] = *(const v4u*)(uv + (size_t)rr * ldu); }
#pragma unroll
        for (int i = 0; i < 4; ++i) {
            float ng[8], nv[8]; cvt8(rg[i], ng); cvt8(rv[i], nv);
            if (i == 3) { const float f = (4 * blk + 4 < NR) ? 1.f : fn;
#pragma unroll
                for (int e = 0; e < 8; ++e) { ng[e] *= f; nv[e] *= f; } }
            float o[8];
#pragma unroll
            for (int e = 0; e < 8; ++e) { const float g = wg[0][e] * pg[e] + wg[1][e] * cg[e] + wg[2][e] * ng[e], v = wv[0][e] * pv[e] + wv[1][e] * cv[e] + wv[2][e] * nv[e]; o[e] = siluf_(g) * v; }
            v4u w; w.x = pk2(o[0], o[1]); w.y = pk2(o[2], o[3]); w.z = pk2(o[4], o[5]); w.w = pk2(o[6], o[7]);
            *(v4u*)(Go + (size_t)(4 * blk + i) * DFF) = w;
#pragma unroll
            for (int e = 0; e < 8; ++e) { pg[e] = cg[e]; pv[e] = cv[e]; cg[e] = ng[e]; cv[e] = nv[e]; }
        }
    }
}
__device__ __forceinline__ void ffn_gate_ctx_phase(CArgs a, int tid) {
    const bf16* UC = (const bf16*)(a->ws + WS_UC);
    bf16* G = (bf16*)(a->ws + WS_G);
    const float* cw = a->in[I_FCONV];
    constexpr int NC8 = DFF / 8;
    constexpr int NIT = 8 * NC8 * 4, PER = (NIT + 255) / 256;
    for (int it = blockIdx.x * PER + tid; tid < PER && it < NIT; it += gridDim.x * PER) {
        const int q4 = it & 3, rest = it >> 2, c8 = rest % NC8, blk = rest / NC8, ch = c8 * 8;
        const int p0 = (blk & 3) * 64 + q4 * 16, lrow0 = (blk >> 2) * CTXL + p0;
        const bf16* ug = UC + 256 * (ch >> 7) + (ch & 127);
        ffn_gate_slide<16>(ug, ug + 128, DFF2, G + (size_t)(ML + lrow0) * DFF + ch, cw + ch, cw + DFF + ch, lrow0, p0 > 0 ? lrow0 - 1 : -1, p0 + 16 < CTXL ? lrow0 + 16 : -1);
    }
}

__device__ __forceinline__ int chunk_row0(int dir, int b, int c) {
    if (dir == 0) return c < 2 ? ML + b * CTXL + 128 * c : b * SEQ + 128 * (c - 2);
    return c < 2 ? ML + b * CTXL + 128 * (1 - c) : b * SEQ + 128 * (63 - (c - 2));
}
__device__ __forceinline__ float wave_incl_sum(float v, int lane) {
#pragma unroll
    for (int o = 1; o < 64; o <<= 1) { const float t = __shfl_up(v, o); if (lane >= o) v += t; }
    return v;
}
__device__ __forceinline__ float wave_incl_max(float v, int lane) {
#pragma unroll
    for (int o = 1; o < 64; o <<= 1) { const float t = __shfl_up(v, o); if (lane >= o) v = fmaxf(v, t); }
    return v;
}
__device__ __forceinline__ bf16x8 tr_frag(LAS unsigned char* T, int pitch, int k0, int col0, int lane) {
    const int g = lane >> 4, q = (lane & 15) >> 2, p = lane & 3;
    LAS unsigned char* p0 = T + (k0 + 8 * g + q) * pitch + (col0 + 4 * p) * 2;
    const s16x4 lo = __builtin_amdgcn_ds_read_tr16_b64_v4i16((LAS s16x4*)p0);
    const s16x4 hi = __builtin_amdgcn_ds_read_tr16_b64_v4i16((LAS s16x4*)(p0 + 4 * pitch));
    bf16x8 r; r[0] = lo[0]; r[1] = lo[1]; r[2] = lo[2]; r[3] = lo[3]; r[4] = hi[0]; r[5] = hi[1]; r[6] = hi[2]; r[7] = hi[3];
    return r;
}
#ifndef SCAN_REP
#define SCAN_REP 1
#endif
#define MFMA16(y, x, acc) __builtin_amdgcn_mfma_f32_16x16x32_bf16((y), (x), (acc), 0, 0, 0)

constexpr int SK_PITCH = 528;

constexpr size_t WS_QT = WS_G;
constexpr size_t WS_SPP = WS_Y;
constexpr size_t WS_DEN = WS_Y + 64 * MiB;
static_assert((size_t)32 * 64 * 128 * 128 * 2 <= 64 * MiB && WS_DEN + (size_t)32 * 64 * 128 * 4 <= WS_HS, "scan scratch");
__device__ __forceinline__ void chunk_scalars(CArgs a, int dir, int b, int h, int c, LAS float* sAl, LAS float* sPl, int lane) {
    const float* GT = (const float*)(a->ws + WS_GATES);
    float* SCP = (float*)(a->ws + WS_SCP); float* SCG = (float*)(a->ws + WS_SCC);
    const int chain = dir * 16 + b * 8 + h, R0 = chunk_row0(dir, b, c);
    const float bi = a->in[I_MBG][dir * 16 + h], bf = a->in[I_MBG][dir * 16 + 8 + h];
    const int r0 = dir ? 127 - lane : lane, r1 = dir ? 63 - lane : 64 + lane;
    const float i0 = GT[(size_t)(R0 + r0) * 32 + dir * 16 + h] + bi, i1 = GT[(size_t)(R0 + r1) * 32 + dir * 16 + h] + bi;
    const float x0 = GT[(size_t)(R0 + r0) * 32 + dir * 16 + 8 + h] + bf, x1 = GT[(size_t)(R0 + r1) * 32 + dir * 16 + 8 + h] + bf;
    const float f0 = fminf(x0, 0.f) - log1pf(__expf(-fabsf(x0))), f1 = fminf(x1, 0.f) - log1pf(__expf(-fabsf(x1)));
    const float s0 = wave_incl_sum(f0, lane); const float tot0 = __shfl(s0, 63);
    const float s1 = wave_incl_sum(f1, lane) + tot0;
    const float a0 = i0 - s0, a1 = i1 - s1;
    const float p0 = wave_incl_max(a0, lane); const float pm0 = __shfl(p0, 63);
    const float p1 = fmaxf(wave_incl_max(a1, lane), pm0);
    float* o = SCP + ((size_t)chain * NCH + c) * 384;
    o[r0] = a0; o[128 + r0] = p0; o[256 + r0] = s0;
    o[r1] = a1; o[128 + r1] = p1; o[256 + r1] = s1;
    if (sAl) { sAl[r0] = a0; sAl[r1] = a1; }
    if (lane == 63) { SCG[((size_t)chain * NCH + c) * 2] = s1; SCG[((size_t)chain * NCH + c) * 2 + 1] = p1; if (sPl) sPl[0] = p1; }
}
__device__ __forceinline__ void scan_pre_phase(CArgs a, LAS unsigned char* lds, int tid, int lane, int wave) {
    const bf16* QK = (const bf16*)(a->ws + WS_U);
    bf16* SPP = (bf16*)(a->ws + WS_SPP); float* DEN = (float*)(a->ws + WS_DEN); const bf16* QT = (const bf16*)(a->ws + WS_QT);
    LAS unsigned char* Kl = lds; LAS float* sA0 = (LAS float*)(lds + 67584); LAS float* sA1 = sA0 + 128; LAS float* sPt = sA0 + 256;
    const int g = lane >> 4, l15 = lane & 15;
    for (int unit = blockIdx.x; unit < 1024 + 64; unit += gridDim.x) {
        if (unit >= 1024) { if (wave == 0) { const int u = unit - 1024, chain = u >> 1, c = u & 1; chunk_scalars(a, chain >> 4, (chain >> 3) & 1, chain & 7, c, nullptr, nullptr, lane); } continue; }
        const int bh = unit >> 6, j = unit & 63, b = bh >> 3, h = bh & 7;
        const int R0 = b * SEQ + 128 * j, c0 = 2 + j, c1 = 2 + (63 - j);
        const int tl = 16 * wave + l15;
#pragma unroll
        for (int i = 0; i < 8; ++i) { const int idx = tid + NTHREADS * i, r = idx >> 5, ch = idx & 31;
            const v4u v = *(const v4u*)(QK + (size_t)(R0 + r) * QKVO + 2048 + h * DQK + ch * 8);
            *(LAS v4u*)(Kl + r * SK_PITCH + ch * 16) = v; }
        bf16x8 qf[8];
#pragma unroll
        for (int kk = 0; kk < 8; ++kk) qf[kk] = *(const bf16x8*)(QT + ((size_t)((R0 >> 4) + wave) * 64 + 8 * h + kk) * 512 + lane * 8);
        if (wave == 0) chunk_scalars(a, 0, b, h, c0, sA0, sPt, lane);
        if (wave == 1) chunk_scalars(a, 1, b, h, c1, sA1, sPt + 1, lane);
        __syncthreads();
        {
            const float pt0 = sPt[0], pt1 = sPt[1];
            float dp0 = 0.f, dp1 = 0.f;
            int tlv = tl, gv = 4 * g; asm volatile("" : "+v"(tlv), "+v"(gv));
            bf16* sp0 = SPP + (size_t)((0 * 16 + bh) * 64 + (c0 - 2)) * 16384 + (size_t)wave * 2048 + (l15 + 16 * (g >> 1)) * 8 + 4 * (g & 1);
            bf16* sp1 = SPP + (size_t)((1 * 16 + bh) * 64 + (c1 - 2)) * 16384 + (size_t)wave * 2048 + (l15 + 16 * (g >> 1)) * 8 + 4 * (g & 1);
#pragma unroll
            for (int nh = 0; nh < 2; ++nh) {
                f32x4 sacc[4];
#pragma unroll
                for (int n = 0; n < 4; ++n) sacc[n] = (f32x4){0.f, 0.f, 0.f, 0.f};
#pragma unroll
                for (int kk = 0; kk < 8; ++kk)
#pragma unroll
                    for (int n = 0; n < 4; ++n) { const bf16x8 yf = *(const LAS bf16x8*)(Kl + (16 * (4 * nh + n) + l15) * SK_PITCH + (32 * kk + 8 * g) * 2); sacc[n] = MFMA16(yf, qf[kk], sacc[n]); }
#pragma unroll
                for (int n = 0; n < 4; ++n) { float sv0[4], sv1[4]; const int n8 = 4 * nh + n;
#pragma unroll
                    for (int r = 0; r < 4; ++r) { const int sl = 16 * n8 + 4 * g + r; const int sidx = gv + (16 * n8 + r);
                        const float qk = sacc[n][r] * 0.0625f;
                        sv0[r] = (sidx <= tlv) ? qk * __expf(sA0[sl] - pt0) : 0.f; dp0 += sv0[r];
                        sv1[r] = (sidx >= tlv) ? qk * __expf(sA1[sl] - pt1) : 0.f; dp1 += sv1[r]; }
                    v2u w0; w0.x = pk2(sv0[0], sv0[1]); w0.y = pk2(sv0[2], sv0[3]); *(v2u*)(sp0 + (n8 >> 1) * 512 + (n8 & 1) * 256) = w0;
                    v2u w1; w1.x = pk2(sv1[0], sv1[1]); w1.y = pk2(sv1[2], sv1[3]); *(v2u*)(sp1 + (n8 >> 1) * 512 + (n8 & 1) * 256) = w1; }
                asm volatile("" ::: "memory");
            }
            dp0 += __shfl_xor(dp0, 16); dp0 += __shfl_xor(dp0, 32); dp1 += __shfl_xor(dp1, 16); dp1 += __shfl_xor(dp1, 32);
            if (g == 0) { DEN[(size_t)((0 * 16 + bh) * 64 + (c0 - 2)) * 128 + tl] = dp0; DEN[(size_t)((1 * 16 + bh) * 64 + (c1 - 2)) * 128 + tl] = dp1; }
        }
        __syncthreads();
    }
}

constexpr int S2V_PITCH = 160;
constexpr int S2K_PITCH = 544;
__device__ __forceinline__ int s2_sigma(int r) { return (r & ~12) | ((r & 4) << 1) | ((r & 8) >> 1); }
__device__ __forceinline__ bf16x8 tr_frag_sw(LAS unsigned char* T, int pitch, int k0, int col0, int lane) {
    const int g = lane >> 4, q = (lane & 15) >> 2, p = lane & 3;
    LAS unsigned char* p0 = T + (k0 + 16 * (g >> 1) + 4 * (g & 1) + q) * pitch + (col0 + 4 * p) * 2;
    const s16x4 lo = __builtin_amdgcn_ds_read_tr16_b64_v4i16((LAS s16x4*)p0);
    const s16x4 hi = __builtin_amdgcn_ds_read_tr16_b64_v4i16((LAS s16x4*)(p0 + 8 * pitch));
    bf16x8 r; r[0] = lo[0]; r[1] = lo[1]; r[2] = lo[2]; r[3] = lo[3]; r[4] = hi[0]; r[5] = hi[1]; r[6] = hi[2]; r[7] = hi[3];
    return r;
}
constexpr int S2K_OFF = 0, S2V_OFF = 128 * S2K_PITCH, S2S_OFF = S2V_OFF + 128 * S2V_PITCH, S2C_OFF = S2S_OFF + 128 * S2V_PITCH, S2M_OFF = S2C_OFF + 80 * SK_PITCH;
static_assert(S2M_OFF + 4 * 272 <= MISC_OFF, "scan v2 LDS map");
#define SCHED_FENCE() do { } while (0)
#define LDS_BARRIER() do { asm volatile("s_waitcnt lgkmcnt(0)" ::: "memory"); __builtin_amdgcn_s_barrier(); asm volatile("" ::: "memory"); } while (0)
__device__ __forceinline__ void scan_seq_phase(CArgs a, LAS unsigned char* lds, int tid, int lane, int wave) {
    const bf16* QK = (const bf16*)(a->ws + WS_U);
    const float* SCP = (const float*)(a->ws + WS_SCP); const float* SCG = (const float*)(a->ws + WS_SCC);
    const bf16* SPP = (const bf16*)(a->ws + WS_SPP); const float* DEN = (const float*)(a->ws + WS_DEN); const bf16* QT = (const bf16*)(a->ws + WS_QT);
    bf16* HS = (bf16*)(a->ws + WS_HS);
    LAS unsigned char* Kl = lds + S2K_OFF; LAS unsigned char* Vl = lds + S2V_OFF; LAS unsigned char* Vs = lds + S2S_OFF; LAS unsigned char* Cl = lds + S2C_OFF;
    LAS float* mp = (LAS float*)(lds + S2M_OFF); LAS float* ml = mp + 68; LAS float* pt = mp + 136; LAS float* gl = mp + 204;
    for (int unit_ = blockIdx.x; unit_ < 256 * SCAN_REP; unit_ += gridDim.x) { const int u0 = unit_ & 255, unit = ((u0 & 7) << 5) | (u0 >> 3);
        const int chain = unit >> 3, slice = unit & 7, dir = chain >> 4, b = (chain >> 3) & 1, h = chain & 7;
        int tid_u = tid; asm volatile("" : "+v"(tid_u));
        if (tid < NCH) { gl[tid] = SCG[((size_t)chain * NCH + tid) * 2]; pt[tid] = SCG[((size_t)chain * NCH + tid) * 2 + 1]; }
        for (int i = tid_u; i < 80 * SK_PITCH / 4; i += NTHREADS) ((LAS unsigned*)Cl)[i] = 0u;
        for (int i = tid_u; i < 128 * 8; i += NTHREADS) { const int r = i >> 3, w = i & 7; ((LAS unsigned*)(Vs + r * S2V_PITCH + 128))[w] = 0u; }
        __syncthreads();
        if (tid == 0) { float m = 0.f; for (int c = 0; c < NCH; ++c) { const float mx = fmaxf(m, pt[c]); mp[c] = m; ml[c] = mx; m = gl[c] + mx; } }
        __syncthreads();
        f32x4 cacc[5][2];
#pragma unroll
        for (int mt = 0; mt < 5; ++mt)
#pragma unroll
            for (int nt = 0; nt < 2; ++nt) cacc[mt][nt] = (f32x4){0.f, 0.f, 0.f, 0.f};
        v4u kreg[8], vreg[2]; float areg[2];
#define S2_LOAD(cc, T) do { const unsigned koff = (unsigned)((((T) >> 5) * QKVO + ((T) & 31) * 8) * 2), voff = (unsigned)((((T) >> 3) * QKVO + ((T) & 7) * 8) * 2); const int R1_ = chunk_row0(dir, b, (cc)); const char* kb_ = (const char*)(QK + (size_t)R1_ * QKVO + 2048 + h * DQK); const char* vb_ = (const char*)(QK + (size_t)R1_ * QKVO + 4096 + h * DV + slice * 64); \
            const float* ab_ = SCP + ((size_t)chain * NCH + (cc)) * 384; \
            _Pragma("unroll") for (int i = 0; i < 8; ++i) kreg[i] = *(const v4u*)(kb_ + (koff + (unsigned)(i * 16 * QKVO * 2))); \
            _Pragma("unroll") for (int i = 0; i < 2; ++i) { vreg[i] = *(const v4u*)(vb_ + (voff + (unsigned)(i * 64 * QKVO * 2))); areg[i] = ab_[((T) >> 3) + 64 * i]; } } while (0)
#define S2_STORE(cc, T) do { const float mlc_ = ml[(cc)]; \
            _Pragma("unroll") for (int i = 0; i < 8; ++i) { const int idx = (T) + NTHREADS * i, r = idx >> 5, ch = idx & 31; *(LAS v4u*)(Kl + s2_sigma(r) * S2K_PITCH + ch * 16) = kreg[i]; } \
            _Pragma("unroll") for (int i = 0; i < 2; ++i) { const int idx = (T) + NTHREADS * i, r = idx >> 3, ch = idx & 7; const float ws_ = __expf(areg[i] - mlc_) * 0.0625f;     \
                *(LAS v4u*)(Vl + s2_sigma(r) * S2V_PITCH + ch * 16) = vreg[i]; \
                v4u sc_; sc_.x = pk2(bflo(vreg[i].x) * ws_, bfhi(vreg[i].x) * ws_); sc_.y = pk2(bflo(vreg[i].y) * ws_, bfhi(vreg[i].y) * ws_); sc_.z = pk2(bflo(vreg[i].z) * ws_, bfhi(vreg[i].z) * ws_); sc_.w = pk2(bflo(vreg[i].w) * ws_, bfhi(vreg[i].w) * ws_); \
                *(LAS v4u*)(Vs + s2_sigma(r) * S2V_PITCH + ch * 16) = sc_; \
                if (ch == 0) *(LAS unsigned*)(Vs + s2_sigma(r) * S2V_PITCH + 128) = f2bf(ws_); } } while (0)
        S2_LOAD(0, tid_u); S2_STORE(0, tid_u);
        __syncthreads();
#define S2_OUTP false
        for (int c = 0; c < 2; ++c) {
            const int R0 = chunk_row0(dir, b, c);
            const float m_prev = mp[c], m_last = ml[c], ptot = pt[c];
            constexpr bool outp = S2_OUTP; const bool more = (c + 1 < NCH);
            int tid_o = tid; asm volatile("" : "+v"(tid_o));
            const int lane_o = tid_o & 63, g = lane_o >> 4, l15 = lane_o & 15, tl = 16 * wave + l15;
            bf16x8 qf[8], sf[4]; float pv = 0.f, bv = 0.f, dn = 0.f;
            v2u hw[4] = {{0u, 0u}, {0u, 0u}, {0u, 0u}, {0u, 0u}}; v4u hv[2] = {{0u, 0u, 0u, 0u}, {0u, 0u, 0u, 0u}};
            if (outp) {
                const char* qb = (const char*)(QT + ((size_t)((R0 >> 4) + wave) * 64 + 8 * h) * 512); const unsigned qoff = (unsigned)(lane_o * 16);
#pragma unroll
                for (int kk = 0; kk < 8; ++kk) qf[kk] = *(const bf16x8*)(qb + (qoff + (unsigned)(kk * 1024)));
                const float* scp = SCP + ((size_t)chain * NCH + c) * 384;
                pv = scp[128 + tl]; bv = scp[256 + tl]; dn = DEN[(size_t)(chain * 64 + (c - 2)) * 128 + tl];
            }
            SCHED_FENCE();
            const float w_old = __expf(m_prev - m_last);
#pragma unroll
            for (int mt = 0; mt < 5; ++mt)
#pragma unroll
                for (int nt = 0; nt < 2; ++nt) cacc[mt][nt] = cacc[mt][nt] * w_old;
#pragma unroll
            for (int kk = 0; kk < 4; ++kk) {
                bf16x8 yf[2], xf[5];
#pragma unroll
                for (int nt = 0; nt < 2; ++nt) yf[nt] = tr_frag_sw(Kl, S2K_PITCH, 32 * kk, 32 * wave + 16 * nt, lane_o);
#pragma unroll
                for (int mt = 0; mt < 5; ++mt) xf[mt] = tr_frag_sw(Vs, S2V_PITCH, 32 * kk, 16 * mt, lane_o);
                SCHED_FENCE();
#pragma unroll
                for (int mt = 0; mt < 5; ++mt)
#pragma unroll
                    for (int nt = 0; nt < 2; ++nt) cacc[mt][nt] = MFMA16(yf[nt], xf[mt], cacc[mt][nt]);
                SCHED_FENCE();
            }
            if (outp) { const char* sb = (const char*)(SPP + (size_t)(chain * 64 + (c - 2)) * 16384 + (size_t)wave * 2048); const unsigned soff = (unsigned)(lane_o * 16);
#pragma unroll
                for (int kk = 0; kk < 4; ++kk) sf[kk] = *(const bf16x8*)(sb + (soff + (unsigned)(kk * 1024))); }
            if (more) S2_LOAD(c + 1, tid_o);
            SCHED_FENCE();
            if (outp) {
                f32x4 qacc[5];
#pragma unroll
                for (int n = 0; n < 5; ++n) qacc[n] = (f32x4){0.f, 0.f, 0.f, 0.f};
#pragma unroll
                for (int kk = 0; kk < 8; ++kk) {
                    bf16x8 cf[5];
#pragma unroll
                    for (int n = 0; n < 5; ++n) cf[n] = *(const LAS bf16x8*)(Cl + (16 * n + l15) * SK_PITCH + (32 * kk + 8 * g) * 2);
                    SCHED_FENCE();
#pragma unroll
                    for (int n = 0; n < 5; ++n) qacc[n] = MFMA16(cf[n], qf[kk], qacc[n]);
                    SCHED_FENCE();
                }
                f32x4 nacc[4];
#pragma unroll
                for (int n = 0; n < 4; ++n) nacc[n] = (f32x4){0.f, 0.f, 0.f, 0.f};
#pragma unroll
                for (int k2 = 0; k2 < 4; k2 += 2) {
                    bf16x8 vf[2][4];
#pragma unroll
                    for (int u = 0; u < 2; ++u)
#pragma unroll
                        for (int n = 0; n < 4; ++n) vf[u][n] = tr_frag_sw(Vl, S2V_PITCH, 32 * (k2 + u), 16 * n, lane_o);
                    SCHED_FENCE();
#pragma unroll
                    for (int u = 0; u < 2; ++u)
#pragma unroll
                        for (int n = 0; n < 4; ++n) nacc[n] = MFMA16(vf[u][n], sf[k2 + u], nacc[n]);
                    SCHED_FENCE();
                }
                const float mxt = fmaxf(m_prev, pv), rowfac = __expf(ptot - mxt), winter = __expf(m_prev - mxt);
                const float nq = __shfl(qacc[4][0], l15);
                const float den = rowfac * dn + winter * nq;
                const float inv = 1.0f / fmaxf(fabsf(den), __expf(-bv - mxt));
#pragma unroll
                for (int n = 0; n < 4; ++n) { const f32x4 o = (nacc[n] * rowfac + qacc[n] * winter) * inv; hw[n].x = pk2(o.x, o.y); hw[n].y = pk2(o.z, o.w); }
                bf16* hp = HS + ((size_t)dir * ML + R0 + tl) * D + h * DV + slice * 64 + 8 * g;
                const int src0 = l15 + 16 * (2 * (g & 1)), src1 = src0 + 16; const bool hi_n = (g >> 1) != 0;
#pragma unroll
                for (int k = 0; k < 2; ++k) {
                    const unsigned a0x = __shfl(hw[2 * k].x, src0), a0y = __shfl(hw[2 * k].y, src0), a1x = __shfl(hw[2 * k].x, src1), a1y = __shfl(hw[2 * k].y, src1);
                    const unsigned b0x = __shfl(hw[2 * k + 1].x, src0), b0y = __shfl(hw[2 * k + 1].y, src0), b1x = __shfl(hw[2 * k + 1].x, src1), b1y = __shfl(hw[2 * k + 1].y, src1);
                    hv[k].x = hi_n ? b0x : a0x; hv[k].y = hi_n ? b0y : a0y; hv[k].z = hi_n ? b1x : a1x; hv[k].w = hi_n ? b1y : a1y;
                    *(v4u*)(hp + 32 * k) = hv[k]; }
            }
            LDS_BARRIER();
#pragma unroll
            for (int mt = 0; mt < 5; ++mt)
#pragma unroll
                for (int nt = 0; nt < 2; ++nt) { v2u w; w.x = pk2(cacc[mt][nt][0], cacc[mt][nt][1]); w.y = pk2(cacc[mt][nt][2], cacc[mt][nt][3]);
                    *(LAS v2u*)(Cl + (16 * mt + l15) * SK_PITCH + (32 * wave + 16 * nt + 4 * g) * 2) = w; }
            if (more) S2_STORE(c + 1, tid_o);
            asm volatile("" :: "v"(hv[0]), "v"(hv[1]));
            LDS_BARRIER();
                }
#undef S2_OUTP
#define S2_OUTP true
        for (int c = 2; c < NCH; ++c) {
            const int R0 = chunk_row0(dir, b, c);
            const float m_prev = mp[c], m_last = ml[c], ptot = pt[c];
            constexpr bool outp = S2_OUTP; const bool more = (c + 1 < NCH);
            int tid_o = tid; asm volatile("" : "+v"(tid_o));
            const int lane_o = tid_o & 63, g = lane_o >> 4, l15 = lane_o & 15, tl = 16 * wave + l15;
            bf16x8 qf[8], sf[4]; float pv = 0.f, bv = 0.f, dn = 0.f;
            v2u hw[4] = {{0u, 0u}, {0u, 0u}, {0u, 0u}, {0u, 0u}}; v4u hv[2] = {{0u, 0u, 0u, 0u}, {0u, 0u, 0u, 0u}};
            if (outp) {
                const char* qb = (const char*)(QT + ((size_t)((R0 >> 4) + wave) * 64 + 8 * h) * 512); const unsigned qoff = (unsigned)(lane_o * 16);
#pragma unroll
                for (int kk = 0; kk < 8; ++kk) qf[kk] = *(const bf16x8*)(qb + (qoff + (unsigned)(kk * 1024)));
                const float* scp = SCP + ((size_t)chain * NCH + c) * 384;
                pv = scp[128 + tl]; bv = scp[256 + tl]; dn = DEN[(size_t)(chain * 64 + (c - 2)) * 128 + tl];
            }
            SCHED_FENCE();
            const float w_old = __expf(m_prev - m_last);
#pragma unroll
            for (int mt = 0; mt < 5; ++mt)
#pragma unroll
                for (int nt = 0; nt < 2; ++nt) cacc[mt][nt] = cacc[mt][nt] * w_old;
#pragma unroll
            for (int kk = 0; kk < 4; ++kk) {
                bf16x8 yf[2], xf[5];
#pragma unroll
                for (int nt = 0; nt < 2; ++nt) yf[nt] = tr_frag_sw(Kl, S2K_PITCH, 32 * kk, 32 * wave + 16 * nt, lane_o);
#pragma unroll
                for (int mt = 0; mt < 5; ++mt) xf[mt] = tr_frag_sw(Vs, S2V_PITCH, 32 * kk, 16 * mt, lane_o);
                SCHED_FENCE();
#pragma unroll
                for (int mt = 0; mt < 5; ++mt)
#pragma unroll
                    for (int nt = 0; nt < 2; ++nt) cacc[mt][nt] = MFMA16(yf[nt], xf[mt], cacc[mt][nt]);
                SCHED_FENCE();
            }
            if (outp) { const char* sb = (const char*)(SPP + (size_t)(chain * 64 + (c - 2)) * 16384 + (size_t)wave * 2048); const unsigned soff = (unsigned)(lane_o * 16);
#pragma unroll
                for (int kk = 0; kk < 4; ++kk) sf[kk] = *(const bf16x8*)(sb + (soff + (unsigned)(kk * 1024))); }
            if (more) S2_LOAD(c + 1, tid_o);
            SCHED_FENCE();
            if (outp) {
                f32x4 qacc[5];
#pragma unroll
                for (int n = 0; n < 5; ++n) qacc[n] = (f32x4){0.f, 0.f, 0.f, 0.f};
#pragma unroll
                for (int kk = 0; kk < 8; ++kk) {
                    bf16x8 cf[5];
#pragma unroll
                    for (int n = 0; n < 5; ++n) cf[n] = *(const LAS bf16x8*)(Cl + (16 * n + l15) * SK_PITCH + (32 * kk + 8 * g) * 2);
                    SCHED_FENCE();
#pragma unroll
                    for (int n = 0; n < 5; ++n) qacc[n] = MFMA16(cf[n], qf[kk], qacc[n]);
                    SCHED_FENCE();
                }
                f32x4 nacc[4];
#pragma unroll
                for (int n = 0; n < 4; ++n) nacc[n] = (f32x4){0.f, 0.f, 0.f, 0.f};
#pragma unroll
                for (int k2 = 0; k2 < 4; k2 += 2) {
                    bf16x8 vf[2][4];
#pragma unroll
                    for (int u = 0; u < 2; ++u)
#pragma unroll
                        for (int n = 0; n < 4; ++n) vf[u][n] = tr_frag_sw(Vl, S2V_PITCH, 32 * (k2 + u), 16 * n, lane_o);
                    SCHED_FENCE();
#pragma unroll
                    for (int u = 0; u < 2; ++u)
#pragma unroll
                        for (int n = 0; n < 4; ++n) nacc[n] = MFMA16(vf[u][n], sf[k2 + u], nacc[n]);
                    SCHED_FENCE();
                }
                const float mxt = fmaxf(m_prev, pv), rowfac = __expf(ptot - mxt), winter = __expf(m_prev - mxt);
                const float nq = __shfl(qacc[4][0], l15);
                const float den = rowfac * dn + winter * nq;
                const float inv = 1.0f / fmaxf(fabsf(den), __expf(-bv - mxt));
#pragma unroll
                for (int n = 0; n < 4; ++n) { const f32x4 o = (nacc[n] * rowfac + qacc[n] * winter) * inv; hw[n].x = pk2(o.x, o.y); hw[n].y = pk2(o.z, o.w); }
                bf16* hp = HS + ((size_t)dir * ML + R0 + tl) * D + h * DV + slice * 64 + 8 * g;
                const int src0 = l15 + 16 * (2 * (g & 1)), src1 = src0 + 16; const bool hi_n = (g >> 1) != 0;
#pragma unroll
                for (int k = 0; k < 2; ++k) {
                    const unsigned a0x = __shfl(hw[2 * k].x, src0), a0y = __shfl(hw[2 * k].y, src0), a1x = __shfl(hw[2 * k].x, src1), a1y = __shfl(hw[2 * k].y, src1);
                    const unsigned b0x = __shfl(hw[2 * k + 1].x, src0), b0y = __shfl(hw[2 * k + 1].y, src0), b1x = __shfl(hw[2 * k + 1].x, src1), b1y = __shfl(hw[2 * k + 1].y, src1);
                    hv[k].x = hi_n ? b0x : a0x; hv[k].y = hi_n ? b0y : a0y; hv[k].z = hi_n ? b1x : a1x; hv[k].w = hi_n ? b1y : a1y;
                    *(v4u*)(hp + 32 * k) = hv[k]; }
            }
            LDS_BARRIER();
#pragma unroll
            for (int mt = 0; mt < 5; ++mt)
#pragma unroll
                for (int nt = 0; nt < 2; ++nt) { v2u w; w.x = pk2(cacc[mt][nt][0], cacc[mt][nt][1]); w.y = pk2(cacc[mt][nt][2], cacc[mt][nt][3]);
                    *(LAS v2u*)(Cl + (16 * mt + l15) * SK_PITCH + (32 * wave + 16 * nt + 4 * g) * 2) = w; }
            if (more) S2_STORE(c + 1, tid_o);
            asm volatile("" :: "v"(hv[0]), "v"(hv[1]));
            LDS_BARRIER();
                }
#undef S2_OUTP
#undef S2_LOAD
#undef S2_STORE
    }
}

__device__ __forceinline__ void scan_out_phase(CArgs a, LAS unsigned char* lds, int tid, int lane, int wave) {
    const bf16* HS = (const bf16*)(a->ws + WS_HS);
    const bf16* QK = (const bf16*)(a->ws + WS_U);
    bf16* A2 = (bf16*)(a->ws + WS_G);
    LAS f32x4* pg = (LAS f32x4*)lds;
    for (int i = tid; i < 1024; i += NTHREADS) pg[i] = ((const f32x4*)a->in[I_MHNG])[i];
    __syncthreads();
    const int G = gridDim.x, rpw = (ML + G - 1) / G, r0 = (int)blockIdx.x * rpw, r1 = (r0 + rpw < ML) ? r0 + rpw : ML;
    for (int row = r0 + wave; row < r1; row += NWAVES) {
        const bf16* hfp = HS + (size_t)row * D + lane * 8; const bf16* hbp = hfp + (size_t)ML * D; const bf16* op = QK + (size_t)row * QKVO + 8192 + lane * 8; bf16* ap = A2 + (size_t)row * D + lane * 8;
#pragma unroll 1
        for (int hb4 = 0; hb4 < HEADS; hb4 += 4) {
            v4u hf[4], hb[4], ov[4];
#pragma unroll
            for (int i = 0; i < 4; ++i) { hf[i] = *(const v4u*)(hfp + (hb4 + i) * DV); hb[i] = *(const v4u*)(hbp + (hb4 + i) * DV); ov[i] = *(const v4u*)(op + (hb4 + i) * DV); }
#pragma unroll
            for (int i = 0; i < 4; ++i) {
                const f32x4 va = {bflo(hf[i].x) + bflo(hb[i].x), bfhi(hf[i].x) + bfhi(hb[i].x), bflo(hf[i].y) + bflo(hb[i].y), bfhi(hf[i].y) + bfhi(hb[i].y)};
                const f32x4 vb = {bflo(hf[i].z) + bflo(hb[i].z), bfhi(hf[i].z) + bfhi(hb[i].z), bflo(hf[i].w) + bflo(hb[i].w), bfhi(hf[i].w) + bfhi(hb[i].w)};
                const float s = ((va.x * va.x + va.y * va.y) + (va.z * va.z + va.w * va.w)) + ((vb.x * vb.x + vb.y * vb.y) + (vb.z * vb.z + vb.w * vb.w));
                const float rstd = 1.0f / sqrtf(wave_sum(s) * (1.0f / DV) + EPS);
                const f32x4 ga = pg[((hb4 + i) * DV) / 4 + lane * 2], gb = pg[((hb4 + i) * DV) / 4 + lane * 2 + 1];
                const f32x4 ya = (va * rstd) * ga, yb = (vb * rstd) * gb;
                v4u w; w.x = pk2(ya.x * sigmoidf_(bflo(ov[i].x)), ya.y * sigmoidf_(bfhi(ov[i].x))); w.y = pk2(ya.z * sigmoidf_(bflo(ov[i].y)), ya.w * sigmoidf_(bfhi(ov[i].y)));
                w.z = pk2(yb.x * sigmoidf_(bflo(ov[i].z)), yb.y * sigmoidf_(bfhi(ov[i].z))); w.w = pk2(yb.z * sigmoidf_(bflo(ov[i].w)), yb.w * sigmoidf_(bfhi(ov[i].w)));
                *(v4u*)(ap + (hb4 + i) * DV) = w; }
        }
    }
}

constexpr int NPHASES = 21;
__global__ void __launch_bounds__(NTHREADS, 2) fwd_kernel(Args args_unused) {
    extern __shared__ __attribute__((aligned(16))) unsigned char lds_raw[];
    LAS unsigned char* lds = (LAS unsigned char*)lds_raw;
    const int wave_s = __builtin_amdgcn_readfirstlane((int)threadIdx.x >> 6);
    { const int tid = threadIdx.x; volatile LAS unsigned* MISC = (volatile LAS unsigned*)(lds + MISC_OFF);
      if (tid < 16) MISC[tid] = 0u;
      __syncthreads();
      if (!MK_PER_PHASE) (void)xcd_barrier_post((unsigned*)(get_args()->ws + WS_CTL) + CW_BAR, MISC); }
#define PH_IDS for (int tid = opaque_tid(wave_s), lane = tid & 63, wave = __builtin_amdgcn_readfirstlane(tid >> 6), once_ = 1; once_; once_ = 0)
#if MK_PER_PHASE
#define IN(k) (get_args()->ph_lo == (k)) PH_IDS if (true
#define SEAM(k) do { } while (0)
#else
#ifndef PROBE_PHASE
#define PROBE_PHASE -1
#endif
#define IN(k) true) for (int rep_ = 0; rep_ < ((k) == PROBE_PHASE ? 2 : 1); ++rep_) PH_IDS if (true
#define SEAM(k) do { XcdBarrier b_; b_.bar = (unsigned*)(get_args()->ws + WS_CTL) + CW_BAR; b_.x = xb_xcc_id(); b_.st = (volatile LAS unsigned*)(lds + MISC_OFF); xcd_barrier(b_); } while (0)
#endif
#define WSP(off) (get_args()->ws + (off))
#define MODP(layer) ((const float*)WSP(WS_MOD) + (layer) * 3 * NMODC)
#define NGP(i) (get_args()->in[I_NORMG] + (i) * D)

#define GEMM_PHASE(EPI, A_, B_, M_, N_, K_, EINIT, HAS_SIDE, SIDE) { const int nwg_ = ((M_) / 256) * ((N_) / 256), gg_ = (HAS_SIDE) ? gemm_wgs(nwg_) : (int)gridDim.x; \
        if ((int)blockIdx.x < gg_) { pg8::Gemm g{A_, B_, M_, N_, K_}; pg8::StaticOrder S; S.init(M_, N_, gg_, blockIdx.x); EPI E EINIT; pg8::gemm_phase<EPI, pg8::StaticOrder, true, true>(lds, g, S, E, tid); } \
          \
        const int t0_ = (HAS_SIDE) ? gg_ : ((nwg_ % (int)gridDim.x) ? nwg_ % (int)gridDim.x : (int)gridDim.x); \
        if (!PROBE_E1 && (int)blockIdx.x >= t0_) { const int si_ = (int)blockIdx.x - t0_, ns_ = (int)gridDim.x - t0_, sf_ = si_ * NWAVES + wave, sn_ = ns_ * NWAVES; (void)si_; (void)ns_; (void)sf_; (void)sn_; SIDE } }

    if (IN(0)) { p0_prologue(get_args(), lds, tid, lane, wave); __syncthreads(); } SEAM(0);
    if (IN(1)) { CArgs a = get_args(); row_phase<false, true, false, false>(lds, MT, a->in[I_X], a->in[I_CTX], nullptr, nullptr, nullptr, nullptr, nullptr, 0, NGP(0), MODP(0), 0, 1, (bf16*)WSP(WS_H), tid, lane, wave); }
    SEAM(1);
    if (IN(2)) GEMM_PHASE(pg8::EpiAB, (const bf16*)WSP(WS_H), (const bf16*)WSP(WS_WABIN), MT, ABIN, D, ({(bf16*)WSP(WS_U)}), false,
                          conv_matrix<CV_ABOUT>(get_args(), lds, sf_, sn_, lane, wave);)
    SEAM(2);
    if (IN(3)) mixer_conv_phase(get_args(), lds, tid, lane);
    SEAM(3);
    if (IN(4)) mixer_ln_phase(get_args(), lds, tid, lane, wave);
    SEAM(4);
    if (IN(5)) GEMM_PHASE(pg8::EpiBf16, (const bf16*)WSP(WS_G), (const bf16*)WSP(WS_WABOUT), MT, D, D, ({(bf16*)WSP(WS_Y), D}), true,
                          conv_matrix<CV_UP0>(get_args(), lds, sf_, sn_, lane, wave);)
    SEAM(5);
    if (IN(6)) { CArgs a = get_args(); row_phase<true, true, false, true>(lds, MT, a->in[I_X], a->in[I_CTX], WSP(WS_XB), nullptr, (const bf16*)WSP(WS_Y), NGP(1), MODP(0), 2, NGP(2), MODP(0), 3, 4, (bf16*)WSP(WS_H), tid, lane, wave); }
    SEAM(6);
    if (IN(7)) GEMM_PHASE(pg8::EpiGate, (const bf16*)WSP(WS_H), (const bf16*)WSP(WS_WUP0), MT, DFF2, D, ({(bf16*)WSP(WS_G), (bf16*)WSP(WS_UC), get_args()->in[I_FCONV]}), false,
                          conv_matrix<CV_DN0>(get_args(), lds, sf_, sn_, lane, wave);)
    SEAM(7);
    if (IN(8)) ffn_gate_ctx_phase(get_args(), tid);
    SEAM(8);
    if (IN(9)) GEMM_PHASE(pg8::EpiBf16, (const bf16*)WSP(WS_G), (const bf16*)WSP(WS_WDN0), MT, D, DFF, ({(bf16*)WSP(WS_Y), D}), true,
                          gemv_units(get_args(), lds, 1, si_, ns_, tid, lane, wave);
                          conv_matrix<CV_MIN>(get_args(), lds, sf_, sn_, lane, wave); conv_matrix<CV_MOUT>(get_args(), lds, sf_, sn_, lane, wave);
                          conv_matrix<CV_UP1>(get_args(), lds, sf_, sn_, lane, wave);)
    SEAM(9);
    if (IN(10)) { CArgs a = get_args(); row_phase<true, true, true, true>(lds, MT, WSP(WS_XB), nullptr, WSP(WS_XB), nullptr, (const bf16*)WSP(WS_Y), NGP(3), MODP(0), 5, NGP(4), MODP(1), 0, 1, (bf16*)WSP(WS_H), tid, lane, wave); }
    SEAM(10);
    if (IN(11)) GEMM_PHASE(pg8::EpiMIn, (const bf16*)WSP(WS_H), (const bf16*)WSP(WS_WMIN), MT, CINP, D, ({(bf16*)WSP(WS_U), QKVO, (float*)WSP(WS_GATES), (bf16*)WSP(WS_QT)}), false,
                           conv_matrix<CV_DN1>(get_args(), lds, sf_, sn_, lane, wave);)
    SEAM(11);
    if (IN(12)) scan_pre_phase(get_args(), lds, tid, lane, wave);
    SEAM(12);
    if (IN(13)) scan_seq_phase(get_args(), lds, tid, lane, wave);
    SEAM(13);
    if (IN(14)) scan_out_phase(get_args(), lds, tid, lane, wave);
    SEAM(14);
    if (IN(15)) GEMM_PHASE(pg8::EpiBf16, (const bf16*)WSP(WS_G), (const bf16*)WSP(WS_WMOUT), ML, D, D, ({(bf16*)WSP(WS_Y), D}), false, ;)
    SEAM(15);
    if (IN(16)) { CArgs a = get_args(); row_phase<true, true, true, true>(lds, ML, WSP(WS_XB), nullptr, WSP(WS_XB), nullptr, (const bf16*)WSP(WS_Y), NGP(5), MODP(1), 2, NGP(6), MODP(1), 3, 4, (bf16*)WSP(WS_H), tid, lane, wave); }
    SEAM(16);
    if (IN(17)) GEMM_PHASE(pg8::EpiGate, (const bf16*)WSP(WS_H), (const bf16*)WSP(WS_WUP0 + 172 * MiB), ML, DFF2, D, ({(bf16*)WSP(WS_G), (bf16*)WSP(WS_UC), get_args()->in[I_FCONV] + 3 * DFF2}), false, ;)
    SEAM(17);
    if (IN(19)) GEMM_PHASE(pg8::EpiBf16, (const bf16*)WSP(WS_G), (const bf16*)WSP(WS_WDN0 + 86 * MiB), ML, D, DFF, ({(bf16*)WSP(WS_Y), D}), false, ;)
    SEAM(19);
    if (IN(20)) { CArgs a = get_args(); row_phase<true, false, true, false>(lds, ML, WSP(WS_XB), nullptr, a->out, nullptr, (const bf16*)WSP(WS_Y), NGP(7), MODP(1), 5, nullptr, nullptr, 0, 0, nullptr, tid, lane, wave); }
#undef IN
#undef SEAM
}

extern "C" void kernel_launch(void* const* d_in, const int* in_sizes, int n_in, void* d_out, int out_size, void* d_ws, size_t ws_size, hipStream_t stream) {
    static int grid = 0;
    if (grid == 0) {
        if (n_in != 21 || out_size != ML * D || ws_size < WS_END) { fprintf(stderr, "kernel_launch: unexpected problem (n_in %d, out %d, ws %zu < %zu); nothing launched\n", n_in, out_size, ws_size, (size_t)WS_END); grid = -1; return; }
        int dev = 0, cus = 0, per_cu = 0;
        if (hipGetDevice(&dev) != hipSuccess || hipDeviceGetAttribute(&cus, hipDeviceAttributeMultiprocessorCount, dev) != hipSuccess) { grid = -1; return; }
        if (hipFuncSetAttribute((const void*)fwd_kernel, hipFuncAttributeMaxDynamicSharedMemorySize, LDS_BYTES) != hipSuccess) { fprintf(stderr, "kernel_launch: hipFuncSetAttribute failed\n"); grid = -1; return; }
        if (hipOccupancyMaxActiveBlocksPerMultiprocessor(&per_cu, (const void*)fwd_kernel, NTHREADS, LDS_BYTES) != hipSuccess || per_cu < 1)
            fprintf(stderr, "kernel_launch: occupancy query reports %d workgroups per CU\n", per_cu);
        (void)hipGetLastError();
        grid = cus;
    }
    if (grid < 0) return;
    if (hipMemsetAsync((char*)d_ws + WS_CTL, 0, CTL_ZERO_BYTES, stream) != hipSuccess) return;
    Args a{};
    for (int i = 0; i < 21; ++i) a.in[i] = (const float*)d_in[i];
    a.out = (float*)d_out; a.ws = (unsigned char*)d_ws;
#if MK_PER_PHASE
    for (int p = 0; p < NPHASES; ++p) { a.ph_lo = p; a.ph_hi = p + 1; hipLaunchKernelGGL(fwd_kernel, dim3(grid), dim3(NTHREADS), LDS_BYTES, stream, a); }
#else
    a.ph_lo = 0; a.ph_hi = NPHASES;
    hipLaunchKernelGGL(fwd_kernel, dim3(grid), dim3(NTHREADS), LDS_BYTES, stream, a);
#endif
}
```
